# Optimizing an MI355X kernel written in HIP

```python
import math
import jax
import jax.numpy as jnp
from jax import lax
import numpy as np

D_MODEL = 1024
BATCH = 8
SEQ = 8192
DEPTH = 2

F32 = jnp.float32
N_EVEN = (DEPTH + 1) // 2
N_ODD = DEPTH // 2

RK_HEADS = 8
RK_HEAD = 64
RK_W = RK_HEADS * RK_HEAD
RK_DECAY_LORA = 64
RK_AAA_LORA = 64
RK_GATE_LORA = 128
RK_DECAY_SCALE = 0.606531
RK_LN_EPS = 64e-5

NS_HEADS = 8
NS_KV = 2
NS_HPG = NS_HEADS // NS_KV
NS_HEAD = 64
NS_W = NS_HEADS * NS_HEAD
CMP_LEN = 32
CMP_STRIDE = 16
CMP_HIDDEN = 128
SEL_BLOCK = 64
SEL_TOPK = 16
WINDOW = 512
Q_BLOCK = 128
ROPE_THETA = 500000.0
ROPE_DIM = NS_HEAD // 4
AB_COLS = 4 * RK_W + NS_W + 6 * NS_KV * NS_HEAD + 3 * NS_HEADS

RT_HEADS = 8
RT_QK = 128
RT_V = 256
RT_QKW = RT_HEADS * RT_QK
RT_VW = RT_HEADS * RT_V
RT_COLS = 2 * RT_QKW + 2 * RT_VW
RT_CHUNK = 128
RT_THETA = 10000.0
RT_GN_EPS = 1e-5

N_EXPERTS = 16
N_GROUPS = 4
EXP_PER_GROUP = N_EXPERTS // N_GROUPS
TOP_K = 2
D_EXPERT = 1024
MOE_BLOCK = 512

ALPHA = (2.0 * DEPTH) ** 0.25
BETA = (8.0 * DEPTH) ** -0.25
LN_EPS = 1e-5
NEG = -1e30

kernel_name = 'hybrid_rwkv7_nsa_retnet_grouped_moe_deepnorm'


def _layer_norm(x, g, b):
    xf = x.astype(F32)
    mu = xf.mean(-1, keepdims=True)
    var = jnp.square(xf - mu).mean(-1, keepdims=True)
    return ((xf - mu) * lax.rsqrt(var + LN_EPS) * g + b).astype(x.dtype)


def _head_norm(o, g, b, eps):
    h, n = o.shape[-2:]
    of = o.astype(F32)
    mu = of.mean(-1, keepdims=True)
    var = jnp.square(of - mu).mean(-1, keepdims=True)
    return (of - mu) * lax.rsqrt(var + eps) * g.reshape(h, n) + b.reshape(h, n)


def _rotate_half(x, cos, sin):
    x1, x2 = jnp.split(x, 2, axis=-1)
    return jnp.concatenate([x1 * cos - x2 * sin, x2 * cos + x1 * sin], axis=-1)


def _partial_rope(x):
    s = x.shape[1]
    half = ROPE_DIM // 2
    inv = ROPE_THETA ** (-jnp.arange(half, dtype=F32) / half)
    ang = jnp.arange(s, dtype=F32)[:, None] * inv[None, :]
    cos = jnp.cos(ang)[:, None, :]
    sin = jnp.sin(ang)[:, None, :]
    rot = _rotate_half(x[..., :ROPE_DIM].astype(F32), cos, sin).astype(x.dtype)
    return jnp.concatenate([rot, x[..., ROPE_DIM:]], axis=-1)


def _masked_softmax(s, mask, axis=-1):
    p = jax.nn.softmax(jnp.where(mask, s, NEG), axis=axis)
    return jnp.where(mask, p, 0.0)


def _token_shift(p):
    return jnp.pad(p[:, :-1], ((0, 0), (1, 0), (0, 0)))


def _rwkv7(p, mu, w0, w1, w2, a0, a1, a2, g1, g2, k_k, k_a, r_k, ln_gb):
    B, S, _ = p.shape
    dp = _token_shift(p) - p
    pr, pk, pv, pz = jnp.split(p, 4, axis=-1)
    dr, dk, dv, dz = jnp.split(dp, 4, axis=-1)
    r = pr + dr * mu[0]
    k = pk + dk * mu[1]
    v = pv + dv * mu[2]
    xw = pz + dz * mu[3]
    xa = pz + dz * mu[4]
    xg = pz + dz * mu[5]
    w = jnp.exp(-RK_DECAY_SCALE * jax.nn.sigmoid((w0 + jnp.tanh(xw @ w1) @ w2).astype(F32)))
    a = jax.nn.sigmoid((a0 + (xa @ a1) @ a2).astype(F32))
    g = jax.nn.sigmoid(xg @ g1) @ g2
    hd = lambda t: t.astype(F32).reshape(B, S, RK_HEADS, RK_HEAD)
    kk = hd(k * k_k)
    kk = kk / jnp.maximum(jnp.sqrt(jnp.sum(kk * kk, axis=-1, keepdims=True)), 1e-12)
    k = hd(k.astype(F32) * (1.0 + (a - 1.0) * k_a))
    r, v, w, a = hd(r), hd(v), hd(w), hd(a)

    def step(state, inp):
        r_t, w_t, k_t, v_t, kk_t, b_t = inp
        sa = jnp.einsum('bhvk,bhk->bhv', state, -kk_t)
        state = (state * w_t[:, :, None, :] + sa[..., None] * b_t[:, :, None, :]
                 + v_t[..., None] * k_t[:, :, None, :])
        return state, jnp.einsum('bhvk,bhk->bhv', state, r_t)

    tm = lambda t: jnp.moveaxis(t, 1, 0)
    s0 = jnp.zeros((B, RK_HEADS, RK_HEAD, RK_HEAD), F32)
    _, o = lax.scan(step, s0, (tm(r), tm(w), tm(k), tm(v), tm(kk), tm(kk * a)))
    o = jnp.moveaxis(o, 0, 1)
    o = _head_norm(o, ln_gb[0], ln_gb[1], RK_LN_EPS)
    bonus = jnp.sum(r * k * r_k.astype(F32).reshape(RK_HEADS, RK_HEAD), axis=-1, keepdims=True) * v
    o = (o + bonus).reshape(B, S, RK_W) * g
    return o.astype(p.dtype)


def _nsa(p, pe, c_w1, c_w2):
    B, S, _ = p.shape
    q = _partial_rope(p[..., :NS_W].reshape(B, S, NS_HEADS, NS_HEAD))
    kv = p[..., NS_W:NS_W + 6 * NS_KV * NS_HEAD].reshape(B, S, 6, NS_KV, NS_HEAD)
    kc = _partial_rope(kv[:, :, 0])
    vc = kv[:, :, 1]
    ks = _partial_rope(kv[:, :, 2])
    vs = kv[:, :, 3]
    kw = _partial_rope(kv[:, :, 4])
    vw = kv[:, :, 5]
    gates = jax.nn.sigmoid(p[..., -3 * NS_HEADS:].astype(F32)).reshape(B, S, 3, NS_KV, NS_HPG)

    n_cmp = (S - CMP_LEN) // CMP_STRIDE + 1
    cidx = jnp.arange(n_cmp)[:, None] * CMP_STRIDE + jnp.arange(CMP_LEN)[None, :]

    def compress(t, pe_i, w1, w2):
        blk = t[:, cidx] + pe_i[None, None, :, None, :]
        blk = jnp.moveaxis(blk, 3, 2).reshape(B, n_cmp, NS_KV, CMP_LEN * NS_HEAD)
        return jax.nn.gelu(blk @ w1) @ w2

    k_cmp = compress(kc, pe[0], c_w1[0], c_w2[0])
    v_cmp = compress(vc, pe[1], c_w1[1], c_w2[1])
    cmp_end = jnp.arange(n_cmp) * CMP_STRIDE + CMP_LEN - 1

    n_sel = S // SEL_BLOCK
    cs = jnp.arange(n_cmp) * CMP_STRIDE
    ss = jnp.arange(n_sel) * SEL_BLOCK
    ov = jnp.clip(jnp.minimum(cs[:, None] + CMP_LEN, ss[None, :] + SEL_BLOCK)
                  - jnp.maximum(cs[:, None], ss[None, :]), 0, None).astype(F32) / CMP_LEN
    top = min(SEL_TOPK, n_sel)
    ks_blk = ks.reshape(B, n_sel, SEL_BLOCK, NS_KV, NS_HEAD).transpose(0, 3, 1, 2, 4)
    vs_blk = vs.reshape(B, n_sel, SEL_BLOCK, NS_KV, NS_HEAD).transpose(0, 3, 1, 2, 4)
    kw_pad = jnp.pad(kw, ((0, 0), (WINDOW, 0), (0, 0), (0, 0)))
    vw_pad = jnp.pad(vw, ((0, 0), (WINDOW, 0), (0, 0), (0, 0)))
    scale = NS_HEAD ** -0.5
    b_ix = jnp.arange(B)[:, None, None, None]
    g_ix = jnp.arange(NS_KV)[None, None, :, None]
    blk_id = jnp.arange(n_sel)

    def block(s0):
        t = s0 + jnp.arange(Q_BLOCK)
        qb = lax.dynamic_slice_in_dim(q, s0, Q_BLOCK, 1).reshape(B, Q_BLOCK, NS_KV, NS_HPG, NS_HEAD)
        gb = lax.dynamic_slice_in_dim(gates, s0, Q_BLOCK, 1)
        s = jnp.einsum('bqghd,bngd->bqghn', qb, k_cmp).astype(F32) * scale
        pc = _masked_softmax(s, (cmp_end[None, :] <= t[:, None])[None, :, None, None, :])
        o_c = jnp.einsum('bqghn,bngd->bqghd', pc, v_cmp.astype(F32))
        imp = jnp.einsum('bqgn,nj->bqgj', pc.sum(3), ov)
        cur = t // SEL_BLOCK
        valid = (blk_id[None, :] <= cur[:, None])[None, :, None, :]
        forced = ((blk_id[None, :] == 0) | (blk_id[None, :] == cur[:, None])
                  | (blk_id[None, :] == cur[:, None] - 1))[None, :, None, :]
        pri = jnp.where(valid, jnp.where(forced, jnp.inf, imp), -jnp.inf)
        _, sel = lax.top_k(pri, top)
        sel_ok = sel <= cur[None, :, None, None]
        k_sel = ks_blk[b_ix, g_ix, sel]
        v_sel = vs_blk[b_ix, g_ix, sel]
        s = jnp.einsum('bqghd,bqgnld->bqghnl', qb, k_sel).astype(F32) * scale
        kpos = sel[..., None] * SEL_BLOCK + jnp.arange(SEL_BLOCK)
        m = (sel_ok[..., None] & (kpos <= t[None, :, None, None, None]))[:, :, :, None]
        ps = _masked_softmax(s, m, axis=(-2, -1))
        o_s = jnp.einsum('bqghnl,bqgnld->bqghd', ps, v_sel.astype(F32))
        kwb = lax.dynamic_slice_in_dim(kw_pad, s0, WINDOW + Q_BLOCK, 1)
        vwb = lax.dynamic_slice_in_dim(vw_pad, s0, WINDOW + Q_BLOCK, 1)
        wpos = s0 - WINDOW + jnp.arange(WINDOW + Q_BLOCK)
        wm = ((wpos[None, :] <= t[:, None]) & (wpos[None, :] > t[:, None] - WINDOW)
              & (wpos[None, :] >= 0))[None, :, None, None, :]
        s = jnp.einsum('bqghd,bkgd->bqghk', qb, kwb).astype(F32) * scale
        pw = _masked_softmax(s, wm)
        o_w = jnp.einsum('bqghk,bkgd->bqghd', pw, vwb.astype(F32))
        o = (gb[:, :, 0][..., None] * o_c + gb[:, :, 1][..., None] * o_s
             + gb[:, :, 2][..., None] * o_w)
        return o.reshape(B, Q_BLOCK, NS_W).astype(p.dtype)

    out = lax.map(block, jnp.arange(S // Q_BLOCK) * Q_BLOCK)
    return jnp.moveaxis(out, 0, 1).reshape(B, S, NS_W)


def _retention(p, gn_gb):
    B, S, _ = p.shape
    q, k, v, g = jnp.split(p, [RT_QKW, 2 * RT_QKW, 2 * RT_QKW + RT_VW], axis=-1)
    inv = RT_THETA ** (-jnp.linspace(0.0, 1.0, RT_QK // 2, dtype=F32))
    ang = jnp.arange(S, dtype=F32)[:, None] * inv[None, :]
    cos = jnp.cos(ang)[:, None, :]
    sin = jnp.sin(ang)[:, None, :]
    q = _rotate_half(q.astype(F32).reshape(B, S, RT_HEADS, RT_QK), cos, sin)
    k = _rotate_half(k.astype(F32).reshape(B, S, RT_HEADS, RT_QK), cos, sin) * RT_QK ** -0.5
    v = v.astype(F32).reshape(B, S, RT_HEADS, RT_V)
    log_g = jnp.log(1.0 - 2.0 ** (-5.0 - jnp.arange(RT_HEADS, dtype=F32)))
    idx = jnp.arange(RT_CHUNK, dtype=F32)
    diff = idx[:, None] - idx[None, :]
    inner_decay = jnp.where(diff >= 0, jnp.exp(jnp.maximum(diff, 0.0) * log_g[:, None, None]), 0.0)
    q_decay = jnp.exp((idx + 1.0) * log_g[:, None])[..., None]
    k_decay = jnp.exp((RT_CHUNK - 1.0 - idx) * log_g[:, None])[..., None]
    chunk_decay = jnp.exp(RT_CHUNK * log_g)[:, None, None]
    n_ch = S // RT_CHUNK
    chunks = lambda t: t.reshape(B, n_ch, RT_CHUNK, RT_HEADS, t.shape[-1]).transpose(1, 0, 3, 2, 4)

    def step(R, inp):
        qc, kc, vc = inp
        att = jnp.einsum('bhid,bhjd->bhij', qc, kc) * inner_decay
        inner = jnp.einsum('bhij,bhjv->bhiv', att, vc)
        cross = jnp.einsum('bhid,bhdv->bhiv', qc, R) * q_decay
        R = R * chunk_decay + jnp.einsum('bhjd,bhjv->bhdv', kc * k_decay, vc)
        return R, inner + cross

    R0 = jnp.zeros((B, RT_HEADS, RT_QK, RT_V), F32)
    _, o = lax.scan(step, R0, (chunks(q), chunks(k), chunks(v)))
    o = o.transpose(1, 0, 3, 2, 4).reshape(B, S, RT_HEADS, RT_V)
    o = _head_norm(o, gn_gb[0], gn_gb[1], RT_GN_EPS).reshape(B, S, RT_VW)
    return (jax.nn.silu(g.astype(F32)) * o).astype(p.dtype)


def _moe(h, router_w, router_b, w_gate, w_up, w_down):
    B, S, D = h.shape
    T = B * S
    xt = h.reshape(T, D)
    aff = jax.nn.sigmoid((xt @ router_w).astype(F32))
    grouped = (aff + router_b.astype(F32)).reshape(T, N_GROUPS, EXP_PER_GROUP)
    grp = jnp.argmax(lax.top_k(grouped, TOP_K)[0].sum(-1), axis=-1)
    in_grp = jnp.take_along_axis(grouped, grp[:, None, None], axis=1)[:, 0]
    _, loc = lax.top_k(in_grp, TOP_K)
    eidx = grp[:, None] * EXP_PER_GROUP + loc
    wts = jnp.take_along_axis(aff, eidx, axis=1)
    wts = wts / wts.sum(-1, keepdims=True)
    A = T * TOP_K
    fe = eidx.reshape(A)
    ftok = jnp.repeat(jnp.arange(T, dtype=jnp.int32), TOP_K)
    fw = wts.reshape(A)
    order = jnp.argsort(fe)
    se, stok, sw = fe[order], ftok[order], fw[order]
    counts = jnp.bincount(fe, length=N_EXPERTS)
    padded = (counts + MOE_BLOCK - 1) // MOE_BLOCK * MOE_BLOCK
    pad_end = jnp.cumsum(padded)
    pad_start = pad_end - padded
    start = jnp.cumsum(counts) - counts
    dest = pad_start[se] + jnp.arange(A) - start[se]
    n_blocks = -(-A // MOE_BLOCK) + N_EXPERTS
    rows = n_blocks * MOE_BLOCK
    row_tok = jnp.full((rows,), T, jnp.int32).at[dest].set(stok)
    row_w = jnp.zeros((rows,), F32).at[dest].set(sw)
    blk_exp = jnp.minimum(jnp.searchsorted(pad_end, jnp.arange(n_blocks) * MOE_BLOCK, side='right'),
                          N_EXPERTS - 1)
    x_pad = jnp.concatenate([xt, jnp.zeros((1, D), xt.dtype)], axis=0)

    def run(args):
        tok, wr, e = args
        xb = x_pad[tok]
        hb = jax.nn.silu(xb @ w_gate[e]) * (xb @ w_up[e])
        return (hb @ w_down[e]) * wr[:, None]

    y = lax.map(run, (row_tok.reshape(n_blocks, MOE_BLOCK), row_w.reshape(n_blocks, MOE_BLOCK), blk_exp))
    out = jax.ops.segment_sum(y.reshape(rows, D), row_tok, num_segments=T + 1)[:T]
    return out.reshape(B, S, D).astype(h.dtype)


def _gain_bias(key, lead, width):
    kg, kb = jax.random.split(key)
    g = 1.0 + 0.05 * jax.random.normal(kg, lead + (1, width), F32)
    b = 0.02 * jax.random.normal(kb, lead + (1, width), F32)
    return jnp.concatenate([g, b], axis=-2)


def setup_inputs(seed: int = 0) -> dict:
    key = jax.random.key(seed)
    ks = jax.random.split(key, 32)
    nrm = lambda k, shape, s: jax.random.normal(k, shape, F32) * s
    NE, NO = N_EVEN, N_ODD
    mix_w = RK_W + NS_W
    return {
        'x': nrm(ks[0], (BATCH, SEQ, D_MODEL), 1.0),
        'ab_w_in': nrm(ks[1], (NE, D_MODEL, AB_COLS), D_MODEL ** -0.5),
        'ab_w_out': nrm(ks[2], (NE, mix_w, D_MODEL), BETA * mix_w ** -0.5),
        'rk_mu': jax.random.uniform(ks[3], (NE, 6, RK_W), F32),
        'rk_w0': -2.0 + nrm(ks[4], (NE, RK_W), 1.5),
        'rk_w1': nrm(ks[5], (NE, RK_W, RK_DECAY_LORA), RK_W ** -0.5),
        'rk_w2': nrm(ks[6], (NE, RK_DECAY_LORA, RK_W), 0.5 * RK_DECAY_LORA ** -0.5),
        'rk_a0': nrm(ks[7], (NE, RK_W), 0.5),
        'rk_a1': nrm(ks[8], (NE, RK_W, RK_AAA_LORA), RK_W ** -0.5),
        'rk_a2': nrm(ks[9], (NE, RK_AAA_LORA, RK_W), 0.5 * RK_AAA_LORA ** -0.5),
        'rk_g1': nrm(ks[10], (NE, RK_W, RK_GATE_LORA), RK_W ** -0.5),
        'rk_g2': nrm(ks[11], (NE, RK_GATE_LORA, RK_W), RK_GATE_LORA ** -0.5),
        'rk_kk': 0.85 + nrm(ks[12], (NE, RK_W), 0.05),
        'rk_ka': 1.0 + nrm(ks[13], (NE, RK_W), 0.05),
        'rk_rk': nrm(ks[14], (NE, RK_W), 0.1),
        'rk_ln': _gain_bias(ks[15], (NE,), RK_W),
        'ns_pe': nrm(ks[16], (NE, 2, CMP_LEN, NS_HEAD), 0.1),
        'ns_c_w1': nrm(ks[17], (NE, 2, CMP_LEN * NS_HEAD, CMP_HIDDEN), (CMP_LEN * NS_HEAD) ** -0.5),
        'ns_c_w2': nrm(ks[18], (NE, 2, CMP_HIDDEN, NS_HEAD), CMP_HIDDEN ** -0.5),
        'rt_w_in': nrm(ks[19], (NO, D_MODEL, RT_COLS), D_MODEL ** -0.5),
        'rt_w_out': nrm(ks[20], (NO, RT_VW, D_MODEL), BETA * RT_VW ** -0.5),
        'rt_gn': _gain_bias(ks[21], (NO,), RT_VW),
        'router_w': nrm(ks[22], (D_MODEL, N_EXPERTS), D_MODEL ** -0.5),
        'router_b': nrm(ks[23], (N_EXPERTS,), 0.01),
        'moe_w_gate': nrm(ks[24], (DEPTH, N_EXPERTS, D_MODEL, D_EXPERT), D_MODEL ** -0.5),
        'moe_w_up': nrm(ks[25], (DEPTH, N_EXPERTS, D_MODEL, D_EXPERT), D_MODEL ** -0.5),
        'moe_w_down': nrm(ks[26], (DEPTH, N_EXPERTS, D_EXPERT, D_MODEL), BETA * D_EXPERT ** -0.5),
        'ln': _gain_bias(ks[27], (DEPTH, 2), D_MODEL),
    }


def reference(x, ab_w_in, ab_w_out, rk_mu, rk_w0, rk_w1, rk_w2, rk_a0, rk_a1, rk_a2, rk_g1, rk_g2,
              rk_kk, rk_ka, rk_rk, rk_ln, ns_pe, ns_c_w1, ns_c_w2, rt_w_in, rt_w_out, rt_gn,
              router_w, router_b, moe_w_gate, moe_w_up, moe_w_down, ln):
    for layer in range(DEPTH):
        i = layer // 2
        if layer % 2 == 0:
            p = x @ ab_w_in[i]
            o_a = _rwkv7(p[..., :4 * RK_W], rk_mu[i], rk_w0[i], rk_w1[i], rk_w2[i], rk_a0[i],
                         rk_a1[i], rk_a2[i], rk_g1[i], rk_g2[i], rk_kk[i], rk_ka[i], rk_rk[i], rk_ln[i])
            o_b = _nsa(p[..., 4 * RK_W:], ns_pe[i], ns_c_w1[i], ns_c_w2[i])
            mix = jnp.concatenate([o_a, o_b], axis=-1) @ ab_w_out[i]
        else:
            p = x @ rt_w_in[i]
            mix = _retention(p, rt_gn[i]) @ rt_w_out[i]
        x = _layer_norm(ALPHA * x + mix, ln[layer, 0, 0], ln[layer, 0, 1])
        ffn = _moe(x, router_w, router_b, moe_w_gate[layer], moe_w_up[layer], moe_w_down[layer])
        x = _layer_norm(ALPHA * x + ffn, ln[layer, 1, 0], ln[layer, 1, 1])
    return x
```

```cpp
#include <hip/hip_runtime.h>
#include <stdint.h>
#include <stdio.h>

#ifndef PROBE
#define PROBE 0
#endif
#define DI __device__ __forceinline__
#define LAS __attribute__((address_space(3)))
typedef unsigned short bf16_t;
typedef short bf16x8 __attribute__((ext_vector_type(8)));
typedef float f32x4 __attribute__((ext_vector_type(4)));
typedef unsigned u32x4 __attribute__((ext_vector_type(4)));
typedef unsigned u32x2 __attribute__((ext_vector_type(2)));
typedef int i32x4 __attribute__((ext_vector_type(4)));
typedef float f32x2 __attribute__((ext_vector_type(2)));

constexpr int T = 65536, D = 1024, SEQ = 8192, NB = 8;
constexpr int NTH = 512, GRID = 256;
constexpr float ALPHA = 1.41421356237309515f;
constexpr float LN_EPS = 1e-5f;
constexpr size_t MiB = (size_t)1 << 20;

constexpr size_t OFF_CTL = 0;
constexpr size_t CTL_BYTES = 256 * 1024;
constexpr size_t CTL_BAR = 0;
constexpr size_t CTL_Q = 16 * 1024;
constexpr size_t CTL_BLKCNT = 32 * 1024;
constexpr size_t CTL_TILES = 96 * 1024;
constexpr size_t OFF_SMALL = 1 * MiB;
constexpr size_t SM_ROPEN = OFF_SMALL + 0;
constexpr size_t SM_ROPER = OFF_SMALL + 1 * MiB;
constexpr size_t SM_CBIAS = OFF_SMALL + 5 * MiB;
constexpr size_t SM_TOKE = OFF_SMALL + 6 * MiB;
constexpr size_t SM_TOKW = OFF_SMALL + 7 * MiB;
constexpr size_t SM_TOKP = OFF_SMALL + 8 * MiB;
constexpr size_t SM_RNORM = OFF_SMALL + 9 * MiB;
constexpr size_t SM_KCMP = OFF_SMALL + 11 * MiB;
constexpr size_t SM_VCMPT = OFF_SMALL + 12 * MiB;
constexpr size_t SM_ROWTOK = OFF_SMALL + 13 * MiB;
constexpr size_t OFF_WSM = 16 * MiB;
constexpr size_t W_IN0 = OFF_WSM;
constexpr size_t W_OUT0 = OFF_WSM + 7 * MiB;
constexpr size_t W_RTIN = OFF_WSM + 9 * MiB;
constexpr size_t W_RTOUT = OFF_WSM + 21 * MiB;
constexpr size_t W_L1 = OFF_WSM + 25 * MiB;
constexpr size_t W_L2 = OFF_WSM + 25 * MiB + 512 * 1024;
constexpr size_t W_C1 = OFF_WSM + 27 * MiB;
constexpr size_t W_C2 = OFF_WSM + 29 * MiB;
constexpr size_t OFF_XB = 48 * MiB;
constexpr size_t OFF_BIG = 176 * MiB;
constexpr size_t OFF_MIX = OFF_BIG;
constexpr size_t OFF_H = OFF_BIG;
constexpr size_t OFF_WMOE = 448 * MiB;
constexpr size_t OFF_XS = 544 * MiB;
constexpr size_t OFF_PR = OFF_BIG;
constexpr size_t OFF_ORAW = OFF_BIG;
constexpr size_t OFF_PN = 433 * MiB;
constexpr size_t OFF_O0 = 625 * MiB;
constexpr size_t OFF_HC = 753 * MiB;
constexpr size_t OFF_PG = OFF_BIG;
constexpr size_t PG_BYTES = 192 * MiB;
constexpr size_t OFF_O1 = 560 * MiB;
constexpr size_t OFF_KV = 816 * MiB;
constexpr size_t KV_BYTES = 64 * MiB;
constexpr size_t OFF_MIX1 = OFF_BIG;
constexpr size_t OFF_XB8 = 816 * MiB;
constexpr size_t OFF_STR = 768 * MiB;
constexpr size_t OFF_XB8B = 944 * MiB;
constexpr size_t WS_END = 1008 * MiB;
constexpr bool MOE8_L0 = true, MOE8_L1 = true;
constexpr bool PGV8 = true;
constexpr int PGLD = PGV8 ? 4096 : 6144;
constexpr bool RTI8 = true;
constexpr bool RTO8 = true;
constexpr float F8_SO = 8.f, F8_SWO = 512.f;
constexpr float F8_SX = 16.f, F8_SW = 256.f, F8_SH = 8.f, F8_SD = 512.f;
constexpr int MOE_ROWS_MAX = 135168;

DI float bf2f(bf16_t b) { return __uint_as_float(((unsigned)b) << 16); }
DI bf16_t f2bf(float f) { unsigned u = __float_as_uint(f); u += 0x7FFFu + ((u >> 16) & 1u); return (bf16_t)(u >> 16); }
typedef __bf16 bf16v2_t __attribute__((ext_vector_type(2)));
DI unsigned pack2(float lo, float hi) { const bf16v2_t r = __builtin_convertvector((f32x2){lo, hi}, bf16v2_t); return __builtin_bit_cast(unsigned, r); }
DI int lane_id() { int l; asm volatile("v_mbcnt_lo_u32_b32 %0, -1, 0\n\tv_mbcnt_hi_u32_b32 %0, -1, %0" : "=v"(l)); return l; }
DI float shx(float v, int m) { const int l = lane_id(); return __int_as_float(__builtin_amdgcn_ds_bpermute((l ^ m) << 2, __float_as_int(v))); }
DI float f8sat(float x) { return __builtin_amdgcn_fmed3f(x, -448.f, 448.f); }
DI unsigned pk_fp8x4(float a, float b, float c, float d) {
    int p = __builtin_amdgcn_cvt_pk_fp8_f32(f8sat(a), f8sat(b), 0, false); p = __builtin_amdgcn_cvt_pk_fp8_f32(f8sat(c), f8sat(d), p, true); return (unsigned)p; }
DI void lds_bar() { asm volatile("s_waitcnt lgkmcnt(0)\n\ts_barrier" ::: "memory"); }
DI float wave_sum(float v) {
#pragma unroll
    for (int o = 32; o; o >>= 1) v += shx(v, o);
    return v;
}
DI int lds_add(LAS int* p, int v) { return __hip_atomic_fetch_add(p, v, __ATOMIC_RELAXED, __HIP_MEMORY_SCOPE_WORKGROUP); }
DI float rcpf_(float x) { return __builtin_amdgcn_rcpf(x); }
DI float sigmoidf_(float x) { return rcpf_(1.0f + __builtin_amdgcn_exp2f(-1.44269504088896341f * x)); }
DI float siluf_(float x) { return x * sigmoidf_(x); }
DI float tanhf_(float x) { return 1.0f - 2.0f * rcpf_(1.0f + __builtin_amdgcn_exp2f(2.88539008177792681f * x)); }

#define XB_TMO      128
#define XB_XCNT(j)  (256  + 64 * (j))
#define XB_XSUB(j)  (1280 + 64 * (j))
#define XB_XGEN(j)  (2304 + 64 * (j))
#define XB_TOP      3328
#define XB_TOPGEN   3392
#define XCD_BAR_WORDS 3456
#define XB_SPIN_CAP (1u << 24)

DI unsigned xb_ld(unsigned* p)              { return __hip_atomic_load(p, __ATOMIC_RELAXED, __HIP_MEMORY_SCOPE_AGENT); }
DI unsigned xb_add(unsigned* p, unsigned v) { return __hip_atomic_fetch_add(p, v, __ATOMIC_RELAXED, __HIP_MEMORY_SCOPE_AGENT); }
DI unsigned xb_xcc_id() { return (unsigned)__builtin_amdgcn_s_getreg((3 << 11) | 20) & 0xFu; }
#define XB_SPIN(cond, bar) do { unsigned _sp = 0; while (cond) { __builtin_amdgcn_s_sleep(1); \
    if ((++_sp & 255u) == 0u) { if (xb_ld(&(bar)[XB_TMO])) break; if (_sp > XB_SPIN_CAP) { atomicAdd(&(bar)[XB_TMO], 1u); break; } } } } while (0)

struct XcdBarrier { unsigned* bar; unsigned x; volatile LAS unsigned* st; };

DI XcdBarrier xcd_barrier_post(unsigned* bar, volatile LAS unsigned* st) {
    XcdBarrier b; b.bar = bar; b.x = xb_xcc_id(); b.st = st;
    if (threadIdx.x == 0) (void)xb_add(&bar[XB_XCNT(b.x)], 1u);
    return b;
}
DI void xcd_barrier_complete(unsigned* bar, unsigned x, unsigned& nloc, unsigned& nx) {
    const unsigned G = gridDim.x * gridDim.y * gridDim.z;
    unsigned sum, cnt, mine, sp = 0u;
    for (;;) {
        sum = 0u; cnt = 0u; mine = 0u;
#pragma unroll
        for (unsigned j = 0; j < 16; ++j) { const unsigned c = xb_ld(&bar[XB_XCNT(j)]); sum += c; cnt += (c > 0u) ? 1u : 0u; mine = (j == x) ? c : mine; }
        if (sum == G) break;
        __builtin_amdgcn_s_sleep(1);
        if ((++sp & 255u) == 0u) { if (xb_ld(&bar[XB_TMO])) break; if (sp > XB_SPIN_CAP) { atomicAdd(&bar[XB_TMO], 1u); break; } }
    }
    nloc = mine > 0u ? mine : 1u; nx = cnt > 0u ? cnt : 1u;
}
DI void xcd_barrier(const XcdBarrier& b) {
    asm volatile("s_waitcnt vmcnt(0)" ::: "memory");
    __syncthreads();
    if (threadIdx.x == 0) {
        unsigned* bar = b.bar;
        __builtin_amdgcn_s_waitcnt(0);
        unsigned nloc = b.st[0], nx = b.st[1];
        if (nloc == 0u) { xcd_barrier_complete(bar, b.x, nloc, nx); b.st[0] = nloc; b.st[1] = nx; }
        const unsigned old = xb_add(&bar[XB_XSUB(b.x)], 1u);
        const unsigned gen = old / nloc;
        if (old + 1u == (gen + 1u) * nloc) {
            __builtin_amdgcn_fence(__ATOMIC_RELEASE, "agent");
            asm volatile("s_waitcnt vmcnt(0)" ::: "memory");
            const unsigned og = xb_add(&bar[XB_TOP], 1u);
            const unsigned tg = og / nx;
            if (og + 1u == (tg + 1u) * nx) xb_add(&bar[XB_TOPGEN], 1u);
            else XB_SPIN(xb_ld(&bar[XB_TOPGEN]) == tg, bar);
            __builtin_amdgcn_fence(__ATOMIC_ACQUIRE, "agent");
            xb_add(&bar[XB_XGEN(b.x)], 1u);
            asm volatile("s_waitcnt vmcnt(0)" ::: "memory");
        } else {
            XB_SPIN(xb_ld(&bar[XB_XGEN(b.x)]) == gen, bar);
            __builtin_amdgcn_fence(__ATOMIC_ACQUIRE, "agent");
            asm volatile("s_waitcnt vmcnt(0)" ::: "memory");
        }
    }
    __syncthreads();
}

namespace pg8 {
constexpr int BM = 256, BK = 64, HALF = 128, HTB = HALF * BK * 2, STAGE_BYTES = 8 * HTB, NXCD = 8, WGM = 8;
DI int lds_byte(int r, int c) { const int st = (r >> 4) * 2 + (c >> 5), rr = r & 15, cc = c & 31, ob = rr * 64 + cc * 2; return st * 1024 + (ob ^ (((ob >> 9) & 1) << 5)); }
DI void stage_rc(int b, int& R, int& C) { const int st = b / 1024, sb = b % 1024, swz = sb ^ (((sb >> 9) & 1) << 5); R = (st >> 1) * 16 + swz / 64; C = (st & 1) * 32 + (swz % 64) / 2; }
DI int perm32(int rho) { const int n = rho >> 4, i = rho & 15; return 8 * (i >> 2) + 4 * n + (i & 3); }

struct Unit { const char* a; const char* b; int pm, pn, aux; const int* rows; };
struct GemmK { int lda, ldb, K, kstepA, ksplit, kjump; };

template <class Epi, class Sched, bool GATHER = false, bool F8 = false>
DI void gemm_phase(LAS unsigned char* lds, int wave_, const GemmK g, const Sched& S, const Epi& E) {
    int tid = wave_ * 64 + lane_id(); asm volatile("" : "+v"(tid));
    const int wid = __builtin_amdgcn_readfirstlane(tid >> 6), lane = tid & 63, wr = wid >> 2, wc = wid & 3, fr = lane & 15, fq = lane >> 4;
    const int nt = g.K / BK;
    unsigned voffA[2], voffB[2], cA2[2]; int rA[2]; unsigned vgc[2][2], vgn[2][2];
#pragma unroll
    for (int i = 0; i < 2; ++i) { int R, C; stage_rc(tid * 16 + i * 8192, R, C); const int Rb = Epi::PERM ? ((R & ~31) + perm32(R & 31)) : R;
        voffA[i] = (unsigned)(R * g.lda + C) * 2u; voffB[i] = (unsigned)(Rb * g.ldb + C) * 2u; rA[i] = R; cA2[i] = (unsigned)C * 2u; }
    const size_t kstepA = (size_t)g.kstepA, kstepB = (size_t)(BK * 2);
    const size_t hstepA = (size_t)HALF * g.lda * 2, hstepB = (size_t)HALF * g.ldb * 2;
    const unsigned ldsw = (unsigned)wid * 1024u;
    const int aoff = lds_byte(wr * 64 + fr, fq * 8), boff = lds_byte(wc * 32 + fr, fq * 8);
#define PG8_AK(base, kt) ((base) + (size_t)(kt) * kstepA + (((kt) >= g.ksplit) ? (long)g.kjump : 0l))
#define PG8_SA(b, h) (((b) * 2 + (h)) * HTB)
#define PG8_SB(b, h) ((4 + (b) * 2 + (h)) * HTB)
#define PG8_STAGE(bufoff, gbase, voff) do { _Pragma("unroll") for (int _i = 0; _i < 2; ++_i) \
        __builtin_amdgcn_global_load_lds((const unsigned*)((const char*)(gbase) + (voff)[_i]), (LAS unsigned*)(lds + (bufoff) + ldsw + _i * 8192), 16, 0, 0); } while (0)
#define PG8_STAGE_A(bufoff, kbase, h, nx) do { if (GATHER) { _Pragma("unroll") for (int _i = 0; _i < 2; ++_i) { const unsigned _vo = (nx) ? vgn[h][_i] : vgc[h][_i]; \
        __builtin_amdgcn_global_load_lds((const unsigned*)((const char*)(kbase) + _vo), (LAS unsigned*)(lds + (bufoff) + ldsw + _i * 8192), 16, 0, 0); } } \
        else PG8_STAGE(bufoff, (kbase) + (h) * hstepA, voffA); } while (0)
#define PG8_ROWS(dst, u) do { if (GATHER) { _Pragma("unroll") for (int _h = 0; _h < 2; ++_h) _Pragma("unroll") for (int _i = 0; _i < 2; ++_i) dst[_h][_i] = (unsigned)(u).rows[128 * _h + rA[_i]] * (unsigned)(g.lda * 2) + cA2[_i]; } } while (0)
#define PG8_LDA(dst, b, h) do { _Pragma("unroll") for (int m = 0; m < 4; ++m) _Pragma("unroll") for (int k = 0; k < 2; ++k) dst[m][k] = *(const LAS bf16x8*)(lds + PG8_SA(b, h) + aoff + m * 2048 + k * 1024); } while (0)
#define PG8_LDB(dst, b, h) do { _Pragma("unroll") for (int n = 0; n < 2; ++n) _Pragma("unroll") for (int k = 0; k < 2; ++k) dst[n][k] = *(const LAS bf16x8*)(lds + PG8_SB(b, h) + boff + n * 2048 + k * 1024); } while (0)
#define PG8_CAT(x, y) __builtin_shufflevector(__builtin_bit_cast(i32x4, x), __builtin_bit_cast(i32x4, y), 0, 1, 2, 3, 4, 5, 6, 7)
#define PG8_MMA(ai, bj, At, Bt) do { __builtin_amdgcn_s_setprio(1); \
        if (F8) { _Pragma("unroll") for (int m = 0; m < 4; ++m) _Pragma("unroll") for (int n = 0; n < 2; ++n) \
            asm volatile("v_mfma_f32_16x16x128_f8f6f4 %0, %1, %2, %0" : "+v"(acc[ai][bj][m][n]) : "v"(PG8_CAT(Bt[n][0], Bt[n][1])), "v"(PG8_CAT(At[m][0], At[m][1]))); }     \
        else { _Pragma("unroll") for (int m = 0; m < 4; ++m) _Pragma("unroll") for (int n = 0; n < 2; ++n) _Pragma("unroll") for (int k = 0; k < 2; ++k) \
            acc[ai][bj][m][n] = __builtin_amdgcn_mfma_f32_16x16x32_bf16(Bt[n][k], At[m][k], acc[ai][bj][m][n], 0, 0, 0); } \
        __builtin_amdgcn_s_setprio(0); } while (0)
#define PG8_WAIT_V(n) asm volatile("s_waitcnt vmcnt(" #n ")" ::: "memory")
#define PG8_WAIT_L(n) asm volatile("s_waitcnt lgkmcnt(" #n ")" ::: "memory")
#define PG8_BAR __builtin_amdgcn_s_barrier()
#define PG8_SCHED __builtin_amdgcn_sched_barrier(0)
    Unit cur, nxt; int ui = 0;
    if (!S.next(0, cur)) return;
    f32x4 acc[2][2][4][2];
#pragma unroll
    for (int a = 0; a < 2; ++a)
#pragma unroll
        for (int b = 0; b < 2; ++b)
#pragma unroll
            for (int m = 0; m < 4; ++m)
#pragma unroll
                for (int n = 0; n < 2; ++n) acc[a][b][m][n] = (f32x4){0.f, 0.f, 0.f, 0.f};
    bf16x8 At[4][2], B0[2][2], B1[2][2];
    const char* cA = cur.a; const char* cB = cur.b;
    PG8_ROWS(vgc, cur);
    PG8_STAGE(PG8_SB(0, 0), cB, voffB); PG8_STAGE_A(PG8_SA(0, 0), cA, 0, false); PG8_STAGE(PG8_SB(0, 1), cB + hstepB, voffB); PG8_STAGE_A(PG8_SA(0, 1), cA, 1, false);
    if (wr == 1) PG8_BAR;
    PG8_WAIT_V(4); PG8_BAR;
    PG8_STAGE(PG8_SB(1, 0), cB + kstepB, voffB); PG8_STAGE_A(PG8_SA(1, 0), PG8_AK(cA, 1), 0, false); PG8_STAGE(PG8_SB(1, 1), cB + hstepB + kstepB, voffB);
    PG8_WAIT_V(6); PG8_BAR;
    for (;;) {
        const bool has_next = S.next(ui + 1, nxt);
        const char* nA = has_next ? nxt.a : cA; const char* nB = has_next ? nxt.b : cB;
        if (GATHER) { if (has_next) PG8_ROWS(vgn, nxt); else { _Pragma("unroll") for (int _h = 0; _h < 2; ++_h) _Pragma("unroll") for (int _i = 0; _i < 2; ++_i) vgn[_h][_i] = vgc[_h][_i]; } }
#pragma unroll 1
        for (int t = 0; t < nt; t += 2) {
            const bool last = (t == nt - 2);
            const char* a1 = PG8_AK(cA, t + 1);
            const char* a2 = last ? nA : PG8_AK(cA, t + 2); const char* b2 = last ? nB : cB + (size_t)(t + 2) * kstepB;
            const char* a3 = last ? PG8_AK(nA, 1) : PG8_AK(cA, t + 3); const char* b3 = b2 + kstepB;
            PG8_LDB(B0, 0, 0); PG8_SCHED; PG8_LDA(At, 0, 0); PG8_STAGE_A(PG8_SA(1, 1), a1, 1, false);
            PG8_WAIT_L(8); PG8_BAR; PG8_WAIT_L(0); PG8_MMA(0, 0, At, B0); PG8_BAR; PG8_SCHED;
            PG8_LDB(B1, 0, 1); PG8_STAGE(PG8_SB(0, 0), b2, voffB);
            PG8_BAR; PG8_WAIT_L(0); PG8_MMA(0, 1, At, B1); PG8_BAR;
            PG8_LDA(At, 0, 1); PG8_STAGE_A(PG8_SA(0, 0), a2, 0, last);
            PG8_BAR; PG8_WAIT_L(0); PG8_MMA(1, 0, At, B0); PG8_BAR; PG8_SCHED;
            PG8_STAGE(PG8_SB(0, 1), b2 + hstepB, voffB);
            PG8_WAIT_V(6); PG8_BAR; PG8_MMA(1, 1, At, B1); PG8_BAR;
            PG8_LDB(B0, 1, 0); PG8_SCHED; PG8_LDA(At, 1, 0); PG8_STAGE_A(PG8_SA(0, 1), a2, 1, last);
            PG8_WAIT_L(8); PG8_BAR; PG8_WAIT_L(0); PG8_MMA(0, 0, At, B0); PG8_BAR; PG8_SCHED;
            PG8_LDB(B1, 1, 1); PG8_STAGE(PG8_SB(1, 0), b3, voffB);
            PG8_BAR; PG8_WAIT_L(0); PG8_MMA(0, 1, At, B1); PG8_BAR;
            PG8_LDA(At, 1, 1); PG8_STAGE_A(PG8_SA(1, 0), a3, 0, last);
            PG8_BAR; PG8_WAIT_L(0); PG8_MMA(1, 0, At, B0); PG8_BAR; PG8_SCHED;
            PG8_STAGE(PG8_SB(1, 1), b3 + hstepB, voffB);
            PG8_WAIT_V(6); PG8_BAR; PG8_MMA(1, 1, At, B1); PG8_BAR;
        }
        if (F8) {
#pragma unroll
            for (int a = 0; a < 2; ++a)
#pragma unroll
                for (int b = 0; b < 2; ++b) {
                    if (a == 0 && b == 0) asm volatile("s_nop 15\n\ts_nop 15" : "+v"(acc[a][b][0][0]), "+v"(acc[a][b][0][1]), "+v"(acc[a][b][1][0]), "+v"(acc[a][b][1][1]), "+v"(acc[a][b][2][0]), "+v"(acc[a][b][2][1]), "+v"(acc[a][b][3][0]), "+v"(acc[a][b][3][1]));
                    else asm volatile("" : "+v"(acc[a][b][0][0]), "+v"(acc[a][b][0][1]), "+v"(acc[a][b][1][0]), "+v"(acc[a][b][1][1]), "+v"(acc[a][b][2][0]), "+v"(acc[a][b][2][1]), "+v"(acc[a][b][3][0]), "+v"(acc[a][b][3][1])); } }
        E(acc, cur, wr, wc, fr, fq);
        if (!has_next) break;
#pragma unroll
        for (int a = 0; a < 2; ++a)
#pragma unroll
            for (int b = 0; b < 2; ++b)
#pragma unroll
                for (int m = 0; m < 4; ++m)
#pragma unroll
                    for (int n = 0; n < 2; ++n) acc[a][b][m][n] = (f32x4){0.f, 0.f, 0.f, 0.f};
        cur = nxt; cA = nA; cB = nB; ++ui;
        if (GATHER) { _Pragma("unroll") for (int _h = 0; _h < 2; ++_h) _Pragma("unroll") for (int _i = 0; _i < 2; ++_i) vgc[_h][_i] = vgn[_h][_i]; }
    }
    PG8_WAIT_V(0);
    if (wr == 0) PG8_BAR;
    PG8_BAR;
#undef PG8_AK
#undef PG8_SA
#undef PG8_SB
#undef PG8_STAGE
#undef PG8_STAGE_A
#undef PG8_ROWS
#undef PG8_LDA
#undef PG8_LDB
#undef PG8_MMA
#undef PG8_CAT
#undef PG8_WAIT_V
#undef PG8_WAIT_L
#undef PG8_BAR
#undef PG8_SCHED
}

struct DenseSched {
    const char* A; const char* B; size_t tstepA, tstepB; int nM, nN, nwg, G, c; int prp;
    DI void init(const void* A_, int lda, const void* B_, int ldb, int M, int N, int G_, int c_, int prp_ = 0) {
        A = (const char*)A_; B = (const char*)B_; tstepA = (size_t)BM * lda * 2; tstepB = (size_t)BM * ldb * 2; nM = M / BM; nN = N / BM; nwg = nM * nN; G = G_; c = c_; prp = prp_; }
    DI bool next(int i, Unit& u) const {
        const long L = (long)i * G + c; if (L >= nwg) return false;
        int wgid = (int)L; { const int q = nwg / NXCD, r = nwg % NXCD, xcd = wgid % NXCD, off = wgid / NXCD; wgid = (xcd < r ? xcd * (q + 1) : r * (q + 1) + (xcd - r) * q) + off; }
        const int nig = WGM * nN, gid = wgid / nig, fm = gid * WGM, gsz = (nM - fm) < WGM ? (nM - fm) : WGM;
        u.pm = fm + ((wgid % nig) % gsz); u.pn = (wgid % nig) / gsz; u.aux = 0;
        u.a = A + (size_t)u.pm * tstepA + (prp ? (size_t)((u.pm >> 5) + 1) * (tstepA / BM) : (size_t)0);
        u.b = B + (size_t)u.pn * tstepB; u.rows = nullptr;
        return true;
    }
};
struct MoeSched {
    const char* A; const char* B; size_t tstepA, tstepB; const LAS int* ts; int nN, G, c; const int* rowtab;
    DI bool next(int i, Unit& u) const {
        const long L0 = (long)i * G + c; const int nwg = ts[16] * nN; if (L0 >= nwg) return false;
        int L = (int)L0; { const int q = nwg / NXCD, r = nwg % NXCD, xcd = L % NXCD, off = L / NXCD; L = (xcd < r ? xcd * (q + 1) : r * (q + 1) + (xcd - r) * q) + off; }
        const int rt = L / nN, pn = L % nN;
        int e = 0;
#pragma unroll
        for (int j = 1; j < 16; ++j) e += (rt >= ts[j]) ? 1 : 0;
        u.pm = rt; u.pn = pn; u.aux = e;
        u.a = rowtab ? A : A + (size_t)rt * tstepA; u.b = B + (size_t)(e * nN + pn) * tstepB; u.rows = rowtab ? rowtab + rt * 256 : nullptr;
        return true;
    }
};

template <class F> struct EpiRow8 {
    static constexpr bool PERM = true;
    F f;
    DI void operator()(const f32x4 (&acc)[2][2][4][2], const Unit& u, int wr, int wc, int fr, int fq) const {
#pragma unroll
        for (int ai = 0; ai < 2; ++ai)
#pragma unroll
            for (int m = 0; m < 4; ++m) {
                const int row = u.pm * BM + ai * HALF + wr * 64 + m * 16 + fr;
#pragma unroll
                for (int bj = 0; bj < 2; ++bj) {
                    const int col = u.pn * BM + bj * HALF + wc * 32 + 8 * fq;
                    float v[8];
#pragma unroll
                    for (int j = 0; j < 4; ++j) { v[j] = acc[ai][bj][m][0][j]; v[4 + j] = acc[ai][bj][m][1][j]; }
                    f(u, row, col, v);
                }
            }
    }
};
struct EpiF32 {
    static constexpr bool PERM = false;
    float* C; int ldc;
    DI void operator()(const f32x4 (&acc)[2][2][4][2], const Unit& u, int wr, int wc, int fr, int fq) const {
        const int row0 = u.pm * BM + wr * 64 + fr, col0 = u.pn * BM + wc * 32 + 4 * fq;
#pragma unroll
        for (int ai = 0; ai < 2; ++ai)
#pragma unroll
            for (int m = 0; m < 4; ++m) { float* rowp = C + (size_t)(row0 + ai * HALF + m * 16) * ldc + col0;
#pragma unroll
                for (int bj = 0; bj < 2; ++bj)
#pragma unroll
                    for (int n = 0; n < 2; ++n) *(f32x4*)(rowp + bj * HALF + n * 16) = acc[ai][bj][m][n]; }
    }
};
struct EpiGU {
    static constexpr bool PERM = true;
    bf16_t* H;
    DI void operator()(const f32x4 (&acc)[2][2][4][2], const Unit& u, int wr, int wc, int fr, int fq) const {
#pragma unroll
        for (int ai = 0; ai < 2; ++ai)
#pragma unroll
            for (int m = 0; m < 4; ++m) {
                const int row = u.pm * BM + ai * HALF + wr * 64 + m * 16 + fr;
                const int col = u.pn * HALF + wc * 32 + 8 * fq;
                float h[8];
#pragma unroll
                for (int j = 0; j < 4; ++j) {
                    const float g0 = acc[ai][0][m][0][j], u0 = acc[ai][1][m][0][j], g1 = acc[ai][0][m][1][j], u1 = acc[ai][1][m][1][j];
                    h[j] = siluf_(g0) * u0; h[4 + j] = siluf_(g1) * u1;
                }
                u32x4 o; o[0] = pack2(h[0], h[1]); o[1] = pack2(h[2], h[3]); o[2] = pack2(h[4], h[5]); o[3] = pack2(h[6], h[7]);
                *(u32x4*)(H + (size_t)row * 1024 + col) = o;
            }
    }
};
struct EpiGU8 {
    static constexpr bool PERM = true;
    unsigned char* H;
    DI void operator()(const f32x4 (&acc)[2][2][4][2], const Unit& u, int wr, int wc, int fr, int fq) const {
        constexpr float SI = 1.0f / (F8_SX * F8_SW);
#pragma unroll
        for (int ai = 0; ai < 2; ++ai)
#pragma unroll
            for (int m = 0; m < 4; ++m) {
                const int row = u.pm * BM + ai * HALF + wr * 64 + m * 16 + fr;
                const int col = u.pn * HALF + wc * 32 + 8 * fq;
                float h[8];
#pragma unroll
                for (int j = 0; j < 4; ++j) {
                    const float g0 = acc[ai][0][m][0][j] * SI, u0 = acc[ai][1][m][0][j] * (SI * F8_SH), g1 = acc[ai][0][m][1][j] * SI, u1 = acc[ai][1][m][1][j] * (SI * F8_SH);
                    h[j] = siluf_(g0) * u0; h[4 + j] = siluf_(g1) * u1;
                }
                u32x2 o; o[0] = pk_fp8x4(h[0], h[1], h[2], h[3]); o[1] = pk_fp8x4(h[4], h[5], h[6], h[7]);
                *(u32x2*)(H + (size_t)row * 1024 + col) = o;
            }
    }
};
}

DI void unpack8(const u32x4 a, float (&o)[8]) {
#pragma unroll
    for (int i = 0; i < 4; ++i) { o[2 * i] = __uint_as_float(a[i] << 16); o[2 * i + 1] = __uint_as_float(a[i] & 0xffff0000u); }
}
DI u32x4 pack8(const float (&v)[8]) { u32x4 o; o[0] = pack2(v[0], v[1]); o[1] = pack2(v[2], v[3]); o[2] = pack2(v[4], v[5]); o[3] = pack2(v[6], v[7]); return o; }
DI void store8(bf16_t* p, const float (&v)[8]) {
    u32x4 o; o[0] = pack2(v[0], v[1]); o[1] = pack2(v[2], v[3]); o[2] = pack2(v[4], v[5]); o[3] = pack2(v[6], v[7]);
    *(u32x4*)p = o;
}

struct Args { const float* in[28]; float* out; unsigned char* ws; int ph_lo, ph_hi; };
struct Frame {
    LAS unsigned char* lds; int tid, lane, wave, wg;
    unsigned char* ws; float* out; const float* const* in;
};

constexpr int LDS_SCR = 1024;
constexpr int LDS_BYTES = 1024 + 155 * 1024;

struct TrTile { const float* src; int ldsrc, N; bf16_t* dst; int ldd, rowmode, k0, n0; float f8; };
DI void tr_load(const Frame& F, const TrTile& d, f32x4 (&v)[2]) {
#pragma unroll
    for (int i = 0; i < 2; ++i) { const int kk = (F.tid >> 4) + 32 * i, n4 = (F.tid & 15) * 4;
        v[i] = (d.n0 + n4 < d.N) ? *(const f32x4*)(d.src + (size_t)(d.k0 + kk) * d.ldsrc + d.n0 + n4) : (f32x4){0.f, 0.f, 0.f, 0.f}; }
}
template <class Desc> DI void tr_run(const Frame& F, int ntiles, Desc desc) {
    LAS float* tile = (LAS float*)F.lds;
    const int nq = ntiles >> 2;
    int id = F.wg; if (id >= nq) return;
    TrTile d[4]; f32x4 v[4][2];
#pragma unroll
    for (int s4 = 0; s4 < 4; ++s4) { d[s4] = desc(4 * id + s4); tr_load(F, d[s4], v[s4]); }
    for (;;) {
        __syncthreads();
#pragma unroll
        for (int s4 = 0; s4 < 4; ++s4)
#pragma unroll
            for (int i = 0; i < 2; ++i) { const int kk = (F.tid >> 4) + 32 * i, n4 = (F.tid & 15) * 4;
#pragma unroll
                for (int e = 0; e < 4; ++e) tile[s4 * (64 * 65) + kk * 65 + n4 + e] = v[s4][i][e]; }
        __syncthreads();
        TrTile cur[4];
#pragma unroll
        for (int s4 = 0; s4 < 4; ++s4) cur[s4] = d[s4];
        const int nid = id + GRID; const bool more = nid < nq;
        if (more) {
#pragma unroll
            for (int s4 = 0; s4 < 4; ++s4) { d[s4] = desc(4 * nid + s4); tr_load(F, d[s4], v[s4]); } }
#pragma unroll
        for (int s4 = 0; s4 < 4; ++s4) { const TrTile& c = cur[s4]; const int nn = F.tid >> 3, kc = (F.tid & 7) * 8; const int n = c.n0 + nn;
          const int r = c.rowmode == 0 ? n : (c.rowmode == 3 ? (n < 2048 ? ((n & ~127) + 2 * (n & 63) + ((n >> 6) & 1)) : n) : ((n >> 7) * 256 + (n & 127) + (c.rowmode == 2 ? 128 : 0)));
          float o[8];
#pragma unroll
          for (int e = 0; e < 8; ++e) o[e] = tile[s4 * (64 * 65) + (kc + e) * 65 + nn];
          if (c.f8 != 0.f) { u32x2 w; w[0] = pk_fp8x4(o[0] * c.f8, o[1] * c.f8, o[2] * c.f8, o[3] * c.f8); w[1] = pk_fp8x4(o[4] * c.f8, o[5] * c.f8, o[6] * c.f8, o[7] * c.f8);
              *(u32x2*)((unsigned char*)c.dst + (size_t)r * c.ldd + c.k0 + kc) = w; }
          else store8(c.dst + (size_t)r * c.ldd + c.k0 + kc, o); }
        if (!more) break;
        id = nid;
    }
    __syncthreads();
}
DI void tr_job(const Frame& F, const float* src, int ldsrc, int K, int N, int Npad, bf16_t* dst, int ldd, int rowmode, float f8 = 0.f) {
    const int tn = Npad / 64, n = (K / 64) * tn;
    tr_run(F, n, [=](int i) { return TrTile{src, ldsrc, N, dst, ldd, rowmode, (i / tn) * 64, (i % tn) * 64, f8}; });
}
DI void moe_weights(const Frame& F0, int layer, const bool f8 = false) {
    Frame F = F0; F.tid = F.wave * 64 + lane_id(); asm volatile("" : "+v"(F.tid)); F.lane = F.tid & 63;
    const size_t esz = f8 ? 1 : 2;
    unsigned char* wgu = F.ws + OFF_WMOE; unsigned char* wd = wgu + (size_t)16 * 2048 * 1024 * esz;
    const size_t lo_ = (size_t)layer * 16 * 1024 * 1024;
    const float* g = F.in[24] + lo_; const float* u = F.in[25] + lo_; const float* dn = F.in[26] + lo_;
    const float sgu = f8 ? F8_SW : 0.f, sdn = f8 ? F8_SD : 0.f;
    tr_run(F, 16 * 256, [=](int id) { const int e = id >> 8, tl = id & 255; return TrTile{g + (size_t)e * 1024 * 1024, 1024, 1024, (bf16_t*)(wgu + (size_t)e * 2048 * 1024 * esz), 1024, 1, (tl >> 4) * 64, (tl & 15) * 64, sgu}; });
    tr_run(F, 16 * 256, [=](int id) { const int e = id >> 8, tl = id & 255; return TrTile{u + (size_t)e * 1024 * 1024, 1024, 1024, (bf16_t*)(wgu + (size_t)e * 2048 * 1024 * esz), 1024, 2, (tl >> 4) * 64, (tl & 15) * 64, sgu}; });
    tr_run(F, 16 * 256, [=](int id) { const int e = id >> 8, tl = id & 255; return TrTile{dn + (size_t)e * 1024 * 1024, 1024, 1024, (bf16_t*)(wd + (size_t)e * 1024 * 1024 * esz), 1024, 0, (tl >> 4) * 64, (tl & 15) * 64, sdn}; });
}

DI void ln1_router_phase(const Frame& F0, const float* xin  , const bf16_t* mix, bf16_t* xb, const float* lng, const float* lnb, int layer, unsigned char* xb8 = nullptr  ) {
    Frame F = F0; F.tid = F.wave * 64 + lane_id(); asm volatile("" : "+v"(F.tid)); F.lane = F.tid & 63;
    LAS float* tile = (LAS float*)F.lds;
    LAS float* part = (LAS float*)(F.lds + 16 * 1028 * 4);
    LAS float* lgt = part + 8 * 256;
    LAS float* scr = lgt + 256;
    LAS int* hist = (LAS int*)(scr + 256);
    const float* rw = F.in[22]; const float* rb = F.in[23];
    const int lane = F.lane, w = F.wave, fr = lane & 15, fq = lane >> 4;
    if (F.tid < 16) hist[F.tid] = 0;
    float bfrag[32];
#pragma unroll
    for (int s = 0; s < 32; ++s) bfrag[s] = rw[(size_t)(128 * w + 4 * s + fq) * 16 + fr];
    f32x4 gv[4], bv[4];
#pragma unroll
    for (int j = 0; j < 4; ++j) { gv[j] = *(const f32x4*)(lng + j * 256 + lane * 4); bv[j] = *(const f32x4*)(lnb + j * 256 + lane * 4); }
    int* tok_e = (int*)(F.ws + SM_TOKE); float* tok_w = (float*)(F.ws + SM_TOKW);
    const int t0 = F.wg * 256;
    f32x4 xv[2][4]; u32x2 mv[2][4];
    auto issue_rows = [&](int grp) {
#pragma unroll
        for (int rr = 0; rr < 2; ++rr) { const size_t t = (size_t)t0 + grp * 16 + 2 * w + rr;
#pragma unroll
            for (int j = 0; j < 4; ++j) {
                if (xin) xv[rr][j] = *(const f32x4*)(xin + t * D + j * 256 + lane * 4);
                else { const u32x2 xr = *(const u32x2*)(xb + t * D + j * 256 + lane * 4); xv[rr][j] = (f32x4){__uint_as_float(xr[0] << 16), __uint_as_float(xr[0] & 0xffff0000u), __uint_as_float(xr[1] << 16), __uint_as_float(xr[1] & 0xffff0000u)}; }
                if (mix) mv[rr][j] = *(const u32x2*)(mix + t * D + j * 256 + lane * 4); } }
    };
    issue_rows(0);
    for (int grp = 0; grp < 16; ++grp) {
        __syncthreads();
#pragma unroll
        for (int rr = 0; rr < 2; ++rr) {
            const int i = 2 * w + rr; const size_t t = (size_t)t0 + grp * 16 + i;
            f32x4 y[4]; float s = 0.f;
#pragma unroll
            for (int j = 0; j < 4; ++j) { y[j] = xv[rr][j] * ALPHA;
                if (mix) { const u32x2 m2 = mv[rr][j]; y[j] += (f32x4){__uint_as_float(m2[0] << 16), __uint_as_float(m2[0] & 0xffff0000u), __uint_as_float(m2[1] << 16), __uint_as_float(m2[1] & 0xffff0000u)}; }
                s += y[j][0] + y[j][1] + y[j][2] + y[j][3]; }
            const float mean = wave_sum(s) * (1.0f / D); float q = 0.f;
#pragma unroll
            for (int j = 0; j < 4; ++j) { y[j] -= mean; q += y[j][0] * y[j][0] + y[j][1] * y[j][1] + y[j][2] * y[j][2] + y[j][3] * y[j][3]; }
            const float rstd = rsqrtf(wave_sum(q) * (1.0f / D) + LN_EPS);
#pragma unroll
            for (int j = 0; j < 4; ++j) { f32x4 o = y[j] * rstd * gv[j] + bv[j];
                { u32x2 ob; ob[0] = pack2(o[0], o[1]); ob[1] = pack2(o[2], o[3]); *(u32x2*)(xb + t * D + j * 256 + lane * 4) = ob; }
                if (xb8) *(unsigned*)(xb8 + t * D + j * 256 + lane * 4) = pk_fp8x4(o[0] * F8_SX, o[1] * F8_SX, o[2] * F8_SX, o[3] * F8_SX);
                *(LAS f32x4*)(tile + i * 1028 + j * 256 + lane * 4) = o; }
        }
        if (grp + 1 < 16) issue_rows(grp + 1);
        __syncthreads();
        f32x4 acc = (f32x4){0.f, 0.f, 0.f, 0.f};
#pragma unroll
        for (int s = 0; s < 32; ++s) { const float a = tile[fr * 1028 + 128 * w + 4 * s + fq]; acc = __builtin_amdgcn_mfma_f32_16x16x4f32(a, bfrag[s], acc, 0, 0, 0); }
#pragma unroll
        for (int r = 0; r < 4; ++r) part[w * 256 + (4 * fq + r) * 16 + fr] = acc[r];
        __syncthreads();
        if (F.tid < 256) { float s = 0.f;
#pragma unroll
            for (int ww = 0; ww < 8; ++ww) s += part[ww * 256 + F.tid];
            const float aff = sigmoidf_(s); lgt[F.tid] = aff; scr[F.tid] = aff + rb[F.tid & 15]; }
        __syncthreads();
        if (F.tid < 16) {
            const int i = F.tid; const LAS float* sc = scr + i * 16; const LAS float* af = lgt + i * 16;
            int bg = 0; float bs = -1e30f;
#pragma unroll
            for (int gr = 0; gr < 4; ++gr) { const float a = sc[4 * gr], b = sc[4 * gr + 1], c = sc[4 * gr + 2], d = sc[4 * gr + 3];
                const float x = fmaxf(a, b), yv = fminf(a, b), z = fmaxf(c, d), u = fminf(c, d);
                const float top2 = fmaxf(x, z) + fmaxf(fminf(x, z), fmaxf(yv, u));
                if (top2 > bs) { bs = top2; bg = gr; } }
            const float v0 = sc[4 * bg], v1 = sc[4 * bg + 1], v2 = sc[4 * bg + 2], v3 = sc[4 * bg + 3];
            int l0 = 0; float m0 = v0; if (v1 > m0) { m0 = v1; l0 = 1; } if (v2 > m0) { m0 = v2; l0 = 2; } if (v3 > m0) { m0 = v3; l0 = 3; }
            int l1 = -1; float m1 = -1e30f;
            if (l0 != 0 && v0 > m1) { m1 = v0; l1 = 0; } if (l0 != 1 && v1 > m1) { m1 = v1; l1 = 1; } if (l0 != 2 && v2 > m1) { m1 = v2; l1 = 2; } if (l0 != 3 && v3 > m1) { m1 = v3; l1 = 3; }
            const int e0 = 4 * bg + l0, e1 = 4 * bg + l1; const float a0 = af[e0], a1 = af[e1], inv = rcpf_(a0 + a1);
            const size_t t = (size_t)t0 + grp * 16 + i;
            tok_e[2 * t] = e0; tok_e[2 * t + 1] = e1; tok_w[2 * t] = a0 * inv; tok_w[2 * t + 1] = a1 * inv;
            lds_add(&hist[e0], 1); lds_add(&hist[e1], 1);
        }
    }
    __syncthreads();
    if (F.tid < 16) ((int*)(F.ws + CTL_BLKCNT))[(layer * 256 + F.wg) * 16 + F.tid] = hist[F.tid];
    __syncthreads();
}

DI void moe_scatter_phase(const Frame& F0, const float* xa, int layer) {
    Frame F = F0; F.tid = F.wave * 64 + lane_id(); asm volatile("" : "+v"(F.tid)); F.lane = F.tid & 63;
    LAS int* tot = (LAS int*)F.lds; LAS int* before = tot + 16; LAS int* base = tot + 32; LAS int* lcnt = tot + 48;
    const int* blk = (const int*)(F.ws + CTL_BLKCNT) + layer * 256 * 16;
    __syncthreads();
    if (F.tid < 16) { int tt = 0, bb = 0; for (int g = 0; g < 256; ++g) { const int c = blk[g * 16 + F.tid]; tt += c; bb += (g < F.wg) ? c : 0; } tot[F.tid] = tt; before[F.tid] = bb; lcnt[F.tid] = 0; }
    __syncthreads();
    if (F.tid == 0) { int ts = 0; int* gts = (int*)(F.ws + CTL_TILES) + layer * 32;
        for (int e = 0; e < 16; ++e) { base[e] = ts * 256 + before[e]; if (F.wg == 0) gts[e] = ts; ts += (tot[e] + 255) >> 8; }
        if (F.wg == 0) gts[16] = ts; }
    __syncthreads();
    const int* tok_e = (const int*)(F.ws + SM_TOKE); int* tok_p = (int*)(F.ws + SM_TOKP); int* rowtok = (int*)(F.ws + SM_ROWTOK);
    const int t0 = F.wg * 256;
    { const int i = F.tid; const int e = tok_e[2 * t0 + i]; const int pos = base[e] + lds_add(&lcnt[e], 1); tok_p[2 * t0 + i] = pos; rowtok[pos] = t0 + (i >> 1); }
    if (F.wg == 0) {
        for (int e = 0; e < 16; ++e) { const int rs = base[e] - before[e], lo = rs + tot[e], hi = rs + (((tot[e] + 255) >> 8) << 8);
            for (int i = lo + F.tid; i < hi; i += NTH) rowtok[i] = 0; }
    }
    __syncthreads();
}

DI void ln2_phase(const Frame& F0, float* xout  , const float* lng, const float* lnb, bf16_t* xb, bool use_ffn, unsigned char* xb8 = nullptr  ) {
    Frame F = F0; F.tid = F.wave * 64 + lane_id(); asm volatile("" : "+v"(F.tid)); F.lane = F.tid & 63;
    const int lane = F.lane; const bf16_t* Y = (const bf16_t*)(F.ws + OFF_XS);
    const int* tok_p = (const int*)(F.ws + SM_TOKP); const float* tok_w = (const float*)(F.ws + SM_TOKW);
    f32x4 gv[4], bv[4];
#pragma unroll
    for (int j = 0; j < 4; ++j) { gv[j] = *(const f32x4*)(lng + j * 256 + lane * 4); bv[j] = *(const f32x4*)(lnb + j * 256 + lane * 4); }
    for (int r = F.wave; r < 256; r += 16) {
        size_t t[2]; int p0[2], p1[2]; float w0[2], w1[2]; f32x4 xv[2][4]; u32x2 ya[2][4], yb[2][4];
#pragma unroll
        for (int k = 0; k < 2; ++k) { t[k] = (size_t)F.wg * 256 + r + 8 * k; p0[k] = tok_p[2 * t[k]]; p1[k] = tok_p[2 * t[k] + 1]; w0[k] = tok_w[2 * t[k]]; w1[k] = tok_w[2 * t[k] + 1]; }
#pragma unroll
        for (int k = 0; k < 2; ++k)
#pragma unroll
            for (int j = 0; j < 4; ++j) { const u32x2 xr = *(const u32x2*)(xb + t[k] * D + j * 256 + lane * 4); xv[k][j] = (f32x4){__uint_as_float(xr[0] << 16), __uint_as_float(xr[0] & 0xffff0000u), __uint_as_float(xr[1] << 16), __uint_as_float(xr[1] & 0xffff0000u)}; }
        if (use_ffn) {
#pragma unroll
            for (int k = 0; k < 2; ++k)
#pragma unroll
                for (int j = 0; j < 4; ++j) { ya[k][j] = *(const u32x2*)(Y + (size_t)p0[k] * D + j * 256 + lane * 4); yb[k][j] = *(const u32x2*)(Y + (size_t)p1[k] * D + j * 256 + lane * 4); }
        }
#pragma unroll
        for (int k = 0; k < 2; ++k) {
            f32x4 y[4]; float s = 0.f;
#pragma unroll
            for (int j = 0; j < 4; ++j) { y[j] = xv[k][j] * ALPHA;
                if (use_ffn) { const u32x2 a = ya[k][j], b = yb[k][j];
                    y[j][0] += w0[k] * __uint_as_float(a[0] << 16) + w1[k] * __uint_as_float(b[0] << 16);
                    y[j][1] += w0[k] * __uint_as_float(a[0] & 0xffff0000u) + w1[k] * __uint_as_float(b[0] & 0xffff0000u);
                    y[j][2] += w0[k] * __uint_as_float(a[1] << 16) + w1[k] * __uint_as_float(b[1] << 16);
                    y[j][3] += w0[k] * __uint_as_float(a[1] & 0xffff0000u) + w1[k] * __uint_as_float(b[1] & 0xffff0000u); }
                s += y[j][0] + y[j][1] + y[j][2] + y[j][3]; }
            const float mean = wave_sum(s) * (1.0f / D); float q = 0.f;
#pragma unroll
            for (int j = 0; j < 4; ++j) { y[j] -= mean; q += y[j][0] * y[j][0] + y[j][1] * y[j][1] + y[j][2] * y[j][2] + y[j][3] * y[j][3]; }
            const float rstd = rsqrtf(wave_sum(q) * (1.0f / D) + LN_EPS);
#pragma unroll
            for (int j = 0; j < 4; ++j) { f32x4 o = y[j] * rstd * gv[j] + bv[j];
                if (xout) *(f32x4*)(xout + t[k] * D + j * 256 + lane * 4) = o;
                else { u32x2 ob; ob[0] = pack2(o[0], o[1]); ob[1] = pack2(o[2], o[3]); *(u32x2*)(xb + t[k] * D + j * 256 + lane * 4) = ob;
                    if (xb8) *(unsigned*)(xb8 + t[k] * D + j * 256 + lane * 4) = pk_fp8x4(o[0] * F8_SX, o[1] * F8_SX, o[2] * F8_SX, o[3] * F8_SX); } }
        }
    }
}

typedef short s16x4 __attribute__((ext_vector_type(4)));
#define MFMA16(a, b, c) __builtin_amdgcn_mfma_f32_16x16x32_bf16((a), (b), (c), 0, 0, 0)
DI bf16x8 ld_row(const LAS bf16_t* p) { return *(const LAS bf16x8*)p; }
DI bf16x8 ld_tr2(const LAS bf16_t* pa, const LAS bf16_t* pb) {
    const s16x4 lo = __builtin_amdgcn_ds_read_tr16_b64_v4i16((LAS s16x4*)pa), hi = __builtin_amdgcn_ds_read_tr16_b64_v4i16((LAS s16x4*)pb);
    return __builtin_shufflevector(lo, hi, 0, 1, 2, 3, 4, 5, 6, 7);
}

constexpr int R_LDK = 136, R_LDV = 264;
template <int NCOLS> DI void ret_copy(const Frame& F, const bf16_t* src, size_t gld, LAS bf16_t* dst, int lld) {
    constexpr int cpr = NCOLS >> 3, n = 128 * cpr;
    u32x4 v[n / NTH];
#pragma unroll
    for (int i = 0; i < n / NTH; ++i) { const int id = F.tid + i * NTH, r = id / cpr, ch = id % cpr; v[i] = *(const u32x4*)(src + (size_t)r * gld + ch * 8); }
#pragma unroll
    for (int i = 0; i < n / NTH; ++i) { const int id = F.tid + i * NTH, r = id / cpr, ch = id % cpr; *(LAS u32x4*)(dst + r * lld + ch * 8) = v[i]; }
}
template <int NCOLS> DI void blk_fetch(const Frame& F, const bf16_t* src, int gld, u32x4 (&v)[128 * (NCOLS >> 3) / NTH]) {
    constexpr int cpr = NCOLS >> 3;
    int t_ = F.tid; asm volatile("" : "+v"(t_));
#pragma unroll
    for (int i = 0; i < 128 * cpr / NTH; ++i) { const int id = t_ + i * NTH, r = id / cpr, ch = id % cpr; v[i] = *(const u32x4*)((const char*)src + (unsigned)(r * gld + ch * 8) * 2u); }
}
template <int NCOLS> DI void blk_put(const Frame& F, const u32x4 (&v)[128 * (NCOLS >> 3) / NTH], LAS bf16_t* dst, int lld) {
    constexpr int cpr = NCOLS >> 3;
    int t_ = F.tid; asm volatile("" : "+v"(t_));
#pragma unroll
    for (int i = 0; i < 128 * cpr / NTH; ++i) { const int id = t_ + i * NTH, r = id / cpr, ch = id % cpr; *(LAS u32x4*)(dst + r * lld + ch * 8) = v[i]; }
}
template <int NCOLS> DI void blk_fetch8(const Frame& F, const unsigned char* src, int gld, u32x4 (&v)[128 * (NCOLS >> 4) / NTH]) {
    constexpr int cpr = NCOLS >> 4;
    int t_ = F.tid; asm volatile("" : "+v"(t_));
#pragma unroll
    for (int i = 0; i < 128 * cpr / NTH; ++i) { const int id = t_ + i * NTH, r = id / cpr, ch = id % cpr; v[i] = *(const u32x4*)(src + (unsigned)(r * gld + ch * 16)); }
}
DI u32x2 fp8x4_bf16(unsigned d) { const auto a = __builtin_amdgcn_cvt_pk_f32_fp8((int)d, false), b = __builtin_amdgcn_cvt_pk_f32_fp8((int)d, true); u32x2 o; o[0] = pack2(a[0], a[1]); o[1] = pack2(b[0], b[1]); return o; }
template <int NCOLS> DI void blk_put8(const Frame& F, const u32x4 (&v)[128 * (NCOLS >> 4) / NTH], LAS bf16_t* dst, int lld) {
    constexpr int cpr = NCOLS >> 4;
    int t_ = F.tid; asm volatile("" : "+v"(t_));
#pragma unroll
    for (int i = 0; i < 128 * cpr / NTH; ++i) { const int id = t_ + i * NTH, r = id / cpr, ch = id % cpr; u32x4 lo, hi;
        const u32x2 c0 = fp8x4_bf16(v[i][0]), c1 = fp8x4_bf16(v[i][1]), c2 = fp8x4_bf16(v[i][2]), c3 = fp8x4_bf16(v[i][3]);
        lo = (u32x4){c0[0], c0[1], c1[0], c1[1]}; hi = (u32x4){c2[0], c2[1], c3[0], c3[1]};
        *(LAS u32x4*)(dst + r * lld + ch * 16) = lo; *(LAS u32x4*)(dst + r * lld + ch * 16 + 8) = hi; }
}
DI void ret_r1_unit(const Frame& F0, const bf16_t* Pg, bf16_t* KV, int unit) {
    Frame F = F0; F.tid = F.wave * 64 + lane_id(); asm volatile("" : "+v"(F.tid)); F.lane = F.tid & 63;
    const int c = unit & 63, h = (unit >> 6) & 7, bl = unit >> 9;
    LAS bf16_t* Kd = (LAS bf16_t*)F.lds; LAS bf16_t* Vs = Kd + 128 * R_LDK;
    const size_t row0 = (size_t)bl * 8192 + c * 128;
    const float l2g = log2f(1.0f - exp2f(-5.0f - (float)h));
    __syncthreads();
    { u32x4 kv_[4]; blk_fetch<128>(F, Pg + row0 * PGLD + 1024 + h * 128, PGLD, kv_);
#pragma unroll
      for (int i = 0; i < 4; ++i) { const int r_ = (F.tid + i * NTH) >> 4; const float sc = 0.08838834764831845f * __builtin_amdgcn_exp2f((float)(127 - r_) * l2g); float t8[8]; unpack8(kv_[i], t8);
#pragma unroll
          for (int e = 0; e < 8; ++e) t8[e] *= sc;
          kv_[i] = pack8(t8); }
      blk_put<128>(F, kv_, Kd, R_LDK); }
    if (PGV8) { u32x4 vv_[4]; blk_fetch8<256>(F, (const unsigned char*)Pg + row0 * 8192 + 4096 + h * 256, 8192, vv_); blk_put8<256>(F, vv_, Vs, R_LDV); }
    else ret_copy<256>(F, Pg + row0 * 6144 + 2048 + h * 256, 6144, Vs, R_LDV);
    __syncthreads();
    int w = F.wave; asm volatile("" : "+s"(w));
    const int lane = F.lane, fq = lane >> 4, q = (lane & 15) >> 2, pp = lane & 3;
    f32x4 acc[16];
#pragma unroll
    for (int i = 0; i < 16; ++i) acc[i] = (f32x4){0.f, 0.f, 0.f, 0.f};
#pragma unroll
    for (int ks = 0; ks < 4; ++ks) {
        const int ra = 32 * ks + 8 * fq + q, rb = ra + 4;
        const bf16x8 X = ld_tr2(Kd + ra * R_LDK + 16 * w + 4 * pp, Kd + rb * R_LDK + 16 * w + 4 * pp);
#pragma unroll
        for (int vt = 0; vt < 16; ++vt) { const bf16x8 Y = ld_tr2(Vs + ra * R_LDV + 16 * vt + 4 * pp, Vs + rb * R_LDV + 16 * vt + 4 * pp); acc[vt] = MFMA16(Y, X, acc[vt]); }
    }
    bf16_t* o = KV + (size_t)unit * 32768 + (16 * w + (lane & 15)) * 256 + 4 * fq;
#pragma unroll
    for (int vt = 0; vt < 16; ++vt) { u32x2 ov; ov[0] = pack2(acc[vt][0], acc[vt][1]); ov[1] = pack2(acc[vt][2], acc[vt][3]); *(u32x2*)(o + 16 * vt) = ov; }
}
DI void ret_r2_phase(const Frame& F0, bf16_t* KV) {
    Frame F = F0; F.tid = F.wave * 64 + lane_id(); asm volatile("" : "+v"(F.tid)); F.lane = F.tid & 63;
    const int gt = F.wg * NTH + F.tid;
    if (gt >= 65536) return;
    const int pair = gt >> 12, e8 = gt & 4095, h = pair & 7;
    const float cd = exp2f(128.0f * log2f(1.0f - exp2f(-5.0f - (float)h)));
    float st[8];
#pragma unroll
    for (int i = 0; i < 8; ++i) st[i] = 0.f;
#pragma unroll 8
    for (int c = 0; c < 64; ++c) {
        bf16_t* p = KV + ((size_t)(pair * 64 + c)) * 32768 + (size_t)e8 * 8;
        float kv[8]; unpack8(*(const u32x4*)p, kv);
        *(u32x4*)p = pack8(st);
#pragma unroll
        for (int i = 0; i < 8; ++i) st[i] = st[i] * cd + kv[i];
    }
}
DI void ret_r3_phase(const Frame& F0, const bf16_t* Pg, const bf16_t* RS, bf16_t* O1, int gq, const float* gn) {
    Frame F = F0; F.tid = F.wave * 64 + lane_id(); asm volatile("" : "+v"(F.tid)); F.lane = F.tid & 63;
    LAS bf16_t* Qs = (LAS bf16_t*)F.lds; LAS bf16_t* Ks = Qs + 128 * R_LDK; LAS bf16_t* Vh = Ks + 128 * R_LDK; LAS bf16_t* Rh = Vh + 128 * R_LDK;
    int w = F.wave; asm volatile("" : "+s"(w));
    u32x4 RQ[4], RK[4];
    { const int u0 = F.wg; const size_t r0 = (size_t)(u0 >> 9) * 8192 + (u0 & 63) * 128; const int h0 = (u0 >> 6) & 7;
      blk_fetch<128>(F, Pg + r0 * PGLD + h0 * 128, PGLD, RQ); blk_fetch<128>(F, Pg + r0 * PGLD + 1024 + h0 * 128, PGLD, RK); }
#pragma unroll 1
    for (int unit = F.wg; unit < 1024; unit += GRID) {
        const int c = unit & 63, h = (unit >> 6) & 7, bl = unit >> 9;
        const size_t row0 = (size_t)bl * 8192 + c * 128;
        const float l2g = log2f(1.0f - exp2f(-5.0f - (float)h));
        const bf16_t* rsu = RS + (size_t)unit * 32768;
        int lane = F.lane; asm volatile("" : "+v"(lane));
        const int fr = lane & 15, fq = lane >> 4, q = fr >> 2, pp = lane & 3;
        lds_bar();
        blk_put<128>(F, RQ, Qs, R_LDK); blk_put<128>(F, RK, Ks, R_LDK);
        static_assert(PGV8, "the chunk-output phase reads v and g as e4m3");
        u32x4 RV[2], RR[4];
        const unsigned char* Pg8 = (const unsigned char*)Pg + row0 * 8192 + 4096 + h * 256;
        blk_fetch8<128>(F, Pg8, 8192, RV);
        blk_fetch<128>(F, rsu, 256, RR);
        lds_bar();
        f32x4 sacc[8];
#pragma unroll
        for (int jt = 0; jt < 8; ++jt) sacc[jt] = (f32x4){0.f, 0.f, 0.f, 0.f};
#pragma unroll
        for (int ks = 0; ks < 4; ++ks) {
            const bf16x8 Yq = ld_row(Qs + (16 * w + fr) * R_LDK + 32 * ks + 8 * fq);
#pragma unroll
            for (int jt = 0; jt < 8; ++jt) { const bf16x8 Xk = ld_row(Ks + (16 * jt + fr) * R_LDK + 32 * ks + 8 * fq); sacc[jt] = MFMA16(Xk, Yq, sacc[jt]); }
        }
        lds_bar();
        { const int i = 16 * w + fr;
#pragma unroll
          for (int jt = 0; jt < 8; ++jt) { float pv[4];
#pragma unroll
              for (int r = 0; r < 4; ++r) { const int j = 16 * jt + 4 * fq + r; pv[r] = (i >= j) ? sacc[jt][r] * (0.08838834764831845f * __builtin_amdgcn_exp2f((float)(i - j) * l2g)) : 0.f; }
              u32x2 o; o[0] = pack2(pv[0], pv[1]); o[1] = pack2(pv[2], pv[3]);
              *(LAS u32x2*)(Ks + i * R_LDK + 16 * jt + 4 * fq) = o; } }
        f32x4 acc[16];
#pragma unroll
        for (int i = 0; i < 16; ++i) acc[i] = (f32x4){0.f, 0.f, 0.f, 0.f};
        const float qdec = exp2f((float)(16 * w + fr + 1) * l2g);
        u32x4 RG[4];
#pragma unroll
        for (int half = 0; half < 2; ++half) {
            if (half) lds_bar();
            blk_put8<128>(F, RV, Vh, R_LDK);
            blk_put<128>(F, RR, Rh, R_LDK);
            if (half == 0) { blk_fetch8<128>(F, Pg8 + 128, 8192, RV);
                blk_fetch<128>(F, rsu + 128, 256, RR); }
            else blk_fetch8<256>(F, Pg8 + 2048, 8192, RG);
            lds_bar();
#pragma unroll
            for (int ks = 0; ks < 4; ++ks) {
                const bf16x8 Yq = ld_row(Qs + (16 * w + fr) * R_LDK + 32 * ks + 8 * fq);
                const int ra = 32 * ks + 8 * fq + q, rb = ra + 4;
#pragma unroll
                for (int vt = 0; vt < 8; ++vt) { const bf16x8 Xr = ld_tr2(Rh + ra * R_LDK + 16 * vt + 4 * pp, Rh + rb * R_LDK + 16 * vt + 4 * pp); acc[half * 8 + vt] = MFMA16(Xr, Yq, acc[half * 8 + vt]); }
            }
#pragma unroll
            for (int vt = 0; vt < 8; ++vt) acc[half * 8 + vt] *= qdec;
#pragma unroll
            for (int ks = 0; ks < 4; ++ks) {
                const bf16x8 Yp = ld_row(Ks + (16 * w + fr) * R_LDK + 32 * ks + 8 * fq);
                const int ra = 32 * ks + 8 * fq + q, rb = ra + 4;
#pragma unroll
                for (int vt = 0; vt < 8; ++vt) { const bf16x8 Xv = ld_tr2(Vh + ra * R_LDK + 16 * vt + 4 * pp, Vh + rb * R_LDK + 16 * vt + 4 * pp); acc[half * 8 + vt] = MFMA16(Xv, Yp, acc[half * 8 + vt]); }
            }
        }
        lds_bar();
        LAS bf16_t* Gs = Vh;
        LAS float* gnl = (LAS float*)(Qs);
        blk_put8<256>(F, RG, Gs, R_LDV);
        if (F.tid < 256) { gnl[F.tid] = gn[h * 256 + F.tid]; gnl[256 + F.tid] = gn[2048 + h * 256 + F.tid]; }
        { const int un = unit + GRID; if (un < 1024) { const size_t rn = (size_t)(un >> 9) * 8192 + (un & 63) * 128; const int hn = (un >> 6) & 7;
            blk_fetch<128>(F, Pg + rn * PGLD + hn * 128, PGLD, RQ); blk_fetch<128>(F, Pg + rn * PGLD + 1024 + hn * 128, PGLD, RK); } }
        float s = 0.f;
#pragma unroll
        for (int vt = 0; vt < 16; ++vt) s += acc[vt][0] + acc[vt][1] + acc[vt][2] + acc[vt][3];
        s += shx(s, 16); s += shx(s, 32);
        const float mean = s * (1.0f / 256.0f); float qq = 0.f;
#pragma unroll
        for (int vt = 0; vt < 16; ++vt)
#pragma unroll
            for (int r = 0; r < 4; ++r) { const float d = acc[vt][r] - mean; qq += d * d; }
        qq += shx(qq, 16); qq += shx(qq, 32);
        const float rstd = rsqrtf(qq * (1.0f / 256.0f) + (PGV8 ? 1e-5f * F8_SX * F8_SX : 1e-5f));
        lds_bar();
        const size_t trow = row0 + 16 * w + fr;
        bf16_t* op = O1 + ((size_t)gq * 16384 + trow) * 2048 + h * 256;
#pragma unroll
        for (int vt = 0; vt < 16; ++vt) {
            const int v0 = 16 * vt + 4 * fq;
            if ((vt & 3) == 0) asm volatile("" ::: "memory");
            const u32x2 gr = *(const LAS u32x2*)(Gs + (16 * w + fr) * R_LDV + v0);
            const f32x4 gg = *(const LAS f32x4*)(gnl + v0), gb = *(const LAS f32x4*)(gnl + 256 + v0);
            float gv[4] = {__uint_as_float(gr[0] << 16), __uint_as_float(gr[0] & 0xffff0000u), __uint_as_float(gr[1] << 16), __uint_as_float(gr[1] & 0xffff0000u)};
            if (PGV8) {
#pragma unroll
                for (int r = 0; r < 4; ++r) gv[r] *= (1.0f / F8_SX); }
            float o[4];
#pragma unroll
            for (int r = 0; r < 4; ++r) { const float nv = (acc[vt][r] - mean) * rstd * gg[r] + gb[r]; o[r] = siluf_(gv[r]) * nv; }
            if (RTO8) *(unsigned*)((unsigned char*)O1 + ((size_t)gq * 16384 + trow) * 2048 + h * 256 + v0) = pk_fp8x4(o[0] * F8_SO, o[1] * F8_SO, o[2] * F8_SO, o[3] * F8_SO);
            else { u32x2 ov; ov[0] = pack2(o[0], o[1]); ov[1] = pack2(o[2], o[3]);
            *(u32x2*)(op + v0) = ov; }
        }
    }
}

DI bf16_t* st_w(const Frame& F) { return (bf16_t*)(F.ws + OFF_STR); }
DI bf16_t* st_kk(const Frame& F) { return (bf16_t*)(F.ws + OFF_STR) + (size_t)T * 512; }
DI bf16_t* st_b(const Frame& F) { return (bf16_t*)F.out; }
DI bf16_t* st_kp(const Frame& F) { return (bf16_t*)F.out + (size_t)T * 512; }
DI bf16_t* st_r(const Frame& F) { return (bf16_t*)F.out + (size_t)T * 1024; }
DI bf16_t* st_v(const Frame& F) { return (bf16_t*)F.out + (size_t)T * 1536; }

DI void rwkv_e1_phase(const Frame& F0) {
    Frame F = F0; F.tid = F.wave * 64 + lane_id(); asm volatile("" : "+v"(F.tid)); F.lane = F.tid & 63;
    const bf16_t* PR = (const bf16_t*)(F.ws + OFF_PR); const float* mu = F.in[3]; const float* kkw = F.in[12];
    const int c = F.lane * 8;
    float m0[8], m1[8], m2[8], kw[8];
#pragma unroll
    for (int i = 0; i < 8; ++i) { m0[i] = mu[c + i]; m1[i] = mu[512 + c + i]; m2[i] = mu[1024 + c + i]; kw[i] = kkw[c + i]; }
    float* rn = (float*)(F.ws + SM_RNORM);
    for (int r = F.wave; r < 256; r += 16) {
        u32x4 ld[2][6]; size_t t[2];
#pragma unroll
        for (int k = 0; k < 2; ++k) { t[k] = (size_t)F.wg * 256 + r + 8 * k; const size_t row = t[k] + (t[k] >> 13) + 1;
            const bf16_t* cur = PR + row * 2048 + c; const bf16_t* prv = cur - 2048;
            ld[k][0] = *(const u32x4*)cur; ld[k][1] = *(const u32x4*)prv; ld[k][2] = *(const u32x4*)(cur + 512); ld[k][3] = *(const u32x4*)(prv + 512); ld[k][4] = *(const u32x4*)(cur + 1024); ld[k][5] = *(const u32x4*)(prv + 1024); }
#pragma unroll
        for (int k = 0; k < 2; ++k) {
            float a[8], p[8], o[8];
            unpack8(ld[k][0], a); unpack8(ld[k][1], p);
#pragma unroll
            for (int i = 0; i < 8; ++i) o[i] = a[i] + (p[i] - a[i]) * m0[i];
            *(u32x4*)(st_r(F) + t[k] * 512 + c) = pack8(o);
            unpack8(ld[k][2], a); unpack8(ld[k][3], p);
            float ss = 0.f;
#pragma unroll
            for (int i = 0; i < 8; ++i) { o[i] = a[i] + (p[i] - a[i]) * m1[i]; const float q = o[i] * kw[i]; ss += q * q; }
            *(u32x4*)(st_kp(F) + t[k] * 512 + c) = pack8(o);
            ss += shx(ss, 1); ss += shx(ss, 2); ss += shx(ss, 4);
            if ((F.lane & 7) == 0) rn[t[k] * 8 + (F.lane >> 3)] = rcpf_(fmaxf(__builtin_amdgcn_sqrtf(ss), 1e-12f));
            unpack8(ld[k][4], a); unpack8(ld[k][5], p);
#pragma unroll
            for (int i = 0; i < 8; ++i) o[i] = a[i] + (p[i] - a[i]) * m2[i];
            *(u32x4*)(st_v(F) + t[k] * 512 + c) = pack8(o);
        }
    }
}

DI float dpp_f(float v, int ctrl_qp1, int) { return v; }
template <int CTRL> DI float dpp_mov(float v) { return __int_as_float(__builtin_amdgcn_update_dpp(0, __float_as_int(v), CTRL, 0xf, 0xf, true)); }
DI float row_sum16(float v) {
    v += dpp_mov<0xB1>(v);
    v += dpp_mov<0x4E>(v);
    v += dpp_mov<0x141>(v);
    v += dpp_mov<0x140>(v);
    return v;
}

DI float row_sum8(float v) {
    v += dpp_mov<0xB1>(v);
    v += dpp_mov<0x4E>(v);
    v += dpp_mov<0x141>(v);
    return v;
}
typedef _Float16 h2_t __attribute__((ext_vector_type(2)));
typedef _Float16 h8_t __attribute__((ext_vector_type(8)));
constexpr int SC_STEPS = 32;
constexpr int SC_BUF = SC_STEPS * (5 * 64 + 64) * 2;
constexpr int SC_WGS = 64;
constexpr int SC_OBS = 260;
struct ScOp { u32x4 a0, a1, a2, a3, a4; unsigned v0, v1; };
template <int U> DI void sc_ld(ScOp& o, unsigned pb, unsigned pv) {
    asm volatile("ds_read_b128 %0, %1 offset:%c2" : "=v"(o.a0) : "v"(pb), "i"(U * 640) : "memory");
    asm volatile("ds_read_b128 %0, %1 offset:%c2" : "=v"(o.a1) : "v"(pb), "i"(U * 640 + 128) : "memory");
    asm volatile("ds_read_b128 %0, %1 offset:%c2" : "=v"(o.a2) : "v"(pb), "i"(U * 640 + 256) : "memory");
    asm volatile("ds_read_b128 %0, %1 offset:%c2" : "=v"(o.a3) : "v"(pb), "i"(U * 640 + 384) : "memory");
    asm volatile("ds_read_b128 %0, %1 offset:%c2" : "=v"(o.a4) : "v"(pb), "i"(U * 640 + 512) : "memory");
    asm volatile("ds_read_u16 %0, %1 offset:%c2" : "=v"(o.v0) : "v"(pv), "i"(U * 128) : "memory");
    asm volatile("ds_read_u16 %0, %1 offset:%c2" : "=v"(o.v1) : "v"(pv), "i"(U * 128 + 2) : "memory");
}
DI void sc_wait(ScOp& o) { asm volatile("s_waitcnt lgkmcnt(0)" : "+v"(o.a0), "+v"(o.a1), "+v"(o.a2), "+v"(o.a3), "+v"(o.a4), "+v"(o.v0), "+v"(o.v1) :: "memory"); }
DI h2_t h2of(unsigned x) { return __builtin_bit_cast(h2_t, x); }
DI float dot2z(h2_t a, h2_t b) { float r; asm("v_dot2_f32_f16 %0, %1, %2, 0" : "=v"(r) : "v"(a), "v"(b)); return r; }
DI float sc_dot(const h2_t (&S)[4], const u32x4& x) {
    float o = dot2z(S[0], h2of(x[0])); o = __builtin_amdgcn_fdot2(S[1], h2of(x[1]), o, false); o = __builtin_amdgcn_fdot2(S[2], h2of(x[2]), o, false); return __builtin_amdgcn_fdot2(S[3], h2of(x[3]), o, false); }
DI unsigned sc_readout(const h2_t (&S)[2][4], const u32x4& rp) {
    const float o0 = sc_dot(S[0], rp), o1 = sc_dot(S[1], rp);
    return __builtin_bit_cast(unsigned, __builtin_amdgcn_cvt_pkrtz(o0, o1));
}
template <int U> DI void sc_step(h2_t (&S)[2][4], ScOp& cur, u32x4& rp, LAS unsigned* obw, unsigned pb, unsigned pv) {
    ScOp nxt; sc_ld<U + 1>(nxt, pb, pv);
    __builtin_amdgcn_sched_barrier(0);
    const float sa0 = sc_dot(S[0], cur.a1), sa1 = sc_dot(S[1], cur.a1);
    obw[U * SC_OBS] = sc_readout(S, rp);
    const _Float16 sh0 = (_Float16)(-row_sum8(sa0)), sh1 = (_Float16)(-row_sum8(sa1));
    const h2_t sav[2] = {(h2_t){sh0, sh0}, (h2_t){sh1, sh1}};
    const _Float16 vh0 = h2of(cur.v0)[0], vh1 = h2of(cur.v1)[0];
    const h2_t vv2[2] = {(h2_t){vh0, vh0}, (h2_t){vh1, vh1}};
#pragma unroll
    for (int rw = 0; rw < 2; ++rw)
#pragma unroll
        for (int i = 0; i < 4; ++i) S[rw][i] = S[rw][i] * h2of(cur.a0[i]) + (sav[rw] * h2of(cur.a2[i]) + vv2[rw] * h2of(cur.a3[i]));
    rp = cur.a4;
    __builtin_amdgcn_sched_barrier(0);
    sc_wait(nxt); cur = nxt;
}
DI void rwkv_scan(const Frame& F0, const bool do_post = true) {
    Frame F = F0; F.tid = F.wave * 64 + lane_id(); asm volatile("" : "+v"(F.tid)); F.lane = F.tid & 63;
    const int stream = F.wg, b = stream >> 3, h = stream & 7;
    const int rloc = 16 * F.wave + 2 * (F.lane >> 3), cg = F.lane & 7;
    const size_t tb = (size_t)b * SEQ;
    LAS unsigned* OBP = (LAS unsigned*)(F.lds + 2 * SC_BUF);
    const bf16_t* arrs[6] = {st_w(F), st_kk(F), st_b(F), st_kp(F), st_r(F), st_v(F)};
    u32x4 stage[3];
    auto issue = [&](int chunk) {
#pragma unroll
        for (int i = 0; i < 3; ++i) { const int id = F.tid + NTH * i, arr = id >> 8, rem = id & 255, step = rem >> 3, ch = rem & 7;
            const bf16_t* base = arr == 0 ? arrs[0] : arr == 1 ? arrs[1] : arr == 2 ? arrs[2] : arr == 3 ? arrs[3] : arr == 4 ? arrs[4] : arrs[5];
            stage[i] = *(const u32x4*)(base + (tb + (size_t)chunk * SC_STEPS + step) * 512 + h * 64 + ch * 8); }
    };
    auto commit = [&](int buf) {
        LAS _Float16* L = (LAS _Float16*)(F.lds + buf * SC_BUF);
#pragma unroll
        for (int i = 0; i < 3; ++i) { const int id = F.tid + NTH * i, arr = id >> 8, rem = id & 255, step = rem >> 3, ch = rem & 7;
            float v[8]; unpack8(stage[i], v);
            h8_t hv;
#pragma unroll
            for (int e = 0; e < 8; ++e) hv[e] = (_Float16)v[e];
            LAS _Float16* d = arr < 5 ? (L + step * 320 + arr * 64 + ch * 8) : (L + SC_STEPS * 320 + step * 64 + ch * 8);
            *(LAS h8_t*)d = hv; }
    };
    const int pstep = (F.tid - 256) >> 3, pc = h * 64 + 8 * (F.tid & 7);
    float lg[8], lb[8], rk[8];
    if (F.wave >= 4) {
#pragma unroll
        for (int i = 0; i < 8; ++i) { lg[i] = F.in[15][pc + i]; lb[i] = F.in[15][512 + pc + i]; rk[i] = F.in[14][pc + i]; } }
    bf16_t* O0 = (bf16_t*)(F.ws + OFF_O0);
    auto post = [&](int chunk) {
        const size_t t = tb + (size_t)chunk * SC_STEPS + pstep;
        const LAS unsigned* ob = OBP + ((chunk & 1) * (SC_STEPS + 1) + pstep + 1) * SC_OBS + 32 * (F.tid & 7);
        float o[8];
#pragma unroll
        for (int p = 0; p < 4; ++p) { float s0 = 0.f, s1 = 0.f;
#pragma unroll
            for (int hf = 0; hf < 2; ++hf) { const u32x4 q = *(const LAS u32x4*)(ob + p * 8 + hf * 4);
#pragma unroll
                for (int e = 0; e < 4; ++e) { const h2_t hv = h2of(q[e]); s0 += (float)hv[0]; s1 += (float)hv[1]; } }
            o[2 * p] = s0; o[2 * p + 1] = s1; }
        float rr[8], kp[8], vv[8], gg[8];
        unpack8(*(const u32x4*)(st_r(F) + t * 512 + pc), rr); unpack8(*(const u32x4*)(st_kp(F) + t * 512 + pc), kp); unpack8(*(const u32x4*)(st_v(F) + t * 512 + pc), vv);
        unpack8(*(const u32x4*)(O0 + t * 1024 + pc), gg);
        float s = 0.f, bs = 0.f;
#pragma unroll
        for (int i = 0; i < 8; ++i) { s += o[i]; bs += rr[i] * kp[i] * rk[i]; }
        s += shx(s, 1); s += shx(s, 2); s += shx(s, 4);
        bs += shx(bs, 1); bs += shx(bs, 2); bs += shx(bs, 4);
        const float mean = s * (1.0f / 64.0f); float q = 0.f;
#pragma unroll
        for (int i = 0; i < 8; ++i) { const float d = o[i] - mean; q += d * d; }
        q += shx(q, 1); q += shx(q, 2); q += shx(q, 4);
        const float rstd = rsqrtf(q * (1.0f / 64.0f) + 64e-5f);
        float res[8];
#pragma unroll
        for (int i = 0; i < 8; ++i) res[i] = ((o[i] - mean) * rstd * lg[i] + lb[i] + bs * vv[i]) * gg[i];
        *(u32x4*)(O0 + t * 1024 + pc) = pack8(res);
    };
    h2_t S[2][4];
#pragma unroll
    for (int i = 0; i < 4; ++i) { S[0][i] = (h2_t){(_Float16)0.f, (_Float16)0.f}; S[1][i] = S[0][i]; }
    __syncthreads();
    issue(0); commit(0);
    __syncthreads();
    constexpr int NCH = SEQ / SC_STEPS;
    for (int chunk = 0; chunk < NCH; ++chunk) {
        if (chunk + 1 < NCH) issue(chunk + 1);
        const LAS _Float16* L = (const LAS _Float16*)(F.lds + (chunk & 1) * SC_BUF);
        if (F.wave < 4) {
            LAS unsigned* obw = OBP + (chunk & 1) * (SC_STEPS + 1) * SC_OBS + F.tid;
            unsigned pb = (unsigned)(size_t)(F.lds + (chunk & 1) * SC_BUF) + 16 * cg, pv = (unsigned)(size_t)(F.lds + (chunk & 1) * SC_BUF) + SC_STEPS * 640 + 2 * rloc;
            ScOp cur; sc_ld<0>(cur, pb, pv); sc_wait(cur);
            u32x4 rp = cur.a4;
#pragma unroll 1
            for (int g8 = 0; g8 < SC_STEPS / 8; ++g8) {
                sc_step<0>(S, cur, rp, obw, pb, pv); sc_step<1>(S, cur, rp, obw, pb, pv); sc_step<2>(S, cur, rp, obw, pb, pv); sc_step<3>(S, cur, rp, obw, pb, pv);
                sc_step<4>(S, cur, rp, obw, pb, pv); sc_step<5>(S, cur, rp, obw, pb, pv); sc_step<6>(S, cur, rp, obw, pb, pv); sc_step<7>(S, cur, rp, obw, pb, pv);
                pb += 8 * 640; pv += 8 * 128; obw += 8 * SC_OBS;
            }
            obw[0] = sc_readout(S, rp);
        } else if (chunk > 0 && do_post) post(chunk - 1);
        if (chunk + 1 < NCH) commit((chunk + 1) & 1);
        __syncthreads();
    }
    if (F.wave >= 4 && do_post) post(NCH - 1);
}

DI void nsa_rope_phase(const Frame& F0) {
    Frame F = F0; F.tid = F.wave * 64 + lane_id(); asm volatile("" : "+v"(F.tid)); F.lane = F.tid & 63;
    bf16_t* PN = (bf16_t*)(F.ws + OFF_PN); const float* tab = (const float*)(F.ws + SM_ROPEN);
    const int hh = F.lane >> 2, j0 = (F.lane & 3) * 2;
    const int col = hh < 8 ? hh * 64 : 512 + ((hh - 8) >> 1) * 256 + ((hh - 8) & 1) * 64;
    if (hh >= 14) return;
    for (int r = F.wave; r < 256; r += 8) {
        const size_t t = (size_t)F.wg * 256 + r; const int pos = (int)(t & 8191);
        bf16_t* p = PN + t * 1536 + col + j0;
        const unsigned a = *(const unsigned*)p, bq = *(const unsigned*)(p + 8);
        const f32x4 cs = *(const f32x4*)(tab + ((size_t)pos * 8 + j0) * 2);
        const float x10 = __uint_as_float(a << 16), x11 = __uint_as_float(a & 0xffff0000u), x20 = __uint_as_float(bq << 16), x21 = __uint_as_float(bq & 0xffff0000u);
        *(unsigned*)p = pack2(x10 * cs[0] - x20 * cs[1], x11 * cs[2] - x21 * cs[3]);
        *(unsigned*)(p + 8) = pack2(x20 * cs[0] + x10 * cs[1], x21 * cs[2] + x11 * cs[3]);
    }
}
namespace pg8 {
struct CmpSched {
    const char* A; const char* B; size_t slotstepA, tstepA, bstride; int G, c;
    DI bool next(int i, Unit& u) const {
        const int L = i * G + c; if (L >= 64) return false;
        const int slot = L >> 4, pm = L & 15; u.pm = pm; u.pn = 0; u.aux = slot;
        u.a = A + (size_t)slot * slotstepA + (size_t)pm * tstepA; u.b = B + (size_t)(slot >> 1) * bstride; u.rows = nullptr; return true;
    }
};
}
constexpr int NS_STG = 16384, NS_NSTG = 4;
constexpr int NS_OFF_IMP = NS_NSTG * NS_STG, NS_OFF_SEL = NS_OFF_IMP + 128 * 128 * 4, NS_OFF_U = NS_OFF_SEL + 2048;
constexpr float NS_C = 0.125f * 1.44269504088896341f;
struct FState { f32x4 o[4][4]; float m[4], l[4]; };
struct TileSrc { const bf16_t* k; const bf16_t* v; size_t rstride; };
DI void ns_dma(const Frame& F, const TileSrc& S, int j, int stage) {
    int l_ = F.lane; asm volatile("" : "+v"(l_));
    const int row = 8 * F.wave + (l_ >> 3), c = (l_ & 7) ^ (l_ >> 3);
    const unsigned off = ((unsigned)(j * 64 + row) * (unsigned)S.rstride + c * 8) * 2u;
    LAS unsigned char* base = F.lds + stage * NS_STG + F.wave * 1024;
    __builtin_amdgcn_global_load_lds((const unsigned*)((const char*)S.k + off), (LAS unsigned*)base, 16, 0, 0);
    __builtin_amdgcn_global_load_lds((const unsigned*)((const char*)S.v + off), (LAS unsigned*)(base + 8192), 16, 0, 0);
}
DI void ns_wait(int after) {
    if (after >= 2) asm volatile("s_waitcnt vmcnt(4)" ::: "memory"); else if (after == 1) asm volatile("s_waitcnt vmcnt(2)" ::: "memory"); else asm volatile("s_waitcnt vmcnt(0)" ::: "memory");
    __builtin_amdgcn_s_barrier(); asm volatile("" ::: "memory");
}
DI float fexp2(float x) { return __builtin_amdgcn_exp2f(x); }
DI unsigned cvtpk(float lo, float hi) { return pack2(lo, hi); }
constexpr float NS_NINF = -__builtin_inff();
DI float vmax(float a, float b) { return __builtin_fmaxf(a, b); }
DI float vmax3(float a, float b, float c) { return __builtin_fmaxf(__builtin_fmaxf(a, b), c); }
DI float xquad_max(float v) {
    u32x2 r = __builtin_amdgcn_permlane16_swap(__float_as_uint(v), __float_as_uint(v), false, false);
    v = vmax(__uint_as_float(r[0]), __uint_as_float(r[1]));
    r = __builtin_amdgcn_permlane32_swap(__float_as_uint(v), __float_as_uint(v), false, false);
    return vmax(__uint_as_float(r[0]), __uint_as_float(r[1]));
}
template <int MM, bool PV, bool CMPHI = false, bool QL = false>
DI void ns_step(const LAS unsigned char* tb  , int kabs, const bf16x8 (&Qf)[4][2], FState& st, unsigned rtm, unsigned sb, int posl, int lod, int fr, int fq, int q, int pp, const LAS bf16_t* qb = nullptr) {
    const int lk = fr * 128 + ((fq ^ (fr & 7)) << 4);
    const int m_ = (4 * fq + q) & 7, vbl = (4 * fq + q) * 128 + ((((pp >> 1) ^ (m_ & 1))) << 4) + (pp & 1) * 8 + ((m_ >> 1) << 5);
    const LAS unsigned char* kp0 = tb + lk; const LAS unsigned char* kp1 = tb + (lk ^ 64); const LAS unsigned char* vp_ = tb + 8192 + vbl;
    asm volatile("" : "+v"(kp0), "+v"(kp1), "+v"(vp_));
    f32x4 s[2][4];
    bf16x8 X[2][2];
#pragma unroll
    for (int kt = 0; kt < 2; ++kt) { X[kt][0] = *(const LAS bf16x8*)(kp0 + kt * 2048); X[kt][1] = *(const LAS bf16x8*)(kp1 + kt * 2048); }
#pragma unroll
    for (int rt = 0; rt < 4; ++rt) if ((rtm >> rt) & 1u) {
        const bf16x8 q0 = QL ? ld_row(qb + (rt * 2 + 0) * 512) : Qf[rt][0], q1 = QL ? ld_row(qb + (rt * 2 + 1) * 512) : Qf[rt][1];
#pragma unroll
        for (int kt = 0; kt < 2; ++kt) { s[kt][rt] = MFMA16(X[kt][0], q0, ((f32x4){0.f, 0.f, 0.f, 0.f})); s[kt][rt] = MFMA16(X[kt][1], q1, s[kt][rt]); }
    }
    bf16x8 Y[4];
#pragma unroll
    for (int rt = 0; rt < 4; ++rt) {
        if ((rtm >> rt) & 1u) {
            if (MM) {
#pragma unroll
                for (int kt = 0; kt < 2; ++kt)
#pragma unroll
                    for (int r = 0; r < 4; ++r) { const int key = kabs + 16 * kt + 4 * fq + r; const int hi_ = CMPHI ? ((posl + 4 * rt - 31) >> 4) : (posl + 4 * rt);
                        const bool ok = MM == 1 ? (key <= hi_) : (key <= hi_ && key > hi_ - lod);
                        s[kt][rt][r] = ok ? s[kt][rt][r] : NS_NINF; }
            }
            const float rowneg = ((sb >> rt) & 1u) ? 0.f : NS_NINF;
            float mx = vmax3(s[0][rt][0], s[0][rt][1], s[0][rt][2]); mx = vmax3(mx, s[0][rt][3], s[1][rt][0]); mx = vmax3(mx, s[1][rt][1], s[1][rt][2]); mx = vmax(mx, s[1][rt][3]);
            mx = vmax(mx + rowneg, st.m[rt]);
            mx = xquad_max(mx);
            const float alpha = fexp2(st.m[rt] - mx); st.m[rt] = mx;
            const float c = rowneg - mx; const f32x2 c2 = (f32x2){c, c};
            f32x2 p[4];
#pragma unroll
            for (int kt = 0; kt < 2; ++kt) { const f32x2 a = (f32x2){s[kt][rt][0], s[kt][rt][1]} + c2, b = (f32x2){s[kt][rt][2], s[kt][rt][3]} + c2;
                p[2 * kt] = (f32x2){fexp2(a[0]), fexp2(a[1])}; p[2 * kt + 1] = (f32x2){fexp2(b[0]), fexp2(b[1])}; }
            const f32x2 ps2 = (p[0] + p[1]) + (p[2] + p[3]);
            st.l[rt] = st.l[rt] * alpha + (ps2[0] + ps2[1]);
            if (PV) {
                if (__ballot(alpha != 1.0f) != 0ull) {
#pragma unroll
                    for (int dt = 0; dt < 4; ++dt) st.o[dt][rt] *= alpha; }
                u32x4 w; w[0] = cvtpk(p[0][0], p[0][1]); w[1] = cvtpk(p[1][0], p[1][1]); w[2] = cvtpk(p[2][0], p[2][1]); w[3] = cvtpk(p[3][0], p[3][1]);
                Y[rt] = __builtin_bit_cast(bf16x8, w);
            }
        } else if (PV) {
            Y[rt] = (bf16x8){0, 0, 0, 0, 0, 0, 0, 0};
        }
    }
    if (PV) {
        const unsigned a0 = (unsigned)(size_t)vp_, a1 = a0 ^ 32u, a2 = a0 ^ 64u, a3 = a0 ^ 96u;
        s16x4 t0, t1, t2, t3, t4, t5, t6, t7;
        asm volatile("ds_read_b64_tr_b16 %0, %8\n\tds_read_b64_tr_b16 %1, %8 offset:2048\n\tds_read_b64_tr_b16 %2, %9\n\tds_read_b64_tr_b16 %3, %9 offset:2048\n\t"
                     "ds_read_b64_tr_b16 %4, %10\n\tds_read_b64_tr_b16 %5, %10 offset:2048\n\tds_read_b64_tr_b16 %6, %11\n\tds_read_b64_tr_b16 %7, %11 offset:2048\n\ts_waitcnt lgkmcnt(0)"
                     : "=&v"(t0), "=&v"(t1), "=&v"(t2), "=&v"(t3), "=&v"(t4), "=&v"(t5), "=&v"(t6), "=&v"(t7) : "v"(a0), "v"(a1), "v"(a2), "v"(a3) : "memory");
        const bf16x8 Xv[4] = {__builtin_shufflevector(t0, t1, 0, 1, 2, 3, 4, 5, 6, 7), __builtin_shufflevector(t2, t3, 0, 1, 2, 3, 4, 5, 6, 7), __builtin_shufflevector(t4, t5, 0, 1, 2, 3, 4, 5, 6, 7), __builtin_shufflevector(t6, t7, 0, 1, 2, 3, 4, 5, 6, 7)};
#pragma unroll
        for (int dt = 0; dt < 4; ++dt)
#pragma unroll
            for (int rt = 0; rt < 4; ++rt) st.o[dt][rt] = MFMA16(Xv[dt], Y[rt], st.o[dt][rt]);
    }
}
DI void ns_reset(FState& st) {
#pragma unroll
    for (int rt = 0; rt < 4; ++rt) { st.m[rt] = -1e30f; st.l[rt] = 0.f;
#pragma unroll
        for (int dt = 0; dt < 4; ++dt) st.o[dt][rt] = (f32x4){0.f, 0.f, 0.f, 0.f}; }
}


namespace nsb {
typedef float f32x16 __attribute__((ext_vector_type(16)));
constexpr int NSLOT = 3, SLOTB = 8192, LDS_K = 0, LDS_V = NSLOT * SLOTB, LDS_WS = 2 * NSLOT * SLOTB, LDS_OST = LDS_WS + 8 * 64 * 4, LDS_BYTES = LDS_OST + 8 * 4096;
constexpr int PITCH = 1536;
DI int crow(int r, int hi) { return (r & 3) + 8 * (r >> 2) + 4 * hi; }
#define NSB_SBAR() __builtin_amdgcn_sched_barrier(0)
DI void glds16(const void* sbase_, unsigned voff, unsigned lds_dst) { unsigned keep;
    const unsigned long long a_ = (unsigned long long)sbase_;
    const unsigned long long sbase = ((unsigned long long)(unsigned)__builtin_amdgcn_readfirstlane((int)(a_ >> 32)) << 32) | (unsigned)__builtin_amdgcn_readfirstlane((int)a_);
    asm volatile("s_mov_b32 %0, m0\n\ts_mov_b32 m0, %3\n\ts_nop 0\n\tglobal_load_lds_dwordx4 %1, %2\n\ts_mov_b32 m0, %0" : "=&s"(keep) : "v"(voff), "s"(sbase), "s"(lds_dst) : "memory"); }
DI float max3f(float a, float b, float c) { float r; asm("v_max3_f32 %0, %1, %2, %3" : "=v"(r) : "v"(a), "v"(b), "v"(c)); return r; }
DI float max2f(float a, float b) { float r; asm("v_max_f32_e32 %0, %1, %2" : "=v"(r) : "v"(a), "v"(b)); return r; }
DI float fadd_s(float a, float b) { float r; asm("v_add_f32_e32 %0, %1, %2" : "=v"(r) : "v"(a), "v"(b)); return r; }
DI float fsub_s(float a, float b) { float r; asm("v_sub_f32_e32 %0, %1, %2" : "=v"(r) : "v"(a), "v"(b)); return r; }
#define NSB_WAIT_BAR(N) asm volatile("s_waitcnt vmcnt(" #N ") lgkmcnt(0)\n\ts_barrier" ::: "memory")
typedef LAS const char* lds_cptr;
DI void qkt(f32x16& p0, f32x16& p1, lds_cptr Kslot, const bf16x8* qr, const f32x16& negm, int r32, int hi) {
    lds_cptr kb = Kslot + hi * 1024 + r32 * 16;
#pragma unroll
    for (int d0 = 0; d0 < 4; ++d0) {
        const bf16x8 b0 = *(const LAS bf16x8*)(kb + d0 * 2048), b1 = *(const LAS bf16x8*)(kb + d0 * 2048 + 512);
        if (d0 == 0) { p0 = __builtin_amdgcn_mfma_f32_32x32x16_bf16(b0, qr[0], negm, 0, 0, 0); p1 = __builtin_amdgcn_mfma_f32_32x32x16_bf16(b1, qr[0], negm, 0, 0, 0); }
        else { p0 = __builtin_amdgcn_mfma_f32_32x32x16_bf16(b0, qr[d0], p0, 0, 0, 0); p1 = __builtin_amdgcn_mfma_f32_32x32x16_bf16(b1, qr[d0], p1, 0, 0, 0); } }
}
DI void kload8(bf16x8* kf, lds_cptr kp) {
    kf[0] = *(const LAS bf16x8*)(kp);        kf[1] = *(const LAS bf16x8*)(kp + 512);
    kf[2] = *(const LAS bf16x8*)(kp + 2048); kf[3] = *(const LAS bf16x8*)(kp + 2560);
    kf[4] = *(const LAS bf16x8*)(kp + 4096); kf[5] = *(const LAS bf16x8*)(kp + 4608);
    kf[6] = *(const LAS bf16x8*)(kp + 6144); kf[7] = *(const LAS bf16x8*)(kp + 6656);
}
DI void kload2(bf16x8* kf, lds_cptr kp, int j) { kf[2 * j] = *(const LAS bf16x8*)(kp + j * 2048); kf[2 * j + 1] = *(const LAS bf16x8*)(kp + j * 2048 + 512); }
DI s16x4 vtr(lds_cptr p) { return __builtin_amdgcn_ds_read_tr16_b64_v4i16((LAS s16x4*)p); }
DI float rowmax(const f32x16& p0, const f32x16& p1) {
    float a = max3f(p0[0], p0[1], p1[0]), b = max3f(p0[2], p0[3], p1[1]); a = max3f(a, p1[2], p1[3]);
#pragma unroll
    for (int r = 4; r < 16; r += 4) { a = max3f(a, p0[r], p0[r + 1]); b = max3f(b, p0[r + 2], p0[r + 3]); a = max3f(a, p1[r], p1[r + 1]); b = max3f(b, p1[r + 2], p1[r + 3]); }
    const float m = max2f(a, b);
    auto rr = __builtin_amdgcn_permlane32_swap(__float_as_uint(m), __float_as_uint(m), false, false);
    return max2f(__uint_as_float(rr[0]), __uint_as_float(rr[1]));
}
DI void pv(f32x16* o, int vb, bf16x8 pa0, bf16x8 pa1, bf16x8 pa2, bf16x8 pa3) {
#pragma unroll
    for (int d0 = 0; d0 < 2; ++d0) { s16x4 lo[4], hi[4];
#pragma unroll
        for (int ks = 0; ks < 4; ++ks) {
            asm volatile("ds_read_b64_tr_b16 %0,%1 offset:%c2" : "=&v"(lo[ks]) : "v"(vb), "i"(d0 * 4096 + ks * 1024) : "memory");
            asm volatile("ds_read_b64_tr_b16 %0,%1 offset:%c2" : "=&v"(hi[ks]) : "v"(vb), "i"(d0 * 4096 + ks * 1024 + 512) : "memory"); }
        asm volatile("s_waitcnt lgkmcnt(0)" ::: "memory"); NSB_SBAR();
#define NSB_PK(k) (bf16x8){lo[k][0], lo[k][1], lo[k][2], lo[k][3], hi[k][0], hi[k][1], hi[k][2], hi[k][3]}
        o[d0] = __builtin_amdgcn_mfma_f32_32x32x16_bf16(pa0, NSB_PK(0), o[d0], 0, 0, 0);
        o[d0] = __builtin_amdgcn_mfma_f32_32x32x16_bf16(pa1, NSB_PK(1), o[d0], 0, 0, 0);
        o[d0] = __builtin_amdgcn_mfma_f32_32x32x16_bf16(pa2, NSB_PK(2), o[d0], 0, 0, 0);
        o[d0] = __builtin_amdgcn_mfma_f32_32x32x16_bf16(pa3, NSB_PK(3), o[d0], 0, 0, 0);
#undef NSB_PK
    }
}
DI void tmask(f32x16& p0, f32x16& p1, int mode, int tl, int hi) {
    const float NEG = -__builtin_inff();
#pragma unroll
    for (int r = 0; r < 16; ++r) { const int k0 = crow(r, hi), k1 = k0 + 32;
        const bool m0 = mode == 3 || (mode == 1 ? k0 > tl : (mode == 2 && k0 <= tl)), m1 = mode == 3 || (mode == 1 ? k1 > tl : (mode == 2 && k1 <= tl));
        if (m0) p0[r] = NEG; if (m1) p1[r] = NEG; }
}
template <int THRL, int BR>
DI void unit(const Frame& F, int b, int g, int tok0, const bf16_t* PN, bf16_t* O0, LAS char* shm, const LAS unsigned* selm_tok0, const bool do_store = true) {
    const int lane = F.lane, r32 = lane & 31, hi = lane >> 5, wid = F.wave;
    const long rowbase = (long)b * SEQ; const int jq = tok0 >> 6;
    const int tl = 8 * wid + (r32 >> 2);
    const bf16_t* Qw = PN + (rowbase + tok0 + tl) * PITCH + (g * 4 + (r32 & 3)) * 64;
    const bf16_t* Kh = PN + rowbase * PITCH + 512 + (BR == 1 ? 2 : 4) * 128 + g * 64; const bf16_t* Vh = PN + rowbase * PITCH + 512 + (BR == 1 ? 3 : 5) * 128 + g * 64;
    const unsigned lds0 = (unsigned)(size_t)shm;
    LAS float* wsf = (LAS float*)(shm + LDS_WS) + wid * 64;
    const int NTreal = BR == 1 ? jq + 1 : (jq + 1 < 9 ? jq + 1 : 9);
    int NT = (NTreal + 1) & ~1; if (NT < 4) NT = 4;
#define NSB_TILE(t) (((t) < NTreal) ? (jq - (t)) : 0)
    const bf16_t* ksrc = Kh + wid * 8; const unsigned koff = (unsigned)lane * (PITCH * 2);
    const bf16_t* vsrc = Vh + (long)(16 * (wid & 3)) * PITCH + (wid >> 2) * 32; const unsigned voff = (unsigned)(lane >> 2) * (PITCH * 2) + (lane & 3) * 16;
    const unsigned kdst = lds0 + LDS_K + wid * 1024, vdst = lds0 + LDS_V + wid * 1024;
#define NSB_DMA_K(t, slot) glds16(ksrc + (long)NSB_TILE(t) * 64 * PITCH, koff, (unsigned)__builtin_amdgcn_readfirstlane(kdst + (slot)))
#define NSB_DMA_V(t, slot) glds16(vsrc + (long)NSB_TILE(t) * 64 * PITCH, voff, (unsigned)__builtin_amdgcn_readfirstlane(vdst + (slot)))
    const int vb0 = (int)(lds0 + LDS_V) + ((lane >> 4) & 1) * 32 + (lane & 3) * 8 + (4 * hi + ((lane & 15) >> 2)) * 64;
    const lds_cptr shm3 = (lds_cptr)shm; const lds_cptr Kbase = shm3 + LDS_K; bf16x8 kf[8];
    const lds_cptr kp0 = shm3 + LDS_K + hi * 1024 + r32 * 16; const lds_cptr vp0 = shm3 + LDS_V + ((lane >> 4) & 1) * 32 + (lane & 3) * 8 + (4 * hi + ((lane & 15) >> 2)) * 64;
    NSB_DMA_K(0, 0); NSB_DMA_V(0, 0); NSB_DMA_K(1, SLOTB);
    bf16x8 qr[4];
#pragma unroll
    for (int d0 = 0; d0 < 4; ++d0) qr[d0] = *(const bf16x8*)(Qw + d0 * 16 + hi * 8);
    unsigned selw[4] = {0xFFFFFFFFu, 0xFFFFFFFFu, 0xFFFFFFFFu, 0xFFFFFFFFu};
    if (BR == 1) {
#pragma unroll
        for (int i = 0; i < 4; ++i) selw[i] = selm_tok0[tl * 4 + i]; }
    float mhat = 0.f, l_reg = 0.f; f32x16 o[2]; o[0] = f32x16{}; o[1] = f32x16{}; f32x16 negm = f32x16{}; asm volatile("" : "+v"(negm));
#define NSB_CMASK(P0, P1, t) do { const int t_ = (t); if (t_ == 0) tmask(P0, P1, 1, tl, hi); else if (t_ >= NTreal) tmask(P0, P1, 3, tl, hi); else if (BR == 2 && t_ == 8) tmask(P0, P1, 2, tl, hi); } while (0)
#define NSB_NEGM(t) do { if (BR == 1) { const int j_ = NSB_TILE(t); const unsigned wq_ = (j_ >> 5) == 0 ? selw[0] : ((j_ >> 5) == 1 ? selw[1] : ((j_ >> 5) == 2 ? selw[2] : selw[3])); const float nm_ = ((wq_ >> (j_ & 31)) & 1u) ? -mhat : -__builtin_inff(); \
        _Pragma("unroll") for (int r = 0; r < 16; ++r) negm[r] = nm_; asm volatile("" : "+v"(negm)); } } while (0)
    bool resc = false;
#define NSB_START(P0, P1) do { const float rm = rowmax(P0, P1); resc = false; \
    { const float dl = rm; mhat = fadd_s(mhat, dl); \
      _Pragma("unroll") for (int r = 0; r < 16; ++r) { P0[r] = fsub_s(P0[r], dl); P1[r] = fsub_s(P1[r], dl); } \
      if (BR != 1) { _Pragma("unroll") for (int r = 0; r < 16; ++r) negm[r] = -mhat; asm volatile("" : "+v"(negm)); } } \
    _Pragma("unroll") for (int r = 0; r < 16; ++r) P0[r] = __builtin_amdgcn_exp2f(P0[r]); } while (0)
#define NSB_RESC() do { if (resc) { asm volatile("s_waitcnt lgkmcnt(0)" ::: "memory"); \
      _Pragma("unroll") for (int d_ = 0; d_ < 2; ++d_) _Pragma("unroll") for (int r = 0; r < 16; ++r) o[d_][r] *= wsf[crow(r, hi)]; } } while (0)
    f32x16 pA0, pA1, pB0, pB1;
    int sl_prev = 0, sl_cur = 0, sl_next = SLOTB;
#define NSB_ROT() do { sl_prev = sl_cur; sl_cur = sl_next; sl_next = (sl_next == (NSLOT - 1) * SLOTB) ? 0 : sl_next + SLOTB; } while (0)
    NSB_DMA_K(2, 2 * SLOTB);
    NSB_WAIT_BAR(3);
    qkt(pA0, pA1, Kbase, qr, negm, r32, hi); asm volatile("s_nop 15\n\ts_nop 7" : "+v"(pA0), "+v"(pA1)); NSB_CMASK(pA0, pA1, 0);
    NSB_START(pA0, pA1);
#pragma unroll
    for (int r = 0; r < 16; ++r) pA1[r] = __builtin_amdgcn_exp2f(pA1[r]);
    NSB_WAIT_BAR(0);
    NSB_DMA_K(3, 0); NSB_DMA_V(1, SLOTB);
    NSB_ROT();
    kload8(kf, kp0 + sl_cur);
    NSB_WAIT_BAR(2);
    s16x4 vlo[8], vhi[8]; u32x4 pw0, pw1, pw2, pw3;
#define NSB_PKW(P, B) pack2(P[B], P[B + 1])
#define NSB_PAF(k) __builtin_bit_cast(bf16x8, pw##k)
#define NSB_VFR(i) (bf16x8){vlo[i][0], vlo[i][1], vlo[i][2], vlo[i][3], vhi[i][0], vhi[i][1], vhi[i][2], vhi[i][3]}
#define NSB_PIN(x) asm volatile("" : "+v"(x))
#define NSB_MX3(a, b, c) __builtin_fmaxf(__builtin_fmaxf((a), (b)), (c))
#define NSB_GAPA(MF, A0, A1, A2, A3, W0, W1, PW) do { MF; sacc += A0; sacc += A1; sacc += A2; sacc += A3; NSB_PIN(sacc); W0; W1; NSB_PIN(PW); NSB_SBAR(); } while (0)
#define NSB_EX(v) __builtin_amdgcn_exp2f(v)
#define NSB_GAPB(MF, X, B) do { MF; X[B] = NSB_EX(X[B]); X[B + 1] = NSB_EX(X[B + 1]); X[B + 2] = NSB_EX(X[B + 2]); X[B + 3] = NSB_EX(X[B + 3]); NSB_PIN(X); NSB_SBAR(); } while (0)
#define NSB_VRD(i) do { vlo[i] = vtr(vp_ + (((i) >> 2) * 4096 + ((i) & 3) * 1024)); vhi[i] = vtr(vp_ + (((i) >> 2) * 4096 + ((i) & 3) * 1024 + 512)); } while (0)
#define NSB_KRD(G, j) do { if (G) { kload2(kf, kp0 + sl_next, j); NSB_SBAR(); } } while (0)
#define NSB_STEP(C0, C1, P0, P1, t, GK, GV, GL) do { NSB_SBAR(); \
    const lds_cptr vp_ = vp0 + sl_prev; NSB_NEGM(t); \
    NSB_VRD(0); NSB_SBAR(); float sacc = (P0[0] + P0[1]); \
    NSB_GAPA(C0 = __builtin_amdgcn_mfma_f32_32x32x16_bf16(kf[0], qr[0], negm, 0, 0, 0), P0[2], P0[3], P0[4], P0[5],     pw0[0] = NSB_PKW(P0, 0), pw0[1] = NSB_PKW(P0, 2), pw0); \
    NSB_VRD(4); NSB_SBAR(); NSB_GAPA(C1 = __builtin_amdgcn_mfma_f32_32x32x16_bf16(kf[1], qr[0], negm, 0, 0, 0), P0[6], P0[7], P0[8], P0[9],     pw0[2] = NSB_PKW(P0, 4), pw0[3] = NSB_PKW(P0, 6), pw0); \
    NSB_VRD(1); NSB_SBAR(); NSB_GAPA(C0 = __builtin_amdgcn_mfma_f32_32x32x16_bf16(kf[2], qr[1], C0, 0, 0, 0),   P0[10], P0[11], P0[12], P0[13], pw1[0] = NSB_PKW(P0, 8), pw1[1] = NSB_PKW(P0, 10), pw1); \
    NSB_VRD(5); NSB_SBAR(); NSB_GAPA(C1 = __builtin_amdgcn_mfma_f32_32x32x16_bf16(kf[3], qr[1], C1, 0, 0, 0),   P0[14], P0[15], P1[0], P1[1],   pw1[2] = NSB_PKW(P0, 12), pw1[3] = NSB_PKW(P0, 14), pw1); \
    NSB_VRD(2); NSB_SBAR(); NSB_GAPA(C0 = __builtin_amdgcn_mfma_f32_32x32x16_bf16(kf[4], qr[2], C0, 0, 0, 0),   P1[2], P1[3], P1[4], P1[5],     pw2[0] = NSB_PKW(P1, 0), pw2[1] = NSB_PKW(P1, 2), pw2); \
    NSB_VRD(6); NSB_SBAR(); NSB_GAPA(C1 = __builtin_amdgcn_mfma_f32_32x32x16_bf16(kf[5], qr[2], C1, 0, 0, 0),   P1[6], P1[7], P1[8], P1[9],     pw2[2] = NSB_PKW(P1, 4), pw2[3] = NSB_PKW(P1, 6), pw2); \
    NSB_VRD(3); NSB_SBAR(); NSB_GAPA(C0 = __builtin_amdgcn_mfma_f32_32x32x16_bf16(kf[6], qr[3], C0, 0, 0, 0),   P1[10], P1[11], P1[12], P1[13], pw3[0] = NSB_PKW(P1, 8), pw3[1] = NSB_PKW(P1, 10), pw3); \
    NSB_VRD(7); NSB_SBAR(); NSB_GAPA(C1 = __builtin_amdgcn_mfma_f32_32x32x16_bf16(kf[7], qr[3], C1, 0, 0, 0),   P1[14], P1[15], 0.f, 0.f,       pw3[2] = NSB_PKW(P1, 12), pw3[3] = NSB_PKW(P1, 14), pw3); \
    l_reg += sacc; \
    if (GK) { NSB_DMA_K((t) + 3, sl_cur); } if (GV) { NSB_DMA_V((t) + 1, sl_next); } \
    NSB_CMASK2(C0, C1, t); \
    { float a = NSB_MX3(C0[0], C0[1], C1[0]), b_ = NSB_MX3(C0[2], C0[3], C1[1]); a = NSB_MX3(a, C1[2], C1[3]); \
      _Pragma("unroll") for (int r = 4; r < 16; r += 4) { a = NSB_MX3(a, C0[r], C0[r + 1]); b_ = NSB_MX3(b_, C0[r + 2], C0[r + 3]); a = NSB_MX3(a, C1[r], C1[r + 1]); b_ = NSB_MX3(b_, C1[r + 2], C1[r + 3]); } \
      float rm = __builtin_fmaxf(a, b_); { auto rr = __builtin_amdgcn_permlane32_swap(__float_as_uint(rm), __float_as_uint(rm), false, false); rm = __builtin_fmaxf(__uint_as_float(rr[0]), __uint_as_float(rr[1])); } \
      resc = false; \
      if (__builtin_expect(__any(rm > (float)THRL), 0)) { const float dl = __builtin_fmaxf(rm, 0.f); mhat += dl; \
        _Pragma("unroll") for (int r = 0; r < 16; ++r) { C0[r] -= dl; C1[r] -= dl; } \
        if (BR != 1) { _Pragma("unroll") for (int r = 0; r < 16; ++r) negm[r] = -mhat; asm volatile("" : "+v"(negm)); } \
        const float f = __builtin_amdgcn_exp2f(-dl); l_reg *= f; if (hi == 0) wsf[r32] = f; resc = true; } } \
    NSB_SBAR(); \
    NSB_GAPB(o[0] = __builtin_amdgcn_mfma_f32_32x32x16_bf16(NSB_PAF(0), NSB_VFR(0), o[0], 0, 0, 0), C0, 0); \
    NSB_GAPB(o[1] = __builtin_amdgcn_mfma_f32_32x32x16_bf16(NSB_PAF(0), NSB_VFR(4), o[1], 0, 0, 0), C0, 4); \
    NSB_KRD(GL, 0); NSB_GAPB(o[0] = __builtin_amdgcn_mfma_f32_32x32x16_bf16(NSB_PAF(1), NSB_VFR(1), o[0], 0, 0, 0), C0, 8); \
    NSB_KRD(GL, 1); NSB_GAPB(o[1] = __builtin_amdgcn_mfma_f32_32x32x16_bf16(NSB_PAF(1), NSB_VFR(5), o[1], 0, 0, 0), C0, 12); \
    NSB_KRD(GL, 2); NSB_GAPB(o[0] = __builtin_amdgcn_mfma_f32_32x32x16_bf16(NSB_PAF(2), NSB_VFR(2), o[0], 0, 0, 0), C1, 0); \
    NSB_KRD(GL, 3); NSB_GAPB(o[1] = __builtin_amdgcn_mfma_f32_32x32x16_bf16(NSB_PAF(2), NSB_VFR(6), o[1], 0, 0, 0), C1, 4); \
    NSB_GAPB(o[0] = __builtin_amdgcn_mfma_f32_32x32x16_bf16(NSB_PAF(3), NSB_VFR(3), o[0], 0, 0, 0), C1, 8); \
    NSB_GAPB(o[1] = __builtin_amdgcn_mfma_f32_32x32x16_bf16(NSB_PAF(3), NSB_VFR(7), o[1], 0, 0, 0), C1, 12); \
    } while (0)
    int t = 1;
#define NSB_CMASK2(P0, P1, t) do {} while (0)
    for (; t + 5 < NT; t += 2) {
        NSB_STEP(pB0, pB1, pA0, pA1, t, true, true, true);     NSB_WAIT_BAR(2); NSB_RESC(); NSB_ROT();
        NSB_STEP(pA0, pA1, pB0, pB1, t + 1, true, true, true); NSB_WAIT_BAR(2); NSB_RESC(); NSB_ROT();
    }
#undef NSB_CMASK2
#define NSB_CMASK2(P0, P1, t) NSB_CMASK(P0, P1, t)
#define NSB_ENDW(tt) do { if ((tt) + 3 < NT) { NSB_WAIT_BAR(2); } else if ((tt) + 2 < NT) { NSB_WAIT_BAR(1); } else { NSB_WAIT_BAR(0); } } while (0)
    for (; t + 1 < NT; t += 2) {
        NSB_STEP(pB0, pB1, pA0, pA1, t, (t + 3 < NT), (t + 1 < NT), (t + 1 < NT));         NSB_ENDW(t);     NSB_RESC(); NSB_ROT();
        NSB_STEP(pA0, pA1, pB0, pB1, t + 1, (t + 4 < NT), (t + 2 < NT), (t + 2 < NT));     NSB_ENDW(t + 1); NSB_RESC(); NSB_ROT();
    }
    NSB_STEP(pB0, pB1, pA0, pA1, NT - 1, false, false, false); NSB_RESC();
    { float sacc = pB0[0] + pB0[1];
#pragma unroll
      for (int r = 2; r < 16; ++r) sacc += pB0[r];
#pragma unroll
      for (int r = 0; r < 16; ++r) sacc += pB1[r];
      l_reg += sacc;
      pw0 = (u32x4){NSB_PKW(pB0, 0), NSB_PKW(pB0, 2), NSB_PKW(pB0, 4), NSB_PKW(pB0, 6)}; pw1 = (u32x4){NSB_PKW(pB0, 8), NSB_PKW(pB0, 10), NSB_PKW(pB0, 12), NSB_PKW(pB0, 14)};
      pw2 = (u32x4){NSB_PKW(pB1, 0), NSB_PKW(pB1, 2), NSB_PKW(pB1, 4), NSB_PKW(pB1, 6)}; pw3 = (u32x4){NSB_PKW(pB1, 8), NSB_PKW(pB1, 10), NSB_PKW(pB1, 12), NSB_PKW(pB1, 14)};
      NSB_SBAR(); pv(o, vb0 + sl_cur, NSB_PAF(0), NSB_PAF(1), NSB_PAF(2), NSB_PAF(3)); }
    { auto rr = __builtin_amdgcn_permlane32_swap(__float_as_uint(l_reg), __float_as_uint(l_reg), false, false); l_reg = __uint_as_float(rr[0]) + __uint_as_float(rr[1]); }
    const int lane2 = lane_id(), r32b = lane2 & 31, hib = lane2 >> 5;
    if (hib == 0) { const float gt = sigmoidf_(bf2f(PN[(rowbase + tok0 + 8 * wid + (r32b >> 2)) * PITCH + 1280 + BR * 8 + g * 4 + (r32b & 3)])); wsf[32 + r32b] = l_reg > 0.f ? gt * rcpf_(l_reg) : 0.f; }
    asm volatile("s_waitcnt lgkmcnt(0)" ::: "memory");
    float rli[16];
#pragma unroll
    for (int r = 0; r < 16; ++r) rli[r] = wsf[32 + crow(r, hib)];
    { LAS bf16_t* stg = (LAS bf16_t*)(shm + LDS_OST) + wid * 2048;
#pragma unroll
      for (int r = 0; r < 16; ++r) { const int orow = crow(r, hib);
#pragma unroll
          for (int d0 = 0; d0 < 2; ++d0) stg[orow * 64 + d0 * 32 + r32b] = f2bf(o[d0][r] * rli[r]); }
      asm volatile("s_waitcnt lgkmcnt(0)" ::: "memory");
#pragma unroll
      for (int i = 0; i < 4; ++i) { const int row = i * 8 + (lane2 >> 3), ch = lane2 & 7; const u32x4 v = *(const LAS u32x4*)(stg + row * 64 + ch * 8);
          bf16_t* op = O0 + (rowbase + tok0 + 8 * wid + (row >> 2)) * 1024 + 512 + (g * 4 + (row & 3)) * 64 + ch * 8;
          if (do_store) { float a8[8], b8[8]; unpack8(*(const u32x4*)op, a8); unpack8(v, b8);
#pragma unroll
              for (int e = 0; e < 8; ++e) a8[e] += b8[e];
              *(u32x4*)op = pack8(a8); }
          else asm volatile("" :: "v"(v)); } }
    asm volatile("s_waitcnt vmcnt(0) lgkmcnt(0)\n\ts_barrier" ::: "memory");
#undef NSB_TILE
#undef NSB_DMA_K
#undef NSB_DMA_V
#undef NSB_CMASK
#undef NSB_CMASK2
#undef NSB_NEGM
#undef NSB_START
#undef NSB_RESC
#undef NSB_ROT
#undef NSB_PKW
#undef NSB_PAF
#undef NSB_VFR
#undef NSB_PIN
#undef NSB_MX3
#undef NSB_GAPA
#undef NSB_GAPB
#undef NSB_EX
#undef NSB_VRD
#undef NSB_KRD
#undef NSB_STEP
#undef NSB_ENDW
}
#undef NSB_SBAR
#undef NSB_WAIT_BAR
}

DI void nsa_unit(const Frame& F0, int unit, const int mode = 0x3F) {
    Frame F = F0; F.tid = F.wave * 64 + lane_id(); asm volatile("" : "+v"(F.tid)); F.lane = F.tid & 63;
    const int qt = 63 - (unit >> 4), b = (unit >> 1) & 7, g = unit & 1;
    const int t0 = qt * 128, tw = t0 + 16 * F.wave;
    const size_t tokb = (size_t)b * SEQ;
    const int lane = F.lane, fr = lane & 15, fq = lane >> 4, q = fr >> 2, pp = lane & 3;
    const bf16_t* PN = (const bf16_t*)(F.ws + OFF_PN);
    LAS float* imp = (LAS float*)(F.lds + NS_OFF_IMP); LAS unsigned* selm = (LAS unsigned*)(F.lds + NS_OFF_SEL);
    const int hd = fr & 3, posl = tw + (fr >> 2);
    bf16x8 Qf[4][2];
#pragma unroll
    for (int rt = 0; rt < 4; ++rt)
#pragma unroll
        for (int ks = 0; ks < 2; ++ks) { float v[8]; unpack8(*(const u32x4*)(PN + (tokb + posl + 4 * rt) * 1536 + (g * 4 + hd) * 64 + 32 * ks + 8 * fq), v);
            u32x4 w; w[0] = cvtpk(v[0], v[1]); w[1] = cvtpk(v[2], v[3]); w[2] = cvtpk(v[4], v[5]); w[3] = cvtpk(v[6], v[7]);
            Qf[rt][ks] = __builtin_bit_cast(bf16x8, w); }
    __syncthreads();
    for (int i = F.tid; i < 128 * 128; i += NTH) imp[i] = 0.f;
    FState st;
    bf16_t* O0 = (bf16_t*)(F.ws + OFF_O0);
    if (mode & 1) {
        TileSrc S{(const bf16_t*)(F.ws + SM_KCMP) + ((size_t)b * 512 * 2 + g) * 64, (const bf16_t*)(F.ws + SM_VCMPT) + ((size_t)b * 512 * 2 + g) * 64, 128};
        int nmax = (t0 + 96) >> 4; if (nmax > 510) nmax = 510;
        const int ntl = (nmax >> 6) + 1;
        const int nfull = (tw - 31) >> 4;
        ns_reset(st);
        asm volatile("s_waitcnt vmcnt(0)" ::: "memory"); __syncthreads();
        for (int p_ = 0; p_ < 3 && p_ < ntl; ++p_) ns_dma(F, S, p_, p_);
#pragma unroll 1
        for (int j = 0; j < ntl; ++j) {
            ns_wait(ntl - 1 - j);
            if (j + 3 < ntl) ns_dma(F, S, j + 3, (j + 3) & 3);
            const LAS unsigned char* tb0 = F.lds + (j & 3) * NS_STG;
#pragma unroll 1
            for (int koff = 0; koff < 64; koff += 32) {
                const int nb = j * 64 + koff;
                if (16 * nb + 31 > tw + 15) continue;
                if (nb + 31 <= nfull) ns_step<0, false, true>(tb0 + koff * 128, nb, Qf, st, 0xFu, 0xFu, posl, 0, fr, fq, q, pp);
                else ns_step<1, false, true>(tb0 + koff * 128, nb, Qf, st, 0xFu, 0xFu, posl, 0, fr, fq, q, pp);
            }
        }
        float il[4];
#pragma unroll
        for (int rt = 0; rt < 4; ++rt) { float l = st.l[rt]; l += shx(l, 16); l += shx(l, 32); il[rt] = l > 0.f ? rcpf_(l) : 0.f; }
        __syncthreads();
        for (int p_ = 0; p_ < 3 && p_ < ntl; ++p_) ns_dma(F, S, p_, p_);
#pragma unroll 1
        for (int j = 0; j < ntl; ++j) {
            ns_wait(ntl - 1 - j);
            if (j + 3 < ntl) ns_dma(F, S, j + 3, (j + 3) & 3);
            const LAS unsigned char* tb0 = F.lds + (j & 3) * NS_STG;
#pragma unroll 1
            for (int koff = 0; koff < 64; koff += 32) {
                const int nb = j * 64 + koff;
                if (16 * nb + 31 > tw + 15) continue;
                const LAS unsigned char* tb = tb0 + koff * 128;
                const int lk = fr * 128 + ((fq ^ (fr & 7)) << 4);
                const int m_ = (4 * fq + q) & 7, vbl = (4 * fq + q) * 128 + ((((pp >> 1) ^ (m_ & 1))) << 4) + (pp & 1) * 8 + ((m_ >> 1) << 5);
                const LAS unsigned char* kp0 = tb + lk; const LAS unsigned char* kp1 = tb + (lk ^ 64); const LAS unsigned char* vp_ = tb + 8192 + vbl;
                asm volatile("" : "+v"(kp0), "+v"(kp1), "+v"(vp_));
                f32x4 s[2][4];
#pragma unroll
                for (int rt = 0; rt < 4; ++rt) { s[0][rt] = (f32x4){0.f, 0.f, 0.f, 0.f}; s[1][rt] = s[0][rt]; }
#pragma unroll
                for (int ks = 0; ks < 2; ++ks)
#pragma unroll
                    for (int kt = 0; kt < 2; ++kt) { const bf16x8 X = *(const LAS bf16x8*)((ks ? kp1 : kp0) + kt * 2048);
#pragma unroll
                        for (int rt = 0; rt < 4; ++rt) s[kt][rt] = MFMA16(X, Qf[rt][ks], s[kt][rt]); }
                bf16x8 Y[4];
#pragma unroll
                for (int rt = 0; rt < 4; ++rt) {
#pragma unroll
                    for (int kt = 0; kt < 2; ++kt) {
#pragma unroll
                        for (int r = 0; r < 4; ++r) { const int n = nb + 16 * kt + 4 * fq + r; s[kt][rt][r] = (n <= ((posl + 4 * rt - 31) >> 4)) ? fexp2(s[kt][rt][r] - st.m[rt]) * il[rt] : 0.f; }
                        float a = s[kt][rt][0] + s[kt][rt][1] + s[kt][rt][2] + 0.5f * s[kt][rt][3], bb = 0.5f * s[kt][rt][3];
                        a += dpp_mov<0xB1>(a); a += dpp_mov<0x4E>(a); bb += dpp_mov<0xB1>(bb); bb += dpp_mov<0x4E>(bb);
                        if (hd == 0) { const int jj = (nb >> 2) + 4 * kt + fq; const int tl = 16 * F.wave + 4 * rt + (fr >> 2);
                            __hip_atomic_fetch_add(imp + tl * 128 + jj, a, __ATOMIC_RELAXED, __HIP_MEMORY_SCOPE_WORKGROUP);
                            if (jj + 1 < 128) __hip_atomic_fetch_add(imp + tl * 128 + jj + 1, bb, __ATOMIC_RELAXED, __HIP_MEMORY_SCOPE_WORKGROUP); }
                    }
                    u32x4 w; w[0] = cvtpk(s[0][rt][0], s[0][rt][1]); w[1] = cvtpk(s[0][rt][2], s[0][rt][3]); w[2] = cvtpk(s[1][rt][0], s[1][rt][1]); w[3] = cvtpk(s[1][rt][2], s[1][rt][3]);
                    Y[rt] = __builtin_bit_cast(bf16x8, w);
                }
#pragma unroll
                for (int dt = 0; dt < 4; ++dt) { const LAS unsigned char* va = (const LAS unsigned char*)((unsigned)(size_t)vp_ ^ (unsigned)(dt * 32));
                    const bf16x8 X = ld_tr2((const LAS bf16_t*)va, (const LAS bf16_t*)(va + 2048));
#pragma unroll
                    for (int rt = 0; rt < 4; ++rt) st.o[dt][rt] = MFMA16(X, Y[rt], st.o[dt][rt]); }
            }
        }
        int pl_ = posl; asm volatile("" : "+v"(pl_));
#pragma unroll
        for (int rt = 0; rt < 4; ++rt) { const float gt = sigmoidf_(bf2f(PN[(tokb + pl_ + 4 * rt) * 1536 + 1280 + 0 * 8 + g * 4 + hd]));
#pragma unroll
            for (int dt = 0; dt < 4; ++dt) { const f32x4 v = st.o[dt][rt] * gt; u32x2 o; o[0] = cvtpk(v[0], v[1]); o[1] = cvtpk(v[2], v[3]);
                if (mode & 16) *(u32x2*)(O0 + (tokb + pl_ + 4 * rt) * 1024 + 512 + (g * 4 + hd) * 64 + 16 * dt + 4 * fq) = o; } }
    }
    __syncthreads();
#pragma unroll 1
    for (int tl = 0; tl < ((mode & 2) ? 16 : 0); ++tl) {
        const int pos = tw + tl, cur = pos >> 6; const int tg = 16 * F.wave + tl;
        const int j0 = lane, j1 = lane + 64;
        bool s0, s1;
        if (cur < 16) { s0 = j0 <= cur; s1 = false; }
        else {
            const bool c0 = j0 >= 1 && j0 <= cur - 2, c1 = j1 <= cur - 2;
            const unsigned v0 = c0 ? __float_as_uint(imp[tg * 128 + j0]) : 0u, v1 = c1 ? __float_as_uint(imp[tg * 128 + j1]) : 0u;
            unsigned thr = 0u; bool exact = false;
#pragma unroll 1
            for (int bit = 30; bit >= 0; --bit) {
                const unsigned cand = thr | (1u << bit);
                const int cnt = __popcll(__ballot(c0 && v0 >= cand)) + __popcll(__ballot(c1 && v1 >= cand));
                if (cnt >= 13) { thr = cand; if (cnt == 13) { exact = true; break; } }
            }
            if (exact) { s0 = c0 && v0 >= thr; s1 = c1 && v1 >= thr; }
            else {
                const unsigned long long g0 = __ballot(c0 && v0 > thr), g1 = __ballot(c1 && v1 > thr), e0 = __ballot(c0 && v0 == thr), e1 = __ballot(c1 && v1 == thr);
                const int need = 13 - __popcll(g0) - __popcll(g1);
                const unsigned long long lt = (1ull << lane) - 1ull;
                s0 = c0 && (v0 > thr || (v0 == thr && __popcll(e0 & lt) < need));
                s1 = c1 && (v1 > thr || (v1 == thr && __popcll(e0) + __popcll(e1 & lt) < need));
            }
            s0 = s0 || j0 == 0 || j0 == cur - 1 || j0 == cur; s1 = s1 || j1 == cur - 1 || j1 == cur;
        }
        const unsigned long long m0 = __ballot(s0), m1 = __ballot(s1);
        if (lane == 0) { selm[tg * 4 + 0] = (unsigned)m0; selm[tg * 4 + 1] = (unsigned)(m0 >> 32); selm[tg * 4 + 2] = (unsigned)m1; selm[tg * 4 + 3] = (unsigned)(m1 >> 32); }
    }
    __syncthreads();
    if (mode & 4) {
#pragma unroll 1
        for (int half = 0; half < 2; ++half) {
            nsb::unit<8, 1>(F, b, g, t0 + 64 * half, PN, O0, (LAS char*)F.lds, selm + 64 * half * 4, (mode & 16) != 0);
            if (mode & 8) nsb::unit<8, 2>(F, b, g, t0 + 64 * half, PN, O0, (LAS char*)F.lds, selm, (mode & 16) != 0);
        }
    }
}
DI void nsa_phase(const Frame& F0, int qi = 0, const int mode = 0x3F) {
    Frame F = F0; F.tid = F.wave * 64 + lane_id(); F.lane = F.tid & 63;
    LAS int* uw = (LAS int*)(F.lds + NS_OFF_U);
    unsigned* qh = (unsigned*)(F.ws + CTL_Q) + 64 * qi;
    for (;;) {
        __syncthreads();
        if (F.tid == 0) *uw = (int)__hip_atomic_fetch_add(qh, 1u, __ATOMIC_RELAXED, __HIP_MEMORY_SCOPE_AGENT);
        __syncthreads();
        const int u = *uw;
        if (u >= 1024) break;
        nsa_unit(F, u, mode);
    }
}

__global__ void __launch_bounds__(NTH, 2) fwd_kernel(Args args) {
    extern __shared__ __attribute__((aligned(16))) unsigned char lds_raw[];
    Frame F;
    F.lds = (LAS unsigned char*)lds_raw + LDS_SCR; F.tid = threadIdx.x; F.lane = F.tid & 63; F.wave = __builtin_amdgcn_readfirstlane(F.tid >> 6); F.wg = blockIdx.x;
    F.ws = args.ws; F.out = args.out; F.in = args.in;
    volatile LAS unsigned* misc = (volatile LAS unsigned*)((LAS unsigned char*)lds_raw);
    if (F.tid < 64) misc[F.tid] = 0u;
    __syncthreads();
    XcdBarrier bar = xcd_barrier_post((unsigned*)(F.ws + CTL_BAR), misc);
    LAS int* tile_start = (LAS int*)((LAS unsigned char*)lds_raw + 256);
    const int lo = args.ph_lo, hi = args.ph_hi;
#define IN(k) (lo <= (k) && (k) < hi)
#define SEAM(k) do { if (IN(k) && IN((k) + 1)) xcd_barrier(bar); } while (0)
    const float* ln = F.in[27];

    if (IN(0)) {
        tr_job(F, F.in[1], 3352, 1024, 3352, 3584, (bf16_t*)(F.ws + W_IN0), 1024, 0);
        tr_job(F, F.in[2], 1024, 1024, 1024, 1024, (bf16_t*)(F.ws + W_OUT0), 1024, 0);
        {
          const float* x = F.in[0]; bf16_t* xb = (bf16_t*)(F.ws + OFF_XB);
          for (size_t i0 = (size_t)F.wg * NTH + F.tid; i0 < (size_t)T * D / 8; i0 += (size_t)GRID * NTH * 4) {
              f32x4 a[4], b[4];
#pragma unroll
              for (int k = 0; k < 4; ++k) { const size_t i = i0 + (size_t)k * GRID * NTH; a[k] = *(const f32x4*)(x + i * 8); b[k] = *(const f32x4*)(x + i * 8 + 4); }
#pragma unroll
              for (int k = 0; k < 4; ++k) { const size_t i = i0 + (size_t)k * GRID * NTH; u32x4 o; o[0] = pack2(a[k][0], a[k][1]); o[1] = pack2(a[k][2], a[k][3]); o[2] = pack2(b[k][0], b[k][1]); o[3] = pack2(b[k][2], b[k][3]);
                  *(u32x4*)(xb + i * 8) = o; } } }
        {
          bf16_t* wl1 = (bf16_t*)(F.ws + W_L1); const float* mu = F.in[3];
          for (int i = F.wg * NTH + F.tid; i < 256 * 1024; i += GRID * NTH) { const int n = i >> 10, k = i & 1023, kk = k & 511;
              const int which = n < 64 ? 0 : (n < 128 ? 1 : 2); const int j = n - (which == 0 ? 0 : (which == 1 ? 64 : 128));
              const float* X1 = which == 0 ? F.in[5] : (which == 1 ? F.in[8] : F.in[10]); const int ldx = which == 2 ? 128 : 64;
              const float m = mu[(3 + which) * 512 + kk]; wl1[i] = f2bf((k < 512 ? (1.0f - m) : m) * X1[kk * ldx + j]); }
          bf16_t* wl2 = (bf16_t*)(F.ws + W_L2);
          for (int i = F.wg * NTH + F.tid; i < 1536 * 256; i += GRID * NTH) { const int n = i >> 8, k = i & 255; float v = 0.f;
              if (n < 512) { if (k < 64) v = F.in[6][k * 512 + n]; } else if (n < 1024) { if (k >= 64 && k < 128) v = F.in[9][(k - 64) * 512 + n - 512]; } else { if (k >= 128) v = F.in[11][(k - 128) * 512 + n - 1024]; }
              wl2[i] = f2bf(v); }
          bf16_t* pr = (bf16_t*)(F.ws + OFF_PR);
          for (int i = F.wg * NTH + F.tid; i < 8 * 2048; i += GRID * NTH) pr[(size_t)(i >> 11) * 8193 * 2048 + (i & 2047)] = 0; }
        tr_job(F, F.in[17], 128, 2048, 128, 256, (bf16_t*)(F.ws + W_C1), 2048, 0);
        tr_job(F, F.in[17] + 2048 * 128, 128, 2048, 128, 256, (bf16_t*)(F.ws + W_C1) + 256 * 2048, 2048, 0);
        {
          bf16_t* wc2 = (bf16_t*)(F.ws + W_C2);
          for (int i = F.wg * NTH + F.tid; i < 2 * 256 * 256; i += GRID * NTH) { const int kv = i >> 16, n = (i >> 8) & 255, k = i & 255;
              wc2[i] = f2bf((n < 64 && k < 128) ? F.in[18][(size_t)kv * 128 * 64 + k * 64 + n] : 0.f); }
          float* cb = (float*)(F.ws + SM_CBIAS);
          { const int i = F.wg * 8 + F.wave; if (i < 512) { const int kv = i >> 8, n = i & 255; float acc = 0.f;
              if (n < 128) { for (int k = F.tid & 63; k < 2048; k += 64) acc += F.in[16][kv * 2048 + k] * F.in[17][((size_t)kv * 2048 + k) * 128 + n]; acc = wave_sum(acc); }
              if ((F.tid & 63) == 0) cb[i] = acc; } }
          float* rn = (float*)(F.ws + SM_ROPEN);
          for (int i = F.wg * NTH + F.tid; i < 8192 * 8; i += GRID * NTH) { const int p = i >> 3, k = i & 7;
              const double ang = (double)p * exp(-13.122363377404328 * (double)k / 8.0); rn[2 * i] = (float)cos(ang); rn[2 * i + 1] = (float)sin(ang); } }
        tr_job(F, F.in[19], 6144, 1024, 6144, 6144, (bf16_t*)(F.ws + W_RTIN), 1024, 3, RTI8 ? F8_SW : 0.f);
        tr_job(F, F.in[20], 1024, 2048, 1024, 1024, (bf16_t*)(F.ws + W_RTOUT), 2048, 0, RTO8 ? F8_SWO : 0.f);
        __syncthreads();
    }
    SEAM(0);
#if PROBE == 11
    {
        tr_job(F, F.in[1], 3352, 1024, 3352, 3584, (bf16_t*)(F.ws + W_IN0), 1024, 0);
        tr_job(F, F.in[2], 1024, 1024, 1024, 1024, (bf16_t*)(F.ws + W_OUT0), 1024, 0);
        {
          const float* x = F.in[0]; bf16_t* xb = (bf16_t*)(F.ws + OFF_XB);
          for (size_t i0 = (size_t)F.wg * NTH + F.tid; i0 < (size_t)T * D / 8; i0 += (size_t)GRID * NTH * 4) {
              f32x4 a[4], b[4];
#pragma unroll
              for (int k = 0; k < 4; ++k) { const size_t i = i0 + (size_t)k * GRID * NTH; a[k] = *(const f32x4*)(x + i * 8); b[k] = *(const f32x4*)(x + i * 8 + 4); }
#pragma unroll
              for (int k = 0; k < 4; ++k) { const size_t i = i0 + (size_t)k * GRID * NTH; u32x4 o; o[0] = pack2(a[k][0], a[k][1]); o[1] = pack2(a[k][2], a[k][3]); o[2] = pack2(b[k][0], b[k][1]); o[3] = pack2(b[k][2], b[k][3]);
                  *(u32x4*)(xb + i * 8) = o; } } }
        {
          bf16_t* wl1 = (bf16_t*)(F.ws + W_L1); const float* mu = F.in[3];
          for (int i = F.wg * NTH + F.tid; i < 256 * 1024; i += GRID * NTH) { const int n = i >> 10, k = i & 1023, kk = k & 511;
              const int which = n < 64 ? 0 : (n < 128 ? 1 : 2); const int j = n - (which == 0 ? 0 : (which == 1 ? 64 : 128));
              const float* X1 = which == 0 ? F.in[5] : (which == 1 ? F.in[8] : F.in[10]); const int ldx = which == 2 ? 128 : 64;
              const float m = mu[(3 + which) * 512 + kk]; wl1[i] = f2bf((k < 512 ? (1.0f - m) : m) * X1[kk * ldx + j]); }
          bf16_t* wl2 = (bf16_t*)(F.ws + W_L2);
          for (int i = F.wg * NTH + F.tid; i < 1536 * 256; i += GRID * NTH) { const int n = i >> 8, k = i & 255; float v = 0.f;
              if (n < 512) { if (k < 64) v = F.in[6][k * 512 + n]; } else if (n < 1024) { if (k >= 64 && k < 128) v = F.in[9][(k - 64) * 512 + n - 512]; } else { if (k >= 128) v = F.in[11][(k - 128) * 512 + n - 1024]; }
              wl2[i] = f2bf(v); }
          bf16_t* pr = (bf16_t*)(F.ws + OFF_PR);
          for (int i = F.wg * NTH + F.tid; i < 8 * 2048; i += GRID * NTH) pr[(size_t)(i >> 11) * 8193 * 2048 + (i & 2047)] = 0; }
        tr_job(F, F.in[17], 128, 2048, 128, 256, (bf16_t*)(F.ws + W_C1), 2048, 0);
        tr_job(F, F.in[17] + 2048 * 128, 128, 2048, 128, 256, (bf16_t*)(F.ws + W_C1) + 256 * 2048, 2048, 0);
        {
          bf16_t* wc2 = (bf16_t*)(F.ws + W_C2);
          for (int i = F.wg * NTH + F.tid; i < 2 * 256 * 256; i += GRID * NTH) { const int kv = i >> 16, n = (i >> 8) & 255, k = i & 255;
              wc2[i] = f2bf((n < 64 && k < 128) ? F.in[18][(size_t)kv * 128 * 64 + k * 64 + n] : 0.f); }
          float* cb = (float*)(F.ws + SM_CBIAS);
          { const int i = F.wg * 8 + F.wave; if (i < 512) { const int kv = i >> 8, n = i & 255; float acc = 0.f;
              if (n < 128) { for (int k = F.tid & 63; k < 2048; k += 64) acc += F.in[16][kv * 2048 + k] * F.in[17][((size_t)kv * 2048 + k) * 128 + n]; acc = wave_sum(acc); }
              if ((F.tid & 63) == 0) cb[i] = acc; } }
          float* rn = (float*)(F.ws + SM_ROPEN);
          for (int i = F.wg * NTH + F.tid; i < 8192 * 8; i += GRID * NTH) { const int p = i >> 3, k = i & 7;
              const double ang = (double)p * exp(-13.122363377404328 * (double)k / 8.0); rn[2 * i] = (float)cos(ang); rn[2 * i + 1] = (float)sin(ang); } }
        tr_job(F, F.in[19], 6144, 1024, 6144, 6144, (bf16_t*)(F.ws + W_RTIN), 1024, 3, RTI8 ? F8_SW : 0.f);
        tr_job(F, F.in[20], 1024, 2048, 1024, 1024, (bf16_t*)(F.ws + W_RTOUT), 2048, 0, RTO8 ? F8_SWO : 0.f);
        __syncthreads();
        { float* rr = (float*)(F.ws + SM_ROPER);
          for (int i = F.wg * NTH + F.tid; i < 8192 * 64; i += GRID * NTH) { const int p = i >> 6, k = i & 63;
              const double ang = (double)p * exp(-9.210340371976184 * (double)k / 63.0); rr[2 * i] = (float)cos(ang); rr[2 * i + 1] = (float)sin(ang); } }
    }
    xcd_barrier(bar);
#endif
    if (IN(1)) {
        pg8::GemmK g{1024, 1024, 1024, 128, 1 << 30, 0};
        pg8::DenseSched S; S.init(F.ws + OFF_XB, 1024, F.ws + W_IN0, 1024, T, 3584, GRID, F.wg);
        bf16_t* PR = (bf16_t*)(F.ws + OFF_PR); bf16_t* PN = (bf16_t*)(F.ws + OFF_PN);
        auto f = [PR, PN](const pg8::Unit&, int row, int col, const float (&v)[8]) {
            if (col < 2048) store8(PR + ((size_t)row + (row >> 13) + 1) * 2048 + col, v);
            else if (col < 2560) { float o[8];
#pragma unroll
                for (int i = 0; i < 8; ++i) o[i] = v[i] * NS_C;
                store8(PN + (size_t)row * 1536 + (col - 2048), o); }
            else store8(PN + (size_t)row * 1536 + (col - 2048), v); };
        pg8::EpiRow8<decltype(f)> E{f};
        pg8::gemm_phase(F.lds, F.wave, g, S, E);
    }
    SEAM(1);
#if PROBE == 6
    {
        pg8::GemmK g{1024, 1024, 1024, 128, 1 << 30, 0};
        pg8::DenseSched S; S.init(F.ws + OFF_XB, 1024, F.ws + W_IN0, 1024, T, 3584, GRID, F.wg);
        bf16_t* PR = (bf16_t*)(F.ws + OFF_PR); bf16_t* PN = (bf16_t*)(F.ws + OFF_PN);
        auto f = [PR, PN](const pg8::Unit&, int row, int col, const float (&v)[8]) {
            if (col < 2048) store8(PR + ((size_t)row + (row >> 13) + 1) * 2048 + col, v);
            else if (col < 2560) { float o[8];
#pragma unroll
                for (int i = 0; i < 8; ++i) o[i] = v[i] * NS_C;
                store8(PN + (size_t)row * 1536 + (col - 2048), o); }
            else store8(PN + (size_t)row * 1536 + (col - 2048), v); };
        pg8::EpiRow8<decltype(f)> E{f};
        pg8::gemm_phase(F.lds, F.wave, g, S, E);
        xcd_barrier(bar);
    }
#endif
    if (IN(2)) {
        rwkv_e1_phase(F);
        nsa_rope_phase(F);
        pg8::GemmK g{2048, 1024, 1024, 128, 8, -5120};
        pg8::DenseSched S; S.init(F.ws + OFF_PR + 1536 * 2, 2048, F.ws + W_L1, 1024, T, 256, GRID, F.wg, 1);
        bf16_t* HID = (bf16_t*)(F.ws + OFF_O0) + 512;
        auto f = [HID](const pg8::Unit&, int row, int col, const float (&v)[8]) {
            float o[8];
#pragma unroll
            for (int i = 0; i < 8; ++i) o[i] = col < 64 ? tanhf_(v[i]) : (col < 128 ? v[i] : sigmoidf_(v[i]));
            store8(HID + (size_t)row * 1024 + col, o); };
        pg8::EpiRow8<decltype(f)> E{f};
        pg8::gemm_phase(F.lds, F.wave, g, S, E);
    }
    SEAM(2);
    if (IN(3) && F.wg >= 64) {
        pg8::GemmK g{1024, 256, 256, 128, 1 << 30, 0};
        pg8::DenseSched S; S.init(F.ws + OFF_O0 + 512 * 2, 1024, F.ws + W_L2, 256, T, 1536, GRID - 64, F.wg - 64);
        bf16_t* SW = st_w(F); bf16_t* SKK = st_kk(F); bf16_t* SB = st_b(F); bf16_t* SKP = st_kp(F); bf16_t* O0 = (bf16_t*)(F.ws + OFF_O0);
        const float* w0 = F.in[4]; const float* a0 = F.in[7]; const float* kkw = F.in[12]; const float* kaw = F.in[13]; const float* rn = (const float*)(F.ws + SM_RNORM);
        auto f = [=](const pg8::Unit&, int row, int col, const float (&v)[8]) {
            float o[8];
            if (col < 512) {
#pragma unroll
                for (int i = 0; i < 8; ++i) o[i] = __builtin_amdgcn_exp2f(-0.606531f * 1.44269504088896341f * sigmoidf_(w0[col + i] + v[i]));
                store8(SW + (size_t)row * 512 + col, o);
            } else if (col < 1024) {
                const int c = col - 512; float k[8], kk[8], bb[8];
                unpack8(*(const u32x4*)(SKP + (size_t)row * 512 + c), k);
                const float r = rn[(size_t)row * 8 + (c >> 6)];
#pragma unroll
                for (int i = 0; i < 8; ++i) { const float a = sigmoidf_(a0[c + i] + v[i]); kk[i] = k[i] * kkw[c + i] * r; bb[i] = kk[i] * a; o[i] = k[i] * (1.0f + (a - 1.0f) * kaw[c + i]); }
                store8(SKK + (size_t)row * 512 + c, kk); store8(SB + (size_t)row * 512 + c, bb); store8(SKP + (size_t)row * 512 + c, o);
            } else {
                store8(O0 + (size_t)row * 1024 + (col - 1024), v);
            } };
        pg8::EpiRow8<decltype(f)> E{f};
        pg8::gemm_phase(F.lds, F.wave, g, S, E);
    }
    if (IN(3)) {
        pg8::GemmK g{16 * 1536, 2048, 2048, 1536 * 2, 1 << 30, 0};
        pg8::CmpSched S{(const char*)(F.ws + OFF_PN + 512 * 2), (const char*)(F.ws + W_C1), (size_t)128, (size_t)256 * 16 * 1536 * 2, (size_t)256 * 2048 * 2, GRID, F.wg};
        bf16_t* HC = (bf16_t*)(F.ws + OFF_HC); const float* cb = (const float*)(F.ws + SM_CBIAS);
        auto f = [HC, cb](const pg8::Unit& u, int row, int col, const float (&v)[8]) {
            float o[8];
#pragma unroll
            for (int i = 0; i < 8; ++i) { const float x = v[i] + cb[(u.aux >> 1) * 256 + col + i]; o[i] = 0.5f * x * (1.0f + tanhf(0.7978845608028654f * (x + 0.044715f * x * x * x))); }
            store8(HC + ((size_t)u.aux * 4096 + row) * 256 + col, o); };
        pg8::EpiRow8<decltype(f)> E{f};
        pg8::gemm_phase(F.lds, F.wave, g, S, E);
        __threadfence(); __syncthreads();
    }
    if (IN(3)) {
        pg8::GemmK g{256, 256, 256, 128, 1 << 30, 0};
        pg8::CmpSched S{(const char*)(F.ws + OFF_HC), (const char*)(F.ws + W_C2), (size_t)4096 * 256 * 2, (size_t)256 * 256 * 2, (size_t)256 * 256 * 2, GRID, F.wg};
        bf16_t* KC = (bf16_t*)(F.ws + SM_KCMP); bf16_t* VC = (bf16_t*)(F.ws + SM_VCMPT);
        auto f = [KC, VC](const pg8::Unit& u, int row, int col, const float (&v)[8]) {
            if (col < 64) store8((u.aux < 2 ? KC : VC) + ((size_t)row * 2 + (u.aux & 1)) * 64 + col, v); };
        pg8::EpiRow8<decltype(f)> E{f};
        pg8::gemm_phase(F.lds, F.wave, g, S, E);
    }
    SEAM(3);
    if (IN(5)) { if (F.wg < SC_WGS) rwkv_scan(F); nsa_phase(F); }
    SEAM(5);
#if PROBE == 1
    if (F.wg < SC_WGS) rwkv_scan(F, false);
    xcd_barrier(bar);
#elif PROBE == 2
    nsa_phase(F, 1);
    xcd_barrier(bar);
#elif PROBE >= 20 && PROBE < 30
    nsa_phase(F, 1, PROBE == 20 ? 0x01 : PROBE == 21 ? 0x03 : PROBE == 22 ? 0x07 : PROBE == 23 ? 0x27 : PROBE == 24 ? 0x2B : PROBE == 25 ? 0x0B : 0x2F);
    xcd_barrier(bar);
#endif
    if (IN(7)) {
        pg8::GemmK g{1024, 1024, 1024, 128, 1 << 30, 0};
        pg8::DenseSched S; S.init(F.ws + OFF_O0, 1024, F.ws + W_OUT0, 1024, T, 1024, GRID, F.wg);
        bf16_t* MX = (bf16_t*)(F.ws + OFF_MIX);
        auto f = [MX](const pg8::Unit&, int row, int col, const float (&v)[8]) { store8(MX + (size_t)row * 1024 + col, v); };
        pg8::EpiRow8<decltype(f)> E{f};
        pg8::gemm_phase(F.lds, F.wave, g, S, E);
    }
    SEAM(7);
    if (IN(10)) { ln1_router_phase(F, nullptr  , (const bf16_t*)(F.ws + OFF_MIX), (bf16_t*)(F.ws + OFF_XB), ln + 0 * 1024, ln + 1 * 1024, 0, MOE8_L0 ? F.ws + OFF_XB8 : nullptr); moe_weights(F, 0, MOE8_L0); }
    SEAM(10);
#if PROBE == 5
    ln1_router_phase(F, F.in[0], (const bf16_t*)(F.ws + OFF_MIX), (bf16_t*)(F.ws + OFF_XB), ln + 0 * 1024, ln + 1 * 1024, 0); moe_weights(F, 0);
    xcd_barrier(bar);
#endif
    if (IN(11)) moe_scatter_phase(F, nullptr, 0);
    SEAM(11);
#if PROBE == 7
    moe_scatter_phase(F, nullptr, 0);
    xcd_barrier(bar);
#endif
    if (IN(12)) {
        { const int kt_ = F.wave * 64 + lane_id(); if (kt_ < 17) tile_start[kt_] = ((const int*)(F.ws + CTL_TILES))[kt_]; }
        __syncthreads();
        if (MOE8_L0) {
            pg8::GemmK g{512, 512, 512, 128, 1 << 30, 0};
            pg8::MoeSched S{(const char*)(F.ws + OFF_XB8), (const char*)(F.ws + OFF_WMOE), (size_t)0, (size_t)256 * 1024, tile_start, 8, GRID, F.wg, (const int*)(F.ws + SM_ROWTOK)};
            pg8::EpiGU8 E{F.ws + OFF_H};
            pg8::gemm_phase<pg8::EpiGU8, pg8::MoeSched, true, true>(F.lds, F.wave, g, S, E);
        } else {
        pg8::GemmK g{1024, 1024, 1024, 128, 1 << 30, 0};
        pg8::MoeSched S{(const char*)(F.ws + OFF_XB), (const char*)(F.ws + OFF_WMOE), (size_t)0, (size_t)256 * 1024 * 2, tile_start, 8, GRID, F.wg, (const int*)(F.ws + SM_ROWTOK)};
        pg8::EpiGU E{(bf16_t*)(F.ws + OFF_H)};
        pg8::gemm_phase<pg8::EpiGU, pg8::MoeSched, true>(F.lds, F.wave, g, S, E);
        }
    }
    SEAM(12);
    if (IN(13)) {
        { const int kt_ = F.wave * 64 + lane_id(); if (kt_ < 17) tile_start[kt_] = ((const int*)(F.ws + CTL_TILES))[kt_]; }
        __syncthreads();
        bf16_t* Y = (bf16_t*)(F.ws + OFF_XS);
        if (MOE8_L0) {
            pg8::GemmK g{512, 512, 512, 128, 1 << 30, 0};
            pg8::MoeSched S{(const char*)(F.ws + OFF_H), (const char*)(F.ws + OFF_WMOE + (size_t)16 * 2048 * 1024), (size_t)256 * 1024, (size_t)256 * 1024, tile_start, 4, GRID, F.wg};
            auto f = [Y](const pg8::Unit&, int row, int col, const float (&v)[8]) { float o[8];
#pragma unroll
                for (int i = 0; i < 8; ++i) o[i] = v[i] * (1.0f / (F8_SH * F8_SD));
                store8(Y + (size_t)row * 1024 + col, o); };
            pg8::EpiRow8<decltype(f)> E{f};
            pg8::gemm_phase<decltype(E), pg8::MoeSched, false, true>(F.lds, F.wave, g, S, E);
        } else {
        pg8::GemmK g{1024, 1024, 1024, 128, 1 << 30, 0};
        pg8::MoeSched S{(const char*)(F.ws + OFF_H), (const char*)(F.ws + OFF_WMOE + (size_t)16 * 2048 * 1024 * 2), (size_t)256 * 1024 * 2, (size_t)256 * 1024 * 2, tile_start, 4, GRID, F.wg};
        auto f = [Y](const pg8::Unit&, int row, int col, const float (&v)[8]) { store8(Y + (size_t)row * 1024 + col, v); };
        pg8::EpiRow8<decltype(f)> E{f};
        pg8::gemm_phase(F.lds, F.wave, g, S, E);
        }
    }
    SEAM(13);
#if PROBE == 4
    {
        { const int kt_ = F.wave * 64 + lane_id(); if (kt_ < 17) tile_start[kt_] = ((const int*)(F.ws + CTL_TILES))[kt_]; }
        __syncthreads();
        pg8::GemmK g{1024, 1024, 1024, 128, 1 << 30, 0};
        pg8::MoeSched S{(const char*)(F.ws + OFF_XB), (const char*)(F.ws + OFF_WMOE), (size_t)0, (size_t)256 * 1024 * 2, tile_start, 8, GRID, F.wg, (const int*)(F.ws + SM_ROWTOK)};
        pg8::EpiGU E{(bf16_t*)(F.ws + OFF_H)};
        pg8::gemm_phase<pg8::EpiGU, pg8::MoeSched, true>(F.lds, F.wave, g, S, E);
        xcd_barrier(bar);
    }
#endif
    if (IN(14)) { ln2_phase(F, nullptr, ln + 2 * 1024, ln + 3 * 1024, (bf16_t*)(F.ws + OFF_XB), true, RTI8 ? F.ws + OFF_XB8B : nullptr); }
    SEAM(14);
#pragma unroll 1
    for (int k_ = 0; k_ < (PROBE == 12 ? 10 : 5); ++k_) { const int k = k_ % 5;
        if (IN(20)) {
#define PGB(j) ((bf16_t*)(F.ws + OFF_PG + (size_t)((j) & 1) * PG_BYTES))
#define KVB(j) ((bf16_t*)(F.ws + OFF_KV + (size_t)((j) & 1) * KV_BYTES))
            if (k >= 1) ret_r2_phase(F, KVB(k - 1));
            if (k <= 3) {
                pg8::GemmK g{RTI8 ? 512 : 1024, RTI8 ? 512 : 1024, RTI8 ? 512 : 1024, 128, 1 << 30, 0};
                pg8::DenseSched S; if (RTI8) S.init(F.ws + OFF_XB8B + (size_t)k * 16384 * 1024, 512, F.ws + W_RTIN, 512, 16384, 6144, GRID, F.wg); else S.init(F.ws + OFF_XB + (size_t)k * 16384 * 1024 * 2, 1024, F.ws + W_RTIN, 1024, 16384, 6144, GRID, F.wg);
                bf16_t* P = PGB(k);
                auto f = [P](const pg8::Unit&, int row, int col, const float (&v_)[8]) {
                    float v[8];
#pragma unroll
                    for (int i = 0; i < 8; ++i) v[i] = RTI8 ? v_[i] * (1.0f / (F8_SX * F8_SW)) : v_[i];
                    if (col < 2048) {
                        float o[8]; const float posf = (float)(row & 8191); const int m0 = (col & 127) >> 1;
#pragma unroll
                        for (int i = 0; i < 4; ++i) { const float rev = __builtin_amdgcn_fractf(posf * (__builtin_amdgcn_exp2f((float)(m0 + i) * (-13.287712379549449f / 63.0f)) * 0.15915494309189535f));
                            const float co = __builtin_amdgcn_cosf(rev), si = __builtin_amdgcn_sinf(rev); o[2 * i] = v[2 * i] * co - v[2 * i + 1] * si; o[2 * i + 1] = v[2 * i + 1] * co + v[2 * i] * si; }
                        store8(P + (size_t)row * PGLD + col, o);
                    } else if (PGV8) { u32x2 w8; w8[0] = pk_fp8x4(v[0] * F8_SX, v[1] * F8_SX, v[2] * F8_SX, v[3] * F8_SX); w8[1] = pk_fp8x4(v[4] * F8_SX, v[5] * F8_SX, v[6] * F8_SX, v[7] * F8_SX);
                        *(u32x2*)((unsigned char*)P + (size_t)row * 8192 + 4096 + (col - 2048)) = w8; }
                    else store8(P + (size_t)row * 6144 + col, v); };
                pg8::EpiRow8<decltype(f)> E{f};
                pg8::gemm_phase<decltype(E), pg8::DenseSched, false, RTI8>(F.lds, F.wave, g, S, E);
            }
            xcd_barrier(bar);
            if (k >= 1) ret_r3_phase(F, PGB(k - 1), KVB(k - 1), (bf16_t*)(F.ws + OFF_O1), k - 1, F.in[21]);
            if (k <= 3) { for (int u = F.wg; u < 1024; u += GRID) ret_r1_unit(F, PGB(k), KVB(k), u); }
            xcd_barrier(bar);
#undef PGB
#undef KVB
        }
    }
    if (IN(20)) {
        bf16_t* MX = (bf16_t*)(F.ws + OFF_MIX1);
        if (RTO8) {
            pg8::GemmK g{1024, 1024, 1024, 128, 1 << 30, 0};
            pg8::DenseSched S; S.init(F.ws + OFF_O1, 1024, F.ws + W_RTOUT, 1024, T, 1024, GRID, F.wg);
            auto f = [MX](const pg8::Unit&, int row, int col, const float (&v)[8]) { float o[8];
#pragma unroll
                for (int i = 0; i < 8; ++i) o[i] = v[i] * (1.0f / (F8_SO * F8_SWO));
                store8(MX + (size_t)row * 1024 + col, o); };
            pg8::EpiRow8<decltype(f)> E{f};
            pg8::gemm_phase<decltype(E), pg8::DenseSched, false, true>(F.lds, F.wave, g, S, E);
        } else {
        pg8::GemmK g{2048, 2048, 2048, 128, 1 << 30, 0};
        pg8::DenseSched S; S.init(F.ws + OFF_O1, 2048, F.ws + W_RTOUT, 2048, T, 1024, GRID, F.wg);
        auto f = [MX](const pg8::Unit&, int row, int col, const float (&v)[8]) { store8(MX + (size_t)row * 1024 + col, v); };
        pg8::EpiRow8<decltype(f)> E{f};
        pg8::gemm_phase(F.lds, F.wave, g, S, E);
        }
        xcd_barrier(bar);
    }
    if (IN(30)) { ln1_router_phase(F, nullptr, (const bf16_t*)(F.ws + OFF_MIX1), (bf16_t*)(F.ws + OFF_XB), ln + 4 * 1024, ln + 5 * 1024, 1, MOE8_L1 ? F.ws + OFF_XB8 : nullptr); moe_weights(F, 1, MOE8_L1); }
    SEAM(30);
    if (IN(31)) moe_scatter_phase(F, nullptr, 1);
    SEAM(31);
    if (IN(32)) {
        { const int kt_ = F.wave * 64 + lane_id(); if (kt_ < 17) tile_start[kt_] = ((const int*)(F.ws + CTL_TILES))[32 + kt_]; }
        __syncthreads();
        if (MOE8_L1) {
            pg8::GemmK g{512, 512, 512, 128, 1 << 30, 0};
            pg8::MoeSched S{(const char*)(F.ws + OFF_XB8), (const char*)(F.ws + OFF_WMOE), (size_t)0, (size_t)256 * 1024, tile_start, 8, GRID, F.wg, (const int*)(F.ws + SM_ROWTOK)};
            pg8::EpiGU8 E{F.ws + OFF_H};
            pg8::gemm_phase<pg8::EpiGU8, pg8::MoeSched, true, true>(F.lds, F.wave, g, S, E);
        } else {
        pg8::GemmK g{1024, 1024, 1024, 128, 1 << 30, 0};
        pg8::MoeSched S{(const char*)(F.ws + OFF_XB), (const char*)(F.ws + OFF_WMOE), (size_t)0, (size_t)256 * 1024 * 2, tile_start, 8, GRID, F.wg, (const int*)(F.ws + SM_ROWTOK)};
        pg8::EpiGU E{(bf16_t*)(F.ws + OFF_H)};
        pg8::gemm_phase<pg8::EpiGU, pg8::MoeSched, true>(F.lds, F.wave, g, S, E);
        }
    }
    SEAM(32);
    if (IN(33)) {
        { const int kt_ = F.wave * 64 + lane_id(); if (kt_ < 17) tile_start[kt_] = ((const int*)(F.ws + CTL_TILES))[32 + kt_]; }
        __syncthreads();
        bf16_t* Y = (bf16_t*)(F.ws + OFF_XS);
        if (MOE8_L1) {
            pg8::GemmK g{512, 512, 512, 128, 1 << 30, 0};
            pg8::MoeSched S{(const char*)(F.ws + OFF_H), (const char*)(F.ws + OFF_WMOE + (size_t)16 * 2048 * 1024), (size_t)256 * 1024, (size_t)256 * 1024, tile_start, 4, GRID, F.wg};
            auto f = [Y](const pg8::Unit&, int row, int col, const float (&v)[8]) { float o[8];
#pragma unroll
                for (int i = 0; i < 8; ++i) o[i] = v[i] * (1.0f / (F8_SH * F8_SD));
                store8(Y + (size_t)row * 1024 + col, o); };
            pg8::EpiRow8<decltype(f)> E{f};
            pg8::gemm_phase<decltype(E), pg8::MoeSched, false, true>(F.lds, F.wave, g, S, E);
        } else {
        pg8::GemmK g{1024, 1024, 1024, 128, 1 << 30, 0};
        pg8::MoeSched S{(const char*)(F.ws + OFF_H), (const char*)(F.ws + OFF_WMOE + (size_t)16 * 2048 * 1024 * 2), (size_t)256 * 1024 * 2, (size_t)256 * 1024 * 2, tile_start, 4, GRID, F.wg};
        auto f = [Y](const pg8::Unit&, int row, int col, const float (&v)[8]) { store8(Y + (size_t)row * 1024 + col, v); };
        pg8::EpiRow8<decltype(f)> E{f};
        pg8::gemm_phase(F.lds, F.wave, g, S, E);
        }
    }
    SEAM(33);
    if (IN(34)) ln2_phase(F, F.out, ln + 6 * 1024, ln + 7 * 1024, (bf16_t*)(F.ws + OFF_XB), true);
#undef IN
#undef SEAM
}

extern "C" void kernel_launch(void* const* d_in, const int* in_sizes, int n_in, void* d_out, int out_size, void* d_ws, size_t ws_size, hipStream_t stream) {
    static int ready = 0;
    if (ready == 0) {
        if (n_in != 28 || out_size != T * D || ws_size < WS_END) { fprintf(stderr, "kernel_launch: unexpected shapes / workspace (%d inputs, out %d, ws %zu)\n", n_in, out_size, ws_size); ready = -1; return; }
        if (hipFuncSetAttribute((const void*)fwd_kernel, hipFuncAttributeMaxDynamicSharedMemorySize, LDS_BYTES) != hipSuccess) { fprintf(stderr, "kernel_launch: hipFuncSetAttribute failed\n"); ready = -1; return; }
        int per_cu = 0;
        if (hipOccupancyMaxActiveBlocksPerMultiprocessor(&per_cu, (const void*)fwd_kernel, NTH, LDS_BYTES) != hipSuccess || per_cu < 1) { fprintf(stderr, "kernel_launch: occupancy query says %d\n", per_cu); }
        (void)hipGetLastError();
        ready = 1;
    }
    if (ready < 0) return;
    (void)hipMemsetAsync((char*)d_ws + OFF_CTL, 0, CTL_BYTES, stream);
    Args a{};
    for (int i = 0; i < 28; ++i) a.in[i] = (const float*)d_in[i];
    a.out = (float*)d_out; a.ws = (unsigned char*)d_ws; a.ph_lo = 0; a.ph_hi = 1000;
    hipLaunchKernelGGL(fwd_kernel, dim3(GRID), dim3(NTH), LDS_BYTES, stream, a);
}
```

```cpp
#include <hip/hip_runtime.h>
#include <stdint.h>
#include <stdio.h>

#ifndef PROBE
#define PROBE 0
#endif
#define DI __device__ __forceinline__
#define LAS __attribute__((address_space(3)))
typedef unsigned short bf16_t;
typedef short bf16x8 __attribute__((ext_vector_type(8)));
typedef float f32x4 __attribute__((ext_vector_type(4)));
typedef unsigned u32x4 __attribute__((ext_vector_type(4)));
typedef unsigned u32x2 __attribute__((ext_vector_type(2)));
typedef int i32x4 __attribute__((ext_vector_type(4)));
typedef float f32x2 __attribute__((ext_vector_type(2)));

constexpr int T = 65536, D = 1024, SEQ = 8192, NB = 8;
constexpr int NTH = 512, GRID = 256;
constexpr float ALPHA = 1.41421356237309515f;
constexpr float LN_EPS = 1e-5f;
constexpr size_t MiB = (size_t)1 << 20;

constexpr size_t OFF_CTL = 0;
constexpr size_t CTL_BYTES = 256 * 1024;
constexpr size_t CTL_BAR = 0;
constexpr size_t CTL_Q = 16 * 1024;
constexpr size_t CTL_BLKCNT = 32 * 1024;
constexpr size_t CTL_TILES = 96 * 1024;
constexpr size_t OFF_SMALL = 1 * MiB;
constexpr size_t SM_ROPEN = OFF_SMALL + 0;
constexpr size_t SM_ROPER = OFF_SMALL + 1 * MiB;
constexpr size_t SM_CBIAS = OFF_SMALL + 5 * MiB;
constexpr size_t SM_TOKE = OFF_SMALL + 6 * MiB;
constexpr size_t SM_TOKW = OFF_SMALL + 7 * MiB;
constexpr size_t SM_TOKP = OFF_SMALL + 8 * MiB;
constexpr size_t SM_RNORM = OFF_SMALL + 9 * MiB;
constexpr size_t SM_KCMP = OFF_SMALL + 11 * MiB;
constexpr size_t SM_VCMPT = OFF_SMALL + 12 * MiB;
constexpr size_t SM_ROWTOK = OFF_SMALL + 13 * MiB;
constexpr size_t OFF_WSM = 16 * MiB;
constexpr size_t W_IN0 = OFF_WSM;
constexpr size_t W_OUT0 = OFF_WSM + 7 * MiB;
constexpr size_t W_RTIN = OFF_WSM + 9 * MiB;
constexpr size_t W_RTOUT = OFF_WSM + 21 * MiB;
constexpr size_t W_L1 = OFF_WSM + 25 * MiB;
constexpr size_t W_L2 = OFF_WSM + 25 * MiB + 512 * 1024;
constexpr size_t W_C1 = OFF_WSM + 27 * MiB;
constexpr size_t W_C2 = OFF_WSM + 29 * MiB;
constexpr size_t OFF_XB = 48 * MiB;
constexpr size_t OFF_BIG = 176 * MiB;
constexpr size_t OFF_MIX = OFF_BIG;
constexpr size_t OFF_H = OFF_BIG;
constexpr size_t OFF_WMOE = 448 * MiB;
constexpr size_t OFF_XS = 544 * MiB;
constexpr size_t OFF_PR = OFF_BIG;
constexpr size_t OFF_ORAW = OFF_BIG;
constexpr size_t OFF_PN = 433 * MiB;
constexpr size_t OFF_O0 = 625 * MiB;
constexpr size_t OFF_HC = 753 * MiB;
constexpr size_t OFF_PG = OFF_BIG;
constexpr size_t PG_BYTES = 192 * MiB;
constexpr size_t OFF_O1 = 560 * MiB;
constexpr size_t OFF_KV = 816 * MiB;
constexpr size_t KV_BYTES = 64 * MiB;
constexpr size_t OFF_MIX1 = OFF_BIG;
constexpr size_t OFF_XB8 = 816 * MiB;
constexpr size_t OFF_STR = 768 * MiB;
constexpr size_t OFF_XB8B = 944 * MiB;
constexpr size_t WS_END = 1008 * MiB;
constexpr bool MOE8_L0 = true, MOE8_L1 = true;
constexpr bool PGV8 = true;
constexpr int PGLD = PGV8 ? 4096 : 6144;
constexpr bool RTI8 = true;
constexpr bool RTO8 = true;
constexpr float F8_SO = 8.f, F8_SWO = 512.f;
constexpr float F8_SX = 16.f, F8_SW = 256.f, F8_SH = 8.f, F8_SD = 512.f;
constexpr int MOE_ROWS_MAX = 135168;

DI float bf2f(bf16_t b) { return __uint_as_float(((unsigned)b) << 16); }
DI bf16_t f2bf(float f) { unsigned u = __float_as_uint(f); u += 0x7FFFu + ((u >> 16) & 1u); return (bf16_t)(u >> 16); }
typedef __bf16 bf16v2_t __attribute__((ext_vector_type(2)));
DI unsigned pack2(float lo, float hi) { const bf16v2_t r = __builtin_convertvector((f32x2){lo, hi}, bf16v2_t); return __builtin_bit_cast(unsigned, r); }
DI int lane_id() { int l; asm volatile("v_mbcnt_lo_u32_b32 %0, -1, 0\n\tv_mbcnt_hi_u32_b32 %0, -1, %0" : "=v"(l)); return l; }
DI float shx(float v, int m) { const int l = lane_id(); return __int_as_float(__builtin_amdgcn_ds_bpermute((l ^ m) << 2, __float_as_int(v))); }
DI float f8sat(float x) { return __builtin_amdgcn_fmed3f(x, -448.f, 448.f); }
DI unsigned pk_fp8x4(float a, float b, float c, float d) {
    int p = __builtin_amdgcn_cvt_pk_fp8_f32(f8sat(a), f8sat(b), 0, false); p = __builtin_amdgcn_cvt_pk_fp8_f32(f8sat(c), f8sat(d), p, true); return (unsigned)p; }
DI float wave_sum(float v) {
#pragma unroll
    for (int o = 32; o; o >>= 1) v += shx(v, o);
    return v;
}
DI int lds_add(LAS int* p, int v) { return __hip_atomic_fetch_add(p, v, __ATOMIC_RELAXED, __HIP_MEMORY_SCOPE_WORKGROUP); }
DI float rcpf_(float x) { return __builtin_amdgcn_rcpf(x); }
DI float sigmoidf_(float x) { return rcpf_(1.0f + __builtin_amdgcn_exp2f(-1.44269504088896341f * x)); }
DI float siluf_(float x) { return x * sigmoidf_(x); }
DI float tanhf_(float x) { return 1.0f - 2.0f * rcpf_(1.0f + __builtin_amdgcn_exp2f(2.88539008177792681f * x)); }

#define XB_TMO      128
#define XB_XCNT(j)  (256  + 64 * (j))
#define XB_XSUB(j)  (1280 + 64 * (j))
#define XB_XGEN(j)  (2304 + 64 * (j))
#define XB_TOP      3328
#define XB_TOPGEN   3392
#define XCD_BAR_WORDS 3456
#define XB_SPIN_CAP (1u << 24)

DI unsigned xb_ld(unsigned* p)              { return __hip_atomic_load(p, __ATOMIC_RELAXED, __HIP_MEMORY_SCOPE_AGENT); }
DI unsigned xb_add(unsigned* p, unsigned v) { return __hip_atomic_fetch_add(p, v, __ATOMIC_RELAXED, __HIP_MEMORY_SCOPE_AGENT); }
DI unsigned xb_xcc_id() { return (unsigned)__builtin_amdgcn_s_getreg((3 << 11) | 20) & 0xFu; }
#define XB_SPIN(cond, bar) do { unsigned _sp = 0; while (cond) { __builtin_amdgcn_s_sleep(1); \
    if ((++_sp & 255u) == 0u) { if (xb_ld(&(bar)[XB_TMO])) break; if (_sp > XB_SPIN_CAP) { atomicAdd(&(bar)[XB_TMO], 1u); break; } } } } while (0)

struct XcdBarrier { unsigned* bar; unsigned x; volatile LAS unsigned* st; };

DI XcdBarrier xcd_barrier_post(unsigned* bar, volatile LAS unsigned* st) {
    XcdBarrier b; b.bar = bar; b.x = xb_xcc_id(); b.st = st;
    if (threadIdx.x == 0) (void)xb_add(&bar[XB_XCNT(b.x)], 1u);
    return b;
}
DI void xcd_barrier_complete(unsigned* bar, unsigned x, unsigned& nloc, unsigned& nx) {
    const unsigned G = gridDim.x * gridDim.y * gridDim.z;
    unsigned sum, cnt, mine, sp = 0u;
    for (;;) {
        sum = 0u; cnt = 0u; mine = 0u;
#pragma unroll
        for (unsigned j = 0; j < 16; ++j) { const unsigned c = xb_ld(&bar[XB_XCNT(j)]); sum += c; cnt += (c > 0u) ? 1u : 0u; mine = (j == x) ? c : mine; }
        if (sum == G) break;
        __builtin_amdgcn_s_sleep(1);
        if ((++sp & 255u) == 0u) { if (xb_ld(&bar[XB_TMO])) break; if (sp > XB_SPIN_CAP) { atomicAdd(&bar[XB_TMO], 1u); break; } }
    }
    nloc = mine > 0u ? mine : 1u; nx = cnt > 0u ? cnt : 1u;
}
DI void xcd_barrier(const XcdBarrier& b) {
    asm volatile("s_waitcnt vmcnt(0)" ::: "memory");
    __syncthreads();
    if (threadIdx.x == 0) {
        unsigned* bar = b.bar;
        __builtin_amdgcn_s_waitcnt(0);
        unsigned nloc = b.st[0], nx = b.st[1];
        if (nloc == 0u) { xcd_barrier_complete(bar, b.x, nloc, nx); b.st[0] = nloc; b.st[1] = nx; }
        const unsigned old = xb_add(&bar[XB_XSUB(b.x)], 1u);
        const unsigned gen = old / nloc;
        if (old + 1u == (gen + 1u) * nloc) {
            __builtin_amdgcn_fence(__ATOMIC_RELEASE, "agent");
            asm volatile("s_waitcnt vmcnt(0)" ::: "memory");
            const unsigned og = xb_add(&bar[XB_TOP], 1u);
            const unsigned tg = og / nx;
            if (og + 1u == (tg + 1u) * nx) xb_add(&bar[XB_TOPGEN], 1u);
            else XB_SPIN(xb_ld(&bar[XB_TOPGEN]) == tg, bar);
            __builtin_amdgcn_fence(__ATOMIC_ACQUIRE, "agent");
            xb_add(&bar[XB_XGEN(b.x)], 1u);
            asm volatile("s_waitcnt vmcnt(0)" ::: "memory");
        } else {
            XB_SPIN(xb_ld(&bar[XB_XGEN(b.x)]) == gen, bar);
            __builtin_amdgcn_fence(__ATOMIC_ACQUIRE, "agent");
            asm volatile("s_waitcnt vmcnt(0)" ::: "memory");
        }
    }
    __syncthreads();
}

namespace pg8 {
constexpr int BM = 256, BK = 64, HALF = 128, HTB = HALF * BK * 2, STAGE_BYTES = 8 * HTB, NXCD = 8, WGM = 8;
DI int lds_byte(int r, int c) { const int st = (r >> 4) * 2 + (c >> 5), rr = r & 15, cc = c & 31, ob = rr * 64 + cc * 2; return st * 1024 + (ob ^ (((ob >> 9) & 1) << 5)); }
DI void stage_rc(int b, int& R, int& C) { const int st = b / 1024, sb = b % 1024, swz = sb ^ (((sb >> 9) & 1) << 5); R = (st >> 1) * 16 + swz / 64; C = (st & 1) * 32 + (swz % 64) / 2; }
DI int perm32(int rho) { const int n = rho >> 4, i = rho & 15; return 8 * (i >> 2) + 4 * n + (i & 3); }

struct Unit { const char* a; const char* b; int pm, pn, aux; const int* rows; };
struct GemmK { int lda, ldb, K, kstepA, ksplit, kjump; };

template <class Epi, class Sched, bool GATHER = false, bool F8 = false>
DI void gemm_phase(LAS unsigned char* lds, int wave_, const GemmK g, const Sched& S, const Epi& E) {
    int tid = wave_ * 64 + lane_id(); asm volatile("" : "+v"(tid));
    const int wid = __builtin_amdgcn_readfirstlane(tid >> 6), lane = tid & 63, wr = wid >> 2, wc = wid & 3, fr = lane & 15, fq = lane >> 4;
    const int nt = g.K / BK;
    unsigned voffA[2], voffB[2], cA2[2]; int rA[2]; unsigned vgc[2][2], vgn[2][2];
#pragma unroll
    for (int i = 0; i < 2; ++i) { int R, C; stage_rc(tid * 16 + i * 8192, R, C); const int Rb = Epi::PERM ? ((R & ~31) + perm32(R & 31)) : R;
        voffA[i] = (unsigned)(R * g.lda + C) * 2u; voffB[i] = (unsigned)(Rb * g.ldb + C) * 2u; rA[i] = R; cA2[i] = (unsigned)C * 2u; }
    const size_t kstepA = (size_t)g.kstepA, kstepB = (size_t)(BK * 2);
    const size_t hstepA = (size_t)HALF * g.lda * 2, hstepB = (size_t)HALF * g.ldb * 2;
    const unsigned ldsw = (unsigned)wid * 1024u;
    const int aoff = lds_byte(wr * 64 + fr, fq * 8), boff = lds_byte(wc * 32 + fr, fq * 8);
#define PG8_AK(base, kt) ((base) + (size_t)(kt) * kstepA + (((kt) >= g.ksplit) ? (long)g.kjump : 0l))
#define PG8_SA(b, h) (((b) * 2 + (h)) * HTB)
#define PG8_SB(b, h) ((4 + (b) * 2 + (h)) * HTB)
#define PG8_STAGE(bufoff, gbase, voff) do { _Pragma("unroll") for (int _i = 0; _i < 2; ++_i) \
        __builtin_amdgcn_global_load_lds((const unsigned*)((const char*)(gbase) + (voff)[_i]), (LAS unsigned*)(lds + (bufoff) + ldsw + _i * 8192), 16, 0, 0); } while (0)
#define PG8_STAGE_A(bufoff, kbase, h, nx) do { if (GATHER) { _Pragma("unroll") for (int _i = 0; _i < 2; ++_i) { const unsigned _vo = (nx) ? vgn[h][_i] : vgc[h][_i]; \
        __builtin_amdgcn_global_load_lds((const unsigned*)((const char*)(kbase) + _vo), (LAS unsigned*)(lds + (bufoff) + ldsw + _i * 8192), 16, 0, 0); } } \
        else PG8_STAGE(bufoff, (kbase) + (h) * hstepA, voffA); } while (0)
#define PG8_ROWS(dst, u) do { if (GATHER) { _Pragma("unroll") for (int _h = 0; _h < 2; ++_h) _Pragma("unroll") for (int _i = 0; _i < 2; ++_i) dst[_h][_i] = (unsigned)(u).rows[128 * _h + rA[_i]] * (unsigned)(g.lda * 2) + cA2[_i]; } } while (0)
#define PG8_LDA(dst, b, h) do { _Pragma("unroll") for (int m = 0; m < 4; ++m) _Pragma("unroll") for (int k = 0; k < 2; ++k) dst[m][k] = *(const LAS bf16x8*)(lds + PG8_SA(b, h) + aoff + m * 2048 + k * 1024); } while (0)
#define PG8_LDB(dst, b, h) do { _Pragma("unroll") for (int n = 0; n < 2; ++n) _Pragma("unroll") for (int k = 0; k < 2; ++k) dst[n][k] = *(const LAS bf16x8*)(lds + PG8_SB(b, h) + boff + n * 2048 + k * 1024); } while (0)
#define PG8_CAT(x, y) __builtin_shufflevector(__builtin_bit_cast(i32x4, x), __builtin_bit_cast(i32x4, y), 0, 1, 2, 3, 4, 5, 6, 7)
#define PG8_MMA(ai, bj, At, Bt) do { __builtin_amdgcn_s_setprio(1); \
        if (F8) { _Pragma("unroll") for (int m = 0; m < 4; ++m) _Pragma("unroll") for (int n = 0; n < 2; ++n) \
            asm volatile("v_mfma_f32_16x16x128_f8f6f4 %0, %1, %2, %0" : "+v"(acc[ai][bj][m][n]) : "v"(PG8_CAT(Bt[n][0], Bt[n][1])), "v"(PG8_CAT(At[m][0], At[m][1]))); }     \
        else { _Pragma("unroll") for (int m = 0; m < 4; ++m) _Pragma("unroll") for (int n = 0; n < 2; ++n) _Pragma("unroll") for (int k = 0; k < 2; ++k) \
            acc[ai][bj][m][n] = __builtin_amdgcn_mfma_f32_16x16x32_bf16(Bt[n][k], At[m][k], acc[ai][bj][m][n], 0, 0, 0); } \
        __builtin_amdgcn_s_setprio(0); } while (0)
#define PG8_WAIT_V(n) asm volatile("s_waitcnt vmcnt(" #n ")" ::: "memory")
#define PG8_WAIT_L(n) asm volatile("s_waitcnt lgkmcnt(" #n ")" ::: "memory")
#define PG8_BAR __builtin_amdgcn_s_barrier()
#define PG8_SCHED __builtin_amdgcn_sched_barrier(0)
    Unit cur, nxt; int ui = 0;
    if (!S.next(0, cur)) return;
    f32x4 acc[2][2][4][2];
#pragma unroll
    for (int a = 0; a < 2; ++a)
#pragma unroll
        for (int b = 0; b < 2; ++b)
#pragma unroll
            for (int m = 0; m < 4; ++m)
#pragma unroll
                for (int n = 0; n < 2; ++n) acc[a][b][m][n] = (f32x4){0.f, 0.f, 0.f, 0.f};
    bf16x8 At[4][2], B0[2][2], B1[2][2];
    const char* cA = cur.a; const char* cB = cur.b;
    PG8_ROWS(vgc, cur);
    PG8_STAGE(PG8_SB(0, 0), cB, voffB); PG8_STAGE_A(PG8_SA(0, 0), cA, 0, false); PG8_STAGE(PG8_SB(0, 1), cB + hstepB, voffB); PG8_STAGE_A(PG8_SA(0, 1), cA, 1, false);
    if (wr == 1) PG8_BAR;
    PG8_WAIT_V(4); PG8_BAR;
    PG8_STAGE(PG8_SB(1, 0), cB + kstepB, voffB); PG8_STAGE_A(PG8_SA(1, 0), PG8_AK(cA, 1), 0, false); PG8_STAGE(PG8_SB(1, 1), cB + hstepB + kstepB, voffB);
    PG8_WAIT_V(6); PG8_BAR;
    for (;;) {
        const bool has_next = S.next(ui + 1, nxt);
        const char* nA = has_next ? nxt.a : cA; const char* nB = has_next ? nxt.b : cB;
        if (GATHER) { if (has_next) PG8_ROWS(vgn, nxt); else { _Pragma("unroll") for (int _h = 0; _h < 2; ++_h) _Pragma("unroll") for (int _i = 0; _i < 2; ++_i) vgn[_h][_i] = vgc[_h][_i]; } }
#pragma unroll 1
        for (int t = 0; t < nt; t += 2) {
            const bool last = (t == nt - 2);
            const char* a1 = PG8_AK(cA, t + 1);
            const char* a2 = last ? nA : PG8_AK(cA, t + 2); const char* b2 = last ? nB : cB + (size_t)(t + 2) * kstepB;
            const char* a3 = last ? PG8_AK(nA, 1) : PG8_AK(cA, t + 3); const char* b3 = b2 + kstepB;
            PG8_LDB(B0, 0, 0); PG8_SCHED; PG8_LDA(At, 0, 0); PG8_STAGE_A(PG8_SA(1, 1), a1, 1, false);
            PG8_WAIT_L(8); PG8_BAR; PG8_WAIT_L(0); PG8_MMA(0, 0, At, B0); PG8_BAR; PG8_SCHED;
            PG8_LDB(B1, 0, 1); PG8_STAGE(PG8_SB(0, 0), b2, voffB);
            PG8_BAR; PG8_WAIT_L(0); PG8_MMA(0, 1, At, B1); PG8_BAR;
            PG8_LDA(At, 0, 1); PG8_STAGE_A(PG8_SA(0, 0), a2, 0, last);
            PG8_BAR; PG8_WAIT_L(0); PG8_MMA(1, 0, At, B0); PG8_BAR; PG8_SCHED;
            PG8_STAGE(PG8_SB(0, 1), b2 + hstepB, voffB);
            PG8_WAIT_V(6); PG8_BAR; PG8_MMA(1, 1, At, B1); PG8_BAR;
            PG8_LDB(B0, 1, 0); PG8_SCHED; PG8_LDA(At, 1, 0); PG8_STAGE_A(PG8_SA(0, 1), a2, 1, last);
            PG8_WAIT_L(8); PG8_BAR; PG8_WAIT_L(0); PG8_MMA(0, 0, At, B0); PG8_BAR; PG8_SCHED;
            PG8_LDB(B1, 1, 1); PG8_STAGE(PG8_SB(1, 0), b3, voffB);
            PG8_BAR; PG8_WAIT_L(0); PG8_MMA(0, 1, At, B1); PG8_BAR;
            PG8_LDA(At, 1, 1); PG8_STAGE_A(PG8_SA(1, 0), a3, 0, last);
            PG8_BAR; PG8_WAIT_L(0); PG8_MMA(1, 0, At, B0); PG8_BAR; PG8_SCHED;
            PG8_STAGE(PG8_SB(1, 1), b3 + hstepB, voffB);
            PG8_WAIT_V(6); PG8_BAR; PG8_MMA(1, 1, At, B1); PG8_BAR;
        }
        if (F8) {
#pragma unroll
            for (int a = 0; a < 2; ++a)
#pragma unroll
                for (int b = 0; b < 2; ++b) {
                    if (a == 0 && b == 0) asm volatile("s_nop 15\n\ts_nop 15" : "+v"(acc[a][b][0][0]), "+v"(acc[a][b][0][1]), "+v"(acc[a][b][1][0]), "+v"(acc[a][b][1][1]), "+v"(acc[a][b][2][0]), "+v"(acc[a][b][2][1]), "+v"(acc[a][b][3][0]), "+v"(acc[a][b][3][1]));
                    else asm volatile("" : "+v"(acc[a][b][0][0]), "+v"(acc[a][b][0][1]), "+v"(acc[a][b][1][0]), "+v"(acc[a][b][1][1]), "+v"(acc[a][b][2][0]), "+v"(acc[a][b][2][1]), "+v"(acc[a][b][3][0]), "+v"(acc[a][b][3][1])); } }
        E(acc, cur, wr, wc, fr, fq);
        if (!has_next) break;
#pragma unroll
        for (int a = 0; a < 2; ++a)
#pragma unroll
            for (int b = 0; b < 2; ++b)
#pragma unroll
                for (int m = 0; m < 4; ++m)
#pragma unroll
                    for (int n = 0; n < 2; ++n) acc[a][b][m][n] = (f32x4){0.f, 0.f, 0.f, 0.f};
        cur = nxt; cA = nA; cB = nB; ++ui;
        if (GATHER) { _Pragma("unroll") for (int _h = 0; _h < 2; ++_h) _Pragma("unroll") for (int _i = 0; _i < 2; ++_i) vgc[_h][_i] = vgn[_h][_i]; }
    }
    PG8_WAIT_V(0);
    if (wr == 0) PG8_BAR;
    PG8_BAR;
#undef PG8_AK
#undef PG8_SA
#undef PG8_SB
#undef PG8_STAGE
#undef PG8_STAGE_A
#undef PG8_ROWS
#undef PG8_LDA
#undef PG8_LDB
#undef PG8_MMA
#undef PG8_CAT
#undef PG8_WAIT_V
#undef PG8_WAIT_L
#undef PG8_BAR
#undef PG8_SCHED
}

struct DenseSched {
    const char* A; const char* B; size_t tstepA, tstepB; int nM, nN, nwg, G, c; int prp;
    DI void init(const void* A_, int lda, const void* B_, int ldb, int M, int N, int G_, int c_, int prp_ = 0) {
        A = (const char*)A_; B = (const char*)B_; tstepA = (size_t)BM * lda * 2; tstepB = (size_t)BM * ldb * 2; nM = M / BM; nN = N / BM; nwg = nM * nN; G = G_; c = c_; prp = prp_; }
    DI bool next(int i, Unit& u) const {
        const long L = (long)i * G + c; if (L >= nwg) return false;
        int wgid = (int)L; { const int q = nwg / NXCD, r = nwg % NXCD, xcd = wgid % NXCD, off = wgid / NXCD; wgid = (xcd < r ? xcd * (q + 1) : r * (q + 1) + (xcd - r) * q) + off; }
        const int nig = WGM * nN, gid = wgid / nig, fm = gid * WGM, gsz = (nM - fm) < WGM ? (nM - fm) : WGM;
        u.pm = fm + ((wgid % nig) % gsz); u.pn = (wgid % nig) / gsz; u.aux = 0;
        u.a = A + (size_t)u.pm * tstepA + (prp ? (size_t)((u.pm >> 5) + 1) * (tstepA / BM) : (size_t)0);
        u.b = B + (size_t)u.pn * tstepB; u.rows = nullptr;
        return true;
    }
};
struct MoeSched {
    const char* A; const char* B; size_t tstepA, tstepB; const LAS int* ts; int nN, G, c; const int* rowtab;
    DI bool next(int i, Unit& u) const {
        const long L0 = (long)i * G + c; const int nwg = ts[16] * nN; if (L0 >= nwg) return false;
        int L = (int)L0; { const int q = nwg / NXCD, r = nwg % NXCD, xcd = L % NXCD, off = L / NXCD; L = (xcd < r ? xcd * (q + 1) : r * (q + 1) + (xcd - r) * q) + off; }
        const int rt = L / nN, pn = L % nN;
        int e = 0;
#pragma unroll
        for (int j = 1; j < 16; ++j) e += (rt >= ts[j]) ? 1 : 0;
        u.pm = rt; u.pn = pn; u.aux = e;
        u.a = rowtab ? A : A + (size_t)rt * tstepA; u.b = B + (size_t)(e * nN + pn) * tstepB; u.rows = rowtab ? rowtab + rt * 256 : nullptr;
        return true;
    }
};

template <class F> struct EpiRow8 {
    static constexpr bool PERM = true;
    F f;
    DI void operator()(const f32x4 (&acc)[2][2][4][2], const Unit& u, int wr, int wc, int fr, int fq) const {
#pragma unroll
        for (int ai = 0; ai < 2; ++ai)
#pragma unroll
            for (int m = 0; m < 4; ++m) {
                const int row = u.pm * BM + ai * HALF + wr * 64 + m * 16 + fr;
#pragma unroll
                for (int bj = 0; bj < 2; ++bj) {
                    const int col = u.pn * BM + bj * HALF + wc * 32 + 8 * fq;
                    float v[8];
#pragma unroll
                    for (int j = 0; j < 4; ++j) { v[j] = acc[ai][bj][m][0][j]; v[4 + j] = acc[ai][bj][m][1][j]; }
                    f(u, row, col, v);
                }
            }
    }
};
struct EpiF32 {
    static constexpr bool PERM = false;
    float* C; int ldc;
    DI void operator()(const f32x4 (&acc)[2][2][4][2], const Unit& u, int wr, int wc, int fr, int fq) const {
        const int row0 = u.pm * BM + wr * 64 + fr, col0 = u.pn * BM + wc * 32 + 4 * fq;
#pragma unroll
        for (int ai = 0; ai < 2; ++ai)
#pragma unroll
            for (int m = 0; m < 4; ++m) { float* rowp = C + (size_t)(row0 + ai * HALF + m * 16) * ldc + col0;
#pragma unroll
                for (int bj = 0; bj < 2; ++bj)
#pragma unroll
                    for (int n = 0; n < 2; ++n) *(f32x4*)(rowp + bj * HALF + n * 16) = acc[ai][bj][m][n]; }
    }
};
struct EpiGU {
    static constexpr bool PERM = true;
    bf16_t* H;
    DI void operator()(const f32x4 (&acc)[2][2][4][2], const Unit& u, int wr, int wc, int fr, int fq) const {
#pragma unroll
        for (int ai = 0; ai < 2; ++ai)
#pragma unroll
            for (int m = 0; m < 4; ++m) {
                const int row = u.pm * BM + ai * HALF + wr * 64 + m * 16 + fr;
                const int col = u.pn * HALF + wc * 32 + 8 * fq;
                float h[8];
#pragma unroll
                for (int j = 0; j < 4; ++j) {
                    const float g0 = acc[ai][0][m][0][j], u0 = acc[ai][1][m][0][j], g1 = acc[ai][0][m][1][j], u1 = acc[ai][1][m][1][j];
                    h[j] = siluf_(g0) * u0; h[4 + j] = siluf_(g1) * u1;
                }
                u32x4 o; o[0] = pack2(h[0], h[1]); o[1] = pack2(h[2], h[3]); o[2] = pack2(h[4], h[5]); o[3] = pack2(h[6], h[7]);
                *(u32x4*)(H + (size_t)row * 1024 + col) = o;
            }
    }
};
struct EpiGU8 {
    static constexpr bool PERM = true;
    unsigned char* H;
    DI void operator()(const f32x4 (&acc)[2][2][4][2], const Unit& u, int wr, int wc, int fr, int fq) const {
        constexpr float SI = 1.0f / (F8_SX * F8_SW);
#pragma unroll
        for (int ai = 0; ai < 2; ++ai)
#pragma unroll
            for (int m = 0; m < 4; ++m) {
                const int row = u.pm * BM + ai * HALF + wr * 64 + m * 16 + fr;
                const int col = u.pn * HALF + wc * 32 + 8 * fq;
                float h[8];
#pragma unroll
                for (int j = 0; j < 4; ++j) {
                    const float g0 = acc[ai][0][m][0][j] * SI, u0 = acc[ai][1][m][0][j] * (SI * F8_SH), g1 = acc[ai][0][m][1][j] * SI, u1 = acc[ai][1][m][1][j] * (SI * F8_SH);
                    h[j] = siluf_(g0) * u0; h[4 + j] = siluf_(g1) * u1;
                }
                u32x2 o; o[0] = pk_fp8x4(h[0], h[1], h[2], h[3]); o[1] = pk_fp8x4(h[4], h[5], h[6], h[7]);
                *(u32x2*)(H + (size_t)row * 1024 + col) = o;
            }
    }
};
}

DI void unpack8(const u32x4 a, float (&o)[8]) {
#pragma unroll
    for (int i = 0; i < 4; ++i) { o[2 * i] = __uint_as_float(a[i] << 16); o[2 * i + 1] = __uint_as_float(a[i] & 0xffff0000u); }
}
DI u32x4 pack8(const float (&v)[8]) { u32x4 o; o[0] = pack2(v[0], v[1]); o[1] = pack2(v[2], v[3]); o[2] = pack2(v[4], v[5]); o[3] = pack2(v[6], v[7]); return o; }
DI void store8(bf16_t* p, const float (&v)[8]) {
    u32x4 o; o[0] = pack2(v[0], v[1]); o[1] = pack2(v[2], v[3]); o[2] = pack2(v[4], v[5]); o[3] = pack2(v[6], v[7]);
    *(u32x4*)p = o;
}

struct Args { const float* in[28]; float* out; unsigned char* ws; int ph_lo, ph_hi; };
struct Frame {
    LAS unsigned char* lds; int tid, lane, wave, wg;
    unsigned char* ws; float* out; const float* const* in;
};

constexpr int LDS_SCR = 1024;
constexpr int LDS_BYTES = 1024 + 155 * 1024;

struct TrTile { const float* src; int ldsrc, N; bf16_t* dst; int ldd, rowmode, k0, n0; float f8; };
DI void tr_load(const Frame& F, const TrTile& d, f32x4 (&v)[2]) {
#pragma unroll
    for (int i = 0; i < 2; ++i) { const int kk = (F.tid >> 4) + 32 * i, n4 = (F.tid & 15) * 4;
        v[i] = (d.n0 + n4 < d.N) ? *(const f32x4*)(d.src + (size_t)(d.k0 + kk) * d.ldsrc + d.n0 + n4) : (f32x4){0.f, 0.f, 0.f, 0.f}; }
}
template <class Desc> DI void tr_run(const Frame& F, int ntiles, Desc desc) {
    LAS float* tile = (LAS float*)F.lds;
    const int nq = ntiles >> 2;
    int id = F.wg; if (id >= nq) return;
    TrTile d[4]; f32x4 v[4][2];
#pragma unroll
    for (int s4 = 0; s4 < 4; ++s4) { d[s4] = desc(4 * id + s4); tr_load(F, d[s4], v[s4]); }
    for (;;) {
        __syncthreads();
#pragma unroll
        for (int s4 = 0; s4 < 4; ++s4)
#pragma unroll
            for (int i = 0; i < 2; ++i) { const int kk = (F.tid >> 4) + 32 * i, n4 = (F.tid & 15) * 4;
#pragma unroll
                for (int e = 0; e < 4; ++e) tile[s4 * (64 * 65) + kk * 65 + n4 + e] = v[s4][i][e]; }
        __syncthreads();
        TrTile cur[4];
#pragma unroll
        for (int s4 = 0; s4 < 4; ++s4) cur[s4] = d[s4];
        const int nid = id + GRID; const bool more = nid < nq;
        if (more) {
#pragma unroll
            for (int s4 = 0; s4 < 4; ++s4) { d[s4] = desc(4 * nid + s4); tr_load(F, d[s4], v[s4]); } }
#pragma unroll
        for (int s4 = 0; s4 < 4; ++s4) { const TrTile& c = cur[s4]; const int nn = F.tid >> 3, kc = (F.tid & 7) * 8; const int n = c.n0 + nn;
          const int r = c.rowmode == 0 ? n : (c.rowmode == 3 ? (n < 2048 ? ((n & ~127) + 2 * (n & 63) + ((n >> 6) & 1)) : n) : ((n >> 7) * 256 + (n & 127) + (c.rowmode == 2 ? 128 : 0)));
          float o[8];
#pragma unroll
          for (int e = 0; e < 8; ++e) o[e] = tile[s4 * (64 * 65) + (kc + e) * 65 + nn];
          if (c.f8 != 0.f) { u32x2 w; w[0] = pk_fp8x4(o[0] * c.f8, o[1] * c.f8, o[2] * c.f8, o[3] * c.f8); w[1] = pk_fp8x4(o[4] * c.f8, o[5] * c.f8, o[6] * c.f8, o[7] * c.f8);
              *(u32x2*)((unsigned char*)c.dst + (size_t)r * c.ldd + c.k0 + kc) = w; }
          else store8(c.dst + (size_t)r * c.ldd + c.k0 + kc, o); }
        if (!more) break;
        id = nid;
    }
    __syncthreads();
}
DI void tr_job(const Frame& F, const float* src, int ldsrc, int K, int N, int Npad, bf16_t* dst, int ldd, int rowmode, float f8 = 0.f) {
    const int tn = Npad / 64, n = (K / 64) * tn;
    tr_run(F, n, [=](int i) { return TrTile{src, ldsrc, N, dst, ldd, rowmode, (i / tn) * 64, (i % tn) * 64, f8}; });
}
DI void moe_weights(const Frame& F0, int layer, const bool f8 = false) {
    Frame F = F0; F.tid = F.wave * 64 + lane_id(); asm volatile("" : "+v"(F.tid)); F.lane = F.tid & 63;
    const size_t esz = f8 ? 1 : 2;
    unsigned char* wgu = F.ws + OFF_WMOE; unsigned char* wd = wgu + (size_t)16 * 2048 * 1024 * esz;
    const size_t lo_ = (size_t)layer * 16 * 1024 * 1024;
    const float* g = F.in[24] + lo_; const float* u = F.in[25] + lo_; const float* dn = F.in[26] + lo_;
    const float sgu = f8 ? F8_SW : 0.f, sdn = f8 ? F8_SD : 0.f;
    tr_run(F, 16 * 256, [=](int id) { const int e = id >> 8, tl = id & 255; return TrTile{g + (size_t)e * 1024 * 1024, 1024, 1024, (bf16_t*)(wgu + (size_t)e * 2048 * 1024 * esz), 1024, 1, (tl >> 4) * 64, (tl & 15) * 64, sgu}; });
    tr_run(F, 16 * 256, [=](int id) { const int e = id >> 8, tl = id & 255; return TrTile{u + (size_t)e * 1024 * 1024, 1024, 1024, (bf16_t*)(wgu + (size_t)e * 2048 * 1024 * esz), 1024, 2, (tl >> 4) * 64, (tl & 15) * 64, sgu}; });
    tr_run(F, 16 * 256, [=](int id) { const int e = id >> 8, tl = id & 255; return TrTile{dn + (size_t)e * 1024 * 1024, 1024, 1024, (bf16_t*)(wd + (size_t)e * 1024 * 1024 * esz), 1024, 0, (tl >> 4) * 64, (tl & 15) * 64, sdn}; });
}

DI void ln1_router_phase(const Frame& F0, const float* xin  , const bf16_t* mix, bf16_t* xb, const float* lng, const float* lnb, int layer, unsigned char* xb8 = nullptr  ) {
    Frame F = F0; F.tid = F.wave * 64 + lane_id(); asm volatile("" : "+v"(F.tid)); F.lane = F.tid & 63;
    LAS float* tile = (LAS float*)F.lds;
    LAS float* part = (LAS float*)(F.lds + 16 * 1028 * 4);
    LAS float* lgt = part + 8 * 256;
    LAS float* scr = lgt + 256;
    LAS int* hist = (LAS int*)(scr + 256);
    const float* rw = F.in[22]; const float* rb = F.in[23];
    const int lane = F.lane, w = F.wave, fr = lane & 15, fq = lane >> 4;
    if (F.tid < 16) hist[F.tid] = 0;
    float bfrag[32];
#pragma unroll
    for (int s = 0; s < 32; ++s) bfrag[s] = rw[(size_t)(128 * w + 4 * s + fq) * 16 + fr];
    f32x4 gv[4], bv[4];
#pragma unroll
    for (int j = 0; j < 4; ++j) { gv[j] = *(const f32x4*)(lng + j * 256 + lane * 4); bv[j] = *(const f32x4*)(lnb + j * 256 + lane * 4); }
    int* tok_e = (int*)(F.ws + SM_TOKE); float* tok_w = (float*)(F.ws + SM_TOKW);
    const int t0 = F.wg * 256;
    f32x4 xv[2][4]; u32x2 mv[2][4];
    auto issue_rows = [&](int grp) {
#pragma unroll
        for (int rr = 0; rr < 2; ++rr) { const size_t t = (size_t)t0 + grp * 16 + 2 * w + rr;
#pragma unroll
            for (int j = 0; j < 4; ++j) {
                if (xin) xv[rr][j] = *(const f32x4*)(xin + t * D + j * 256 + lane * 4);
                else { const u32x2 xr = *(const u32x2*)(xb + t * D + j * 256 + lane * 4); xv[rr][j] = (f32x4){__uint_as_float(xr[0] << 16), __uint_as_float(xr[0] & 0xffff0000u), __uint_as_float(xr[1] << 16), __uint_as_float(xr[1] & 0xffff0000u)}; }
                if (mix) mv[rr][j] = *(const u32x2*)(mix + t * D + j * 256 + lane * 4); } }
    };
    issue_rows(0);
    for (int grp = 0; grp < 16; ++grp) {
        __syncthreads();
#pragma unroll
        for (int rr = 0; rr < 2; ++rr) {
            const int i = 2 * w + rr; const size_t t = (size_t)t0 + grp * 16 + i;
            f32x4 y[4]; float s = 0.f;
#pragma unroll
            for (int j = 0; j < 4; ++j) { y[j] = xv[rr][j] * ALPHA;
                if (mix) { const u32x2 m2 = mv[rr][j]; y[j] += (f32x4){__uint_as_float(m2[0] << 16), __uint_as_float(m2[0] & 0xffff0000u), __uint_as_float(m2[1] << 16), __uint_as_float(m2[1] & 0xffff0000u)}; }
                s += y[j][0] + y[j][1] + y[j][2] + y[j][3]; }
            const float mean = wave_sum(s) * (1.0f / D); float q = 0.f;
#pragma unroll
            for (int j = 0; j < 4; ++j) { y[j] -= mean; q += y[j][0] * y[j][0] + y[j][1] * y[j][1] + y[j][2] * y[j][2] + y[j][3] * y[j][3]; }
            const float rstd = rsqrtf(wave_sum(q) * (1.0f / D) + LN_EPS);
#pragma unroll
            for (int j = 0; j < 4; ++j) { f32x4 o = y[j] * rstd * gv[j] + bv[j];
                { u32x2 ob; ob[0] = pack2(o[0], o[1]); ob[1] = pack2(o[2], o[3]); *(u32x2*)(xb + t * D + j * 256 + lane * 4) = ob; }
                if (xb8) *(unsigned*)(xb8 + t * D + j * 256 + lane * 4) = pk_fp8x4(o[0] * F8_SX, o[1] * F8_SX, o[2] * F8_SX, o[3] * F8_SX);
                *(LAS f32x4*)(tile + i * 1028 + j * 256 + lane * 4) = o; }
        }
        if (grp + 1 < 16) issue_rows(grp + 1);
        __syncthreads();
        f32x4 acc = (f32x4){0.f, 0.f, 0.f, 0.f};
#pragma unroll
        for (int s = 0; s < 32; ++s) { const float a = tile[fr * 1028 + 128 * w + 4 * s + fq]; acc = __builtin_amdgcn_mfma_f32_16x16x4f32(a, bfrag[s], acc, 0, 0, 0); }
#pragma unroll
        for (int r = 0; r < 4; ++r) part[w * 256 + (4 * fq + r) * 16 + fr] = acc[r];
        __syncthreads();
        if (F.tid < 256) { float s = 0.f;
#pragma unroll
            for (int ww = 0; ww < 8; ++ww) s += part[ww * 256 + F.tid];
            const float aff = sigmoidf_(s); lgt[F.tid] = aff; scr[F.tid] = aff + rb[F.tid & 15]; }
        __syncthreads();
        if (F.tid < 16) {
            const int i = F.tid; const LAS float* sc = scr + i * 16; const LAS float* af = lgt + i * 16;
            int bg = 0; float bs = -1e30f;
#pragma unroll
            for (int gr = 0; gr < 4; ++gr) { const float a = sc[4 * gr], b = sc[4 * gr + 1], c = sc[4 * gr + 2], d = sc[4 * gr + 3];
                const float x = fmaxf(a, b), yv = fminf(a, b), z = fmaxf(c, d), u = fminf(c, d);
                const float top2 = fmaxf(x, z) + fmaxf(fminf(x, z), fmaxf(yv, u));
                if (top2 > bs) { bs = top2; bg = gr; } }
            const float v0 = sc[4 * bg], v1 = sc[4 * bg + 1], v2 = sc[4 * bg + 2], v3 = sc[4 * bg + 3];
            int l0 = 0; float m0 = v0; if (v1 > m0) { m0 = v1; l0 = 1; } if (v2 > m0) { m0 = v2; l0 = 2; } if (v3 > m0) { m0 = v3; l0 = 3; }
            int l1 = -1; float m1 = -1e30f;
            if (l0 != 0 && v0 > m1) { m1 = v0; l1 = 0; } if (l0 != 1 && v1 > m1) { m1 = v1; l1 = 1; } if (l0 != 2 && v2 > m1) { m1 = v2; l1 = 2; } if (l0 != 3 && v3 > m1) { m1 = v3; l1 = 3; }
            const int e0 = 4 * bg + l0, e1 = 4 * bg + l1; const float a0 = af[e0], a1 = af[e1], inv = rcpf_(a0 + a1);
            const size_t t = (size_t)t0 + grp * 16 + i;
            tok_e[2 * t] = e0; tok_e[2 * t + 1] = e1; tok_w[2 * t] = a0 * inv; tok_w[2 * t + 1] = a1 * inv;
            lds_add(&hist[e0], 1); lds_add(&hist[e1], 1);
        }
    }
    __syncthreads();
    if (F.tid < 16) ((int*)(F.ws + CTL_BLKCNT))[(layer * 256 + F.wg) * 16 + F.tid] = hist[F.tid];
    __syncthreads();
}

DI void moe_scatter_phase(const Frame& F0, const float* xa, int layer) {
    Frame F = F0; F.tid = F.wave * 64 + lane_id(); asm volatile("" : "+v"(F.tid)); F.lane = F.tid & 63;
    LAS int* tot = (LAS int*)F.lds; LAS int* before = tot + 16; LAS int* base = tot + 32; LAS int* lcnt = tot + 48;
    const int* blk = (const int*)(F.ws + CTL_BLKCNT) + layer * 256 * 16;
    __syncthreads();
    if (F.tid < 16) { int tt = 0, bb = 0; for (int g = 0; g < 256; ++g) { const int c = blk[g * 16 + F.tid]; tt += c; bb += (g < F.wg) ? c : 0; } tot[F.tid] = tt; before[F.tid] = bb; lcnt[F.tid] = 0; }
    __syncthreads();
    if (F.tid == 0) { int ts = 0; int* gts = (int*)(F.ws + CTL_TILES) + layer * 32;
        for (int e = 0; e < 16; ++e) { base[e] = ts * 256 + before[e]; if (F.wg == 0) gts[e] = ts; ts += (tot[e] + 255) >> 8; }
        if (F.wg == 0) gts[16] = ts; }
    __syncthreads();
    const int* tok_e = (const int*)(F.ws + SM_TOKE); int* tok_p = (int*)(F.ws + SM_TOKP); int* rowtok = (int*)(F.ws + SM_ROWTOK);
    const int t0 = F.wg * 256;
    { const int i = F.tid; const int e = tok_e[2 * t0 + i]; const int pos = base[e] + lds_add(&lcnt[e], 1); tok_p[2 * t0 + i] = pos; rowtok[pos] = t0 + (i >> 1); }
    if (F.wg == 0) {
        for (int e = 0; e < 16; ++e) { const int rs = base[e] - before[e], lo = rs + tot[e], hi = rs + (((tot[e] + 255) >> 8) << 8);
            for (int i = lo + F.tid; i < hi; i += NTH) rowtok[i] = 0; }
    }
    __syncthreads();
}

DI void ln2_phase(const Frame& F0, float* xout  , const float* lng, const float* lnb, bf16_t* xb, bool use_ffn, unsigned char* xb8 = nullptr  ) {
    Frame F = F0; F.tid = F.wave * 64 + lane_id(); asm volatile("" : "+v"(F.tid)); F.lane = F.tid & 63;
    const int lane = F.lane; const bf16_t* Y = (const bf16_t*)(F.ws + OFF_XS);
    const int* tok_p = (const int*)(F.ws + SM_TOKP); const float* tok_w = (const float*)(F.ws + SM_TOKW);
    f32x4 gv[4], bv[4];
#pragma unroll
    for (int j = 0; j < 4; ++j) { gv[j] = *(const f32x4*)(lng + j * 256 + lane * 4); bv[j] = *(const f32x4*)(lnb + j * 256 + lane * 4); }
    for (int r = F.wave; r < 256; r += 16) {
        size_t t[2]; int p0[2], p1[2]; float w0[2], w1[2]; f32x4 xv[2][4]; u32x2 ya[2][4], yb[2][4];
#pragma unroll
        for (int k = 0; k < 2; ++k) { t[k] = (size_t)F.wg * 256 + r + 8 * k; p0[k] = tok_p[2 * t[k]]; p1[k] = tok_p[2 * t[k] + 1]; w0[k] = tok_w[2 * t[k]]; w1[k] = tok_w[2 * t[k] + 1]; }
#pragma unroll
        for (int k = 0; k < 2; ++k)
#pragma unroll
            for (int j = 0; j < 4; ++j) { const u32x2 xr = *(const u32x2*)(xb + t[k] * D + j * 256 + lane * 4); xv[k][j] = (f32x4){__uint_as_float(xr[0] << 16), __uint_as_float(xr[0] & 0xffff0000u), __uint_as_float(xr[1] << 16), __uint_as_float(xr[1] & 0xffff0000u)}; }
        if (use_ffn) {
#pragma unroll
            for (int k = 0; k < 2; ++k)
#pragma unroll
                for (int j = 0; j < 4; ++j) { ya[k][j] = *(const u32x2*)(Y + (size_t)p0[k] * D + j * 256 + lane * 4); yb[k][j] = *(const u32x2*)(Y + (size_t)p1[k] * D + j * 256 + lane * 4); }
        }
#pragma unroll
        for (int k = 0; k < 2; ++k) {
            f32x4 y[4]; float s = 0.f;
#pragma unroll
            for (int j = 0; j < 4; ++j) { y[j] = xv[k][j] * ALPHA;
                if (use_ffn) { const u32x2 a = ya[k][j], b = yb[k][j];
                    y[j][0] += w0[k] * __uint_as_float(a[0] << 16) + w1[k] * __uint_as_float(b[0] << 16);
                    y[j][1] += w0[k] * __uint_as_float(a[0] & 0xffff0000u) + w1[k] * __uint_as_float(b[0] & 0xffff0000u);
                    y[j][2] += w0[k] * __uint_as_float(a[1] << 16) + w1[k] * __uint_as_float(b[1] << 16);
                    y[j][3] += w0[k] * __uint_as_float(a[1] & 0xffff0000u) + w1[k] * __uint_as_float(b[1] & 0xffff0000u); }
                s += y[j][0] + y[j][1] + y[j][2] + y[j][3]; }
            const float mean = wave_sum(s) * (1.0f / D); float q = 0.f;
#pragma unroll
            for (int j = 0; j < 4; ++j) { y[j] -= mean; q += y[j][0] * y[j][0] + y[j][1] * y[j][1] + y[j][2] * y[j][2] + y[j][3] * y[j][3]; }
            const float rstd = rsqrtf(wave_sum(q) * (1.0f / D) + LN_EPS);
#pragma unroll
            for (int j = 0; j < 4; ++j) { f32x4 o = y[j] * rstd * gv[j] + bv[j];
                if (xout) *(f32x4*)(xout + t[k] * D + j * 256 + lane * 4) = o;
                else { u32x2 ob; ob[0] = pack2(o[0], o[1]); ob[1] = pack2(o[2], o[3]); *(u32x2*)(xb + t[k] * D + j * 256 + lane * 4) = ob;
                    if (xb8) *(unsigned*)(xb8 + t[k] * D + j * 256 + lane * 4) = pk_fp8x4(o[0] * F8_SX, o[1] * F8_SX, o[2] * F8_SX, o[3] * F8_SX); } }
        }
    }
}

typedef short s16x4 __attribute__((ext_vector_type(4)));
#define MFMA16(a, b, c) __builtin_amdgcn_mfma_f32_16x16x32_bf16((a), (b), (c), 0, 0, 0)
DI bf16x8 ld_row(const LAS bf16_t* p) { return *(const LAS bf16x8*)p; }
DI bf16x8 ld_tr2(const LAS bf16_t* pa, const LAS bf16_t* pb) {
    const s16x4 lo = __builtin_amdgcn_ds_read_tr16_b64_v4i16((LAS s16x4*)pa), hi = __builtin_amdgcn_ds_read_tr16_b64_v4i16((LAS s16x4*)pb);
    return __builtin_shufflevector(lo, hi, 0, 1, 2, 3, 4, 5, 6, 7);
}

constexpr int R_LDK = 136, R_LDV = 264;
template <int NCOLS> DI void ret_copy(const Frame& F, const bf16_t* src, size_t gld, LAS bf16_t* dst, int lld) {
    constexpr int cpr = NCOLS >> 3, n = 128 * cpr;
    u32x4 v[n / NTH];
#pragma unroll
    for (int i = 0; i < n / NTH; ++i) { const int id = F.tid + i * NTH, r = id / cpr, ch = id % cpr; v[i] = *(const u32x4*)(src + (size_t)r * gld + ch * 8); }
#pragma unroll
    for (int i = 0; i < n / NTH; ++i) { const int id = F.tid + i * NTH, r = id / cpr, ch = id % cpr; *(LAS u32x4*)(dst + r * lld + ch * 8) = v[i]; }
}
template <int NCOLS> DI void blk_fetch(const Frame& F, const bf16_t* src, int gld, u32x4 (&v)[128 * (NCOLS >> 3) / NTH]) {
    constexpr int cpr = NCOLS >> 3;
    int t_ = F.tid; asm volatile("" : "+v"(t_));
#pragma unroll
    for (int i = 0; i < 128 * cpr / NTH; ++i) { const int id = t_ + i * NTH, r = id / cpr, ch = id % cpr; v[i] = *(const u32x4*)((const char*)src + (unsigned)(r * gld + ch * 8) * 2u); }
}
template <int NCOLS> DI void blk_put(const Frame& F, const u32x4 (&v)[128 * (NCOLS >> 3) / NTH], LAS bf16_t* dst, int lld) {
    constexpr int cpr = NCOLS >> 3;
    int t_ = F.tid; asm volatile("" : "+v"(t_));
#pragma unroll
    for (int i = 0; i < 128 * cpr / NTH; ++i) { const int id = t_ + i * NTH, r = id / cpr, ch = id % cpr; *(LAS u32x4*)(dst + r * lld + ch * 8) = v[i]; }
}
template <int NCOLS> DI void blk_fetch8(const Frame& F, const unsigned char* src, int gld, u32x4 (&v)[128 * (NCOLS >> 4) / NTH]) {
    constexpr int cpr = NCOLS >> 4;
    int t_ = F.tid; asm volatile("" : "+v"(t_));
#pragma unroll
    for (int i = 0; i < 128 * cpr / NTH; ++i) { const int id = t_ + i * NTH, r = id / cpr, ch = id % cpr; v[i] = *(const u32x4*)(src + (unsigned)(r * gld + ch * 16)); }
}
DI u32x2 fp8x4_bf16(unsigned d) { const auto a = __builtin_amdgcn_cvt_pk_f32_fp8((int)d, false), b = __builtin_amdgcn_cvt_pk_f32_fp8((int)d, true); u32x2 o; o[0] = pack2(a[0], a[1]); o[1] = pack2(b[0], b[1]); return o; }
template <int NCOLS> DI void blk_put8(const Frame& F, const u32x4 (&v)[128 * (NCOLS >> 4) / NTH], LAS bf16_t* dst, int lld) {
    constexpr int cpr = NCOLS >> 4;
    int t_ = F.tid; asm volatile("" : "+v"(t_));
#pragma unroll
    for (int i = 0; i < 128 * cpr / NTH; ++i) { const int id = t_ + i * NTH, r = id / cpr, ch = id % cpr; u32x4 lo, hi;
        const u32x2 c0 = fp8x4_bf16(v[i][0]), c1 = fp8x4_bf16(v[i][1]), c2 = fp8x4_bf16(v[i][2]), c3 = fp8x4_bf16(v[i][3]);
        lo = (u32x4){c0[0], c0[1], c1[0], c1[1]}; hi = (u32x4){c2[0], c2[1], c3[0], c3[1]};
        *(LAS u32x4*)(dst + r * lld + ch * 16) = lo; *(LAS u32x4*)(dst + r * lld + ch * 16 + 8) = hi; }
}
DI void ret_r1_unit(const Frame& F0, const bf16_t* Pg, bf16_t* KV, int unit) {
    Frame F = F0; F.tid = F.wave * 64 + lane_id(); asm volatile("" : "+v"(F.tid)); F.lane = F.tid & 63;
    const int c = unit & 63, h = (unit >> 6) & 7, bl = unit >> 9;
    LAS bf16_t* Kd = (LAS bf16_t*)F.lds; LAS bf16_t* Vs = Kd + 128 * R_LDK;
    const size_t row0 = (size_t)bl * 8192 + c * 128;
    const float l2g = log2f(1.0f - exp2f(-5.0f - (float)h));
    __syncthreads();
    { u32x4 kv_[4]; blk_fetch<128>(F, Pg + row0 * PGLD + 1024 + h * 128, PGLD, kv_);
#pragma unroll
      for (int i = 0; i < 4; ++i) { const int r_ = (F.tid + i * NTH) >> 4; const float sc = 0.08838834764831845f * __builtin_amdgcn_exp2f((float)(127 - r_) * l2g); float t8[8]; unpack8(kv_[i], t8);
#pragma unroll
          for (int e = 0; e < 8; ++e) t8[e] *= sc;
          kv_[i] = pack8(t8); }
      blk_put<128>(F, kv_, Kd, R_LDK); }
    if (PGV8) { u32x4 vv_[4]; blk_fetch8<256>(F, (const unsigned char*)Pg + row0 * 8192 + 4096 + h * 256, 8192, vv_); blk_put8<256>(F, vv_, Vs, R_LDV); }
    else ret_copy<256>(F, Pg + row0 * 6144 + 2048 + h * 256, 6144, Vs, R_LDV);
    __syncthreads();
    int w = F.wave; asm volatile("" : "+s"(w));
    const int lane = F.lane, fq = lane >> 4, q = (lane & 15) >> 2, pp = lane & 3;
    f32x4 acc[16];
#pragma unroll
    for (int i = 0; i < 16; ++i) acc[i] = (f32x4){0.f, 0.f, 0.f, 0.f};
#pragma unroll
    for (int ks = 0; ks < 4; ++ks) {
        const int ra = 32 * ks + 8 * fq + q, rb = ra + 4;
        const bf16x8 X = ld_tr2(Kd + ra * R_LDK + 16 * w + 4 * pp, Kd + rb * R_LDK + 16 * w + 4 * pp);
#pragma unroll
        for (int vt = 0; vt < 16; ++vt) { const bf16x8 Y = ld_tr2(Vs + ra * R_LDV + 16 * vt + 4 * pp, Vs + rb * R_LDV + 16 * vt + 4 * pp); acc[vt] = MFMA16(Y, X, acc[vt]); }
    }
    bf16_t* o = KV + (size_t)unit * 32768 + (16 * w + (lane & 15)) * 256 + 4 * fq;
#pragma unroll
    for (int vt = 0; vt < 16; ++vt) { u32x2 ov; ov[0] = pack2(acc[vt][0], acc[vt][1]); ov[1] = pack2(acc[vt][2], acc[vt][3]); *(u32x2*)(o + 16 * vt) = ov; }
}
DI void ret_r2_phase(const Frame& F0, bf16_t* KV) {
    Frame F = F0; F.tid = F.wave * 64 + lane_id(); asm volatile("" : "+v"(F.tid)); F.lane = F.tid & 63;
    const int gt = F.wg * NTH + F.tid;
    if (gt >= 65536) return;
    const int pair = gt >> 12, e8 = gt & 4095, h = pair & 7;
    const float cd = exp2f(128.0f * log2f(1.0f - exp2f(-5.0f - (float)h)));
    float st[8];
#pragma unroll
    for (int i = 0; i < 8; ++i) st[i] = 0.f;
#pragma unroll 8
    for (int c = 0; c < 64; ++c) {
        bf16_t* p = KV + ((size_t)(pair * 64 + c)) * 32768 + (size_t)e8 * 8;
        float kv[8]; unpack8(*(const u32x4*)p, kv);
        *(u32x4*)p = pack8(st);
#pragma unroll
        for (int i = 0; i < 8; ++i) st[i] = st[i] * cd + kv[i];
    }
}
DI void ret_r3_phase(const Frame& F0, const bf16_t* Pg, const bf16_t* RS, bf16_t* O1, int gq, const float* gn) {
    Frame F = F0; F.tid = F.wave * 64 + lane_id(); asm volatile("" : "+v"(F.tid)); F.lane = F.tid & 63;
    LAS bf16_t* Qs = (LAS bf16_t*)F.lds; LAS bf16_t* Ks = Qs + 128 * R_LDK; LAS bf16_t* Vh = Ks + 128 * R_LDK; LAS bf16_t* Rh = Vh + 128 * R_LDK;
    int w = F.wave; asm volatile("" : "+s"(w));
    u32x4 RQ[4], RK[4];
    { const int u0 = F.wg; const size_t r0 = (size_t)(u0 >> 9) * 8192 + (u0 & 63) * 128; const int h0 = (u0 >> 6) & 7;
      blk_fetch<128>(F, Pg + r0 * PGLD + h0 * 128, PGLD, RQ); blk_fetch<128>(F, Pg + r0 * PGLD + 1024 + h0 * 128, PGLD, RK); }
#pragma unroll 1
    for (int unit = F.wg; unit < 1024; unit += GRID) {
        const int c = unit & 63, h = (unit >> 6) & 7, bl = unit >> 9;
        const size_t row0 = (size_t)bl * 8192 + c * 128;
        const float l2g = log2f(1.0f - exp2f(-5.0f - (float)h));
        const bf16_t* rsu = RS + (size_t)unit * 32768;
        int lane = F.lane; asm volatile("" : "+v"(lane));
        const int fr = lane & 15, fq = lane >> 4, q = fr >> 2, pp = lane & 3;
        __syncthreads();
        blk_put<128>(F, RQ, Qs, R_LDK); blk_put<128>(F, RK, Ks, R_LDK);
        static_assert(PGV8, "the chunk-output phase reads v and g as e4m3");
        u32x4 RV[2], RR[4];
        const unsigned char* Pg8 = (const unsigned char*)Pg + row0 * 8192 + 4096 + h * 256;
        blk_fetch8<128>(F, Pg8, 8192, RV);
        blk_fetch<128>(F, rsu, 256, RR);
        __syncthreads();
        f32x4 sacc[8];
#pragma unroll
        for (int jt = 0; jt < 8; ++jt) sacc[jt] = (f32x4){0.f, 0.f, 0.f, 0.f};
#pragma unroll
        for (int ks = 0; ks < 4; ++ks) {
            const bf16x8 Yq = ld_row(Qs + (16 * w + fr) * R_LDK + 32 * ks + 8 * fq);
#pragma unroll
            for (int jt = 0; jt < 8; ++jt) { const bf16x8 Xk = ld_row(Ks + (16 * jt + fr) * R_LDK + 32 * ks + 8 * fq); sacc[jt] = MFMA16(Xk, Yq, sacc[jt]); }
        }
        __syncthreads();
        { const int i = 16 * w + fr;
#pragma unroll
          for (int jt = 0; jt < 8; ++jt) { float pv[4];
#pragma unroll
              for (int r = 0; r < 4; ++r) { const int j = 16 * jt + 4 * fq + r; pv[r] = (i >= j) ? sacc[jt][r] * (0.08838834764831845f * __builtin_amdgcn_exp2f((float)(i - j) * l2g)) : 0.f; }
              u32x2 o; o[0] = pack2(pv[0], pv[1]); o[1] = pack2(pv[2], pv[3]);
              *(LAS u32x2*)(Ks + i * R_LDK + 16 * jt + 4 * fq) = o; } }
        f32x4 acc[16];
#pragma unroll
        for (int i = 0; i < 16; ++i) acc[i] = (f32x4){0.f, 0.f, 0.f, 0.f};
        const float qdec = exp2f((float)(16 * w + fr + 1) * l2g);
        u32x4 RG[4];
#pragma unroll
        for (int half = 0; half < 2; ++half) {
            if (half) __syncthreads();
            blk_put8<128>(F, RV, Vh, R_LDK);
            blk_put<128>(F, RR, Rh, R_LDK);
            if (half == 0) { blk_fetch8<128>(F, Pg8 + 128, 8192, RV);
                blk_fetch<128>(F, rsu + 128, 256, RR); }
            else blk_fetch8<256>(F, Pg8 + 2048, 8192, RG);
            __syncthreads();
#pragma unroll
            for (int ks = 0; ks < 4; ++ks) {
                const bf16x8 Yq = ld_row(Qs + (16 * w + fr) * R_LDK + 32 * ks + 8 * fq);
                const int ra = 32 * ks + 8 * fq + q, rb = ra + 4;
#pragma unroll
                for (int vt = 0; vt < 8; ++vt) { const bf16x8 Xr = ld_tr2(Rh + ra * R_LDK + 16 * vt + 4 * pp, Rh + rb * R_LDK + 16 * vt + 4 * pp); acc[half * 8 + vt] = MFMA16(Xr, Yq, acc[half * 8 + vt]); }
            }
#pragma unroll
            for (int vt = 0; vt < 8; ++vt) acc[half * 8 + vt] *= qdec;
#pragma unroll
            for (int ks = 0; ks < 4; ++ks) {
                const bf16x8 Yp = ld_row(Ks + (16 * w + fr) * R_LDK + 32 * ks + 8 * fq);
                const int ra = 32 * ks + 8 * fq + q, rb = ra + 4;
#pragma unroll
                for (int vt = 0; vt < 8; ++vt) { const bf16x8 Xv = ld_tr2(Vh + ra * R_LDK + 16 * vt + 4 * pp, Vh + rb * R_LDK + 16 * vt + 4 * pp); acc[half * 8 + vt] = MFMA16(Xv, Yp, acc[half * 8 + vt]); }
            }
        }
        __syncthreads();
        LAS bf16_t* Gs = Vh;
        LAS float* gnl = (LAS float*)(Qs);
        blk_put8<256>(F, RG, Gs, R_LDV);
        if (F.tid < 256) { gnl[F.tid] = gn[h * 256 + F.tid]; gnl[256 + F.tid] = gn[2048 + h * 256 + F.tid]; }
        { const int un = unit + GRID; if (un < 1024) { const size_t rn = (size_t)(un >> 9) * 8192 + (un & 63) * 128; const int hn = (un >> 6) & 7;
            blk_fetch<128>(F, Pg + rn * PGLD + hn * 128, PGLD, RQ); blk_fetch<128>(F, Pg + rn * PGLD + 1024 + hn * 128, PGLD, RK); } }
        float s = 0.f;
#pragma unroll
        for (int vt = 0; vt < 16; ++vt) s += acc[vt][0] + acc[vt][1] + acc[vt][2] + acc[vt][3];
        s += shx(s, 16); s += shx(s, 32);
        const float mean = s * (1.0f / 256.0f); float qq = 0.f;
#pragma unroll
        for (int vt = 0; vt < 16; ++vt)
#pragma unroll
            for (int r = 0; r < 4; ++r) { const float d = acc[vt][r] - mean; qq += d * d; }
        qq += shx(qq, 16); qq += shx(qq, 32);
        const float rstd = rsqrtf(qq * (1.0f / 256.0f) + (PGV8 ? 1e-5f * F8_SX * F8_SX : 1e-5f));
        __syncthreads();
        const size_t trow = row0 + 16 * w + fr;
        bf16_t* op = O1 + ((size_t)gq * 16384 + trow) * 2048 + h * 256;
#pragma unroll
        for (int vt = 0; vt < 16; ++vt) {
            const int v0 = 16 * vt + 4 * fq;
            if ((vt & 3) == 0) asm volatile("" ::: "memory");
            const u32x2 gr = *(const LAS u32x2*)(Gs + (16 * w + fr) * R_LDV + v0);
            const f32x4 gg = *(const LAS f32x4*)(gnl + v0), gb = *(const LAS f32x4*)(gnl + 256 + v0);
            float gv[4] = {__uint_as_float(gr[0] << 16), __uint_as_float(gr[0] & 0xffff0000u), __uint_as_float(gr[1] << 16), __uint_as_float(gr[1] & 0xffff0000u)};
            if (PGV8) {
#pragma unroll
                for (int r = 0; r < 4; ++r) gv[r] *= (1.0f / F8_SX); }
            float o[4];
#pragma unroll
            for (int r = 0; r < 4; ++r) { const float nv = (acc[vt][r] - mean) * rstd * gg[r] + gb[r]; o[r] = siluf_(gv[r]) * nv; }
            if (RTO8) *(unsigned*)((unsigned char*)O1 + ((size_t)gq * 16384 + trow) * 2048 + h * 256 + v0) = pk_fp8x4(o[0] * F8_SO, o[1] * F8_SO, o[2] * F8_SO, o[3] * F8_SO);
            else { u32x2 ov; ov[0] = pack2(o[0], o[1]); ov[1] = pack2(o[2], o[3]);
            *(u32x2*)(op + v0) = ov; }
        }
    }
}

DI bf16_t* st_w(const Frame& F) { return (bf16_t*)(F.ws + OFF_STR); }
DI bf16_t* st_kk(const Frame& F) { return (bf16_t*)(F.ws + OFF_STR) + (size_t)T * 512; }
DI bf16_t* st_b(const Frame& F) { return (bf16_t*)F.out; }
DI bf16_t* st_kp(const Frame& F) { return (bf16_t*)F.out + (size_t)T * 512; }
DI bf16_t* st_r(const Frame& F) { return (bf16_t*)F.out + (size_t)T * 1024; }
DI bf16_t* st_v(const Frame& F) { return (bf16_t*)F.out + (size_t)T * 1536; }

DI void rwkv_e1_phase(const Frame& F0) {
    Frame F = F0; F.tid = F.wave * 64 + lane_id(); asm volatile("" : "+v"(F.tid)); F.lane = F.tid & 63;
    const bf16_t* PR = (const bf16_t*)(F.ws + OFF_PR); const float* mu = F.in[3]; const float* kkw = F.in[12];
    const int c = F.lane * 8;
    float m0[8], m1[8], m2[8], kw[8];
#pragma unroll
    for (int i = 0; i < 8; ++i) { m0[i] = mu[c + i]; m1[i] = mu[512 + c + i]; m2[i] = mu[1024 + c + i]; kw[i] = kkw[c + i]; }
    float* rn = (float*)(F.ws + SM_RNORM);
    for (int r = F.wave; r < 256; r += 16) {
        u32x4 ld[2][6]; size_t t[2];
#pragma unroll
        for (int k = 0; k < 2; ++k) { t[k] = (size_t)F.wg * 256 + r + 8 * k; const size_t row = t[k] + (t[k] >> 13) + 1;
            const bf16_t* cur = PR + row * 2048 + c; const bf16_t* prv = cur - 2048;
            ld[k][0] = *(const u32x4*)cur; ld[k][1] = *(const u32x4*)prv; ld[k][2] = *(const u32x4*)(cur + 512); ld[k][3] = *(const u32x4*)(prv + 512); ld[k][4] = *(const u32x4*)(cur + 1024); ld[k][5] = *(const u32x4*)(prv + 1024); }
#pragma unroll
        for (int k = 0; k < 2; ++k) {
            float a[8], p[8], o[8];
            unpack8(ld[k][0], a); unpack8(ld[k][1], p);
#pragma unroll
            for (int i = 0; i < 8; ++i) o[i] = a[i] + (p[i] - a[i]) * m0[i];
            *(u32x4*)(st_r(F) + t[k] * 512 + c) = pack8(o);
            unpack8(ld[k][2], a); unpack8(ld[k][3], p);
            float ss = 0.f;
#pragma unroll
            for (int i = 0; i < 8; ++i) { o[i] = a[i] + (p[i] - a[i]) * m1[i]; const float q = o[i] * kw[i]; ss += q * q; }
            *(u32x4*)(st_kp(F) + t[k] * 512 + c) = pack8(o);
            ss += shx(ss, 1); ss += shx(ss, 2); ss += shx(ss, 4);
            if ((F.lane & 7) == 0) rn[t[k] * 8 + (F.lane >> 3)] = rcpf_(fmaxf(__builtin_amdgcn_sqrtf(ss), 1e-12f));
            unpack8(ld[k][4], a); unpack8(ld[k][5], p);
#pragma unroll
            for (int i = 0; i < 8; ++i) o[i] = a[i] + (p[i] - a[i]) * m2[i];
            *(u32x4*)(st_v(F) + t[k] * 512 + c) = pack8(o);
        }
    }
}

DI float dpp_f(float v, int ctrl_qp1, int) { return v; }
template <int CTRL> DI float dpp_mov(float v) { return __int_as_float(__builtin_amdgcn_update_dpp(0, __float_as_int(v), CTRL, 0xf, 0xf, true)); }
DI float row_sum16(float v) {
    v += dpp_mov<0xB1>(v);
    v += dpp_mov<0x4E>(v);
    v += dpp_mov<0x141>(v);
    v += dpp_mov<0x140>(v);
    return v;
}

DI float row_sum8(float v) {
    v += dpp_mov<0xB1>(v);
    v += dpp_mov<0x4E>(v);
    v += dpp_mov<0x141>(v);
    return v;
}
typedef _Float16 h2_t __attribute__((ext_vector_type(2)));
typedef _Float16 h8_t __attribute__((ext_vector_type(8)));
constexpr int SC_STEPS = 32;
constexpr int SC_BUF = SC_STEPS * (5 * 64 + 64) * 2;
constexpr int SC_WGS = 64;
constexpr int SC_OBS = 260;
struct ScOp { u32x4 a0, a1, a2, a3, a4; unsigned v0, v1; };
template <int U> DI void sc_ld(ScOp& o, unsigned pb, unsigned pv) {
    asm volatile("ds_read_b128 %0, %1 offset:%c2" : "=v"(o.a0) : "v"(pb), "i"(U * 640) : "memory");
    asm volatile("ds_read_b128 %0, %1 offset:%c2" : "=v"(o.a1) : "v"(pb), "i"(U * 640 + 128) : "memory");
    asm volatile("ds_read_b128 %0, %1 offset:%c2" : "=v"(o.a2) : "v"(pb), "i"(U * 640 + 256) : "memory");
    asm volatile("ds_read_b128 %0, %1 offset:%c2" : "=v"(o.a3) : "v"(pb), "i"(U * 640 + 384) : "memory");
    asm volatile("ds_read_b128 %0, %1 offset:%c2" : "=v"(o.a4) : "v"(pb), "i"(U * 640 + 512) : "memory");
    asm volatile("ds_read_u16 %0, %1 offset:%c2" : "=v"(o.v0) : "v"(pv), "i"(U * 128) : "memory");
    asm volatile("ds_read_u16 %0, %1 offset:%c2" : "=v"(o.v1) : "v"(pv), "i"(U * 128 + 2) : "memory");
}
DI void sc_wait(ScOp& o) { asm volatile("s_waitcnt lgkmcnt(0)" : "+v"(o.a0), "+v"(o.a1), "+v"(o.a2), "+v"(o.a3), "+v"(o.a4), "+v"(o.v0), "+v"(o.v1) :: "memory"); }
DI h2_t h2of(unsigned x) { return __builtin_bit_cast(h2_t, x); }
DI float dot2z(h2_t a, h2_t b) { float r; asm("v_dot2_f32_f16 %0, %1, %2, 0" : "=v"(r) : "v"(a), "v"(b)); return r; }
DI float sc_dot(const h2_t (&S)[4], const u32x4& x) {
    float o = dot2z(S[0], h2of(x[0])); o = __builtin_amdgcn_fdot2(S[1], h2of(x[1]), o, false); o = __builtin_amdgcn_fdot2(S[2], h2of(x[2]), o, false); return __builtin_amdgcn_fdot2(S[3], h2of(x[3]), o, false); }
DI unsigned sc_readout(const h2_t (&S)[2][4], const u32x4& rp) {
    const float o0 = sc_dot(S[0], rp), o1 = sc_dot(S[1], rp);
    return __builtin_bit_cast(unsigned, __builtin_amdgcn_cvt_pkrtz(o0, o1));
}
template <int U> DI void sc_step(h2_t (&S)[2][4], ScOp& cur, u32x4& rp, LAS unsigned* obw, unsigned pb, unsigned pv) {
    ScOp nxt; sc_ld<U + 1>(nxt, pb, pv);
    __builtin_amdgcn_sched_barrier(0);
    const float sa0 = sc_dot(S[0], cur.a1), sa1 = sc_dot(S[1], cur.a1);
    obw[U * SC_OBS] = sc_readout(S, rp);
    const _Float16 sh0 = (_Float16)(-row_sum8(sa0)), sh1 = (_Float16)(-row_sum8(sa1));
    const h2_t sav[2] = {(h2_t){sh0, sh0}, (h2_t){sh1, sh1}};
    const _Float16 vh0 = h2of(cur.v0)[0], vh1 = h2of(cur.v1)[0];
    const h2_t vv2[2] = {(h2_t){vh0, vh0}, (h2_t){vh1, vh1}};
#pragma unroll
    for (int rw = 0; rw < 2; ++rw)
#pragma unroll
        for (int i = 0; i < 4; ++i) S[rw][i] = S[rw][i] * h2of(cur.a0[i]) + (sav[rw] * h2of(cur.a2[i]) + vv2[rw] * h2of(cur.a3[i]));
    rp = cur.a4;
    __builtin_amdgcn_sched_barrier(0);
    sc_wait(nxt); cur = nxt;
}
DI void rwkv_scan(const Frame& F0, const bool do_post = true) {
    Frame F = F0; F.tid = F.wave * 64 + lane_id(); asm volatile("" : "+v"(F.tid)); F.lane = F.tid & 63;
    const int stream = F.wg, b = stream >> 3, h = stream & 7;
    const int rloc = 16 * F.wave + 2 * (F.lane >> 3), cg = F.lane & 7;
    const size_t tb = (size_t)b * SEQ;
    LAS unsigned* OBP = (LAS unsigned*)(F.lds + 2 * SC_BUF);
    const bf16_t* arrs[6] = {st_w(F), st_kk(F), st_b(F), st_kp(F), st_r(F), st_v(F)};
    u32x4 stage[3];
    auto issue = [&](int chunk) {
#pragma unroll
        for (int i = 0; i < 3; ++i) { const int id = F.tid + NTH * i, arr = id >> 8, rem = id & 255, step = rem >> 3, ch = rem & 7;
            const bf16_t* base = arr == 0 ? arrs[0] : arr == 1 ? arrs[1] : arr == 2 ? arrs[2] : arr == 3 ? arrs[3] : arr == 4 ? arrs[4] : arrs[5];
            stage[i] = *(const u32x4*)(base + (tb + (size_t)chunk * SC_STEPS + step) * 512 + h * 64 + ch * 8); }
    };
    auto commit = [&](int buf) {
        LAS _Float16* L = (LAS _Float16*)(F.lds + buf * SC_BUF);
#pragma unroll
        for (int i = 0; i < 3; ++i) { const int id = F.tid + NTH * i, arr = id >> 8, rem = id & 255, step = rem >> 3, ch = rem & 7;
            float v[8]; unpack8(stage[i], v);
            h8_t hv;
#pragma unroll
            for (int e = 0; e < 8; ++e) hv[e] = (_Float16)v[e];
            LAS _Float16* d = arr < 5 ? (L + step * 320 + arr * 64 + ch * 8) : (L + SC_STEPS * 320 + step * 64 + ch * 8);
            *(LAS h8_t*)d = hv; }
    };
    const int pstep = (F.tid - 256) >> 3, pc = h * 64 + 8 * (F.tid & 7);
    float lg[8], lb[8], rk[8];
    if (F.wave >= 4) {
#pragma unroll
        for (int i = 0; i < 8; ++i) { lg[i] = F.in[15][pc + i]; lb[i] = F.in[15][512 + pc + i]; rk[i] = F.in[14][pc + i]; } }
    bf16_t* O0 = (bf16_t*)(F.ws + OFF_O0);
    auto post = [&](int chunk) {
        const size_t t = tb + (size_t)chunk * SC_STEPS + pstep;
        const LAS unsigned* ob = OBP + ((chunk & 1) * (SC_STEPS + 1) + pstep + 1) * SC_OBS + 32 * (F.tid & 7);
        float o[8];
#pragma unroll
        for (int p = 0; p < 4; ++p) { float s0 = 0.f, s1 = 0.f;
#pragma unroll
            for (int hf = 0; hf < 2; ++hf) { const u32x4 q = *(const LAS u32x4*)(ob + p * 8 + hf * 4);
#pragma unroll
                for (int e = 0; e < 4; ++e) { const h2_t hv = h2of(q[e]); s0 += (float)hv[0]; s1 += (float)hv[1]; } }
            o[2 * p] = s0; o[2 * p + 1] = s1; }
        float rr[8], kp[8], vv[8], gg[8];
        unpack8(*(const u32x4*)(st_r(F) + t * 512 + pc), rr); unpack8(*(const u32x4*)(st_kp(F) + t * 512 + pc), kp); unpack8(*(const u32x4*)(st_v(F) + t * 512 + pc), vv);
        unpack8(*(const u32x4*)(O0 + t * 1024 + pc), gg);
        float s = 0.f, bs = 0.f;
#pragma unroll
        for (int i = 0; i < 8; ++i) { s += o[i]; bs += rr[i] * kp[i] * rk[i]; }
        s += shx(s, 1); s += shx(s, 2); s += shx(s, 4);
        bs += shx(bs, 1); bs += shx(bs, 2); bs += shx(bs, 4);
        const float mean = s * (1.0f / 64.0f); float q = 0.f;
#pragma unroll
        for (int i = 0; i < 8; ++i) { const float d = o[i] - mean; q += d * d; }
        q += shx(q, 1); q += shx(q, 2); q += shx(q, 4);
        const float rstd = rsqrtf(q * (1.0f / 64.0f) + 64e-5f);
        float res[8];
#pragma unroll
        for (int i = 0; i < 8; ++i) res[i] = ((o[i] - mean) * rstd * lg[i] + lb[i] + bs * vv[i]) * gg[i];
        *(u32x4*)(O0 + t * 1024 + pc) = pack8(res);
    };
    h2_t S[2][4];
#pragma unroll
    for (int i = 0; i < 4; ++i) { S[0][i] = (h2_t){(_Float16)0.f, (_Float16)0.f}; S[1][i] = S[0][i]; }
    __syncthreads();
    issue(0); commit(0);
    __syncthreads();
    constexpr int NCH = SEQ / SC_STEPS;
    for (int chunk = 0; chunk < NCH; ++chunk) {
        if (chunk + 1 < NCH) issue(chunk + 1);
        const LAS _Float16* L = (const LAS _Float16*)(F.lds + (chunk & 1) * SC_BUF);
        if (F.wave < 4) {
            LAS unsigned* obw = OBP + (chunk & 1) * (SC_STEPS + 1) * SC_OBS + F.tid;
            unsigned pb = (unsigned)(size_t)(F.lds + (chunk & 1) * SC_BUF) + 16 * cg, pv = (unsigned)(size_t)(F.lds + (chunk & 1) * SC_BUF) + SC_STEPS * 640 + 2 * rloc;
            ScOp cur; sc_ld<0>(cur, pb, pv); sc_wait(cur);
            u32x4 rp = cur.a4;
#pragma unroll 1
            for (int g8 = 0; g8 < SC_STEPS / 8; ++g8) {
                sc_step<0>(S, cur, rp, obw, pb, pv); sc_step<1>(S, cur, rp, obw, pb, pv); sc_step<2>(S, cur, rp, obw, pb, pv); sc_step<3>(S, cur, rp, obw, pb, pv);
                sc_step<4>(S, cur, rp, obw, pb, pv); sc_step<5>(S, cur, rp, obw, pb, pv); sc_step<6>(S, cur, rp, obw, pb, pv); sc_step<7>(S, cur, rp, obw, pb, pv);
                pb += 8 * 640; pv += 8 * 128; obw += 8 * SC_OBS;
            }
            obw[0] = sc_readout(S, rp);
        } else if (chunk > 0 && do_post) post(chunk - 1);
        if (chunk + 1 < NCH) commit((chunk + 1) & 1);
        __syncthreads();
    }
    if (F.wave >= 4 && do_post) post(NCH - 1);
}

DI void nsa_rope_phase(const Frame& F0) {
    Frame F = F0; F.tid = F.wave * 64 + lane_id(); asm volatile("" : "+v"(F.tid)); F.lane = F.tid & 63;
    bf16_t* PN = (bf16_t*)(F.ws + OFF_PN); const float* tab = (const float*)(F.ws + SM_ROPEN);
    const int hh = F.lane >> 2, j0 = (F.lane & 3) * 2;
    const int col = hh < 8 ? hh * 64 : 512 + ((hh - 8) >> 1) * 256 + ((hh - 8) & 1) * 64;
    if (hh >= 14) return;
    for (int r = F.wave; r < 256; r += 8) {
        const size_t t = (size_t)F.wg * 256 + r; const int pos = (int)(t & 8191);
        bf16_t* p = PN + t * 1536 + col + j0;
        const unsigned a = *(const unsigned*)p, bq = *(const unsigned*)(p + 8);
        const f32x4 cs = *(const f32x4*)(tab + ((size_t)pos * 8 + j0) * 2);
        const float x10 = __uint_as_float(a << 16), x11 = __uint_as_float(a & 0xffff0000u), x20 = __uint_as_float(bq << 16), x21 = __uint_as_float(bq & 0xffff0000u);
        *(unsigned*)p = pack2(x10 * cs[0] - x20 * cs[1], x11 * cs[2] - x21 * cs[3]);
        *(unsigned*)(p + 8) = pack2(x20 * cs[0] + x10 * cs[1], x21 * cs[2] + x11 * cs[3]);
    }
}
namespace pg8 {
struct CmpSched {
    const char* A; const char* B; size_t slotstepA, tstepA, bstride; int G, c;
    DI bool next(int i, Unit& u) const {
        const int L = i * G + c; if (L >= 64) return false;
        const int slot = L >> 4, pm = L & 15; u.pm = pm; u.pn = 0; u.aux = slot;
        u.a = A + (size_t)slot * slotstepA + (size_t)pm * tstepA; u.b = B + (size_t)(slot >> 1) * bstride; u.rows = nullptr; return true;
    }
};
}
constexpr int NS_STG = 16384, NS_NSTG = 4;
constexpr int NS_OFF_IMP = NS_NSTG * NS_STG, NS_OFF_SEL = NS_OFF_IMP + 128 * 128 * 4, NS_OFF_U = NS_OFF_SEL + 2048;
constexpr float NS_C = 0.125f * 1.44269504088896341f;
struct FState { f32x4 o[4][4]; float m[4], l[4]; };
struct TileSrc { const bf16_t* k; const bf16_t* v; size_t rstride; };
DI void ns_dma(const Frame& F, const TileSrc& S, int j, int stage) {
    int l_ = F.lane; asm volatile("" : "+v"(l_));
    const int row = 8 * F.wave + (l_ >> 3), c = (l_ & 7) ^ (l_ >> 3);
    const unsigned off = ((unsigned)(j * 64 + row) * (unsigned)S.rstride + c * 8) * 2u;
    LAS unsigned char* base = F.lds + stage * NS_STG + F.wave * 1024;
    __builtin_amdgcn_global_load_lds((const unsigned*)((const char*)S.k + off), (LAS unsigned*)base, 16, 0, 0);
    __builtin_amdgcn_global_load_lds((const unsigned*)((const char*)S.v + off), (LAS unsigned*)(base + 8192), 16, 0, 0);
}
DI void ns_wait(int after) {
    if (after >= 2) asm volatile("s_waitcnt vmcnt(4)" ::: "memory"); else if (after == 1) asm volatile("s_waitcnt vmcnt(2)" ::: "memory"); else asm volatile("s_waitcnt vmcnt(0)" ::: "memory");
    __builtin_amdgcn_s_barrier(); asm volatile("" ::: "memory");
}
DI float fexp2(float x) { return __builtin_amdgcn_exp2f(x); }
DI unsigned cvtpk(float lo, float hi) { return pack2(lo, hi); }
constexpr float NS_NINF = -__builtin_inff();
DI float vmax(float a, float b) { return __builtin_fmaxf(a, b); }
DI float vmax3(float a, float b, float c) { return __builtin_fmaxf(__builtin_fmaxf(a, b), c); }
DI float xquad_max(float v) {
    u32x2 r = __builtin_amdgcn_permlane16_swap(__float_as_uint(v), __float_as_uint(v), false, false);
    v = vmax(__uint_as_float(r[0]), __uint_as_float(r[1]));
    r = __builtin_amdgcn_permlane32_swap(__float_as_uint(v), __float_as_uint(v), false, false);
    return vmax(__uint_as_float(r[0]), __uint_as_float(r[1]));
}
template <int MM, bool PV, bool CMPHI = false, bool QL = false>
DI void ns_step(const LAS unsigned char* tb  , int kabs, const bf16x8 (&Qf)[4][2], FState& st, unsigned rtm, unsigned sb, int posl, int lod, int fr, int fq, int q, int pp, const LAS bf16_t* qb = nullptr) {
    const int lk = fr * 128 + ((fq ^ (fr & 7)) << 4);
    const int m_ = (4 * fq + q) & 7, vbl = (4 * fq + q) * 128 + ((((pp >> 1) ^ (m_ & 1))) << 4) + (pp & 1) * 8 + ((m_ >> 1) << 5);
    const LAS unsigned char* kp0 = tb + lk; const LAS unsigned char* kp1 = tb + (lk ^ 64); const LAS unsigned char* vp_ = tb + 8192 + vbl;
    asm volatile("" : "+v"(kp0), "+v"(kp1), "+v"(vp_));
    f32x4 s[2][4];
    bf16x8 X[2][2];
#pragma unroll
    for (int kt = 0; kt < 2; ++kt) { X[kt][0] = *(const LAS bf16x8*)(kp0 + kt * 2048); X[kt][1] = *(const LAS bf16x8*)(kp1 + kt * 2048); }
#pragma unroll
    for (int rt = 0; rt < 4; ++rt) if ((rtm >> rt) & 1u) {
        const bf16x8 q0 = QL ? ld_row(qb + (rt * 2 + 0) * 512) : Qf[rt][0], q1 = QL ? ld_row(qb + (rt * 2 + 1) * 512) : Qf[rt][1];
#pragma unroll
        for (int kt = 0; kt < 2; ++kt) { s[kt][rt] = MFMA16(X[kt][0], q0, ((f32x4){0.f, 0.f, 0.f, 0.f})); s[kt][rt] = MFMA16(X[kt][1], q1, s[kt][rt]); }
    }
    bf16x8 Y[4];
#pragma unroll
    for (int rt = 0; rt < 4; ++rt) {
        if ((rtm >> rt) & 1u) {
            if (MM) {
#pragma unroll
                for (int kt = 0; kt < 2; ++kt)
#pragma unroll
                    for (int r = 0; r < 4; ++r) { const int key = kabs + 16 * kt + 4 * fq + r; const int hi_ = CMPHI ? ((posl + 4 * rt - 31) >> 4) : (posl + 4 * rt);
                        const bool ok = MM == 1 ? (key <= hi_) : (key <= hi_ && key > hi_ - lod);
                        s[kt][rt][r] = ok ? s[kt][rt][r] : NS_NINF; }
            }
            const float rowneg = ((sb >> rt) & 1u) ? 0.f : NS_NINF;
            float mx = vmax3(s[0][rt][0], s[0][rt][1], s[0][rt][2]); mx = vmax3(mx, s[0][rt][3], s[1][rt][0]); mx = vmax3(mx, s[1][rt][1], s[1][rt][2]); mx = vmax(mx, s[1][rt][3]);
            mx = vmax(mx + rowneg, st.m[rt]);
            mx = xquad_max(mx);
            const float alpha = fexp2(st.m[rt] - mx); st.m[rt] = mx;
            const float c = rowneg - mx; const f32x2 c2 = (f32x2){c, c};
            f32x2 p[4];
#pragma unroll
            for (int kt = 0; kt < 2; ++kt) { const f32x2 a = (f32x2){s[kt][rt][0], s[kt][rt][1]} + c2, b = (f32x2){s[kt][rt][2], s[kt][rt][3]} + c2;
                p[2 * kt] = (f32x2){fexp2(a[0]), fexp2(a[1])}; p[2 * kt + 1] = (f32x2){fexp2(b[0]), fexp2(b[1])}; }
            const f32x2 ps2 = (p[0] + p[1]) + (p[2] + p[3]);
            st.l[rt] = st.l[rt] * alpha + (ps2[0] + ps2[1]);
            if (PV) {
                if (__ballot(alpha != 1.0f) != 0ull) {
#pragma unroll
                    for (int dt = 0; dt < 4; ++dt) st.o[dt][rt] *= alpha; }
                u32x4 w; w[0] = cvtpk(p[0][0], p[0][1]); w[1] = cvtpk(p[1][0], p[1][1]); w[2] = cvtpk(p[2][0], p[2][1]); w[3] = cvtpk(p[3][0], p[3][1]);
                Y[rt] = __builtin_bit_cast(bf16x8, w);
            }
        } else if (PV) {
            Y[rt] = (bf16x8){0, 0, 0, 0, 0, 0, 0, 0};
        }
    }
    if (PV) {
        const unsigned a0 = (unsigned)(size_t)vp_, a1 = a0 ^ 32u, a2 = a0 ^ 64u, a3 = a0 ^ 96u;
        s16x4 t0, t1, t2, t3, t4, t5, t6, t7;
        asm volatile("ds_read_b64_tr_b16 %0, %8\n\tds_read_b64_tr_b16 %1, %8 offset:2048\n\tds_read_b64_tr_b16 %2, %9\n\tds_read_b64_tr_b16 %3, %9 offset:2048\n\t"
                     "ds_read_b64_tr_b16 %4, %10\n\tds_read_b64_tr_b16 %5, %10 offset:2048\n\tds_read_b64_tr_b16 %6, %11\n\tds_read_b64_tr_b16 %7, %11 offset:2048\n\ts_waitcnt lgkmcnt(0)"
                     : "=&v"(t0), "=&v"(t1), "=&v"(t2), "=&v"(t3), "=&v"(t4), "=&v"(t5), "=&v"(t6), "=&v"(t7) : "v"(a0), "v"(a1), "v"(a2), "v"(a3) : "memory");
        const bf16x8 Xv[4] = {__builtin_shufflevector(t0, t1, 0, 1, 2, 3, 4, 5, 6, 7), __builtin_shufflevector(t2, t3, 0, 1, 2, 3, 4, 5, 6, 7), __builtin_shufflevector(t4, t5, 0, 1, 2, 3, 4, 5, 6, 7), __builtin_shufflevector(t6, t7, 0, 1, 2, 3, 4, 5, 6, 7)};
#pragma unroll
        for (int dt = 0; dt < 4; ++dt)
#pragma unroll
            for (int rt = 0; rt < 4; ++rt) st.o[dt][rt] = MFMA16(Xv[dt], Y[rt], st.o[dt][rt]);
    }
}
DI void ns_reset(FState& st) {
#pragma unroll
    for (int rt = 0; rt < 4; ++rt) { st.m[rt] = -1e30f; st.l[rt] = 0.f;
#pragma unroll
        for (int dt = 0; dt < 4; ++dt) st.o[dt][rt] = (f32x4){0.f, 0.f, 0.f, 0.f}; }
}


DI void ns_vtr8(const LAS unsigned char* vp_, bf16x8 (&Xv)[4]) {
    const unsigned a0 = (unsigned)(size_t)vp_, a1 = a0 ^ 32u, a2 = a0 ^ 64u, a3 = a0 ^ 96u;
    s16x4 t0, t1, t2, t3, t4, t5, t6, t7;
    asm volatile("ds_read_b64_tr_b16 %0, %8\n\tds_read_b64_tr_b16 %1, %8 offset:2048\n\tds_read_b64_tr_b16 %2, %9\n\tds_read_b64_tr_b16 %3, %9 offset:2048\n\t"
                 "ds_read_b64_tr_b16 %4, %10\n\tds_read_b64_tr_b16 %5, %10 offset:2048\n\tds_read_b64_tr_b16 %6, %11\n\tds_read_b64_tr_b16 %7, %11 offset:2048\n\ts_waitcnt lgkmcnt(0)"
                 : "=&v"(t0), "=&v"(t1), "=&v"(t2), "=&v"(t3), "=&v"(t4), "=&v"(t5), "=&v"(t6), "=&v"(t7) : "v"(a0), "v"(a1), "v"(a2), "v"(a3) : "memory");
    Xv[0] = __builtin_shufflevector(t0, t1, 0, 1, 2, 3, 4, 5, 6, 7); Xv[1] = __builtin_shufflevector(t2, t3, 0, 1, 2, 3, 4, 5, 6, 7);
    Xv[2] = __builtin_shufflevector(t4, t5, 0, 1, 2, 3, 4, 5, 6, 7); Xv[3] = __builtin_shufflevector(t6, t7, 0, 1, 2, 3, 4, 5, 6, 7);
}

namespace nsb {
typedef float f32x16 __attribute__((ext_vector_type(16)));
constexpr int NSLOT = 3, SLOTB = 8192, LDS_K = 0, LDS_V = NSLOT * SLOTB, LDS_WS = 2 * NSLOT * SLOTB, LDS_OST = LDS_WS + 8 * 64 * 4, LDS_BYTES = LDS_OST + 8 * 4096;
constexpr int PITCH = 1536;
DI int crow(int r, int hi) { return (r & 3) + 8 * (r >> 2) + 4 * hi; }
#define NSB_SBAR() __builtin_amdgcn_sched_barrier(0)
DI void glds16(const void* sbase_, unsigned voff, unsigned lds_dst) { unsigned keep;
    const unsigned long long a_ = (unsigned long long)sbase_;
    const unsigned long long sbase = ((unsigned long long)(unsigned)__builtin_amdgcn_readfirstlane((int)(a_ >> 32)) << 32) | (unsigned)__builtin_amdgcn_readfirstlane((int)a_);
    asm volatile("s_mov_b32 %0, m0\n\ts_mov_b32 m0, %3\n\ts_nop 0\n\tglobal_load_lds_dwordx4 %1, %2\n\ts_mov_b32 m0, %0" : "=&s"(keep) : "v"(voff), "s"(sbase), "s"(lds_dst) : "memory"); }
DI float max3f(float a, float b, float c) { float r; asm("v_max3_f32 %0, %1, %2, %3" : "=v"(r) : "v"(a), "v"(b), "v"(c)); return r; }
DI float max2f(float a, float b) { float r; asm("v_max_f32_e32 %0, %1, %2" : "=v"(r) : "v"(a), "v"(b)); return r; }
DI float fadd_s(float a, float b) { float r; asm("v_add_f32_e32 %0, %1, %2" : "=v"(r) : "v"(a), "v"(b)); return r; }
DI float fsub_s(float a, float b) { float r; asm("v_sub_f32_e32 %0, %1, %2" : "=v"(r) : "v"(a), "v"(b)); return r; }
#define NSB_WAIT_BAR(N) asm volatile("s_waitcnt vmcnt(" #N ") lgkmcnt(0)\n\ts_barrier" ::: "memory")
typedef LAS const char* lds_cptr;
DI void qkt(f32x16& p0, f32x16& p1, lds_cptr Kslot, const bf16x8* qr, const f32x16& negm, int r32, int hi) {
    lds_cptr kb = Kslot + hi * 1024 + r32 * 16;
#pragma unroll
    for (int d0 = 0; d0 < 4; ++d0) {
        const bf16x8 b0 = *(const LAS bf16x8*)(kb + d0 * 2048), b1 = *(const LAS bf16x8*)(kb + d0 * 2048 + 512);
        if (d0 == 0) { p0 = __builtin_amdgcn_mfma_f32_32x32x16_bf16(b0, qr[0], negm, 0, 0, 0); p1 = __builtin_amdgcn_mfma_f32_32x32x16_bf16(b1, qr[0], negm, 0, 0, 0); }
        else { p0 = __builtin_amdgcn_mfma_f32_32x32x16_bf16(b0, qr[d0], p0, 0, 0, 0); p1 = __builtin_amdgcn_mfma_f32_32x32x16_bf16(b1, qr[d0], p1, 0, 0, 0); } }
}
DI void kload8(bf16x8* kf, lds_cptr kp) {
    kf[0] = *(const LAS bf16x8*)(kp);        kf[1] = *(const LAS bf16x8*)(kp + 512);
    kf[2] = *(const LAS bf16x8*)(kp + 2048); kf[3] = *(const LAS bf16x8*)(kp + 2560);
    kf[4] = *(const LAS bf16x8*)(kp + 4096); kf[5] = *(const LAS bf16x8*)(kp + 4608);
    kf[6] = *(const LAS bf16x8*)(kp + 6144); kf[7] = *(const LAS bf16x8*)(kp + 6656);
}
DI void kload2(bf16x8* kf, lds_cptr kp, int j) { kf[2 * j] = *(const LAS bf16x8*)(kp + j * 2048); kf[2 * j + 1] = *(const LAS bf16x8*)(kp + j * 2048 + 512); }
DI s16x4 vtr(lds_cptr p) { return __builtin_amdgcn_ds_read_tr16_b64_v4i16((LAS s16x4*)p); }
DI float rowmax(const f32x16& p0, const f32x16& p1) {
    float a = max3f(p0[0], p0[1], p1[0]), b = max3f(p0[2], p0[3], p1[1]); a = max3f(a, p1[2], p1[3]);
#pragma unroll
    for (int r = 4; r < 16; r += 4) { a = max3f(a, p0[r], p0[r + 1]); b = max3f(b, p0[r + 2], p0[r + 3]); a = max3f(a, p1[r], p1[r + 1]); b = max3f(b, p1[r + 2], p1[r + 3]); }
    const float m = max2f(a, b);
    auto rr = __builtin_amdgcn_permlane32_swap(__float_as_uint(m), __float_as_uint(m), false, false);
    return max2f(__uint_as_float(rr[0]), __uint_as_float(rr[1]));
}
DI void pv(f32x16* o, int vb, bf16x8 pa0, bf16x8 pa1, bf16x8 pa2, bf16x8 pa3) {
#pragma unroll
    for (int d0 = 0; d0 < 2; ++d0) { s16x4 lo[4], hi[4];
#pragma unroll
        for (int ks = 0; ks < 4; ++ks) {
            asm volatile("ds_read_b64_tr_b16 %0,%1 offset:%c2" : "=&v"(lo[ks]) : "v"(vb), "i"(d0 * 4096 + ks * 1024) : "memory");
            asm volatile("ds_read_b64_tr_b16 %0,%1 offset:%c2" : "=&v"(hi[ks]) : "v"(vb), "i"(d0 * 4096 + ks * 1024 + 512) : "memory"); }
        asm volatile("s_waitcnt lgkmcnt(0)" ::: "memory"); NSB_SBAR();
#define NSB_PK(k) (bf16x8){lo[k][0], lo[k][1], lo[k][2], lo[k][3], hi[k][0], hi[k][1], hi[k][2], hi[k][3]}
        o[d0] = __builtin_amdgcn_mfma_f32_32x32x16_bf16(pa0, NSB_PK(0), o[d0], 0, 0, 0);
        o[d0] = __builtin_amdgcn_mfma_f32_32x32x16_bf16(pa1, NSB_PK(1), o[d0], 0, 0, 0);
        o[d0] = __builtin_amdgcn_mfma_f32_32x32x16_bf16(pa2, NSB_PK(2), o[d0], 0, 0, 0);
        o[d0] = __builtin_amdgcn_mfma_f32_32x32x16_bf16(pa3, NSB_PK(3), o[d0], 0, 0, 0);
#undef NSB_PK
    }
}
DI void tmask(f32x16& p0, f32x16& p1, int mode, int tl, int hi) {
    const float NEG = -__builtin_inff();
#pragma unroll
    for (int r = 0; r < 16; ++r) { const int k0 = crow(r, hi), k1 = k0 + 32;
        const bool m0 = mode == 3 || (mode == 1 ? k0 > tl : (mode == 2 && k0 <= tl)), m1 = mode == 3 || (mode == 1 ? k1 > tl : (mode == 2 && k1 <= tl));
        if (m0) p0[r] = NEG; if (m1) p1[r] = NEG; }
}
template <int THRL, int BR>
DI void unit(const Frame& F, int b, int g, int tok0, const bf16_t* PN, bf16_t* O0, LAS char* shm, const LAS unsigned* selm_tok0, const bool do_store = true) {
    const int lane = F.lane, r32 = lane & 31, hi = lane >> 5, wid = F.wave;
    const long rowbase = (long)b * SEQ; const int jq = tok0 >> 6;
    const int tl = 8 * wid + (r32 >> 2);
    const bf16_t* Qw = PN + (rowbase + tok0 + tl) * PITCH + (g * 4 + (r32 & 3)) * 64;
    const bf16_t* Kh = PN + rowbase * PITCH + 512 + (BR == 1 ? 2 : 4) * 128 + g * 64; const bf16_t* Vh = PN + rowbase * PITCH + 512 + (BR == 1 ? 3 : 5) * 128 + g * 64;
    const unsigned lds0 = (unsigned)(size_t)shm;
    LAS float* wsf = (LAS float*)(shm + LDS_WS) + wid * 64;
    const int NTreal = BR == 1 ? jq + 1 : (jq + 1 < 9 ? jq + 1 : 9);
    int NT = (NTreal + 1) & ~1; if (NT < 4) NT = 4;
#define NSB_TILE(t) (((t) < NTreal) ? (jq - (t)) : 0)
    const bf16_t* ksrc = Kh + wid * 8; const unsigned koff = (unsigned)lane * (PITCH * 2);
    const bf16_t* vsrc = Vh + (long)(16 * (wid & 3)) * PITCH + (wid >> 2) * 32; const unsigned voff = (unsigned)(lane >> 2) * (PITCH * 2) + (lane & 3) * 16;
    const unsigned kdst = lds0 + LDS_K + wid * 1024, vdst = lds0 + LDS_V + wid * 1024;
#define NSB_DMA_K(t, slot) glds16(ksrc + (long)NSB_TILE(t) * 64 * PITCH, koff, (unsigned)__builtin_amdgcn_readfirstlane(kdst + (slot)))
#define NSB_DMA_V(t, slot) glds16(vsrc + (long)NSB_TILE(t) * 64 * PITCH, voff, (unsigned)__builtin_amdgcn_readfirstlane(vdst + (slot)))
    const int vb0 = (int)(lds0 + LDS_V) + ((lane >> 4) & 1) * 32 + (lane & 3) * 8 + (4 * hi + ((lane & 15) >> 2)) * 64;
    const lds_cptr shm3 = (lds_cptr)shm; const lds_cptr Kbase = shm3 + LDS_K; bf16x8 kf[8];
    const lds_cptr kp0 = shm3 + LDS_K + hi * 1024 + r32 * 16; const lds_cptr vp0 = shm3 + LDS_V + ((lane >> 4) & 1) * 32 + (lane & 3) * 8 + (4 * hi + ((lane & 15) >> 2)) * 64;
    NSB_DMA_K(0, 0); NSB_DMA_V(0, 0); NSB_DMA_K(1, SLOTB);
    bf16x8 qr[4];
#pragma unroll
    for (int d0 = 0; d0 < 4; ++d0) qr[d0] = *(const bf16x8*)(Qw + d0 * 16 + hi * 8);
    unsigned selw[4] = {0xFFFFFFFFu, 0xFFFFFFFFu, 0xFFFFFFFFu, 0xFFFFFFFFu};
    if (BR == 1) {
#pragma unroll
        for (int i = 0; i < 4; ++i) selw[i] = selm_tok0[tl * 4 + i]; }
    float mhat = 0.f, l_reg = 0.f; f32x16 o[2]; o[0] = f32x16{}; o[1] = f32x16{}; f32x16 negm = f32x16{}; asm volatile("" : "+v"(negm));
#define NSB_CMASK(P0, P1, t) do { const int t_ = (t); if (t_ == 0) tmask(P0, P1, 1, tl, hi); else if (t_ >= NTreal) tmask(P0, P1, 3, tl, hi); else if (BR == 2 && t_ == 8) tmask(P0, P1, 2, tl, hi); } while (0)
#define NSB_NEGM(t) do { if (BR == 1) { const int j_ = NSB_TILE(t); const unsigned wq_ = (j_ >> 5) == 0 ? selw[0] : ((j_ >> 5) == 1 ? selw[1] : ((j_ >> 5) == 2 ? selw[2] : selw[3])); const float nm_ = ((wq_ >> (j_ & 31)) & 1u) ? -mhat : -__builtin_inff(); \
        _Pragma("unroll") for (int r = 0; r < 16; ++r) negm[r] = nm_; asm volatile("" : "+v"(negm)); } } while (0)
    bool resc = false;
#define NSB_START(P0, P1) do { const float rm = rowmax(P0, P1); resc = false; \
    { const float dl = rm; mhat = fadd_s(mhat, dl); \
      _Pragma("unroll") for (int r = 0; r < 16; ++r) { P0[r] = fsub_s(P0[r], dl); P1[r] = fsub_s(P1[r], dl); } \
      if (BR != 1) { _Pragma("unroll") for (int r = 0; r < 16; ++r) negm[r] = -mhat; asm volatile("" : "+v"(negm)); } } \
    _Pragma("unroll") for (int r = 0; r < 16; ++r) P0[r] = __builtin_amdgcn_exp2f(P0[r]); } while (0)
#define NSB_RESC() do { if (resc) { asm volatile("s_waitcnt lgkmcnt(0)" ::: "memory"); \
      _Pragma("unroll") for (int d_ = 0; d_ < 2; ++d_) _Pragma("unroll") for (int r = 0; r < 16; ++r) o[d_][r] *= wsf[crow(r, hi)]; } } while (0)
    f32x16 pA0, pA1, pB0, pB1;
    int sl_prev = 0, sl_cur = 0, sl_next = SLOTB;
#define NSB_ROT() do { sl_prev = sl_cur; sl_cur = sl_next; sl_next = (sl_next == (NSLOT - 1) * SLOTB) ? 0 : sl_next + SLOTB; } while (0)
    NSB_DMA_K(2, 2 * SLOTB);
    NSB_WAIT_BAR(3);
    qkt(pA0, pA1, Kbase, qr, negm, r32, hi); asm volatile("s_nop 15\n\ts_nop 7" : "+v"(pA0), "+v"(pA1)); NSB_CMASK(pA0, pA1, 0);
    NSB_START(pA0, pA1);
#pragma unroll
    for (int r = 0; r < 16; ++r) pA1[r] = __builtin_amdgcn_exp2f(pA1[r]);
    NSB_WAIT_BAR(0);
    NSB_DMA_K(3, 0); NSB_DMA_V(1, SLOTB);
    NSB_ROT();
    kload8(kf, kp0 + sl_cur);
    NSB_WAIT_BAR(2);
    s16x4 vlo[8], vhi[8]; u32x4 pw0, pw1, pw2, pw3;
#define NSB_PKW(P, B) pack2(P[B], P[B + 1])
#define NSB_PAF(k) __builtin_bit_cast(bf16x8, pw##k)
#define NSB_VFR(i) (bf16x8){vlo[i][0], vlo[i][1], vlo[i][2], vlo[i][3], vhi[i][0], vhi[i][1], vhi[i][2], vhi[i][3]}
#define NSB_PIN(x) asm volatile("" : "+v"(x))
#define NSB_MX3(a, b, c) __builtin_fmaxf(__builtin_fmaxf((a), (b)), (c))
#define NSB_GAPA(MF, A0, A1, A2, A3, W0, W1, PW) do { MF; sacc += A0; sacc += A1; sacc += A2; sacc += A3; NSB_PIN(sacc); W0; W1; NSB_PIN(PW); NSB_SBAR(); } while (0)
#define NSB_EX(v) __builtin_amdgcn_exp2f(v)
#define NSB_GAPB(MF, X, B) do { MF; X[B] = NSB_EX(X[B]); X[B + 1] = NSB_EX(X[B + 1]); X[B + 2] = NSB_EX(X[B + 2]); X[B + 3] = NSB_EX(X[B + 3]); NSB_PIN(X); NSB_SBAR(); } while (0)
#define NSB_VRD(i) do { vlo[i] = vtr(vp_ + (((i) >> 2) * 4096 + ((i) & 3) * 1024)); vhi[i] = vtr(vp_ + (((i) >> 2) * 4096 + ((i) & 3) * 1024 + 512)); } while (0)
#define NSB_KRD(G, j) do { if (G) { kload2(kf, kp0 + sl_next, j); NSB_SBAR(); } } while (0)
#define NSB_STEP(C0, C1, P0, P1, t, GK, GV, GL) do { NSB_SBAR(); \
    const lds_cptr vp_ = vp0 + sl_prev; NSB_NEGM(t); \
    NSB_VRD(0); NSB_SBAR(); float sacc = (P0[0] + P0[1]); \
    NSB_GAPA(C0 = __builtin_amdgcn_mfma_f32_32x32x16_bf16(kf[0], qr[0], negm, 0, 0, 0), P0[2], P0[3], P0[4], P0[5],     pw0[0] = NSB_PKW(P0, 0), pw0[1] = NSB_PKW(P0, 2), pw0); \
    NSB_VRD(4); NSB_SBAR(); NSB_GAPA(C1 = __builtin_amdgcn_mfma_f32_32x32x16_bf16(kf[1], qr[0], negm, 0, 0, 0), P0[6], P0[7], P0[8], P0[9],     pw0[2] = NSB_PKW(P0, 4), pw0[3] = NSB_PKW(P0, 6), pw0); \
    NSB_VRD(1); NSB_SBAR(); NSB_GAPA(C0 = __builtin_amdgcn_mfma_f32_32x32x16_bf16(kf[2], qr[1], C0, 0, 0, 0),   P0[10], P0[11], P0[12], P0[13], pw1[0] = NSB_PKW(P0, 8), pw1[1] = NSB_PKW(P0, 10), pw1); \
    NSB_VRD(5); NSB_SBAR(); NSB_GAPA(C1 = __builtin_amdgcn_mfma_f32_32x32x16_bf16(kf[3], qr[1], C1, 0, 0, 0),   P0[14], P0[15], P1[0], P1[1],   pw1[2] = NSB_PKW(P0, 12), pw1[3] = NSB_PKW(P0, 14), pw1); \
    NSB_VRD(2); NSB_SBAR(); NSB_GAPA(C0 = __builtin_amdgcn_mfma_f32_32x32x16_bf16(kf[4], qr[2], C0, 0, 0, 0),   P1[2], P1[3], P1[4], P1[5],     pw2[0] = NSB_PKW(P1, 0), pw2[1] = NSB_PKW(P1, 2), pw2); \
    NSB_VRD(6); NSB_SBAR(); NSB_GAPA(C1 = __builtin_amdgcn_mfma_f32_32x32x16_bf16(kf[5], qr[2], C1, 0, 0, 0),   P1[6], P1[7], P1[8], P1[9],     pw2[2] = NSB_PKW(P1, 4), pw2[3] = NSB_PKW(P1, 6), pw2); \
    NSB_VRD(3); NSB_SBAR(); NSB_GAPA(C0 = __builtin_amdgcn_mfma_f32_32x32x16_bf16(kf[6], qr[3], C0, 0, 0, 0),   P1[10], P1[11], P1[12], P1[13], pw3[0] = NSB_PKW(P1, 8), pw3[1] = NSB_PKW(P1, 10), pw3); \
    NSB_VRD(7); NSB_SBAR(); NSB_GAPA(C1 = __builtin_amdgcn_mfma_f32_32x32x16_bf16(kf[7], qr[3], C1, 0, 0, 0),   P1[14], P1[15], 0.f, 0.f,       pw3[2] = NSB_PKW(P1, 12), pw3[3] = NSB_PKW(P1, 14), pw3); \
    l_reg += sacc; \
    if (GK) { NSB_DMA_K((t) + 3, sl_cur); } if (GV) { NSB_DMA_V((t) + 1, sl_next); } \
    NSB_CMASK2(C0, C1, t); \
    { float a = NSB_MX3(C0[0], C0[1], C1[0]), b_ = NSB_MX3(C0[2], C0[3], C1[1]); a = NSB_MX3(a, C1[2], C1[3]); \
      _Pragma("unroll") for (int r = 4; r < 16; r += 4) { a = NSB_MX3(a, C0[r], C0[r + 1]); b_ = NSB_MX3(b_, C0[r + 2], C0[r + 3]); a = NSB_MX3(a, C1[r], C1[r + 1]); b_ = NSB_MX3(b_, C1[r + 2], C1[r + 3]); } \
      float rm = __builtin_fmaxf(a, b_); { auto rr = __builtin_amdgcn_permlane32_swap(__float_as_uint(rm), __float_as_uint(rm), false, false); rm = __builtin_fmaxf(__uint_as_float(rr[0]), __uint_as_float(rr[1])); } \
      resc = false; \
      if (__builtin_expect(__any(rm > (float)THRL), 0)) { const float dl = __builtin_fmaxf(rm, 0.f); mhat += dl; \
        _Pragma("unroll") for (int r = 0; r < 16; ++r) { C0[r] -= dl; C1[r] -= dl; } \
        if (BR != 1) { _Pragma("unroll") for (int r = 0; r < 16; ++r) negm[r] = -mhat; asm volatile("" : "+v"(negm)); } \
        const float f = __builtin_amdgcn_exp2f(-dl); l_reg *= f; if (hi == 0) wsf[r32] = f; resc = true; } } \
    NSB_SBAR(); \
    NSB_GAPB(o[0] = __builtin_amdgcn_mfma_f32_32x32x16_bf16(NSB_PAF(0), NSB_VFR(0), o[0], 0, 0, 0), C0, 0); \
    NSB_GAPB(o[1] = __builtin_amdgcn_mfma_f32_32x32x16_bf16(NSB_PAF(0), NSB_VFR(4), o[1], 0, 0, 0), C0, 4); \
    NSB_KRD(GL, 0); NSB_GAPB(o[0] = __builtin_amdgcn_mfma_f32_32x32x16_bf16(NSB_PAF(1), NSB_VFR(1), o[0], 0, 0, 0), C0, 8); \
    NSB_KRD(GL, 1); NSB_GAPB(o[1] = __builtin_amdgcn_mfma_f32_32x32x16_bf16(NSB_PAF(1), NSB_VFR(5), o[1], 0, 0, 0), C0, 12); \
    NSB_KRD(GL, 2); NSB_GAPB(o[0] = __builtin_amdgcn_mfma_f32_32x32x16_bf16(NSB_PAF(2), NSB_VFR(2), o[0], 0, 0, 0), C1, 0); \
    NSB_KRD(GL, 3); NSB_GAPB(o[1] = __builtin_amdgcn_mfma_f32_32x32x16_bf16(NSB_PAF(2), NSB_VFR(6), o[1], 0, 0, 0), C1, 4); \
    NSB_GAPB(o[0] = __builtin_amdgcn_mfma_f32_32x32x16_bf16(NSB_PAF(3), NSB_VFR(3), o[0], 0, 0, 0), C1, 8); \
    NSB_GAPB(o[1] = __builtin_amdgcn_mfma_f32_32x32x16_bf16(NSB_PAF(3), NSB_VFR(7), o[1], 0, 0, 0), C1, 12); \
    } while (0)
    int t = 1;
#define NSB_CMASK2(P0, P1, t) do {} while (0)
    for (; t + 5 < NT; t += 2) {
        NSB_STEP(pB0, pB1, pA0, pA1, t, true, true, true);     NSB_WAIT_BAR(2); NSB_RESC(); NSB_ROT();
        NSB_STEP(pA0, pA1, pB0, pB1, t + 1, true, true, true); NSB_WAIT_BAR(2); NSB_RESC(); NSB_ROT();
    }
#undef NSB_CMASK2
#define NSB_CMASK2(P0, P1, t) NSB_CMASK(P0, P1, t)
#define NSB_ENDW(tt) do { if ((tt) + 3 < NT) { NSB_WAIT_BAR(2); } else if ((tt) + 2 < NT) { NSB_WAIT_BAR(1); } else { NSB_WAIT_BAR(0); } } while (0)
    for (; t + 1 < NT; t += 2) {
        NSB_STEP(pB0, pB1, pA0, pA1, t, (t + 3 < NT), (t + 1 < NT), (t + 1 < NT));         NSB_ENDW(t);     NSB_RESC(); NSB_ROT();
        NSB_STEP(pA0, pA1, pB0, pB1, t + 1, (t + 4 < NT), (t + 2 < NT), (t + 2 < NT));     NSB_ENDW(t + 1); NSB_RESC(); NSB_ROT();
    }
    NSB_STEP(pB0, pB1, pA0, pA1, NT - 1, false, false, false); NSB_RESC();
    { float sacc = pB0[0] + pB0[1];
#pragma unroll
      for (int r = 2; r < 16; ++r) sacc += pB0[r];
#pragma unroll
      for (int r = 0; r < 16; ++r) sacc += pB1[r];
      l_reg += sacc;
      pw0 = (u32x4){NSB_PKW(pB0, 0), NSB_PKW(pB0, 2), NSB_PKW(pB0, 4), NSB_PKW(pB0, 6)}; pw1 = (u32x4){NSB_PKW(pB0, 8), NSB_PKW(pB0, 10), NSB_PKW(pB0, 12), NSB_PKW(pB0, 14)};
      pw2 = (u32x4){NSB_PKW(pB1, 0), NSB_PKW(pB1, 2), NSB_PKW(pB1, 4), NSB_PKW(pB1, 6)}; pw3 = (u32x4){NSB_PKW(pB1, 8), NSB_PKW(pB1, 10), NSB_PKW(pB1, 12), NSB_PKW(pB1, 14)};
      NSB_SBAR(); pv(o, vb0 + sl_cur, NSB_PAF(0), NSB_PAF(1), NSB_PAF(2), NSB_PAF(3)); }
    { auto rr = __builtin_amdgcn_permlane32_swap(__float_as_uint(l_reg), __float_as_uint(l_reg), false, false); l_reg = __uint_as_float(rr[0]) + __uint_as_float(rr[1]); }
    const int lane2 = lane_id(), r32b = lane2 & 31, hib = lane2 >> 5;
    if (hib == 0) { const float gt = sigmoidf_(bf2f(PN[(rowbase + tok0 + 8 * wid + (r32b >> 2)) * PITCH + 1280 + BR * 8 + g * 4 + (r32b & 3)])); wsf[32 + r32b] = l_reg > 0.f ? gt * rcpf_(l_reg) : 0.f; }
    asm volatile("s_waitcnt lgkmcnt(0)" ::: "memory");
    float rli[16];
#pragma unroll
    for (int r = 0; r < 16; ++r) rli[r] = wsf[32 + crow(r, hib)];
    { LAS bf16_t* stg = (LAS bf16_t*)(shm + LDS_OST) + wid * 2048;
#pragma unroll
      for (int r = 0; r < 16; ++r) { const int orow = crow(r, hib);
#pragma unroll
          for (int d0 = 0; d0 < 2; ++d0) stg[orow * 64 + d0 * 32 + r32b] = f2bf(o[d0][r] * rli[r]); }
      asm volatile("s_waitcnt lgkmcnt(0)" ::: "memory");
#pragma unroll
      for (int i = 0; i < 4; ++i) { const int row = i * 8 + (lane2 >> 3), ch = lane2 & 7; const u32x4 v = *(const LAS u32x4*)(stg + row * 64 + ch * 8);
          bf16_t* op = O0 + (rowbase + tok0 + 8 * wid + (row >> 2)) * 1024 + 512 + (g * 4 + (row & 3)) * 64 + ch * 8;
          if (do_store) { float a8[8], b8[8]; unpack8(*(const u32x4*)op, a8); unpack8(v, b8);
#pragma unroll
              for (int e = 0; e < 8; ++e) a8[e] += b8[e];
              *(u32x4*)op = pack8(a8); }
          else asm volatile("" :: "v"(v)); } }
    asm volatile("s_waitcnt vmcnt(0) lgkmcnt(0)\n\ts_barrier" ::: "memory");
#undef NSB_TILE
#undef NSB_DMA_K
#undef NSB_DMA_V
#undef NSB_CMASK
#undef NSB_CMASK2
#undef NSB_NEGM
#undef NSB_START
#undef NSB_RESC
#undef NSB_ROT
#undef NSB_PKW
#undef NSB_PAF
#undef NSB_VFR
#undef NSB_PIN
#undef NSB_MX3
#undef NSB_GAPA
#undef NSB_GAPB
#undef NSB_EX
#undef NSB_VRD
#undef NSB_KRD
#undef NSB_STEP
#undef NSB_ENDW
}
#undef NSB_SBAR
#undef NSB_WAIT_BAR
}

DI void nsa_unit(const Frame& F0, int unit, const int mode = 0x3F) {
    Frame F = F0; F.tid = F.wave * 64 + lane_id(); asm volatile("" : "+v"(F.tid)); F.lane = F.tid & 63;
    const int qt = 63 - (unit >> 4), b = (unit >> 1) & 7, g = unit & 1;
    const int t0 = qt * 128, tw = t0 + 16 * F.wave;
    const size_t tokb = (size_t)b * SEQ;
    const int lane = F.lane, fr = lane & 15, fq = lane >> 4, q = fr >> 2, pp = lane & 3;
    const bf16_t* PN = (const bf16_t*)(F.ws + OFF_PN);
    LAS float* imp = (LAS float*)(F.lds + NS_OFF_IMP); LAS unsigned* selm = (LAS unsigned*)(F.lds + NS_OFF_SEL);
    const int hd = fr & 3, posl = tw + (fr >> 2);
    bf16x8 Qf[4][2];
#pragma unroll
    for (int rt = 0; rt < 4; ++rt)
#pragma unroll
        for (int ks = 0; ks < 2; ++ks) { float v[8]; unpack8(*(const u32x4*)(PN + (tokb + posl + 4 * rt) * 1536 + (g * 4 + hd) * 64 + 32 * ks + 8 * fq), v);
            u32x4 w; w[0] = cvtpk(v[0], v[1]); w[1] = cvtpk(v[2], v[3]); w[2] = cvtpk(v[4], v[5]); w[3] = cvtpk(v[6], v[7]);
            Qf[rt][ks] = __builtin_bit_cast(bf16x8, w); }
    __syncthreads();
    for (int i = F.tid; i < 128 * 128; i += NTH) imp[i] = 0.f;
    FState st;
    bf16_t* O0 = (bf16_t*)(F.ws + OFF_O0);
    if (mode & 1) {
        TileSrc S{(const bf16_t*)(F.ws + SM_KCMP) + ((size_t)b * 512 * 2 + g) * 64, (const bf16_t*)(F.ws + SM_VCMPT) + ((size_t)b * 512 * 2 + g) * 64, 128};
        int nmax = (t0 + 96) >> 4; if (nmax > 510) nmax = 510;
        const int ntl = (nmax >> 6) + 1;
        const int nfull = (tw - 31) >> 4;
        ns_reset(st);
        asm volatile("s_waitcnt vmcnt(0)" ::: "memory"); __syncthreads();
        for (int p_ = 0; p_ < 3 && p_ < ntl; ++p_) ns_dma(F, S, p_, p_);
#pragma unroll 1
        for (int j = 0; j < ntl; ++j) {
            ns_wait(ntl - 1 - j);
            if (j + 3 < ntl) ns_dma(F, S, j + 3, (j + 3) & 3);
            const LAS unsigned char* tb0 = F.lds + (j & 3) * NS_STG;
#pragma unroll 1
            for (int koff = 0; koff < 64; koff += 32) {
                const int nb = j * 64 + koff;
                if (16 * nb + 31 > tw + 15) continue;
                if (nb + 31 <= nfull) ns_step<0, false, true>(tb0 + koff * 128, nb, Qf, st, 0xFu, 0xFu, posl, 0, fr, fq, q, pp);
                else ns_step<1, false, true>(tb0 + koff * 128, nb, Qf, st, 0xFu, 0xFu, posl, 0, fr, fq, q, pp);
            }
        }
        float il[4];
#pragma unroll
        for (int rt = 0; rt < 4; ++rt) { float l = st.l[rt]; l += shx(l, 16); l += shx(l, 32); il[rt] = l > 0.f ? rcpf_(l) : 0.f; }
        __syncthreads();
        float carry[4] = {0.f, 0.f, 0.f, 0.f}; const int bpa = ((lane + 48) & 63) << 2;
        for (int p_ = 0; p_ < 3 && p_ < ntl; ++p_) ns_dma(F, S, p_, p_);
#pragma unroll 1
        for (int j = 0; j < ntl; ++j) {
            ns_wait(ntl - 1 - j);
            if (j + 3 < ntl) ns_dma(F, S, j + 3, (j + 3) & 3);
            const LAS unsigned char* tb0 = F.lds + (j & 3) * NS_STG;
#pragma unroll 1
            for (int koff = 0; koff < 64; koff += 32) {
                const int nb = j * 64 + koff;
                if (16 * nb + 31 > tw + 15) continue;
                const LAS unsigned char* tb = tb0 + koff * 128;
                const int lk = fr * 128 + ((fq ^ (fr & 7)) << 4);
                const int m_ = (4 * fq + q) & 7, vbl = (4 * fq + q) * 128 + ((((pp >> 1) ^ (m_ & 1))) << 4) + (pp & 1) * 8 + ((m_ >> 1) << 5);
                const LAS unsigned char* kp0 = tb + lk; const LAS unsigned char* kp1 = tb + (lk ^ 64); const LAS unsigned char* vp_ = tb + 8192 + vbl;
                asm volatile("" : "+v"(kp0), "+v"(kp1), "+v"(vp_));
                f32x4 s[2][4];
#pragma unroll
                for (int rt = 0; rt < 4; ++rt) { s[0][rt] = (f32x4){0.f, 0.f, 0.f, 0.f}; s[1][rt] = s[0][rt]; }
#pragma unroll
                for (int ks = 0; ks < 2; ++ks)
#pragma unroll
                    for (int kt = 0; kt < 2; ++kt) { const bf16x8 X = *(const LAS bf16x8*)((ks ? kp1 : kp0) + kt * 2048);
#pragma unroll
                        for (int rt = 0; rt < 4; ++rt) s[kt][rt] = MFMA16(X, Qf[rt][ks], s[kt][rt]); }
                bf16x8 Y[4];
#pragma unroll
                for (int rt = 0; rt < 4; ++rt) {
#pragma unroll
                    for (int kt = 0; kt < 2; ++kt) {
#pragma unroll
                        for (int r = 0; r < 4; ++r) { const int n = nb + 16 * kt + 4 * fq + r; s[kt][rt][r] = (n <= ((posl + 4 * rt - 31) >> 4)) ? fexp2(s[kt][rt][r] - st.m[rt]) * il[rt] : 0.f; }
                        float a = s[kt][rt][0] + s[kt][rt][1] + s[kt][rt][2] + 0.5f * s[kt][rt][3], bb = 0.5f * s[kt][rt][3];
                        a += dpp_mov<0xB1>(a); a += dpp_mov<0x4E>(a); bb += dpp_mov<0xB1>(bb); bb += dpp_mov<0x4E>(bb);
                        const float pull = __int_as_float(__builtin_amdgcn_ds_bpermute(bpa, __float_as_int(bb)));
                        const float val = a + (fq > 0 ? pull : carry[rt]); carry[rt] = pull;
                        if (hd == 0) { const int jj = (nb >> 2) + 4 * kt + fq; const int tl = 16 * F.wave + 4 * rt + (fr >> 2);
                            asm volatile("ds_write_b32 %0, %1" :: "v"((unsigned)(size_t)imp + (unsigned)(tl * 128 + jj) * 4u), "v"(val) : "memory"); }
                    }
                    u32x4 w; w[0] = cvtpk(s[0][rt][0], s[0][rt][1]); w[1] = cvtpk(s[0][rt][2], s[0][rt][3]); w[2] = cvtpk(s[1][rt][0], s[1][rt][1]); w[3] = cvtpk(s[1][rt][2], s[1][rt][3]);
                    Y[rt] = __builtin_bit_cast(bf16x8, w);
                }
                bf16x8 Xv[4]; ns_vtr8(vp_, Xv);
#pragma unroll
                for (int dt = 0; dt < 4; ++dt)
#pragma unroll
                    for (int rt = 0; rt < 4; ++rt) st.o[dt][rt] = MFMA16(Xv[dt], Y[rt], st.o[dt][rt]);
            }
        }
        int pl_ = posl; asm volatile("" : "+v"(pl_));
#pragma unroll
        for (int rt = 0; rt < 4; ++rt) { const float gt = sigmoidf_(bf2f(PN[(tokb + pl_ + 4 * rt) * 1536 + 1280 + 0 * 8 + g * 4 + hd]));
#pragma unroll
            for (int dt = 0; dt < 4; ++dt) { const f32x4 v = st.o[dt][rt] * gt; u32x2 o; o[0] = cvtpk(v[0], v[1]); o[1] = cvtpk(v[2], v[3]);
                if (mode & 16) *(u32x2*)(O0 + (tokb + pl_ + 4 * rt) * 1024 + 512 + (g * 4 + hd) * 64 + 16 * dt + 4 * fq) = o; } }
    }
    __syncthreads();
#pragma unroll 1
    for (int tl = 0; tl < ((mode & 2) ? 16 : 0); ++tl) {
        const int pos = tw + tl, cur = pos >> 6; const int tg = 16 * F.wave + tl;
        const int j0 = lane, j1 = lane + 64;
        bool s0, s1;
        if (cur < 16) { s0 = j0 <= cur; s1 = false; }
        else {
            const bool c0 = j0 >= 1 && j0 <= cur - 2, c1 = j1 <= cur - 2;
            const unsigned v0 = c0 ? __float_as_uint(imp[tg * 128 + j0]) : 0u, v1 = c1 ? __float_as_uint(imp[tg * 128 + j1]) : 0u;
            unsigned thr = 0u; bool exact = false;
#pragma unroll 1
            for (int bit = 30; bit >= 0; --bit) {
                const unsigned cand = thr | (1u << bit);
                const int cnt = __popcll(__ballot(c0 && v0 >= cand)) + __popcll(__ballot(c1 && v1 >= cand));
                if (cnt >= 13) { thr = cand; if (cnt == 13) { exact = true; break; } }
            }
            if (exact) { s0 = c0 && v0 >= thr; s1 = c1 && v1 >= thr; }
            else {
                const unsigned long long g0 = __ballot(c0 && v0 > thr), g1 = __ballot(c1 && v1 > thr), e0 = __ballot(c0 && v0 == thr), e1 = __ballot(c1 && v1 == thr);
                const int need = 13 - __popcll(g0) - __popcll(g1);
                const unsigned long long lt = (1ull << lane) - 1ull;
                s0 = c0 && (v0 > thr || (v0 == thr && __popcll(e0 & lt) < need));
                s1 = c1 && (v1 > thr || (v1 == thr && __popcll(e0) + __popcll(e1 & lt) < need));
            }
            s0 = s0 || j0 == 0 || j0 == cur - 1 || j0 == cur; s1 = s1 || j1 == cur - 1 || j1 == cur;
        }
        const unsigned long long m0 = __ballot(s0), m1 = __ballot(s1);
        if (lane == 0) { selm[tg * 4 + 0] = (unsigned)m0; selm[tg * 4 + 1] = (unsigned)(m0 >> 32); selm[tg * 4 + 2] = (unsigned)m1; selm[tg * 4 + 3] = (unsigned)(m1 >> 32); }
    }
    __syncthreads();
    if (mode & 4) {
#pragma unroll 1
        for (int half = 0; half < 2; ++half) {
            nsb::unit<8, 1>(F, b, g, t0 + 64 * half, PN, O0, (LAS char*)F.lds, selm + 64 * half * 4, (mode & 16) != 0);
            if (mode & 8) nsb::unit<8, 2>(F, b, g, t0 + 64 * half, PN, O0, (LAS char*)F.lds, selm, (mode & 16) != 0);
        }
    }
}
DI void nsa_phase(const Frame& F0, int qi = 0, const int mode = 0x3F) {
    Frame F = F0; F.tid = F.wave * 64 + lane_id(); F.lane = F.tid & 63;
    LAS int* uw = (LAS int*)(F.lds + NS_OFF_U);
    unsigned* qh = (unsigned*)(F.ws + CTL_Q) + 64 * qi;
    for (;;) {
        __syncthreads();
        if (F.tid == 0) *uw = (int)__hip_atomic_fetch_add(qh, 1u, __ATOMIC_RELAXED, __HIP_MEMORY_SCOPE_AGENT);
        __syncthreads();
        const int u = *uw;
        if (u >= 1024) break;
        nsa_unit(F, u, mode);
    }
}

__global__ void __launch_bounds__(NTH, 2) fwd_kernel(Args args) {
    extern __shared__ __attribute__((aligned(16))) unsigned char lds_raw[];
    Frame F;
    F.lds = (LAS unsigned char*)lds_raw + LDS_SCR; F.tid = threadIdx.x; F.lane = F.tid & 63; F.wave = __builtin_amdgcn_readfirstlane(F.tid >> 6); F.wg = blockIdx.x;
    F.ws = args.ws; F.out = args.out; F.in = args.in;
    volatile LAS unsigned* misc = (volatile LAS unsigned*)((LAS unsigned char*)lds_raw);
    if (F.tid < 64) misc[F.tid] = 0u;
    __syncthreads();
    XcdBarrier bar = xcd_barrier_post((unsigned*)(F.ws + CTL_BAR), misc);
    LAS int* tile_start = (LAS int*)((LAS unsigned char*)lds_raw + 256);
    const int lo = args.ph_lo, hi = args.ph_hi;
#define IN(k) (lo <= (k) && (k) < hi)
#define SEAM(k) do { if (IN(k) && IN((k) + 1)) xcd_barrier(bar); } while (0)
    const float* ln = F.in[27];

    if (IN(0)) {
        tr_job(F, F.in[1], 3352, 1024, 3352, 3584, (bf16_t*)(F.ws + W_IN0), 1024, 0);
        tr_job(F, F.in[2], 1024, 1024, 1024, 1024, (bf16_t*)(F.ws + W_OUT0), 1024, 0);
        {
          const float* x = F.in[0]; bf16_t* xb = (bf16_t*)(F.ws + OFF_XB);
          for (size_t i0 = (size_t)F.wg * NTH + F.tid; i0 < (size_t)T * D / 8; i0 += (size_t)GRID * NTH * 4) {
              f32x4 a[4], b[4];
#pragma unroll
              for (int k = 0; k < 4; ++k) { const size_t i = i0 + (size_t)k * GRID * NTH; a[k] = *(const f32x4*)(x + i * 8); b[k] = *(const f32x4*)(x + i * 8 + 4); }
#pragma unroll
              for (int k = 0; k < 4; ++k) { const size_t i = i0 + (size_t)k * GRID * NTH; u32x4 o; o[0] = pack2(a[k][0], a[k][1]); o[1] = pack2(a[k][2], a[k][3]); o[2] = pack2(b[k][0], b[k][1]); o[3] = pack2(b[k][2], b[k][3]);
                  *(u32x4*)(xb + i * 8) = o; } } }
        {
          bf16_t* wl1 = (bf16_t*)(F.ws + W_L1); const float* mu = F.in[3];
          for (int i = F.wg * NTH + F.tid; i < 256 * 1024; i += GRID * NTH) { const int n = i >> 10, k = i & 1023, kk = k & 511;
              const int which = n < 64 ? 0 : (n < 128 ? 1 : 2); const int j = n - (which == 0 ? 0 : (which == 1 ? 64 : 128));
              const float* X1 = which == 0 ? F.in[5] : (which == 1 ? F.in[8] : F.in[10]); const int ldx = which == 2 ? 128 : 64;
              const float m = mu[(3 + which) * 512 + kk]; wl1[i] = f2bf((k < 512 ? (1.0f - m) : m) * X1[kk * ldx + j]); }
          bf16_t* wl2 = (bf16_t*)(F.ws + W_L2);
          for (int i = F.wg * NTH + F.tid; i < 1536 * 256; i += GRID * NTH) { const int n = i >> 8, k = i & 255; float v = 0.f;
              if (n < 512) { if (k < 64) v = F.in[6][k * 512 + n]; } else if (n < 1024) { if (k >= 64 && k < 128) v = F.in[9][(k - 64) * 512 + n - 512]; } else { if (k >= 128) v = F.in[11][(k - 128) * 512 + n - 1024]; }
              wl2[i] = f2bf(v); }
          bf16_t* pr = (bf16_t*)(F.ws + OFF_PR);
          for (int i = F.wg * NTH + F.tid; i < 8 * 2048; i += GRID * NTH) pr[(size_t)(i >> 11) * 8193 * 2048 + (i & 2047)] = 0; }
        tr_job(F, F.in[17], 128, 2048, 128, 256, (bf16_t*)(F.ws + W_C1), 2048, 0);
        tr_job(F, F.in[17] + 2048 * 128, 128, 2048, 128, 256, (bf16_t*)(F.ws + W_C1) + 256 * 2048, 2048, 0);
        {
          bf16_t* wc2 = (bf16_t*)(F.ws + W_C2);
          for (int i = F.wg * NTH + F.tid; i < 2 * 256 * 256; i += GRID * NTH) { const int kv = i >> 16, n = (i >> 8) & 255, k = i & 255;
              wc2[i] = f2bf((n < 64 && k < 128) ? F.in[18][(size_t)kv * 128 * 64 + k * 64 + n] : 0.f); }
          float* cb = (float*)(F.ws + SM_CBIAS);
          { const int i = F.wg * 8 + F.wave; if (i < 512) { const int kv = i >> 8, n = i & 255; float acc = 0.f;
              if (n < 128) { for (int k = F.tid & 63; k < 2048; k += 64) acc += F.in[16][kv * 2048 + k] * F.in[17][((size_t)kv * 2048 + k) * 128 + n]; acc = wave_sum(acc); }
              if ((F.tid & 63) == 0) cb[i] = acc; } }
          float* rn = (float*)(F.ws + SM_ROPEN);
          for (int i = F.wg * NTH + F.tid; i < 8192 * 8; i += GRID * NTH) { const int p = i >> 3, k = i & 7;
              const double ang = (double)p * exp(-13.122363377404328 * (double)k / 8.0); rn[2 * i] = (float)cos(ang); rn[2 * i + 1] = (float)sin(ang); } }
        tr_job(F, F.in[19], 6144, 1024, 6144, 6144, (bf16_t*)(F.ws + W_RTIN), 1024, 3, RTI8 ? F8_SW : 0.f);
        tr_job(F, F.in[20], 1024, 2048, 1024, 1024, (bf16_t*)(F.ws + W_RTOUT), 2048, 0, RTO8 ? F8_SWO : 0.f);
        __syncthreads();
    }
    SEAM(0);
#if PROBE == 11
    {
        tr_job(F, F.in[1], 3352, 1024, 3352, 3584, (bf16_t*)(F.ws + W_IN0), 1024, 0);
        tr_job(F, F.in[2], 1024, 1024, 1024, 1024, (bf16_t*)(F.ws + W_OUT0), 1024, 0);
        {
          const float* x = F.in[0]; bf16_t* xb = (bf16_t*)(F.ws + OFF_XB);
          for (size_t i0 = (size_t)F.wg * NTH + F.tid; i0 < (size_t)T * D / 8; i0 += (size_t)GRID * NTH * 4) {
              f32x4 a[4], b[4];
#pragma unroll
              for (int k = 0; k < 4; ++k) { const size_t i = i0 + (size_t)k * GRID * NTH; a[k] = *(const f32x4*)(x + i * 8); b[k] = *(const f32x4*)(x + i * 8 + 4); }
#pragma unroll
              for (int k = 0; k < 4; ++k) { const size_t i = i0 + (size_t)k * GRID * NTH; u32x4 o; o[0] = pack2(a[k][0], a[k][1]); o[1] = pack2(a[k][2], a[k][3]); o[2] = pack2(b[k][0], b[k][1]); o[3] = pack2(b[k][2], b[k][3]);
                  *(u32x4*)(xb + i * 8) = o; } } }
        {
          bf16_t* wl1 = (bf16_t*)(F.ws + W_L1); const float* mu = F.in[3];
          for (int i = F.wg * NTH + F.tid; i < 256 * 1024; i += GRID * NTH) { const int n = i >> 10, k = i & 1023, kk = k & 511;
              const int which = n < 64 ? 0 : (n < 128 ? 1 : 2); const int j = n - (which == 0 ? 0 : (which == 1 ? 64 : 128));
              const float* X1 = which == 0 ? F.in[5] : (which == 1 ? F.in[8] : F.in[10]); const int ldx = which == 2 ? 128 : 64;
              const float m = mu[(3 + which) * 512 + kk]; wl1[i] = f2bf((k < 512 ? (1.0f - m) : m) * X1[kk * ldx + j]); }
          bf16_t* wl2 = (bf16_t*)(F.ws + W_L2);
          for (int i = F.wg * NTH + F.tid; i < 1536 * 256; i += GRID * NTH) { const int n = i >> 8, k = i & 255; float v = 0.f;
              if (n < 512) { if (k < 64) v = F.in[6][k * 512 + n]; } else if (n < 1024) { if (k >= 64 && k < 128) v = F.in[9][(k - 64) * 512 + n - 512]; } else { if (k >= 128) v = F.in[11][(k - 128) * 512 + n - 1024]; }
              wl2[i] = f2bf(v); }
          bf16_t* pr = (bf16_t*)(F.ws + OFF_PR);
          for (int i = F.wg * NTH + F.tid; i < 8 * 2048; i += GRID * NTH) pr[(size_t)(i >> 11) * 8193 * 2048 + (i & 2047)] = 0; }
        tr_job(F, F.in[17], 128, 2048, 128, 256, (bf16_t*)(F.ws + W_C1), 2048, 0);
        tr_job(F, F.in[17] + 2048 * 128, 128, 2048, 128, 256, (bf16_t*)(F.ws + W_C1) + 256 * 2048, 2048, 0);
        {
          bf16_t* wc2 = (bf16_t*)(F.ws + W_C2);
          for (int i = F.wg * NTH + F.tid; i < 2 * 256 * 256; i += GRID * NTH) { const int kv = i >> 16, n = (i >> 8) & 255, k = i & 255;
              wc2[i] = f2bf((n < 64 && k < 128) ? F.in[18][(size_t)kv * 128 * 64 + k * 64 + n] : 0.f); }
          float* cb = (float*)(F.ws + SM_CBIAS);
          { const int i = F.wg * 8 + F.wave; if (i < 512) { const int kv = i >> 8, n = i & 255; float acc = 0.f;
              if (n < 128) { for (int k = F.tid & 63; k < 2048; k += 64) acc += F.in[16][kv * 2048 + k] * F.in[17][((size_t)kv * 2048 + k) * 128 + n]; acc = wave_sum(acc); }
              if ((F.tid & 63) == 0) cb[i] = acc; } }
          float* rn = (float*)(F.ws + SM_ROPEN);
          for (int i = F.wg * NTH + F.tid; i < 8192 * 8; i += GRID * NTH) { const int p = i >> 3, k = i & 7;
              const double ang = (double)p * exp(-13.122363377404328 * (double)k / 8.0); rn[2 * i] = (float)cos(ang); rn[2 * i + 1] = (float)sin(ang); } }
        tr_job(F, F.in[19], 6144, 1024, 6144, 6144, (bf16_t*)(F.ws + W_RTIN), 1024, 3, RTI8 ? F8_SW : 0.f);
        tr_job(F, F.in[20], 1024, 2048, 1024, 1024, (bf16_t*)(F.ws + W_RTOUT), 2048, 0, RTO8 ? F8_SWO : 0.f);
        __syncthreads();
        { float* rr = (float*)(F.ws + SM_ROPER);
          for (int i = F.wg * NTH + F.tid; i < 8192 * 64; i += GRID * NTH) { const int p = i >> 6, k = i & 63;
              const double ang = (double)p * exp(-9.210340371976184 * (double)k / 63.0); rr[2 * i] = (float)cos(ang); rr[2 * i + 1] = (float)sin(ang); } }
    }
    xcd_barrier(bar);
#endif
    if (IN(1)) {
        pg8::GemmK g{1024, 1024, 1024, 128, 1 << 30, 0};
        pg8::DenseSched S; S.init(F.ws + OFF_XB, 1024, F.ws + W_IN0, 1024, T, 3584, GRID, F.wg);
        bf16_t* PR = (bf16_t*)(F.ws + OFF_PR); bf16_t* PN = (bf16_t*)(F.ws + OFF_PN);
        auto f = [PR, PN](const pg8::Unit&, int row, int col, const float (&v)[8]) {
            if (col < 2048) store8(PR + ((size_t)row + (row >> 13) + 1) * 2048 + col, v);
            else if (col < 2560) { float o[8];
#pragma unroll
                for (int i = 0; i < 8; ++i) o[i] = v[i] * NS_C;
                store8(PN + (size_t)row * 1536 + (col - 2048), o); }
            else store8(PN + (size_t)row * 1536 + (col - 2048), v); };
        pg8::EpiRow8<decltype(f)> E{f};
        pg8::gemm_phase(F.lds, F.wave, g, S, E);
    }
    SEAM(1);
#if PROBE == 6
    {
        pg8::GemmK g{1024, 1024, 1024, 128, 1 << 30, 0};
        pg8::DenseSched S; S.init(F.ws + OFF_XB, 1024, F.ws + W_IN0, 1024, T, 3584, GRID, F.wg);
        bf16_t* PR = (bf16_t*)(F.ws + OFF_PR); bf16_t* PN = (bf16_t*)(F.ws + OFF_PN);
        auto f = [PR, PN](const pg8::Unit&, int row, int col, const float (&v)[8]) {
            if (col < 2048) store8(PR + ((size_t)row + (row >> 13) + 1) * 2048 + col, v);
            else if (col < 2560) { float o[8];
#pragma unroll
                for (int i = 0; i < 8; ++i) o[i] = v[i] * NS_C;
                store8(PN + (size_t)row * 1536 + (col - 2048), o); }
            else store8(PN + (size_t)row * 1536 + (col - 2048), v); };
        pg8::EpiRow8<decltype(f)> E{f};
        pg8::gemm_phase(F.lds, F.wave, g, S, E);
        xcd_barrier(bar);
    }
#endif
    if (IN(2)) {
        rwkv_e1_phase(F);
        nsa_rope_phase(F);
        pg8::GemmK g{2048, 1024, 1024, 128, 8, -5120};
        pg8::DenseSched S; S.init(F.ws + OFF_PR + 1536 * 2, 2048, F.ws + W_L1, 1024, T, 256, GRID, F.wg, 1);
        bf16_t* HID = (bf16_t*)(F.ws + OFF_O0) + 512;
        auto f = [HID](const pg8::Unit&, int row, int col, const float (&v)[8]) {
            float o[8];
#pragma unroll
            for (int i = 0; i < 8; ++i) o[i] = col < 64 ? tanhf_(v[i]) : (col < 128 ? v[i] : sigmoidf_(v[i]));
            store8(HID + (size_t)row * 1024 + col, o); };
        pg8::EpiRow8<decltype(f)> E{f};
        pg8::gemm_phase(F.lds, F.wave, g, S, E);
    }
    SEAM(2);
    if (IN(3) && F.wg >= 64) {
        pg8::GemmK g{1024, 256, 256, 128, 1 << 30, 0};
        pg8::DenseSched S; S.init(F.ws + OFF_O0 + 512 * 2, 1024, F.ws + W_L2, 256, T, 1536, GRID - 64, F.wg - 64);
        bf16_t* SW = st_w(F); bf16_t* SKK = st_kk(F); bf16_t* SB = st_b(F); bf16_t* SKP = st_kp(F); bf16_t* O0 = (bf16_t*)(F.ws + OFF_O0);
        const float* w0 = F.in[4]; const float* a0 = F.in[7]; const float* kkw = F.in[12]; const float* kaw = F.in[13]; const float* rn = (const float*)(F.ws + SM_RNORM);
        auto f = [=](const pg8::Unit&, int row, int col, const float (&v)[8]) {
            float o[8];
            if (col < 512) {
#pragma unroll
                for (int i = 0; i < 8; ++i) o[i] = __builtin_amdgcn_exp2f(-0.606531f * 1.44269504088896341f * sigmoidf_(w0[col + i] + v[i]));
                store8(SW + (size_t)row * 512 + col, o);
            } else if (col < 1024) {
                const int c = col - 512; float k[8], kk[8], bb[8];
                unpack8(*(const u32x4*)(SKP + (size_t)row * 512 + c), k);
                const float r = rn[(size_t)row * 8 + (c >> 6)];
#pragma unroll
                for (int i = 0; i < 8; ++i) { const float a = sigmoidf_(a0[c + i] + v[i]); kk[i] = k[i] * kkw[c + i] * r; bb[i] = kk[i] * a; o[i] = k[i] * (1.0f + (a - 1.0f) * kaw[c + i]); }
                store8(SKK + (size_t)row * 512 + c, kk); store8(SB + (size_t)row * 512 + c, bb); store8(SKP + (size_t)row * 512 + c, o);
            } else {
                store8(O0 + (size_t)row * 1024 + (col - 1024), v);
            } };
        pg8::EpiRow8<decltype(f)> E{f};
        pg8::gemm_phase(F.lds, F.wave, g, S, E);
    }
    if (IN(3)) {
        pg8::GemmK g{16 * 1536, 2048, 2048, 1536 * 2, 1 << 30, 0};
        pg8::CmpSched S{(const char*)(F.ws + OFF_PN + 512 * 2), (const char*)(F.ws + W_C1), (size_t)128, (size_t)256 * 16 * 1536 * 2, (size_t)256 * 2048 * 2, GRID, F.wg};
        bf16_t* HC = (bf16_t*)(F.ws + OFF_HC); const float* cb = (const float*)(F.ws + SM_CBIAS);
        auto f = [HC, cb](const pg8::Unit& u, int row, int col, const float (&v)[8]) {
            float o[8];
#pragma unroll
            for (int i = 0; i < 8; ++i) { const float x = v[i] + cb[(u.aux >> 1) * 256 + col + i]; o[i] = 0.5f * x * (1.0f + tanhf(0.7978845608028654f * (x + 0.044715f * x * x * x))); }
            store8(HC + ((size_t)u.aux * 4096 + row) * 256 + col, o); };
        pg8::EpiRow8<decltype(f)> E{f};
        pg8::gemm_phase(F.lds, F.wave, g, S, E);
        __threadfence(); __syncthreads();
    }
    if (IN(3)) {
        pg8::GemmK g{256, 256, 256, 128, 1 << 30, 0};
        pg8::CmpSched S{(const char*)(F.ws + OFF_HC), (const char*)(F.ws + W_C2), (size_t)4096 * 256 * 2, (size_t)256 * 256 * 2, (size_t)256 * 256 * 2, GRID, F.wg};
        bf16_t* KC = (bf16_t*)(F.ws + SM_KCMP); bf16_t* VC = (bf16_t*)(F.ws + SM_VCMPT);
        auto f = [KC, VC](const pg8::Unit& u, int row, int col, const float (&v)[8]) {
            if (col < 64) store8((u.aux < 2 ? KC : VC) + ((size_t)row * 2 + (u.aux & 1)) * 64 + col, v); };
        pg8::EpiRow8<decltype(f)> E{f};
        pg8::gemm_phase(F.lds, F.wave, g, S, E);
    }
    SEAM(3);
    if (IN(5)) { if (F.wg < SC_WGS) rwkv_scan(F); nsa_phase(F); }
    SEAM(5);
#if PROBE == 1
    if (F.wg < SC_WGS) rwkv_scan(F, false);
    xcd_barrier(bar);
#elif PROBE == 2
    nsa_phase(F, 1);
    xcd_barrier(bar);
#elif PROBE >= 20 && PROBE < 30
    nsa_phase(F, 1, PROBE == 20 ? 0x01 : PROBE == 21 ? 0x03 : PROBE == 22 ? 0x07 : PROBE == 23 ? 0x27 : PROBE == 24 ? 0x2B : PROBE == 25 ? 0x0B : 0x2F);
    xcd_barrier(bar);
#endif
    if (IN(7)) {
        pg8::GemmK g{1024, 1024, 1024, 128, 1 << 30, 0};
        pg8::DenseSched S; S.init(F.ws + OFF_O0, 1024, F.ws + W_OUT0, 1024, T, 1024, GRID, F.wg);
        bf16_t* MX = (bf16_t*)(F.ws + OFF_MIX);
        auto f = [MX](const pg8::Unit&, int row, int col, const float (&v)[8]) { store8(MX + (size_t)row * 1024 + col, v); };
        pg8::EpiRow8<decltype(f)> E{f};
        pg8::gemm_phase(F.lds, F.wave, g, S, E);
    }
    SEAM(7);
    if (IN(10)) { ln1_router_phase(F, nullptr  , (const bf16_t*)(F.ws + OFF_MIX), (bf16_t*)(F.ws + OFF_XB), ln + 0 * 1024, ln + 1 * 1024, 0, MOE8_L0 ? F.ws + OFF_XB8 : nullptr); moe_weights(F, 0, MOE8_L0); }
    SEAM(10);
#if PROBE == 5
    ln1_router_phase(F, F.in[0], (const bf16_t*)(F.ws + OFF_MIX), (bf16_t*)(F.ws + OFF_XB), ln + 0 * 1024, ln + 1 * 1024, 0); moe_weights(F, 0);
    xcd_barrier(bar);
#endif
    if (IN(11)) moe_scatter_phase(F, nullptr, 0);
    SEAM(11);
#if PROBE == 7
    moe_scatter_phase(F, nullptr, 0);
    xcd_barrier(bar);
#endif
    if (IN(12)) {
        { const int kt_ = F.wave * 64 + lane_id(); if (kt_ < 17) tile_start[kt_] = ((const int*)(F.ws + CTL_TILES))[kt_]; }
        __syncthreads();
        if (MOE8_L0) {
            pg8::GemmK g{512, 512, 512, 128, 1 << 30, 0};
            pg8::MoeSched S{(const char*)(F.ws + OFF_XB8), (const char*)(F.ws + OFF_WMOE), (size_t)0, (size_t)256 * 1024, tile_start, 8, GRID, F.wg, (const int*)(F.ws + SM_ROWTOK)};
            pg8::EpiGU8 E{F.ws + OFF_H};
            pg8::gemm_phase<pg8::EpiGU8, pg8::MoeSched, true, true>(F.lds, F.wave, g, S, E);
        } else {
        pg8::GemmK g{1024, 1024, 1024, 128, 1 << 30, 0};
        pg8::MoeSched S{(const char*)(F.ws + OFF_XB), (const char*)(F.ws + OFF_WMOE), (size_t)0, (size_t)256 * 1024 * 2, tile_start, 8, GRID, F.wg, (const int*)(F.ws + SM_ROWTOK)};
        pg8::EpiGU E{(bf16_t*)(F.ws + OFF_H)};
        pg8::gemm_phase<pg8::EpiGU, pg8::MoeSched, true>(F.lds, F.wave, g, S, E);
        }
    }
    SEAM(12);
    if (IN(13)) {
        { const int kt_ = F.wave * 64 + lane_id(); if (kt_ < 17) tile_start[kt_] = ((const int*)(F.ws + CTL_TILES))[kt_]; }
        __syncthreads();
        bf16_t* Y = (bf16_t*)(F.ws + OFF_XS);
        if (MOE8_L0) {
            pg8::GemmK g{512, 512, 512, 128, 1 << 30, 0};
            pg8::MoeSched S{(const char*)(F.ws + OFF_H), (const char*)(F.ws + OFF_WMOE + (size_t)16 * 2048 * 1024), (size_t)256 * 1024, (size_t)256 * 1024, tile_start, 4, GRID, F.wg};
            auto f = [Y](const pg8::Unit&, int row, int col, const float (&v)[8]) { float o[8];
#pragma unroll
                for (int i = 0; i < 8; ++i) o[i] = v[i] * (1.0f / (F8_SH * F8_SD));
                store8(Y + (size_t)row * 1024 + col, o); };
            pg8::EpiRow8<decltype(f)> E{f};
            pg8::gemm_phase<decltype(E), pg8::MoeSched, false, true>(F.lds, F.wave, g, S, E);
        } else {
        pg8::GemmK g{1024, 1024, 1024, 128, 1 << 30, 0};
        pg8::MoeSched S{(const char*)(F.ws + OFF_H), (const char*)(F.ws + OFF_WMOE + (size_t)16 * 2048 * 1024 * 2), (size_t)256 * 1024 * 2, (size_t)256 * 1024 * 2, tile_start, 4, GRID, F.wg};
        auto f = [Y](const pg8::Unit&, int row, int col, const float (&v)[8]) { store8(Y + (size_t)row * 1024 + col, v); };
        pg8::EpiRow8<decltype(f)> E{f};
        pg8::gemm_phase(F.lds, F.wave, g, S, E);
        }
    }
    SEAM(13);
#if PROBE == 4
    {
        { const int kt_ = F.wave * 64 + lane_id(); if (kt_ < 17) tile_start[kt_] = ((const int*)(F.ws + CTL_TILES))[kt_]; }
        __syncthreads();
        pg8::GemmK g{1024, 1024, 1024, 128, 1 << 30, 0};
        pg8::MoeSched S{(const char*)(F.ws + OFF_XB), (const char*)(F.ws + OFF_WMOE), (size_t)0, (size_t)256 * 1024 * 2, tile_start, 8, GRID, F.wg, (const int*)(F.ws + SM_ROWTOK)};
        pg8::EpiGU E{(bf16_t*)(F.ws + OFF_H)};
        pg8::gemm_phase<pg8::EpiGU, pg8::MoeSched, true>(F.lds, F.wave, g, S, E);
        xcd_barrier(bar);
    }
#endif
    if (IN(14)) { ln2_phase(F, nullptr, ln + 2 * 1024, ln + 3 * 1024, (bf16_t*)(F.ws + OFF_XB), true, RTI8 ? F.ws + OFF_XB8B : nullptr); }
    SEAM(14);
#pragma unroll 1
    for (int k_ = 0; k_ < (PROBE == 12 ? 10 : 5); ++k_) { const int k = k_ % 5;
        if (IN(20)) {
#define PGB(j) ((bf16_t*)(F.ws + OFF_PG + (size_t)((j) & 1) * PG_BYTES))
#define KVB(j) ((bf16_t*)(F.ws + OFF_KV + (size_t)((j) & 1) * KV_BYTES))
            if (k >= 1) ret_r2_phase(F, KVB(k - 1));
            if (k <= 3) {
                pg8::GemmK g{RTI8 ? 512 : 1024, RTI8 ? 512 : 1024, RTI8 ? 512 : 1024, 128, 1 << 30, 0};
                pg8::DenseSched S; if (RTI8) S.init(F.ws + OFF_XB8B + (size_t)k * 16384 * 1024, 512, F.ws + W_RTIN, 512, 16384, 6144, GRID, F.wg); else S.init(F.ws + OFF_XB + (size_t)k * 16384 * 1024 * 2, 1024, F.ws + W_RTIN, 1024, 16384, 6144, GRID, F.wg);
                bf16_t* P = PGB(k);
                auto f = [P](const pg8::Unit&, int row, int col, const float (&v_)[8]) {
                    float v[8];
#pragma unroll
                    for (int i = 0; i < 8; ++i) v[i] = RTI8 ? v_[i] * (1.0f / (F8_SX * F8_SW)) : v_[i];
                    if (col < 2048) {
                        float o[8]; const float posf = (float)(row & 8191); const int m0 = (col & 127) >> 1;
#pragma unroll
                        for (int i = 0; i < 4; ++i) { const float rev = __builtin_amdgcn_fractf(posf * (__builtin_amdgcn_exp2f((float)(m0 + i) * (-13.287712379549449f / 63.0f)) * 0.15915494309189535f));
                            const float co = __builtin_amdgcn_cosf(rev), si = __builtin_amdgcn_sinf(rev); o[2 * i] = v[2 * i] * co - v[2 * i + 1] * si; o[2 * i + 1] = v[2 * i + 1] * co + v[2 * i] * si; }
                        store8(P + (size_t)row * PGLD + col, o);
                    } else if (PGV8) { u32x2 w8; w8[0] = pk_fp8x4(v[0] * F8_SX, v[1] * F8_SX, v[2] * F8_SX, v[3] * F8_SX); w8[1] = pk_fp8x4(v[4] * F8_SX, v[5] * F8_SX, v[6] * F8_SX, v[7] * F8_SX);
                        *(u32x2*)((unsigned char*)P + (size_t)row * 8192 + 4096 + (col - 2048)) = w8; }
                    else store8(P + (size_t)row * 6144 + col, v); };
                pg8::EpiRow8<decltype(f)> E{f};
                pg8::gemm_phase<decltype(E), pg8::DenseSched, false, RTI8>(F.lds, F.wave, g, S, E);
            }
            xcd_barrier(bar);
            if (k >= 1) ret_r3_phase(F, PGB(k - 1), KVB(k - 1), (bf16_t*)(F.ws + OFF_O1), k - 1, F.in[21]);
            if (k <= 3) { for (int u = F.wg; u < 1024; u += GRID) ret_r1_unit(F, PGB(k), KVB(k), u); }
            xcd_barrier(bar);
#undef PGB
#undef KVB
        }
    }
    if (IN(20)) {
        bf16_t* MX = (bf16_t*)(F.ws + OFF_MIX1);
        if (RTO8) {
            pg8::GemmK g{1024, 1024, 1024, 128, 1 << 30, 0};
            pg8::DenseSched S; S.init(F.ws + OFF_O1, 1024, F.ws + W_RTOUT, 1024, T, 1024, GRID, F.wg);
            auto f = [MX](const pg8::Unit&, int row, int col, const float (&v)[8]) { float o[8];
#pragma unroll
                for (int i = 0; i < 8; ++i) o[i] = v[i] * (1.0f / (F8_SO * F8_SWO));
                store8(MX + (size_t)row * 1024 + col, o); };
            pg8::EpiRow8<decltype(f)> E{f};
            pg8::gemm_phase<decltype(E), pg8::DenseSched, false, true>(F.lds, F.wave, g, S, E);
        } else {
        pg8::GemmK g{2048, 2048, 2048, 128, 1 << 30, 0};
        pg8::DenseSched S; S.init(F.ws + OFF_O1, 2048, F.ws + W_RTOUT, 2048, T, 1024, GRID, F.wg);
        auto f = [MX](const pg8::Unit&, int row, int col, const float (&v)[8]) { store8(MX + (size_t)row * 1024 + col, v); };
        pg8::EpiRow8<decltype(f)> E{f};
        pg8::gemm_phase(F.lds, F.wave, g, S, E);
        }
        xcd_barrier(bar);
    }
    if (IN(30)) { ln1_router_phase(F, nullptr, (const bf16_t*)(F.ws + OFF_MIX1), (bf16_t*)(F.ws + OFF_XB), ln + 4 * 1024, ln + 5 * 1024, 1, MOE8_L1 ? F.ws + OFF_XB8 : nullptr); moe_weights(F, 1, MOE8_L1); }
    SEAM(30);
    if (IN(31)) moe_scatter_phase(F, nullptr, 1);
    SEAM(31);
    if (IN(32)) {
        { const int kt_ = F.wave * 64 + lane_id(); if (kt_ < 17) tile_start[kt_] = ((const int*)(F.ws + CTL_TILES))[32 + kt_]; }
        __syncthreads();
        if (MOE8_L1) {
            pg8::GemmK g{512, 512, 512, 128, 1 << 30, 0};
            pg8::MoeSched S{(const char*)(F.ws + OFF_XB8), (const char*)(F.ws + OFF_WMOE), (size_t)0, (size_t)256 * 1024, tile_start, 8, GRID, F.wg, (const int*)(F.ws + SM_ROWTOK)};
            pg8::EpiGU8 E{F.ws + OFF_H};
            pg8::gemm_phase<pg8::EpiGU8, pg8::MoeSched, true, true>(F.lds, F.wave, g, S, E);
        } else {
        pg8::GemmK g{1024, 1024, 1024, 128, 1 << 30, 0};
        pg8::MoeSched S{(const char*)(F.ws + OFF_XB), (const char*)(F.ws + OFF_WMOE), (size_t)0, (size_t)256 * 1024 * 2, tile_start, 8, GRID, F.wg, (const int*)(F.ws + SM_ROWTOK)};
        pg8::EpiGU E{(bf16_t*)(F.ws + OFF_H)};
        pg8::gemm_phase<pg8::EpiGU, pg8::MoeSched, true>(F.lds, F.wave, g, S, E);
        }
    }
    SEAM(32);
    if (IN(33)) {
        { const int kt_ = F.wave * 64 + lane_id(); if (kt_ < 17) tile_start[kt_] = ((const int*)(F.ws + CTL_TILES))[32 + kt_]; }
        __syncthreads();
        bf16_t* Y = (bf16_t*)(F.ws + OFF_XS);
        if (MOE8_L1) {
            pg8::GemmK g{512, 512, 512, 128, 1 << 30, 0};
            pg8::MoeSched S{(const char*)(F.ws + OFF_H), (const char*)(F.ws + OFF_WMOE + (size_t)16 * 2048 * 1024), (size_t)256 * 1024, (size_t)256 * 1024, tile_start, 4, GRID, F.wg};
            auto f = [Y](const pg8::Unit&, int row, int col, const float (&v)[8]) { float o[8];
#pragma unroll
                for (int i = 0; i < 8; ++i) o[i] = v[i] * (1.0f / (F8_SH * F8_SD));
                store8(Y + (size_t)row * 1024 + col, o); };
            pg8::EpiRow8<decltype(f)> E{f};
            pg8::gemm_phase<decltype(E), pg8::MoeSched, false, true>(F.lds, F.wave, g, S, E);
        } else {
        pg8::GemmK g{1024, 1024, 1024, 128, 1 << 30, 0};
        pg8::MoeSched S{(const char*)(F.ws + OFF_H), (const char*)(F.ws + OFF_WMOE + (size_t)16 * 2048 * 1024 * 2), (size_t)256 * 1024 * 2, (size_t)256 * 1024 * 2, tile_start, 4, GRID, F.wg};
        auto f = [Y](const pg8::Unit&, int row, int col, const float (&v)[8]) { store8(Y + (size_t)row * 1024 + col, v); };
        pg8::EpiRow8<decltype(f)> E{f};
        pg8::gemm_phase(F.lds, F.wave, g, S, E);
        }
    }
    SEAM(33);
    if (IN(34)) ln2_phase(F, F.out, ln + 6 * 1024, ln + 7 * 1024, (bf16_t*)(F.ws + OFF_XB), true);
#undef IN
#undef SEAM
}

extern "C" void kernel_launch(void* const* d_in, const int* in_sizes, int n_in, void* d_out, int out_size, void* d_ws, size_t ws_size, hipStream_t stream) {
    static int ready = 0;
    if (ready == 0) {
        if (n_in != 28 || out_size != T * D || ws_size < WS_END) { fprintf(stderr, "kernel_launch: unexpected shapes / workspace (%d inputs, out %d, ws %zu)\n", n_in, out_size, ws_size); ready = -1; return; }
        if (hipFuncSetAttribute((const void*)fwd_kernel, hipFuncAttributeMaxDynamicSharedMemorySize, LDS_BYTES) != hipSuccess) { fprintf(stderr, "kernel_launch: hipFuncSetAttribute failed\n"); ready = -1; return; }
        int per_cu = 0;
        if (hipOccupancyMaxActiveBlocksPerMultiprocessor(&per_cu, (const void*)fwd_kernel, NTH, LDS_BYTES) != hipSuccess || per_cu < 1) { fprintf(stderr, "kernel_launch: occupancy query says %d\n", per_cu); }
        (void)hipGetLastError();
        ready = 1;
    }
    if (ready < 0) return;
    (void)hipMemsetAsync((char*)d_ws + OFF_CTL, 0, CTL_BYTES, stream);
    Args a{};
    for (int i = 0; i < 28; ++i) a.in[i] = (const float*)d_in[i];
    a.out = (float*)d_out; a.ws = (unsigned char*)d_ws; a.ph_lo = 0; a.ph_hi = 1000;
    hipLaunchKernelGGL(fwd_kernel, dim3(GRID), dim3(NTH), LDS_BYTES, stream, a);
}
```

```cpp
#include <hip/hip_runtime.h>
#include <stdint.h>
#include <stdio.h>

#ifndef PROBE
#define PROBE 0
#endif
#define DI __device__ __forceinline__
#define LAS __attribute__((address_space(3)))
typedef unsigned short bf16_t;
typedef short bf16x8 __attribute__((ext_vector_type(8)));
typedef float f32x4 __attribute__((ext_vector_type(4)));
typedef unsigned u32x4 __attribute__((ext_vector_type(4)));
typedef unsigned u32x2 __attribute__((ext_vector_type(2)));
typedef int i32x4 __attribute__((ext_vector_type(4)));
typedef float f32x2 __attribute__((ext_vector_type(2)));

constexpr int T = 65536, D = 1024, SEQ = 8192, NB = 8;
constexpr int NTH = 512, GRID = 256;
constexpr float ALPHA = 1.41421356237309515f;
constexpr float LN_EPS = 1e-5f;
constexpr size_t MiB = (size_t)1 << 20;

constexpr size_t OFF_CTL = 0;
constexpr size_t CTL_BYTES = 256 * 1024;
constexpr size_t CTL_BAR = 0;
constexpr size_t CTL_Q = 16 * 1024;
constexpr size_t CTL_BLKCNT = 32 * 1024;
constexpr size_t CTL_TILES = 96 * 1024;
constexpr size_t OFF_SMALL = 1 * MiB;
constexpr size_t SM_ROPEN = OFF_SMALL + 0;
constexpr size_t SM_ROPER = OFF_SMALL + 1 * MiB;
constexpr size_t SM_CBIAS = OFF_SMALL + 5 * MiB;
constexpr size_t SM_TOKE = OFF_SMALL + 6 * MiB;
constexpr size_t SM_TOKW = OFF_SMALL + 7 * MiB;
constexpr size_t SM_TOKP = OFF_SMALL + 8 * MiB;
constexpr size_t SM_RNORM = OFF_SMALL + 9 * MiB;
constexpr size_t SM_KCMP = OFF_SMALL + 11 * MiB;
constexpr size_t SM_VCMPT = OFF_SMALL + 12 * MiB;
constexpr size_t SM_ROWTOK = OFF_SMALL + 13 * MiB;
constexpr size_t OFF_WSM = 16 * MiB;
constexpr size_t W_IN0 = OFF_WSM;
constexpr size_t W_OUT0 = OFF_WSM + 7 * MiB;
constexpr size_t W_RTIN = OFF_WSM + 9 * MiB;
constexpr size_t W_RTOUT = OFF_WSM + 21 * MiB;
constexpr size_t W_L1 = OFF_WSM + 25 * MiB;
constexpr size_t W_L2 = OFF_WSM + 25 * MiB + 512 * 1024;
constexpr size_t W_C1 = OFF_WSM + 27 * MiB;
constexpr size_t W_C2 = OFF_WSM + 29 * MiB;
constexpr size_t OFF_XB = 48 * MiB;
constexpr size_t OFF_BIG = 176 * MiB;
constexpr size_t OFF_MIX = OFF_BIG;
constexpr size_t OFF_H = OFF_BIG;
constexpr size_t OFF_WMOE = 448 * MiB;
constexpr size_t OFF_XS = 544 * MiB;
constexpr size_t OFF_PR = OFF_BIG;
constexpr size_t OFF_ORAW = OFF_BIG;
constexpr size_t OFF_PN = 433 * MiB;
constexpr size_t OFF_O0 = 625 * MiB;
constexpr size_t OFF_HC = 753 * MiB;
constexpr size_t OFF_PG = OFF_BIG;
constexpr size_t PG_BYTES = 192 * MiB;
constexpr size_t OFF_O1 = 560 * MiB;
constexpr size_t OFF_KV = 816 * MiB;
constexpr size_t KV_BYTES = 64 * MiB;
constexpr size_t OFF_MIX1 = OFF_BIG;
constexpr size_t OFF_XB8 = 816 * MiB;
constexpr size_t OFF_STR = 768 * MiB;
constexpr size_t OFF_XB8B = 944 * MiB;
constexpr size_t WS_END = 1008 * MiB;
constexpr bool MOE8_L0 = true, MOE8_L1 = true;
constexpr bool PGV8 = true;
constexpr int PGLD = PGV8 ? 4096 : 6144;
constexpr bool RTI8 = true;
constexpr bool RTO8 = true;
constexpr float F8_SO = 8.f, F8_SWO = 512.f;
constexpr float F8_SX = 16.f, F8_SW = 256.f, F8_SH = 8.f, F8_SD = 512.f;
constexpr int MOE_ROWS_MAX = 135168;

DI float bf2f(bf16_t b) { return __uint_as_float(((unsigned)b) << 16); }
DI bf16_t f2bf(float f) { unsigned u = __float_as_uint(f); u += 0x7FFFu + ((u >> 16) & 1u); return (bf16_t)(u >> 16); }
typedef __bf16 bf16v2_t __attribute__((ext_vector_type(2)));
DI unsigned pack2(float lo, float hi) { const bf16v2_t r = __builtin_convertvector((f32x2){lo, hi}, bf16v2_t); return __builtin_bit_cast(unsigned, r); }
DI int lane_id() { int l; asm volatile("v_mbcnt_lo_u32_b32 %0, -1, 0\n\tv_mbcnt_hi_u32_b32 %0, -1, %0" : "=v"(l)); return l; }
DI float shx(float v, int m) { const int l = lane_id(); return __int_as_float(__builtin_amdgcn_ds_bpermute((l ^ m) << 2, __float_as_int(v))); }
DI float f8sat(float x) { return __builtin_amdgcn_fmed3f(x, -448.f, 448.f); }
DI unsigned pk_fp8x4(float a, float b, float c, float d) {
    int p = __builtin_amdgcn_cvt_pk_fp8_f32(f8sat(a), f8sat(b), 0, false); p = __builtin_amdgcn_cvt_pk_fp8_f32(f8sat(c), f8sat(d), p, true); return (unsigned)p; }
DI float wave_sum(float v) {
#pragma unroll
    for (int o = 32; o; o >>= 1) v += shx(v, o);
    return v;
}
DI int lds_add(LAS int* p, int v) { return __hip_atomic_fetch_add(p, v, __ATOMIC_RELAXED, __HIP_MEMORY_SCOPE_WORKGROUP); }
DI float rcpf_(float x) { return __builtin_amdgcn_rcpf(x); }
DI float sigmoidf_(float x) { return rcpf_(1.0f + __builtin_amdgcn_exp2f(-1.44269504088896341f * x)); }
DI float siluf_(float x) { return x * sigmoidf_(x); }
DI float tanhf_(float x) { return 1.0f - 2.0f * rcpf_(1.0f + __builtin_amdgcn_exp2f(2.88539008177792681f * x)); }

#define XB_TMO      128
#define XB_XCNT(j)  (256  + 64 * (j))
#define XB_XSUB(j)  (1280 + 64 * (j))
#define XB_XGEN(j)  (2304 + 64 * (j))
#define XB_TOP      3328
#define XB_TOPGEN   3392
#define XCD_BAR_WORDS 3456
#define XB_SPIN_CAP (1u << 24)

DI unsigned xb_ld(unsigned* p)              { return __hip_atomic_load(p, __ATOMIC_RELAXED, __HIP_MEMORY_SCOPE_AGENT); }
DI unsigned xb_add(unsigned* p, unsigned v) { return __hip_atomic_fetch_add(p, v, __ATOMIC_RELAXED, __HIP_MEMORY_SCOPE_AGENT); }
DI unsigned xb_xcc_id() { return (unsigned)__builtin_amdgcn_s_getreg((3 << 11) | 20) & 0xFu; }
#define XB_SPIN(cond, bar) do { unsigned _sp = 0; while (cond) { __builtin_amdgcn_s_sleep(1); \
    if ((++_sp & 255u) == 0u) { if (xb_ld(&(bar)[XB_TMO])) break; if (_sp > XB_SPIN_CAP) { atomicAdd(&(bar)[XB_TMO], 1u); break; } } } } while (0)

struct XcdBarrier { unsigned* bar; unsigned x; volatile LAS unsigned* st; };

DI XcdBarrier xcd_barrier_post(unsigned* bar, volatile LAS unsigned* st) {
    XcdBarrier b; b.bar = bar; b.x = xb_xcc_id(); b.st = st;
    if (threadIdx.x == 0) (void)xb_add(&bar[XB_XCNT(b.x)], 1u);
    return b;
}
DI void xcd_barrier_complete(unsigned* bar, unsigned x, unsigned& nloc, unsigned& nx) {
    const unsigned G = gridDim.x * gridDim.y * gridDim.z;
    unsigned sum, cnt, mine, sp = 0u;
    for (;;) {
        sum = 0u; cnt = 0u; mine = 0u;
#pragma unroll
        for (unsigned j = 0; j < 16; ++j) { const unsigned c = xb_ld(&bar[XB_XCNT(j)]); sum += c; cnt += (c > 0u) ? 1u : 0u; mine = (j == x) ? c : mine; }
        if (sum == G) break;
        __builtin_amdgcn_s_sleep(1);
        if ((++sp & 255u) == 0u) { if (xb_ld(&bar[XB_TMO])) break; if (sp > XB_SPIN_CAP) { atomicAdd(&bar[XB_TMO], 1u); break; } }
    }
    nloc = mine > 0u ? mine : 1u; nx = cnt > 0u ? cnt : 1u;
}
DI void xcd_barrier(const XcdBarrier& b) {
    asm volatile("s_waitcnt vmcnt(0)" ::: "memory");
    __syncthreads();
    if (threadIdx.x == 0) {
        unsigned* bar = b.bar;
        __builtin_amdgcn_s_waitcnt(0);
        unsigned nloc = b.st[0], nx = b.st[1];
        if (nloc == 0u) { xcd_barrier_complete(bar, b.x, nloc, nx); b.st[0] = nloc; b.st[1] = nx; }
        const unsigned old = xb_add(&bar[XB_XSUB(b.x)], 1u);
        const unsigned gen = old / nloc;
        if (old + 1u == (gen + 1u) * nloc) {
            __builtin_amdgcn_fence(__ATOMIC_RELEASE, "agent");
            asm volatile("s_waitcnt vmcnt(0)" ::: "memory");
            const unsigned og = xb_add(&bar[XB_TOP], 1u);
            const unsigned tg = og / nx;
            if (og + 1u == (tg + 1u) * nx) xb_add(&bar[XB_TOPGEN], 1u);
            else XB_SPIN(xb_ld(&bar[XB_TOPGEN]) == tg, bar);
            __builtin_amdgcn_fence(__ATOMIC_ACQUIRE, "agent");
            xb_add(&bar[XB_XGEN(b.x)], 1u);
            asm volatile("s_waitcnt vmcnt(0)" ::: "memory");
        } else {
            XB_SPIN(xb_ld(&bar[XB_XGEN(b.x)]) == gen, bar);
            __builtin_amdgcn_fence(__ATOMIC_ACQUIRE, "agent");
            asm volatile("s_waitcnt vmcnt(0)" ::: "memory");
        }
    }
    __syncthreads();
}

namespace pg8 {
constexpr int BM = 256, BK = 64, HALF = 128, HTB = HALF * BK * 2, STAGE_BYTES = 8 * HTB, NXCD = 8, WGM = 8;
DI int lds_byte(int r, int c) { const int st = (r >> 4) * 2 + (c >> 5), rr = r & 15, cc = c & 31, ob = rr * 64 + cc * 2; return st * 1024 + (ob ^ (((ob >> 9) & 1) << 5)); }
DI void stage_rc(int b, int& R, int& C) { const int st = b / 1024, sb = b % 1024, swz = sb ^ (((sb >> 9) & 1) << 5); R = (st >> 1) * 16 + swz / 64; C = (st & 1) * 32 + (swz % 64) / 2; }
DI int perm32(int rho) { const int n = rho >> 4, i = rho & 15; return 8 * (i >> 2) + 4 * n + (i & 3); }

struct Unit { const char* a; const char* b; int pm, pn, aux; const int* rows; };
struct GemmK { int lda, ldb, K, kstepA, ksplit, kjump; };

template <class Epi, class Sched, bool GATHER = false, bool F8 = false>
DI void gemm_phase(LAS unsigned char* lds, int wave_, const GemmK g, const Sched& S, const Epi& E) {
    int tid = wave_ * 64 + lane_id(); asm volatile("" : "+v"(tid));
    const int wid = __builtin_amdgcn_readfirstlane(tid >> 6), lane = tid & 63, wr = wid >> 2, wc = wid & 3, fr = lane & 15, fq = lane >> 4;
    const int nt = g.K / BK;
    unsigned voffA[2], voffB[2], cA2[2]; int rA[2]; unsigned vgc[2][2], vgn[2][2];
#pragma unroll
    for (int i = 0; i < 2; ++i) { int R, C; stage_rc(tid * 16 + i * 8192, R, C); const int Rb = Epi::PERM ? ((R & ~31) + perm32(R & 31)) : R;
        voffA[i] = (unsigned)(R * g.lda + C) * 2u; voffB[i] = (unsigned)(Rb * g.ldb + C) * 2u; rA[i] = R; cA2[i] = (unsigned)C * 2u; }
    const size_t kstepA = (size_t)g.kstepA, kstepB = (size_t)(BK * 2);
    const size_t hstepA = (size_t)HALF * g.lda * 2, hstepB = (size_t)HALF * g.ldb * 2;
    const unsigned ldsw = (unsigned)wid * 1024u;
    const int aoff = lds_byte(wr * 64 + fr, fq * 8), boff = lds_byte(wc * 32 + fr, fq * 8);
#define PG8_AK(base, kt) ((base) + (size_t)(kt) * kstepA + (((kt) >= g.ksplit) ? (long)g.kjump : 0l))
#define PG8_SA(b, h) (((b) * 2 + (h)) * HTB)
#define PG8_SB(b, h) ((4 + (b) * 2 + (h)) * HTB)
#define PG8_STAGE(bufoff, gbase, voff) do { _Pragma("unroll") for (int _i = 0; _i < 2; ++_i) \
        __builtin_amdgcn_global_load_lds((const unsigned*)((const char*)(gbase) + (voff)[_i]), (LAS unsigned*)(lds + (bufoff) + ldsw + _i * 8192), 16, 0, 0); } while (0)
#define PG8_STAGE_A(bufoff, kbase, h, nx) do { if (GATHER) { _Pragma("unroll") for (int _i = 0; _i < 2; ++_i) { const unsigned _vo = (nx) ? vgn[h][_i] : vgc[h][_i]; \
        __builtin_amdgcn_global_load_lds((const unsigned*)((const char*)(kbase) + _vo), (LAS unsigned*)(lds + (bufoff) + ldsw + _i * 8192), 16, 0, 0); } } \
        else PG8_STAGE(bufoff, (kbase) + (h) * hstepA, voffA); } while (0)
#define PG8_ROWS(dst, u) do { if (GATHER) { _Pragma("unroll") for (int _h = 0; _h < 2; ++_h) _Pragma("unroll") for (int _i = 0; _i < 2; ++_i) dst[_h][_i] = (unsigned)(u).rows[128 * _h + rA[_i]] * (unsigned)(g.lda * 2) + cA2[_i]; } } while (0)
#define PG8_LDA(dst, b, h) do { _Pragma("unroll") for (int m = 0; m < 4; ++m) _Pragma("unroll") for (int k = 0; k < 2; ++k) dst[m][k] = *(const LAS bf16x8*)(lds + PG8_SA(b, h) + aoff + m * 2048 + k * 1024); } while (0)
#define PG8_LDB(dst, b, h) do { _Pragma("unroll") for (int n = 0; n < 2; ++n) _Pragma("unroll") for (int k = 0; k < 2; ++k) dst[n][k] = *(const LAS bf16x8*)(lds + PG8_SB(b, h) + boff + n * 2048 + k * 1024); } while (0)
#define PG8_CAT(x, y) __builtin_shufflevector(__builtin_bit_cast(i32x4, x), __builtin_bit_cast(i32x4, y), 0, 1, 2, 3, 4, 5, 6, 7)
#define PG8_MMA(ai, bj, At, Bt) do { __builtin_amdgcn_s_setprio(1); \
        if (F8) { _Pragma("unroll") for (int m = 0; m < 4; ++m) _Pragma("unroll") for (int n = 0; n < 2; ++n) \
            asm volatile("v_mfma_f32_16x16x128_f8f6f4 %0, %1, %2, %0" : "+v"(acc[ai][bj][m][n]) : "v"(PG8_CAT(Bt[n][0], Bt[n][1])), "v"(PG8_CAT(At[m][0], At[m][1]))); }     \
        else { _Pragma("unroll") for (int m = 0; m < 4; ++m) _Pragma("unroll") for (int n = 0; n < 2; ++n) _Pragma("unroll") for (int k = 0; k < 2; ++k) \
            acc[ai][bj][m][n] = __builtin_amdgcn_mfma_f32_16x16x32_bf16(Bt[n][k], At[m][k], acc[ai][bj][m][n], 0, 0, 0); } \
        __builtin_amdgcn_s_setprio(0); } while (0)
#define PG8_WAIT_V(n) asm volatile("s_waitcnt vmcnt(" #n ")" ::: "memory")
#define PG8_WAIT_L(n) asm volatile("s_waitcnt lgkmcnt(" #n ")" ::: "memory")
#define PG8_BAR __builtin_amdgcn_s_barrier()
#define PG8_SCHED __builtin_amdgcn_sched_barrier(0)
    Unit cur, nxt; int ui = 0;
    if (!S.next(0, cur)) return;
    f32x4 acc[2][2][4][2];
#pragma unroll
    for (int a = 0; a < 2; ++a)
#pragma unroll
        for (int b = 0; b < 2; ++b)
#pragma unroll
            for (int m = 0; m < 4; ++m)
#pragma unroll
                for (int n = 0; n < 2; ++n) acc[a][b][m][n] = (f32x4){0.f, 0.f, 0.f, 0.f};
    bf16x8 At[4][2], B0[2][2], B1[2][2];
    const char* cA = cur.a; const char* cB = cur.b;
    PG8_ROWS(vgc, cur);
    PG8_STAGE(PG8_SB(0, 0), cB, voffB); PG8_STAGE_A(PG8_SA(0, 0), cA, 0, false); PG8_STAGE(PG8_SB(0, 1), cB + hstepB, voffB); PG8_STAGE_A(PG8_SA(0, 1), cA, 1, false);
    if (wr == 1) PG8_BAR;
    PG8_WAIT_V(4); PG8_BAR;
    PG8_STAGE(PG8_SB(1, 0), cB + kstepB, voffB); PG8_STAGE_A(PG8_SA(1, 0), PG8_AK(cA, 1), 0, false); PG8_STAGE(PG8_SB(1, 1), cB + hstepB + kstepB, voffB);
    PG8_WAIT_V(6); PG8_BAR;
    for (;;) {
        const bool has_next = S.next(ui + 1, nxt);
        const char* nA = has_next ? nxt.a : cA; const char* nB = has_next ? nxt.b : cB;
        if (GATHER) { if (has_next) PG8_ROWS(vgn, nxt); else { _Pragma("unroll") for (int _h = 0; _h < 2; ++_h) _Pragma("unroll") for (int _i = 0; _i < 2; ++_i) vgn[_h][_i] = vgc[_h][_i]; } }
#pragma unroll 1
        for (int t = 0; t < nt; t += 2) {
            const bool last = (t == nt - 2);
            const char* a1 = PG8_AK(cA, t + 1);
            const char* a2 = last ? nA : PG8_AK(cA, t + 2); const char* b2 = last ? nB : cB + (size_t)(t + 2) * kstepB;
            const char* a3 = last ? PG8_AK(nA, 1) : PG8_AK(cA, t + 3); const char* b3 = b2 + kstepB;
            PG8_LDB(B0, 0, 0); PG8_SCHED; PG8_LDA(At, 0, 0); PG8_STAGE_A(PG8_SA(1, 1), a1, 1, false);
            PG8_WAIT_L(8); PG8_BAR; PG8_WAIT_L(0); PG8_MMA(0, 0, At, B0); PG8_BAR; PG8_SCHED;
            PG8_LDB(B1, 0, 1); PG8_STAGE(PG8_SB(0, 0), b2, voffB);
            PG8_BAR; PG8_WAIT_L(0); PG8_MMA(0, 1, At, B1); PG8_BAR;
            PG8_LDA(At, 0, 1); PG8_STAGE_A(PG8_SA(0, 0), a2, 0, last);
            PG8_BAR; PG8_WAIT_L(0); PG8_MMA(1, 0, At, B0); PG8_BAR; PG8_SCHED;
            PG8_STAGE(PG8_SB(0, 1), b2 + hstepB, voffB);
            PG8_WAIT_V(6); PG8_BAR; PG8_MMA(1, 1, At, B1); PG8_BAR;
            PG8_LDB(B0, 1, 0); PG8_SCHED; PG8_LDA(At, 1, 0); PG8_STAGE_A(PG8_SA(0, 1), a2, 1, last);
            PG8_WAIT_L(8); PG8_BAR; PG8_WAIT_L(0); PG8_MMA(0, 0, At, B0); PG8_BAR; PG8_SCHED;
            PG8_LDB(B1, 1, 1); PG8_STAGE(PG8_SB(1, 0), b3, voffB);
            PG8_BAR; PG8_WAIT_L(0); PG8_MMA(0, 1, At, B1); PG8_BAR;
            PG8_LDA(At, 1, 1); PG8_STAGE_A(PG8_SA(1, 0), a3, 0, last);
            PG8_BAR; PG8_WAIT_L(0); PG8_MMA(1, 0, At, B0); PG8_BAR; PG8_SCHED;
            PG8_STAGE(PG8_SB(1, 1), b3 + hstepB, voffB);
            PG8_WAIT_V(6); PG8_BAR; PG8_MMA(1, 1, At, B1); PG8_BAR;
        }
        if (F8) {
#pragma unroll
            for (int a = 0; a < 2; ++a)
#pragma unroll
                for (int b = 0; b < 2; ++b) {
                    if (a == 0 && b == 0) asm volatile("s_nop 15\n\ts_nop 15" : "+v"(acc[a][b][0][0]), "+v"(acc[a][b][0][1]), "+v"(acc[a][b][1][0]), "+v"(acc[a][b][1][1]), "+v"(acc[a][b][2][0]), "+v"(acc[a][b][2][1]), "+v"(acc[a][b][3][0]), "+v"(acc[a][b][3][1]));
                    else asm volatile("" : "+v"(acc[a][b][0][0]), "+v"(acc[a][b][0][1]), "+v"(acc[a][b][1][0]), "+v"(acc[a][b][1][1]), "+v"(acc[a][b][2][0]), "+v"(acc[a][b][2][1]), "+v"(acc[a][b][3][0]), "+v"(acc[a][b][3][1])); } }
        E(acc, cur, wr, wc, fr, fq);
        if (!has_next) break;
#pragma unroll
        for (int a = 0; a < 2; ++a)
#pragma unroll
            for (int b = 0; b < 2; ++b)
#pragma unroll
                for (int m = 0; m < 4; ++m)
#pragma unroll
                    for (int n = 0; n < 2; ++n) acc[a][b][m][n] = (f32x4){0.f, 0.f, 0.f, 0.f};
        cur = nxt; cA = nA; cB = nB; ++ui;
        if (GATHER) { _Pragma("unroll") for (int _h = 0; _h < 2; ++_h) _Pragma("unroll") for (int _i = 0; _i < 2; ++_i) vgc[_h][_i] = vgn[_h][_i]; }
    }
    PG8_WAIT_V(0);
    if (wr == 0) PG8_BAR;
    PG8_BAR;
#undef PG8_AK
#undef PG8_SA
#undef PG8_SB
#undef PG8_STAGE
#undef PG8_STAGE_A
#undef PG8_ROWS
#undef PG8_LDA
#undef PG8_LDB
#undef PG8_MMA
#undef PG8_CAT
#undef PG8_WAIT_V
#undef PG8_WAIT_L
#undef PG8_BAR
#undef PG8_SCHED
}

struct DenseSched {
    const char* A; const char* B; size_t tstepA, tstepB; int nM, nN, nwg, G, c; int prp;
    DI void init(const void* A_, int lda, const void* B_, int ldb, int M, int N, int G_, int c_, int prp_ = 0) {
        A = (const char*)A_; B = (const char*)B_; tstepA = (size_t)BM * lda * 2; tstepB = (size_t)BM * ldb * 2; nM = M / BM; nN = N / BM; nwg = nM * nN; G = G_; c = c_; prp = prp_; }
    DI bool next(int i, Unit& u) const {
        const long L = (long)i * G + c; if (L >= nwg) return false;
        int wgid = (int)L; { const int q = nwg / NXCD, r = nwg % NXCD, xcd = wgid % NXCD, off = wgid / NXCD; wgid = (xcd < r ? xcd * (q + 1) : r * (q + 1) + (xcd - r) * q) + off; }
        const int nig = WGM * nN, gid = wgid / nig, fm = gid * WGM, gsz = (nM - fm) < WGM ? (nM - fm) : WGM;
        u.pm = fm + ((wgid % nig) % gsz); u.pn = (wgid % nig) / gsz; u.aux = 0;
        u.a = A + (size_t)u.pm * tstepA + (prp ? (size_t)((u.pm >> 5) + 1) * (tstepA / BM) : (size_t)0);
        u.b = B + (size_t)u.pn * tstepB; u.rows = nullptr;
        return true;
    }
};
struct MoeSched {
    const char* A; const char* B; size_t tstepA, tstepB; const LAS int* ts; int nN, G, c; const int* rowtab;
    DI bool next(int i, Unit& u) const {
        const long L0 = (long)i * G + c; const int nwg = ts[16] * nN; if (L0 >= nwg) return false;
        int L = (int)L0; { const int q = nwg / NXCD, r = nwg % NXCD, xcd = L % NXCD, off = L / NXCD; L = (xcd < r ? xcd * (q + 1) : r * (q + 1) + (xcd - r) * q) + off; }
        const int rt = L / nN, pn = L % nN;
        int e = 0;
#pragma unroll
        for (int j = 1; j < 16; ++j) e += (rt >= ts[j]) ? 1 : 0;
        u.pm = rt; u.pn = pn; u.aux = e;
        u.a = rowtab ? A : A + (size_t)rt * tstepA; u.b = B + (size_t)(e * nN + pn) * tstepB; u.rows = rowtab ? rowtab + rt * 256 : nullptr;
        return true;
    }
};

template <class F> struct EpiRow8 {
    static constexpr bool PERM = true;
    F f;
    DI void operator()(const f32x4 (&acc)[2][2][4][2], const Unit& u, int wr, int wc, int fr, int fq) const {
#pragma unroll
        for (int ai = 0; ai < 2; ++ai)
#pragma unroll
            for (int m = 0; m < 4; ++m) {
                const int row = u.pm * BM + ai * HALF + wr * 64 + m * 16 + fr;
#pragma unroll
                for (int bj = 0; bj < 2; ++bj) {
                    const int col = u.pn * BM + bj * HALF + wc * 32 + 8 * fq;
                    float v[8];
#pragma unroll
                    for (int j = 0; j < 4; ++j) { v[j] = acc[ai][bj][m][0][j]; v[4 + j] = acc[ai][bj][m][1][j]; }
                    f(u, row, col, v);
                }
            }
    }
};
struct EpiF32 {
    static constexpr bool PERM = false;
    float* C; int ldc;
    DI void operator()(const f32x4 (&acc)[2][2][4][2], const Unit& u, int wr, int wc, int fr, int fq) const {
        const int row0 = u.pm * BM + wr * 64 + fr, col0 = u.pn * BM + wc * 32 + 4 * fq;
#pragma unroll
        for (int ai = 0; ai < 2; ++ai)
#pragma unroll
            for (int m = 0; m < 4; ++m) { float* rowp = C + (size_t)(row0 + ai * HALF + m * 16) * ldc + col0;
#pragma unroll
                for (int bj = 0; bj < 2; ++bj)
#pragma unroll
                    for (int n = 0; n < 2; ++n) *(f32x4*)(rowp + bj * HALF + n * 16) = acc[ai][bj][m][n]; }
    }
};
struct EpiGU {
    static constexpr bool PERM = true;
    bf16_t* H;
    DI void operator()(const f32x4 (&acc)[2][2][4][2], const Unit& u, int wr, int wc, int fr, int fq) const {
#pragma unroll
        for (int ai = 0; ai < 2; ++ai)
#pragma unroll
            for (int m = 0; m < 4; ++m) {
                const int row = u.pm * BM + ai * HALF + wr * 64 + m * 16 + fr;
                const int col = u.pn * HALF + wc * 32 + 8 * fq;
                float h[8];
#pragma unroll
                for (int j = 0; j < 4; ++j) {
                    const float g0 = acc[ai][0][m][0][j], u0 = acc[ai][1][m][0][j], g1 = acc[ai][0][m][1][j], u1 = acc[ai][1][m][1][j];
                    h[j] = siluf_(g0) * u0; h[4 + j] = siluf_(g1) * u1;
                }
                u32x4 o; o[0] = pack2(h[0], h[1]); o[1] = pack2(h[2], h[3]); o[2] = pack2(h[4], h[5]); o[3] = pack2(h[6], h[7]);
                *(u32x4*)(H + (size_t)row * 1024 + col) = o;
            }
    }
};
struct EpiGU8 {
    static constexpr bool PERM = true;
    unsigned char* H;
    DI void operator()(const f32x4 (&acc)[2][2][4][2], const Unit& u, int wr, int wc, int fr, int fq) const {
        constexpr float SI = 1.0f / (F8_SX * F8_SW);
#pragma unroll
        for (int ai = 0; ai < 2; ++ai)
#pragma unroll
            for (int m = 0; m < 4; ++m) {
                const int row = u.pm * BM + ai * HALF + wr * 64 + m * 16 + fr;
                const int col = u.pn * HALF + wc * 32 + 8 * fq;
                float h[8];
#pragma unroll
                for (int j = 0; j < 4; ++j) {
                    const float g0 = acc[ai][0][m][0][j] * SI, u0 = acc[ai][1][m][0][j] * (SI * F8_SH), g1 = acc[ai][0][m][1][j] * SI, u1 = acc[ai][1][m][1][j] * (SI * F8_SH);
                    h[j] = siluf_(g0) * u0; h[4 + j] = siluf_(g1) * u1;
                }
                u32x2 o; o[0] = pk_fp8x4(h[0], h[1], h[2], h[3]); o[1] = pk_fp8x4(h[4], h[5], h[6], h[7]);
                *(u32x2*)(H + (size_t)row * 1024 + col) = o;
            }
    }
};
}

DI void unpack8(const u32x4 a, float (&o)[8]) {
#pragma unroll
    for (int i = 0; i < 4; ++i) { o[2 * i] = __uint_as_float(a[i] << 16); o[2 * i + 1] = __uint_as_float(a[i] & 0xffff0000u); }
}
DI u32x4 pack8(const float (&v)[8]) { u32x4 o; o[0] = pack2(v[0], v[1]); o[1] = pack2(v[2], v[3]); o[2] = pack2(v[4], v[5]); o[3] = pack2(v[6], v[7]); return o; }
DI void store8(bf16_t* p, const float (&v)[8]) {
    u32x4 o; o[0] = pack2(v[0], v[1]); o[1] = pack2(v[2], v[3]); o[2] = pack2(v[4], v[5]); o[3] = pack2(v[6], v[7]);
    *(u32x4*)p = o;
}

struct Args { const float* in[28]; float* out; unsigned char* ws; int ph_lo, ph_hi; };
struct Frame {
    LAS unsigned char* lds; int tid, lane, wave, wg;
    unsigned char* ws; float* out; const float* const* in;
};

constexpr int LDS_SCR = 1024;
constexpr int LDS_BYTES = 1024 + 155 * 1024;

struct TrTile { const float* src; int ldsrc, N; bf16_t* dst; int ldd, rowmode, k0, n0; float f8; };
DI void tr_load(const Frame& F, const TrTile& d, f32x4 (&v)[2]) {
#pragma unroll
    for (int i = 0; i < 2; ++i) { const int kk = (F.tid >> 4) + 32 * i, n4 = (F.tid & 15) * 4;
        v[i] = (d.n0 + n4 < d.N) ? *(const f32x4*)(d.src + (size_t)(d.k0 + kk) * d.ldsrc + d.n0 + n4) : (f32x4){0.f, 0.f, 0.f, 0.f}; }
}
template <class Desc> DI void tr_run(const Frame& F, int ntiles, Desc desc) {
    LAS float* tile = (LAS float*)F.lds;
    const int nq = ntiles >> 2;
    int id = F.wg; if (id >= nq) return;
    TrTile d[4]; f32x4 v[4][2];
#pragma unroll
    for (int s4 = 0; s4 < 4; ++s4) { d[s4] = desc(4 * id + s4); tr_load(F, d[s4], v[s4]); }
    for (;;) {
        __syncthreads();
#pragma unroll
        for (int s4 = 0; s4 < 4; ++s4)
#pragma unroll
            for (int i = 0; i < 2; ++i) { const int kk = (F.tid >> 4) + 32 * i, n4 = (F.tid & 15) * 4;
#pragma unroll
                for (int e = 0; e < 4; ++e) tile[s4 * (64 * 65) + kk * 65 + n4 + e] = v[s4][i][e]; }
        __syncthreads();
        TrTile cur[4];
#pragma unroll
        for (int s4 = 0; s4 < 4; ++s4) cur[s4] = d[s4];
        const int nid = id + GRID; const bool more = nid < nq;
        if (more) {
#pragma unroll
            for (int s4 = 0; s4 < 4; ++s4) { d[s4] = desc(4 * nid + s4); tr_load(F, d[s4], v[s4]); } }
#pragma unroll
        for (int s4 = 0; s4 < 4; ++s4) { const TrTile& c = cur[s4]; const int nn = F.tid >> 3, kc = (F.tid & 7) * 8; const int n = c.n0 + nn;
          const int r = c.rowmode == 0 ? n : (c.rowmode == 3 ? (n < 2048 ? ((n & ~127) + 2 * (n & 63) + ((n >> 6) & 1)) : n) : ((n >> 7) * 256 + (n & 127) + (c.rowmode == 2 ? 128 : 0)));
          float o[8];
#pragma unroll
          for (int e = 0; e < 8; ++e) o[e] = tile[s4 * (64 * 65) + (kc + e) * 65 + nn];
          if (c.f8 != 0.f) { u32x2 w; w[0] = pk_fp8x4(o[0] * c.f8, o[1] * c.f8, o[2] * c.f8, o[3] * c.f8); w[1] = pk_fp8x4(o[4] * c.f8, o[5] * c.f8, o[6] * c.f8, o[7] * c.f8);
              *(u32x2*)((unsigned char*)c.dst + (size_t)r * c.ldd + c.k0 + kc) = w; }
          else store8(c.dst + (size_t)r * c.ldd + c.k0 + kc, o); }
        if (!more) break;
        id = nid;
    }
    __syncthreads();
}
DI void tr_job(const Frame& F, const float* src, int ldsrc, int K, int N, int Npad, bf16_t* dst, int ldd, int rowmode, float f8 = 0.f) {
    const int tn = Npad / 64, n = (K / 64) * tn;
    tr_run(F, n, [=](int i) { return TrTile{src, ldsrc, N, dst, ldd, rowmode, (i / tn) * 64, (i % tn) * 64, f8}; });
}
DI void moe_weights(const Frame& F0, int layer, const bool f8 = false) {
    Frame F = F0; F.tid = F.wave * 64 + lane_id(); asm volatile("" : "+v"(F.tid)); F.lane = F.tid & 63;
    const size_t esz = f8 ? 1 : 2;
    unsigned char* wgu = F.ws + OFF_WMOE; unsigned char* wd = wgu + (size_t)16 * 2048 * 1024 * esz;
    const size_t lo_ = (size_t)layer * 16 * 1024 * 1024;
    const float* g = F.in[24] + lo_; const float* u = F.in[25] + lo_; const float* dn = F.in[26] + lo_;
    const float sgu = f8 ? F8_SW : 0.f, sdn = f8 ? F8_SD : 0.f;
    tr_run(F, 16 * 256, [=](int id) { const int e = id >> 8, tl = id & 255; return TrTile{g + (size_t)e * 1024 * 1024, 1024, 1024, (bf16_t*)(wgu + (size_t)e * 2048 * 1024 * esz), 1024, 1, (tl >> 4) * 64, (tl & 15) * 64, sgu}; });
    tr_run(F, 16 * 256, [=](int id) { const int e = id >> 8, tl = id & 255; return TrTile{u + (size_t)e * 1024 * 1024, 1024, 1024, (bf16_t*)(wgu + (size_t)e * 2048 * 1024 * esz), 1024, 2, (tl >> 4) * 64, (tl & 15) * 64, sgu}; });
    tr_run(F, 16 * 256, [=](int id) { const int e = id >> 8, tl = id & 255; return TrTile{dn + (size_t)e * 1024 * 1024, 1024, 1024, (bf16_t*)(wd + (size_t)e * 1024 * 1024 * esz), 1024, 0, (tl >> 4) * 64, (tl & 15) * 64, sdn}; });
}

DI void ln1_router_phase(const Frame& F0, const float* xin  , const bf16_t* mix, bf16_t* xb, const float* lng, const float* lnb, int layer, unsigned char* xb8 = nullptr  ) {
    Frame F = F0; F.tid = F.wave * 64 + lane_id(); asm volatile("" : "+v"(F.tid)); F.lane = F.tid & 63;
    LAS float* tile = (LAS float*)F.lds;
    LAS float* part = (LAS float*)(F.lds + 16 * 1028 * 4);
    LAS float* lgt = part + 8 * 256;
    LAS float* scr = lgt + 256;
    LAS int* hist = (LAS int*)(scr + 256);
    const float* rw = F.in[22]; const float* rb = F.in[23];
    const int lane = F.lane, w = F.wave, fr = lane & 15, fq = lane >> 4;
    if (F.tid < 16) hist[F.tid] = 0;
    float bfrag[32];
#pragma unroll
    for (int s = 0; s < 32; ++s) bfrag[s] = rw[(size_t)(128 * w + 4 * s + fq) * 16 + fr];
    f32x4 gv[4], bv[4];
#pragma unroll
    for (int j = 0; j < 4; ++j) { gv[j] = *(const f32x4*)(lng + j * 256 + lane * 4); bv[j] = *(const f32x4*)(lnb + j * 256 + lane * 4); }
    int* tok_e = (int*)(F.ws + SM_TOKE); float* tok_w = (float*)(F.ws + SM_TOKW);
    const int t0 = F.wg * 256;
    f32x4 xv[2][4]; u32x2 mv[2][4];
    auto issue_rows = [&](int grp) {
#pragma unroll
        for (int rr = 0; rr < 2; ++rr) { const size_t t = (size_t)t0 + grp * 16 + 2 * w + rr;
#pragma unroll
            for (int j = 0; j < 4; ++j) {
                if (xin) xv[rr][j] = *(const f32x4*)(xin + t * D + j * 256 + lane * 4);
                else { const u32x2 xr = *(const u32x2*)(xb + t * D + j * 256 + lane * 4); xv[rr][j] = (f32x4){__uint_as_float(xr[0] << 16), __uint_as_float(xr[0] & 0xffff0000u), __uint_as_float(xr[1] << 16), __uint_as_float(xr[1] & 0xffff0000u)}; }
                if (mix) mv[rr][j] = *(const u32x2*)(mix + t * D + j * 256 + lane * 4); } }
    };
    issue_rows(0);
    for (int grp = 0; grp < 16; ++grp) {
        __syncthreads();
#pragma unroll
        for (int rr = 0; rr < 2; ++rr) {
            const int i = 2 * w + rr; const size_t t = (size_t)t0 + grp * 16 + i;
            f32x4 y[4]; float s = 0.f;
#pragma unroll
            for (int j = 0; j < 4; ++j) { y[j] = xv[rr][j] * ALPHA;
                if (mix) { const u32x2 m2 = mv[rr][j]; y[j] += (f32x4){__uint_as_float(m2[0] << 16), __uint_as_float(m2[0] & 0xffff0000u), __uint_as_float(m2[1] << 16), __uint_as_float(m2[1] & 0xffff0000u)}; }
                s += y[j][0] + y[j][1] + y[j][2] + y[j][3]; }
            const float mean = wave_sum(s) * (1.0f / D); float q = 0.f;
#pragma unroll
            for (int j = 0; j < 4; ++j) { y[j] -= mean; q += y[j][0] * y[j][0] + y[j][1] * y[j][1] + y[j][2] * y[j][2] + y[j][3] * y[j][3]; }
            const float rstd = rsqrtf(wave_sum(q) * (1.0f / D) + LN_EPS);
#pragma unroll
            for (int j = 0; j < 4; ++j) { f32x4 o = y[j] * rstd * gv[j] + bv[j];
                { u32x2 ob; ob[0] = pack2(o[0], o[1]); ob[1] = pack2(o[2], o[3]); *(u32x2*)(xb + t * D + j * 256 + lane * 4) = ob; }
                if (xb8) *(unsigned*)(xb8 + t * D + j * 256 + lane * 4) = pk_fp8x4(o[0] * F8_SX, o[1] * F8_SX, o[2] * F8_SX, o[3] * F8_SX);
                *(LAS f32x4*)(tile + i * 1028 + j * 256 + lane * 4) = o; }
        }
        if (grp + 1 < 16) issue_rows(grp + 1);
        __syncthreads();
        f32x4 acc = (f32x4){0.f, 0.f, 0.f, 0.f};
#pragma unroll
        for (int s = 0; s < 32; ++s) { const float a = tile[fr * 1028 + 128 * w + 4 * s + fq]; acc = __builtin_amdgcn_mfma_f32_16x16x4f32(a, bfrag[s], acc, 0, 0, 0); }
#pragma unroll
        for (int r = 0; r < 4; ++r) part[w * 256 + (4 * fq + r) * 16 + fr] = acc[r];
        __syncthreads();
        if (F.tid < 256) { float s = 0.f;
#pragma unroll
            for (int ww = 0; ww < 8; ++ww) s += part[ww * 256 + F.tid];
            const float aff = sigmoidf_(s); lgt[F.tid] = aff; scr[F.tid] = aff + rb[F.tid & 15]; }
        __syncthreads();
        if (F.tid < 16) {
            const int i = F.tid; const LAS float* sc = scr + i * 16; const LAS float* af = lgt + i * 16;
            int bg = 0; float bs = -1e30f;
#pragma unroll
            for (int gr = 0; gr < 4; ++gr) { const float a = sc[4 * gr], b = sc[4 * gr + 1], c = sc[4 * gr + 2], d = sc[4 * gr + 3];
                const float x = fmaxf(a, b), yv = fminf(a, b), z = fmaxf(c, d), u = fminf(c, d);
                const float top2 = fmaxf(x, z) + fmaxf(fminf(x, z), fmaxf(yv, u));
                if (top2 > bs) { bs = top2; bg = gr; } }
            const float v0 = sc[4 * bg], v1 = sc[4 * bg + 1], v2 = sc[4 * bg + 2], v3 = sc[4 * bg + 3];
            int l0 = 0; float m0 = v0; if (v1 > m0) { m0 = v1; l0 = 1; } if (v2 > m0) { m0 = v2; l0 = 2; } if (v3 > m0) { m0 = v3; l0 = 3; }
            int l1 = -1; float m1 = -1e30f;
            if (l0 != 0 && v0 > m1) { m1 = v0; l1 = 0; } if (l0 != 1 && v1 > m1) { m1 = v1; l1 = 1; } if (l0 != 2 && v2 > m1) { m1 = v2; l1 = 2; } if (l0 != 3 && v3 > m1) { m1 = v3; l1 = 3; }
            const int e0 = 4 * bg + l0, e1 = 4 * bg + l1; const float a0 = af[e0], a1 = af[e1], inv = rcpf_(a0 + a1);
            const size_t t = (size_t)t0 + grp * 16 + i;
            tok_e[2 * t] = e0; tok_e[2 * t + 1] = e1; tok_w[2 * t] = a0 * inv; tok_w[2 * t + 1] = a1 * inv;
            lds_add(&hist[e0], 1); lds_add(&hist[e1], 1);
        }
    }
    __syncthreads();
    if (F.tid < 16) ((int*)(F.ws + CTL_BLKCNT))[(layer * 256 + F.wg) * 16 + F.tid] = hist[F.tid];
    __syncthreads();
}

DI void moe_scatter_phase(const Frame& F0, const float* xa, int layer) {
    Frame F = F0; F.tid = F.wave * 64 + lane_id(); asm volatile("" : "+v"(F.tid)); F.lane = F.tid & 63;
    LAS int* tot = (LAS int*)F.lds; LAS int* before = tot + 16; LAS int* base = tot + 32; LAS int* lcnt = tot + 48;
    const int* blk = (const int*)(F.ws + CTL_BLKCNT) + layer * 256 * 16;
    __syncthreads();
    if (F.tid < 16) { int tt = 0, bb = 0; for (int g = 0; g < 256; ++g) { const int c = blk[g * 16 + F.tid]; tt += c; bb += (g < F.wg) ? c : 0; } tot[F.tid] = tt; before[F.tid] = bb; lcnt[F.tid] = 0; }
    __syncthreads();
    if (F.tid == 0) { int ts = 0; int* gts = (int*)(F.ws + CTL_TILES) + layer * 32;
        for (int e = 0; e < 16; ++e) { base[e] = ts * 256 + before[e]; if (F.wg == 0) gts[e] = ts; ts += (tot[e] + 255) >> 8; }
        if (F.wg == 0) gts[16] = ts; }
    __syncthreads();
    const int* tok_e = (const int*)(F.ws + SM_TOKE); int* tok_p = (int*)(F.ws + SM_TOKP); int* rowtok = (int*)(F.ws + SM_ROWTOK);
    const int t0 = F.wg * 256;
    { const int i = F.tid; const int e = tok_e[2 * t0 + i]; const int pos = base[e] + lds_add(&lcnt[e], 1); tok_p[2 * t0 + i] = pos; rowtok[pos] = t0 + (i >> 1); }
    if (F.wg == 0) {
        for (int e = 0; e < 16; ++e) { const int rs = base[e] - before[e], lo = rs + tot[e], hi = rs + (((tot[e] + 255) >> 8) << 8);
            for (int i = lo + F.tid; i < hi; i += NTH) rowtok[i] = 0; }
    }
    __syncthreads();
}

DI void ln2_phase(const Frame& F0, float* xout  , const float* lng, const float* lnb, bf16_t* xb, bool use_ffn, unsigned char* xb8 = nullptr  ) {
    Frame F = F0; F.tid = F.wave * 64 + lane_id(); asm volatile("" : "+v"(F.tid)); F.lane = F.tid & 63;
    const int lane = F.lane; const bf16_t* Y = (const bf16_t*)(F.ws + OFF_XS);
    const int* tok_p = (const int*)(F.ws + SM_TOKP); const float* tok_w = (const float*)(F.ws + SM_TOKW);
    f32x4 gv[4], bv[4];
#pragma unroll
    for (int j = 0; j < 4; ++j) { gv[j] = *(const f32x4*)(lng + j * 256 + lane * 4); bv[j] = *(const f32x4*)(lnb + j * 256 + lane * 4); }
    for (int r = F.wave; r < 256; r += 16) {
        size_t t[2]; int p0[2], p1[2]; float w0[2], w1[2]; f32x4 xv[2][4]; u32x2 ya[2][4], yb[2][4];
#pragma unroll
        for (int k = 0; k < 2; ++k) { t[k] = (size_t)F.wg * 256 + r + 8 * k; p0[k] = tok_p[2 * t[k]]; p1[k] = tok_p[2 * t[k] + 1]; w0[k] = tok_w[2 * t[k]]; w1[k] = tok_w[2 * t[k] + 1]; }
#pragma unroll
        for (int k = 0; k < 2; ++k)
#pragma unroll
            for (int j = 0; j < 4; ++j) { const u32x2 xr = *(const u32x2*)(xb + t[k] * D + j * 256 + lane * 4); xv[k][j] = (f32x4){__uint_as_float(xr[0] << 16), __uint_as_float(xr[0] & 0xffff0000u), __uint_as_float(xr[1] << 16), __uint_as_float(xr[1] & 0xffff0000u)}; }
        if (use_ffn) {
#pragma unroll
            for (int k = 0; k < 2; ++k)
#pragma unroll
                for (int j = 0; j < 4; ++j) { ya[k][j] = *(const u32x2*)(Y + (size_t)p0[k] * D + j * 256 + lane * 4); yb[k][j] = *(const u32x2*)(Y + (size_t)p1[k] * D + j * 256 + lane * 4); }
        }
#pragma unroll
        for (int k = 0; k < 2; ++k) {
            f32x4 y[4]; float s = 0.f;
#pragma unroll
            for (int j = 0; j < 4; ++j) { y[j] = xv[k][j] * ALPHA;
                if (use_ffn) { const u32x2 a = ya[k][j], b = yb[k][j];
                    y[j][0] += w0[k] * __uint_as_float(a[0] << 16) + w1[k] * __uint_as_float(b[0] << 16);
                    y[j][1] += w0[k] * __uint_as_float(a[0] & 0xffff0000u) + w1[k] * __uint_as_float(b[0] & 0xffff0000u);
                    y[j][2] += w0[k] * __uint_as_float(a[1] << 16) + w1[k] * __uint_as_float(b[1] << 16);
                    y[j][3] += w0[k] * __uint_as_float(a[1] & 0xffff0000u) + w1[k] * __uint_as_float(b[1] & 0xffff0000u); }
                s += y[j][0] + y[j][1] + y[j][2] + y[j][3]; }
            const float mean = wave_sum(s) * (1.0f / D); float q = 0.f;
#pragma unroll
            for (int j = 0; j < 4; ++j) { y[j] -= mean; q += y[j][0] * y[j][0] + y[j][1] * y[j][1] + y[j][2] * y[j][2] + y[j][3] * y[j][3]; }
            const float rstd = rsqrtf(wave_sum(q) * (1.0f / D) + LN_EPS);
#pragma unroll
            for (int j = 0; j < 4; ++j) { f32x4 o = y[j] * rstd * gv[j] + bv[j];
                if (xout) *(f32x4*)(xout + t[k] * D + j * 256 + lane * 4) = o;
                else { u32x2 ob; ob[0] = pack2(o[0], o[1]); ob[1] = pack2(o[2], o[3]); *(u32x2*)(xb + t[k] * D + j * 256 + lane * 4) = ob;
                    if (xb8) *(unsigned*)(xb8 + t[k] * D + j * 256 + lane * 4) = pk_fp8x4(o[0] * F8_SX, o[1] * F8_SX, o[2] * F8_SX, o[3] * F8_SX); } }
        }
    }
}

typedef short s16x4 __attribute__((ext_vector_type(4)));
#define MFMA16(a, b, c) __builtin_amdgcn_mfma_f32_16x16x32_bf16((a), (b), (c), 0, 0, 0)
DI bf16x8 ld_row(const LAS bf16_t* p) { return *(const LAS bf16x8*)p; }
DI bf16x8 ld_tr2(const LAS bf16_t* pa, const LAS bf16_t* pb) {
    const s16x4 lo = __builtin_amdgcn_ds_read_tr16_b64_v4i16((LAS s16x4*)pa), hi = __builtin_amdgcn_ds_read_tr16_b64_v4i16((LAS s16x4*)pb);
    return __builtin_shufflevector(lo, hi, 0, 1, 2, 3, 4, 5, 6, 7);
}

constexpr int R_LDK = 136, R_LDV = 264;
template <int NCOLS> DI void ret_copy(const Frame& F, const bf16_t* src, size_t gld, LAS bf16_t* dst, int lld) {
    constexpr int cpr = NCOLS >> 3, n = 128 * cpr;
    u32x4 v[n / NTH];
#pragma unroll
    for (int i = 0; i < n / NTH; ++i) { const int id = F.tid + i * NTH, r = id / cpr, ch = id % cpr; v[i] = *(const u32x4*)(src + (size_t)r * gld + ch * 8); }
#pragma unroll
    for (int i = 0; i < n / NTH; ++i) { const int id = F.tid + i * NTH, r = id / cpr, ch = id % cpr; *(LAS u32x4*)(dst + r * lld + ch * 8) = v[i]; }
}
template <int NCOLS> DI void blk_fetch(const Frame& F, const bf16_t* src, int gld, u32x4 (&v)[128 * (NCOLS >> 3) / NTH]) {
    constexpr int cpr = NCOLS >> 3;
    int t_ = F.tid; asm volatile("" : "+v"(t_));
#pragma unroll
    for (int i = 0; i < 128 * cpr / NTH; ++i) { const int id = t_ + i * NTH, r = id / cpr, ch = id % cpr; v[i] = *(const u32x4*)((const char*)src + (unsigned)(r * gld + ch * 8) * 2u); }
}
template <int NCOLS> DI void blk_put(const Frame& F, const u32x4 (&v)[128 * (NCOLS >> 3) / NTH], LAS bf16_t* dst, int lld) {
    constexpr int cpr = NCOLS >> 3;
    int t_ = F.tid; asm volatile("" : "+v"(t_));
#pragma unroll
    for (int i = 0; i < 128 * cpr / NTH; ++i) { const int id = t_ + i * NTH, r = id / cpr, ch = id % cpr; *(LAS u32x4*)(dst + r * lld + ch * 8) = v[i]; }
}
template <int NCOLS> DI void blk_fetch8(const Frame& F, const unsigned char* src, int gld, u32x4 (&v)[128 * (NCOLS >> 4) / NTH]) {
    constexpr int cpr = NCOLS >> 4;
    int t_ = F.tid; asm volatile("" : "+v"(t_));
#pragma unroll
    for (int i = 0; i < 128 * cpr / NTH; ++i) { const int id = t_ + i * NTH, r = id / cpr, ch = id % cpr; v[i] = *(const u32x4*)(src + (unsigned)(r * gld + ch * 16)); }
}
DI u32x2 fp8x4_bf16(unsigned d) { const auto a = __builtin_amdgcn_cvt_pk_f32_fp8((int)d, false), b = __builtin_amdgcn_cvt_pk_f32_fp8((int)d, true); u32x2 o; o[0] = pack2(a[0], a[1]); o[1] = pack2(b[0], b[1]); return o; }
template <int NCOLS> DI void blk_put8(const Frame& F, const u32x4 (&v)[128 * (NCOLS >> 4) / NTH], LAS bf16_t* dst, int lld) {
    constexpr int cpr = NCOLS >> 4;
    int t_ = F.tid; asm volatile("" : "+v"(t_));
#pragma unroll
    for (int i = 0; i < 128 * cpr / NTH; ++i) { const int id = t_ + i * NTH, r = id / cpr, ch = id % cpr; u32x4 lo, hi;
        const u32x2 c0 = fp8x4_bf16(v[i][0]), c1 = fp8x4_bf16(v[i][1]), c2 = fp8x4_bf16(v[i][2]), c3 = fp8x4_bf16(v[i][3]);
        lo = (u32x4){c0[0], c0[1], c1[0], c1[1]}; hi = (u32x4){c2[0], c2[1], c3[0], c3[1]};
        *(LAS u32x4*)(dst + r * lld + ch * 16) = lo; *(LAS u32x4*)(dst + r * lld + ch * 16 + 8) = hi; }
}
DI void ret_r1_unit(const Frame& F0, const bf16_t* Pg, bf16_t* KV, int unit) {
    Frame F = F0; F.tid = F.wave * 64 + lane_id(); asm volatile("" : "+v"(F.tid)); F.lane = F.tid & 63;
    const int c = unit & 63, h = (unit >> 6) & 7, bl = unit >> 9;
    LAS bf16_t* Kd = (LAS bf16_t*)F.lds; LAS bf16_t* Vs = Kd + 128 * R_LDK;
    const size_t row0 = (size_t)bl * 8192 + c * 128;
    const float l2g = log2f(1.0f - exp2f(-5.0f - (float)h));
    __syncthreads();
    { u32x4 kv_[4]; blk_fetch<128>(F, Pg + row0 * PGLD + 1024 + h * 128, PGLD, kv_);
#pragma unroll
      for (int i = 0; i < 4; ++i) { const int r_ = (F.tid + i * NTH) >> 4; const float sc = 0.08838834764831845f * __builtin_amdgcn_exp2f((float)(127 - r_) * l2g); float t8[8]; unpack8(kv_[i], t8);
#pragma unroll
          for (int e = 0; e < 8; ++e) t8[e] *= sc;
          kv_[i] = pack8(t8); }
      blk_put<128>(F, kv_, Kd, R_LDK); }
    if (PGV8) { u32x4 vv_[4]; blk_fetch8<256>(F, (const unsigned char*)Pg + row0 * 8192 + 4096 + h * 256, 8192, vv_); blk_put8<256>(F, vv_, Vs, R_LDV); }
    else ret_copy<256>(F, Pg + row0 * 6144 + 2048 + h * 256, 6144, Vs, R_LDV);
    __syncthreads();
    int w = F.wave; asm volatile("" : "+s"(w));
    const int lane = F.lane, fq = lane >> 4, q = (lane & 15) >> 2, pp = lane & 3;
    f32x4 acc[16];
#pragma unroll
    for (int i = 0; i < 16; ++i) acc[i] = (f32x4){0.f, 0.f, 0.f, 0.f};
#pragma unroll
    for (int ks = 0; ks < 4; ++ks) {
        const int ra = 32 * ks + 8 * fq + q, rb = ra + 4;
        const bf16x8 X = ld_tr2(Kd + ra * R_LDK + 16 * w + 4 * pp, Kd + rb * R_LDK + 16 * w + 4 * pp);
#pragma unroll
        for (int vt = 0; vt < 16; ++vt) { const bf16x8 Y = ld_tr2(Vs + ra * R_LDV + 16 * vt + 4 * pp, Vs + rb * R_LDV + 16 * vt + 4 * pp); acc[vt] = MFMA16(Y, X, acc[vt]); }
    }
    bf16_t* o = KV + (size_t)unit * 32768 + (16 * w + (lane & 15)) * 256 + 4 * fq;
#pragma unroll
    for (int vt = 0; vt < 16; ++vt) { u32x2 ov; ov[0] = pack2(acc[vt][0], acc[vt][1]); ov[1] = pack2(acc[vt][2], acc[vt][3]); *(u32x2*)(o + 16 * vt) = ov; }
}
DI void ret_r2_phase(const Frame& F0, bf16_t* KV) {
    Frame F = F0; F.tid = F.wave * 64 + lane_id(); asm volatile("" : "+v"(F.tid)); F.lane = F.tid & 63;
    const int gt = F.wg * NTH + F.tid;
    if (gt >= 65536) return;
    const int pair = gt >> 12, e8 = gt & 4095, h = pair & 7;
    const float cd = exp2f(128.0f * log2f(1.0f - exp2f(-5.0f - (float)h)));
    float st[8];
#pragma unroll
    for (int i = 0; i < 8; ++i) st[i] = 0.f;
#pragma unroll 8
    for (int c = 0; c < 64; ++c) {
        bf16_t* p = KV + ((size_t)(pair * 64 + c)) * 32768 + (size_t)e8 * 8;
        float kv[8]; unpack8(*(const u32x4*)p, kv);
        *(u32x4*)p = pack8(st);
#pragma unroll
        for (int i = 0; i < 8; ++i) st[i] = st[i] * cd + kv[i];
    }
}
DI void ret_r3_phase(const Frame& F0, const bf16_t* Pg, const bf16_t* RS, bf16_t* O1, int gq, const float* gn) {
    Frame F = F0; F.tid = F.wave * 64 + lane_id(); asm volatile("" : "+v"(F.tid)); F.lane = F.tid & 63;
    LAS bf16_t* Qs = (LAS bf16_t*)F.lds; LAS bf16_t* Ks = Qs + 128 * R_LDK; LAS bf16_t* Vh = Ks + 128 * R_LDK; LAS bf16_t* Rh = Vh + 128 * R_LDK;
    int w = F.wave; asm volatile("" : "+s"(w));
    u32x4 RQ[4], RK[4];
    { const int u0 = F.wg; const size_t r0 = (size_t)(u0 >> 9) * 8192 + (u0 & 63) * 128; const int h0 = (u0 >> 6) & 7;
      blk_fetch<128>(F, Pg + r0 * PGLD + h0 * 128, PGLD, RQ); blk_fetch<128>(F, Pg + r0 * PGLD + 1024 + h0 * 128, PGLD, RK); }
#pragma unroll 1
    for (int unit = F.wg; unit < 1024; unit += GRID) {
        const int c = unit & 63, h = (unit >> 6) & 7, bl = unit >> 9;
        const size_t row0 = (size_t)bl * 8192 + c * 128;
        const float l2g = log2f(1.0f - exp2f(-5.0f - (float)h));
        const bf16_t* rsu = RS + (size_t)unit * 32768;
        int lane = F.lane; asm volatile("" : "+v"(lane));
        const int fr = lane & 15, fq = lane >> 4, q = fr >> 2, pp = lane & 3;
        __syncthreads();
        blk_put<128>(F, RQ, Qs, R_LDK); blk_put<128>(F, RK, Ks, R_LDK);
        static_assert(PGV8, "the chunk-output phase reads v and g as e4m3");
        u32x4 RV[2], RR[4];
        const unsigned char* Pg8 = (const unsigned char*)Pg + row0 * 8192 + 4096 + h * 256;
        blk_fetch8<128>(F, Pg8, 8192, RV);
        blk_fetch<128>(F, rsu, 256, RR);
        __syncthreads();
        f32x4 sacc[8];
#pragma unroll
        for (int jt = 0; jt < 8; ++jt) sacc[jt] = (f32x4){0.f, 0.f, 0.f, 0.f};
#pragma unroll
        for (int ks = 0; ks < 4; ++ks) {
            const bf16x8 Yq = ld_row(Qs + (16 * w + fr) * R_LDK + 32 * ks + 8 * fq);
#pragma unroll
            for (int jt = 0; jt < 8; ++jt) { const bf16x8 Xk = ld_row(Ks + (16 * jt + fr) * R_LDK + 32 * ks + 8 * fq); sacc[jt] = MFMA16(Xk, Yq, sacc[jt]); }
        }
        __syncthreads();
        { const int i = 16 * w + fr;
#pragma unroll
          for (int jt = 0; jt < 8; ++jt) { float pv[4];
#pragma unroll
              for (int r = 0; r < 4; ++r) { const int j = 16 * jt + 4 * fq + r; pv[r] = (i >= j) ? sacc[jt][r] * (0.08838834764831845f * __builtin_amdgcn_exp2f((float)(i - j) * l2g)) : 0.f; }
              u32x2 o; o[0] = pack2(pv[0], pv[1]); o[1] = pack2(pv[2], pv[3]);
              *(LAS u32x2*)(Ks + i * R_LDK + 16 * jt + 4 * fq) = o; } }
        f32x4 acc[16];
#pragma unroll
        for (int i = 0; i < 16; ++i) acc[i] = (f32x4){0.f, 0.f, 0.f, 0.f};
        const float qdec = exp2f((float)(16 * w + fr + 1) * l2g);
        u32x4 RG[4];
#pragma unroll
        for (int half = 0; half < 2; ++half) {
            if (half) __syncthreads();
            blk_put8<128>(F, RV, Vh, R_LDK);
            blk_put<128>(F, RR, Rh, R_LDK);
            if (half == 0) { blk_fetch8<128>(F, Pg8 + 128, 8192, RV);
                blk_fetch<128>(F, rsu + 128, 256, RR); }
            else blk_fetch8<256>(F, Pg8 + 2048, 8192, RG);
            __syncthreads();
#pragma unroll
            for (int ks = 0; ks < 4; ++ks) {
                const bf16x8 Yq = ld_row(Qs + (16 * w + fr) * R_LDK + 32 * ks + 8 * fq);
                const int ra = 32 * ks + 8 * fq + q, rb = ra + 4;
#pragma unroll
                for (int vt = 0; vt < 8; ++vt) { const bf16x8 Xr = ld_tr2(Rh + ra * R_LDK + 16 * vt + 4 * pp, Rh + rb * R_LDK + 16 * vt + 4 * pp); acc[half * 8 + vt] = MFMA16(Xr, Yq, acc[half * 8 + vt]); }
            }
#pragma unroll
            for (int vt = 0; vt < 8; ++vt) acc[half * 8 + vt] *= qdec;
#pragma unroll
            for (int ks = 0; ks < 4; ++ks) {
                const bf16x8 Yp = ld_row(Ks + (16 * w + fr) * R_LDK + 32 * ks + 8 * fq);
                const int ra = 32 * ks + 8 * fq + q, rb = ra + 4;
#pragma unroll
                for (int vt = 0; vt < 8; ++vt) { const bf16x8 Xv = ld_tr2(Vh + ra * R_LDK + 16 * vt + 4 * pp, Vh + rb * R_LDK + 16 * vt + 4 * pp); acc[half * 8 + vt] = MFMA16(Xv, Yp, acc[half * 8 + vt]); }
            }
        }
        __syncthreads();
        LAS bf16_t* Gs = Vh;
        LAS float* gnl = (LAS float*)(Qs);
        blk_put8<256>(F, RG, Gs, R_LDV);
        if (F.tid < 256) { gnl[F.tid] = gn[h * 256 + F.tid]; gnl[256 + F.tid] = gn[2048 + h * 256 + F.tid]; }
        { const int un = unit + GRID; if (un < 1024) { const size_t rn = (size_t)(un >> 9) * 8192 + (un & 63) * 128; const int hn = (un >> 6) & 7;
            blk_fetch<128>(F, Pg + rn * PGLD + hn * 128, PGLD, RQ); blk_fetch<128>(F, Pg + rn * PGLD + 1024 + hn * 128, PGLD, RK); } }
        float s = 0.f;
#pragma unroll
        for (int vt = 0; vt < 16; ++vt) s += acc[vt][0] + acc[vt][1] + acc[vt][2] + acc[vt][3];
        s += shx(s, 16); s += shx(s, 32);
        const float mean = s * (1.0f / 256.0f); float qq = 0.f;
#pragma unroll
        for (int vt = 0; vt < 16; ++vt)
#pragma unroll
            for (int r = 0; r < 4; ++r) { const float d = acc[vt][r] - mean; qq += d * d; }
        qq += shx(qq, 16); qq += shx(qq, 32);
        const float rstd = rsqrtf(qq * (1.0f / 256.0f) + (PGV8 ? 1e-5f * F8_SX * F8_SX : 1e-5f));
        __syncthreads();
        const size_t trow = row0 + 16 * w + fr;
        bf16_t* op = O1 + ((size_t)gq * 16384 + trow) * 2048 + h * 256;
#pragma unroll
        for (int vt = 0; vt < 16; ++vt) {
            const int v0 = 16 * vt + 4 * fq;
            if ((vt & 3) == 0) asm volatile("" ::: "memory");
            const u32x2 gr = *(const LAS u32x2*)(Gs + (16 * w + fr) * R_LDV + v0);
            const f32x4 gg = *(const LAS f32x4*)(gnl + v0), gb = *(const LAS f32x4*)(gnl + 256 + v0);
            float gv[4] = {__uint_as_float(gr[0] << 16), __uint_as_float(gr[0] & 0xffff0000u), __uint_as_float(gr[1] << 16), __uint_as_float(gr[1] & 0xffff0000u)};
            if (PGV8) {
#pragma unroll
                for (int r = 0; r < 4; ++r) gv[r] *= (1.0f / F8_SX); }
            float o[4];
#pragma unroll
            for (int r = 0; r < 4; ++r) { const float nv = (acc[vt][r] - mean) * rstd * gg[r] + gb[r]; o[r] = siluf_(gv[r]) * nv; }
            if (RTO8) *(unsigned*)((unsigned char*)O1 + ((size_t)gq * 16384 + trow) * 2048 + h * 256 + v0) = pk_fp8x4(o[0] * F8_SO, o[1] * F8_SO, o[2] * F8_SO, o[3] * F8_SO);
            else { u32x2 ov; ov[0] = pack2(o[0], o[1]); ov[1] = pack2(o[2], o[3]);
            *(u32x2*)(op + v0) = ov; }
        }
    }
}

DI bf16_t* st_w(const Frame& F) { return (bf16_t*)(F.ws + OFF_STR); }
DI bf16_t* st_kk(const Frame& F) { return (bf16_t*)(F.ws + OFF_STR) + (size_t)T * 512; }
DI bf16_t* st_b(const Frame& F) { return (bf16_t*)F.out; }
DI bf16_t* st_kp(const Frame& F) { return (bf16_t*)F.out + (size_t)T * 512; }
DI bf16_t* st_r(const Frame& F) { return (bf16_t*)F.out + (size_t)T * 1024; }
DI bf16_t* st_v(const Frame& F) { return (bf16_t*)F.out + (size_t)T * 1536; }

DI void rwkv_e1_phase(const Frame& F0) {
    Frame F = F0; F.tid = F.wave * 64 + lane_id(); asm volatile("" : "+v"(F.tid)); F.lane = F.tid & 63;
    const bf16_t* PR = (const bf16_t*)(F.ws + OFF_PR); const float* mu = F.in[3]; const float* kkw = F.in[12];
    const int c = F.lane * 8;
    float m0[8], m1[8], m2[8], kw[8];
#pragma unroll
    for (int i = 0; i < 8; ++i) { m0[i] = mu[c + i]; m1[i] = mu[512 + c + i]; m2[i] = mu[1024 + c + i]; kw[i] = kkw[c + i]; }
    float* rn = (float*)(F.ws + SM_RNORM);
    for (int r = F.wave; r < 256; r += 16) {
        u32x4 ld[2][6]; size_t t[2];
#pragma unroll
        for (int k = 0; k < 2; ++k) { t[k] = (size_t)F.wg * 256 + r + 8 * k; const size_t row = t[k] + (t[k] >> 13) + 1;
            const bf16_t* cur = PR + row * 2048 + c; const bf16_t* prv = cur - 2048;
            ld[k][0] = *(const u32x4*)cur; ld[k][1] = *(const u32x4*)prv; ld[k][2] = *(const u32x4*)(cur + 512); ld[k][3] = *(const u32x4*)(prv + 512); ld[k][4] = *(const u32x4*)(cur + 1024); ld[k][5] = *(const u32x4*)(prv + 1024); }
#pragma unroll
        for (int k = 0; k < 2; ++k) {
            float a[8], p[8], o[8];
            unpack8(ld[k][0], a); unpack8(ld[k][1], p);
#pragma unroll
            for (int i = 0; i < 8; ++i) o[i] = a[i] + (p[i] - a[i]) * m0[i];
            *(u32x4*)(st_r(F) + t[k] * 512 + c) = pack8(o);
            unpack8(ld[k][2], a); unpack8(ld[k][3], p);
            float ss = 0.f;
#pragma unroll
            for (int i = 0; i < 8; ++i) { o[i] = a[i] + (p[i] - a[i]) * m1[i]; const float q = o[i] * kw[i]; ss += q * q; }
            *(u32x4*)(st_kp(F) + t[k] * 512 + c) = pack8(o);
            ss += shx(ss, 1); ss += shx(ss, 2); ss += shx(ss, 4);
            if ((F.lane & 7) == 0) rn[t[k] * 8 + (F.lane >> 3)] = rcpf_(fmaxf(__builtin_amdgcn_sqrtf(ss), 1e-12f));
            unpack8(ld[k][4], a); unpack8(ld[k][5], p);
#pragma unroll
            for (int i = 0; i < 8; ++i) o[i] = a[i] + (p[i] - a[i]) * m2[i];
            *(u32x4*)(st_v(F) + t[k] * 512 + c) = pack8(o);
        }
    }
}

DI float dpp_f(float v, int ctrl_qp1, int) { return v; }
template <int CTRL> DI float dpp_mov(float v) { return __int_as_float(__builtin_amdgcn_update_dpp(0, __float_as_int(v), CTRL, 0xf, 0xf, true)); }
DI float row_sum16(float v) {
    v += dpp_mov<0xB1>(v);
    v += dpp_mov<0x4E>(v);
    v += dpp_mov<0x141>(v);
    v += dpp_mov<0x140>(v);
    return v;
}

DI float row_sum8(float v) {
    v += dpp_mov<0xB1>(v);
    v += dpp_mov<0x4E>(v);
    v += dpp_mov<0x141>(v);
    return v;
}
typedef _Float16 h2_t __attribute__((ext_vector_type(2)));
typedef _Float16 h8_t __attribute__((ext_vector_type(8)));
constexpr int SC_STEPS = 32;
constexpr int SC_BUF = SC_STEPS * (5 * 64 + 64) * 2;
constexpr int SC_WGS = 64;
constexpr int SC_OBS = 260;
struct ScOp { u32x4 a0, a1, a2, a3, a4; unsigned v0, v1; };
template <int U> DI void sc_ld(ScOp& o, unsigned pb, unsigned pv) {
    asm volatile("ds_read_b128 %0, %1 offset:%c2" : "=v"(o.a0) : "v"(pb), "i"(U * 640) : "memory");
    asm volatile("ds_read_b128 %0, %1 offset:%c2" : "=v"(o.a1) : "v"(pb), "i"(U * 640 + 128) : "memory");
    asm volatile("ds_read_b128 %0, %1 offset:%c2" : "=v"(o.a2) : "v"(pb), "i"(U * 640 + 256) : "memory");
    asm volatile("ds_read_b128 %0, %1 offset:%c2" : "=v"(o.a3) : "v"(pb), "i"(U * 640 + 384) : "memory");
    asm volatile("ds_read_b128 %0, %1 offset:%c2" : "=v"(o.a4) : "v"(pb), "i"(U * 640 + 512) : "memory");
    asm volatile("ds_read_u16 %0, %1 offset:%c2" : "=v"(o.v0) : "v"(pv), "i"(U * 128) : "memory");
    asm volatile("ds_read_u16 %0, %1 offset:%c2" : "=v"(o.v1) : "v"(pv), "i"(U * 128 + 2) : "memory");
}
DI void sc_wait(ScOp& o) { asm volatile("s_waitcnt lgkmcnt(0)" : "+v"(o.a0), "+v"(o.a1), "+v"(o.a2), "+v"(o.a3), "+v"(o.a4), "+v"(o.v0), "+v"(o.v1) :: "memory"); }
DI h2_t h2of(unsigned x) { return __builtin_bit_cast(h2_t, x); }
DI float dot2z(h2_t a, h2_t b) { float r; asm("v_dot2_f32_f16 %0, %1, %2, 0" : "=v"(r) : "v"(a), "v"(b)); return r; }
DI float sc_dot(const h2_t (&S)[4], const u32x4& x) {
    float o = dot2z(S[0], h2of(x[0])); o = __builtin_amdgcn_fdot2(S[1], h2of(x[1]), o, false); o = __builtin_amdgcn_fdot2(S[2], h2of(x[2]), o, false); return __builtin_amdgcn_fdot2(S[3], h2of(x[3]), o, false); }
DI unsigned sc_readout(const h2_t (&S)[2][4], const u32x4& rp) {
    const float o0 = sc_dot(S[0], rp), o1 = sc_dot(S[1], rp);
    return __builtin_bit_cast(unsigned, __builtin_amdgcn_cvt_pkrtz(o0, o1));
}
template <int U> DI void sc_step(h2_t (&S)[2][4], ScOp& cur, u32x4& rp, LAS unsigned* obw, unsigned pb, unsigned pv) {
    ScOp nxt; sc_ld<U + 1>(nxt, pb, pv);
    __builtin_amdgcn_sched_barrier(0);
    const float sa0 = sc_dot(S[0], cur.a1), sa1 = sc_dot(S[1], cur.a1);
    obw[U * SC_OBS] = sc_readout(S, rp);
    const _Float16 sh0 = (_Float16)(-row_sum8(sa0)), sh1 = (_Float16)(-row_sum8(sa1));
    const h2_t sav[2] = {(h2_t){sh0, sh0}, (h2_t){sh1, sh1}};
    const _Float16 vh0 = h2of(cur.v0)[0], vh1 = h2of(cur.v1)[0];
    const h2_t vv2[2] = {(h2_t){vh0, vh0}, (h2_t){vh1, vh1}};
#pragma unroll
    for (int rw = 0; rw < 2; ++rw)
#pragma unroll
        for (int i = 0; i < 4; ++i) S[rw][i] = S[rw][i] * h2of(cur.a0[i]) + (sav[rw] * h2of(cur.a2[i]) + vv2[rw] * h2of(cur.a3[i]));
    rp = cur.a4;
    __builtin_amdgcn_sched_barrier(0);
    sc_wait(nxt); cur = nxt;
}
DI void rwkv_scan(const Frame& F0, const bool do_post = true) {
    Frame F = F0; F.tid = F.wave * 64 + lane_id(); asm volatile("" : "+v"(F.tid)); F.lane = F.tid & 63;
    const int stream = F.wg, b = stream >> 3, h = stream & 7;
    const int rloc = 16 * F.wave + 2 * (F.lane >> 3), cg = F.lane & 7;
    const size_t tb = (size_t)b * SEQ;
    LAS unsigned* OBP = (LAS unsigned*)(F.lds + 2 * SC_BUF);
    const bf16_t* arrs[6] = {st_w(F), st_kk(F), st_b(F), st_kp(F), st_r(F), st_v(F)};
    u32x4 stage[3];
    auto issue = [&](int chunk) {
#pragma unroll
        for (int i = 0; i < 3; ++i) { const int id = F.tid + NTH * i, arr = id >> 8, rem = id & 255, step = rem >> 3, ch = rem & 7;
            const bf16_t* base = arr == 0 ? arrs[0] : arr == 1 ? arrs[1] : arr == 2 ? arrs[2] : arr == 3 ? arrs[3] : arr == 4 ? arrs[4] : arrs[5];
            stage[i] = *(const u32x4*)(base + (tb + (size_t)chunk * SC_STEPS + step) * 512 + h * 64 + ch * 8); }
    };
    auto commit = [&](int buf) {
        LAS _Float16* L = (LAS _Float16*)(F.lds + buf * SC_BUF);
#pragma unroll
        for (int i = 0; i < 3; ++i) { const int id = F.tid + NTH * i, arr = id >> 8, rem = id & 255, step = rem >> 3, ch = rem & 7;
            float v[8]; unpack8(stage[i], v);
            h8_t hv;
#pragma unroll
            for (int e = 0; e < 8; ++e) hv[e] = (_Float16)v[e];
            LAS _Float16* d = arr < 5 ? (L + step * 320 + arr * 64 + ch * 8) : (L + SC_STEPS * 320 + step * 64 + ch * 8);
            *(LAS h8_t*)d = hv; }
    };
    const int pstep = (F.tid - 256) >> 3, pc = h * 64 + 8 * (F.tid & 7);
    float lg[8], lb[8], rk[8];
    if (F.wave >= 4) {
#pragma unroll
        for (int i = 0; i < 8; ++i) { lg[i] = F.in[15][pc + i]; lb[i] = F.in[15][512 + pc + i]; rk[i] = F.in[14][pc + i]; } }
    bf16_t* O0 = (bf16_t*)(F.ws + OFF_O0);
    auto post = [&](int chunk) {
        const size_t t = tb + (size_t)chunk * SC_STEPS + pstep;
        const LAS unsigned* ob = OBP + ((chunk & 1) * (SC_STEPS + 1) + pstep + 1) * SC_OBS + 32 * (F.tid & 7);
        float o[8];
#pragma unroll
        for (int p = 0; p < 4; ++p) { float s0 = 0.f, s1 = 0.f;
#pragma unroll
            for (int hf = 0; hf < 2; ++hf) { const u32x4 q = *(const LAS u32x4*)(ob + p * 8 + hf * 4);
#pragma unroll
                for (int e = 0; e < 4; ++e) { const h2_t hv = h2of(q[e]); s0 += (float)hv[0]; s1 += (float)hv[1]; } }
            o[2 * p] = s0; o[2 * p + 1] = s1; }
        float rr[8], kp[8], vv[8], gg[8];
        unpack8(*(const u32x4*)(st_r(F) + t * 512 + pc), rr); unpack8(*(const u32x4*)(st_kp(F) + t * 512 + pc), kp); unpack8(*(const u32x4*)(st_v(F) + t * 512 + pc), vv);
        unpack8(*(const u32x4*)(O0 + t * 1024 + pc), gg);
        float s = 0.f, bs = 0.f;
#pragma unroll
        for (int i = 0; i < 8; ++i) { s += o[i]; bs += rr[i] * kp[i] * rk[i]; }
        s += shx(s, 1); s += shx(s, 2); s += shx(s, 4);
        bs += shx(bs, 1); bs += shx(bs, 2); bs += shx(bs, 4);
        const float mean = s * (1.0f / 64.0f); float q = 0.f;
#pragma unroll
        for (int i = 0; i < 8; ++i) { const float d = o[i] - mean; q += d * d; }
        q += shx(q, 1); q += shx(q, 2); q += shx(q, 4);
        const float rstd = rsqrtf(q * (1.0f / 64.0f) + 64e-5f);
        float res[8];
#pragma unroll
        for (int i = 0; i < 8; ++i) res[i] = ((o[i] - mean) * rstd * lg[i] + lb[i] + bs * vv[i]) * gg[i];
        *(u32x4*)(O0 + t * 1024 + pc) = pack8(res);
    };
    h2_t S[2][4];
#pragma unroll
    for (int i = 0; i < 4; ++i) { S[0][i] = (h2_t){(_Float16)0.f, (_Float16)0.f}; S[1][i] = S[0][i]; }
    __syncthreads();
    issue(0); commit(0);
    __syncthreads();
    constexpr int NCH = SEQ / SC_STEPS;
    for (int chunk = 0; chunk < NCH; ++chunk) {
        if (chunk + 1 < NCH) issue(chunk + 1);
        const LAS _Float16* L = (const LAS _Float16*)(F.lds + (chunk & 1) * SC_BUF);
        if (F.wave < 4) {
            LAS unsigned* obw = OBP + (chunk & 1) * (SC_STEPS + 1) * SC_OBS + F.tid;
            unsigned pb = (unsigned)(size_t)(F.lds + (chunk & 1) * SC_BUF) + 16 * cg, pv = (unsigned)(size_t)(F.lds + (chunk & 1) * SC_BUF) + SC_STEPS * 640 + 2 * rloc;
            ScOp cur; sc_ld<0>(cur, pb, pv); sc_wait(cur);
            u32x4 rp = cur.a4;
#pragma unroll 1
            for (int g8 = 0; g8 < SC_STEPS / 8; ++g8) {
                sc_step<0>(S, cur, rp, obw, pb, pv); sc_step<1>(S, cur, rp, obw, pb, pv); sc_step<2>(S, cur, rp, obw, pb, pv); sc_step<3>(S, cur, rp, obw, pb, pv);
                sc_step<4>(S, cur, rp, obw, pb, pv); sc_step<5>(S, cur, rp, obw, pb, pv); sc_step<6>(S, cur, rp, obw, pb, pv); sc_step<7>(S, cur, rp, obw, pb, pv);
                pb += 8 * 640; pv += 8 * 128; obw += 8 * SC_OBS;
            }
            obw[0] = sc_readout(S, rp);
        } else if (chunk > 0 && do_post) post(chunk - 1);
        if (chunk + 1 < NCH) commit((chunk + 1) & 1);
        __syncthreads();
    }
    if (F.wave >= 4 && do_post) post(NCH - 1);
}

DI void nsa_rope_phase(const Frame& F0) {
    Frame F = F0; F.tid = F.wave * 64 + lane_id(); asm volatile("" : "+v"(F.tid)); F.lane = F.tid & 63;
    bf16_t* PN = (bf16_t*)(F.ws + OFF_PN); const float* tab = (const float*)(F.ws + SM_ROPEN);
    const int hh = F.lane >> 2, j0 = (F.lane & 3) * 2;
    const int col = hh < 8 ? hh * 64 : 512 + ((hh - 8) >> 1) * 256 + ((hh - 8) & 1) * 64;
    if (hh >= 14) return;
    for (int r = F.wave; r < 256; r += 8) {
        const size_t t = (size_t)F.wg * 256 + r; const int pos = (int)(t & 8191);
        bf16_t* p = PN + t * 1536 + col + j0;
        const unsigned a = *(const unsigned*)p, bq = *(const unsigned*)(p + 8);
        const f32x4 cs = *(const f32x4*)(tab + ((size_t)pos * 8 + j0) * 2);
        const float x10 = __uint_as_float(a << 16), x11 = __uint_as_float(a & 0xffff0000u), x20 = __uint_as_float(bq << 16), x21 = __uint_as_float(bq & 0xffff0000u);
        *(unsigned*)p = pack2(x10 * cs[0] - x20 * cs[1], x11 * cs[2] - x21 * cs[3]);
        *(unsigned*)(p + 8) = pack2(x20 * cs[0] + x10 * cs[1], x21 * cs[2] + x11 * cs[3]);
    }
}
namespace pg8 {
struct CmpSched {
    const char* A; const char* B; size_t slotstepA, tstepA, bstride; int G, c;
    DI bool next(int i, Unit& u) const {
        const int L = i * G + c; if (L >= 64) return false;
        const int slot = L >> 4, pm = L & 15; u.pm = pm; u.pn = 0; u.aux = slot;
        u.a = A + (size_t)slot * slotstepA + (size_t)pm * tstepA; u.b = B + (size_t)(slot >> 1) * bstride; u.rows = nullptr; return true;
    }
};
}
constexpr int NS_STG = 16384, NS_NSTG = 4;
constexpr int NS_OFF_IMP = NS_NSTG * NS_STG, NS_OFF_SEL = NS_OFF_IMP + 128 * 128 * 4, NS_OFF_U = NS_OFF_SEL + 2048;
constexpr float NS_C = 0.125f * 1.44269504088896341f;
struct FState { f32x4 o[4][4]; float m[4], l[4]; };
struct TileSrc { const bf16_t* k; const bf16_t* v; size_t rstride; };
DI void ns_dma(const Frame& F, const TileSrc& S, int j, int stage) {
    int l_ = F.lane; asm volatile("" : "+v"(l_));
    const int row = 8 * F.wave + (l_ >> 3), c = (l_ & 7) ^ (l_ >> 3);
    const unsigned off = ((unsigned)(j * 64 + row) * (unsigned)S.rstride + c * 8) * 2u;
    LAS unsigned char* base = F.lds + stage * NS_STG + F.wave * 1024;
    __builtin_amdgcn_global_load_lds((const unsigned*)((const char*)S.k + off), (LAS unsigned*)base, 16, 0, 0);
    __builtin_amdgcn_global_load_lds((const unsigned*)((const char*)S.v + off), (LAS unsigned*)(base + 8192), 16, 0, 0);
}
DI void ns_wait(int after) {
    if (after >= 2) asm volatile("s_waitcnt vmcnt(4)" ::: "memory"); else if (after == 1) asm volatile("s_waitcnt vmcnt(2)" ::: "memory"); else asm volatile("s_waitcnt vmcnt(0)" ::: "memory");
    __builtin_amdgcn_s_barrier(); asm volatile("" ::: "memory");
}
DI float fexp2(float x) { return __builtin_amdgcn_exp2f(x); }
DI unsigned cvtpk(float lo, float hi) { return pack2(lo, hi); }
constexpr float NS_NINF = -__builtin_inff();
DI float vmax(float a, float b) { return __builtin_fmaxf(a, b); }
DI float vmax3(float a, float b, float c) { return __builtin_fmaxf(__builtin_fmaxf(a, b), c); }
DI float xquad_max(float v) {
    u32x2 r = __builtin_amdgcn_permlane16_swap(__float_as_uint(v), __float_as_uint(v), false, false);
    v = vmax(__uint_as_float(r[0]), __uint_as_float(r[1]));
    r = __builtin_amdgcn_permlane32_swap(__float_as_uint(v), __float_as_uint(v), false, false);
    return vmax(__uint_as_float(r[0]), __uint_as_float(r[1]));
}
template <int MM, bool PV, bool CMPHI = false, bool QL = false>
DI void ns_step(const LAS unsigned char* tb  , int kabs, const bf16x8 (&Qf)[4][2], FState& st, unsigned rtm, unsigned sb, int posl, int lod, int fr, int fq, int q, int pp, const LAS bf16_t* qb = nullptr) {
    const int lk = fr * 128 + ((fq ^ (fr & 7)) << 4);
    const int m_ = (4 * fq + q) & 7, vbl = (4 * fq + q) * 128 + ((((pp >> 1) ^ (m_ & 1))) << 4) + (pp & 1) * 8 + ((m_ >> 1) << 5);
    const LAS unsigned char* kp0 = tb + lk; const LAS unsigned char* kp1 = tb + (lk ^ 64); const LAS unsigned char* vp_ = tb + 8192 + vbl;
    asm volatile("" : "+v"(kp0), "+v"(kp1), "+v"(vp_));
    f32x4 s[2][4];
    bf16x8 X[2][2];
#pragma unroll
    for (int kt = 0; kt < 2; ++kt) { X[kt][0] = *(const LAS bf16x8*)(kp0 + kt * 2048); X[kt][1] = *(const LAS bf16x8*)(kp1 + kt * 2048); }
#pragma unroll
    for (int rt = 0; rt < 4; ++rt) if ((rtm >> rt) & 1u) {
        const bf16x8 q0 = QL ? ld_row(qb + (rt * 2 + 0) * 512) : Qf[rt][0], q1 = QL ? ld_row(qb + (rt * 2 + 1) * 512) : Qf[rt][1];
#pragma unroll
        for (int kt = 0; kt < 2; ++kt) { s[kt][rt] = MFMA16(X[kt][0], q0, ((f32x4){0.f, 0.f, 0.f, 0.f})); s[kt][rt] = MFMA16(X[kt][1], q1, s[kt][rt]); }
    }
    bf16x8 Y[4];
#pragma unroll
    for (int rt = 0; rt < 4; ++rt) {
        if ((rtm >> rt) & 1u) {
            if (MM) {
#pragma unroll
                for (int kt = 0; kt < 2; ++kt)
#pragma unroll
                    for (int r = 0; r < 4; ++r) { const int key = kabs + 16 * kt + 4 * fq + r; const int hi_ = CMPHI ? ((posl + 4 * rt - 31) >> 4) : (posl + 4 * rt);
                        const bool ok = MM == 1 ? (key <= hi_) : (key <= hi_ && key > hi_ - lod);
                        s[kt][rt][r] = ok ? s[kt][rt][r] : NS_NINF; }
            }
            const float rowneg = ((sb >> rt) & 1u) ? 0.f : NS_NINF;
            float mx = vmax3(s[0][rt][0], s[0][rt][1], s[0][rt][2]); mx = vmax3(mx, s[0][rt][3], s[1][rt][0]); mx = vmax3(mx, s[1][rt][1], s[1][rt][2]); mx = vmax(mx, s[1][rt][3]);
            mx = vmax(mx + rowneg, st.m[rt]);
            mx = xquad_max(mx);
            const float alpha = fexp2(st.m[rt] - mx); st.m[rt] = mx;
            const float c = rowneg - mx; const f32x2 c2 = (f32x2){c, c};
            f32x2 p[4];
#pragma unroll
            for (int kt = 0; kt < 2; ++kt) { const f32x2 a = (f32x2){s[kt][rt][0], s[kt][rt][1]} + c2, b = (f32x2){s[kt][rt][2], s[kt][rt][3]} + c2;
                p[2 * kt] = (f32x2){fexp2(a[0]), fexp2(a[1])}; p[2 * kt + 1] = (f32x2){fexp2(b[0]), fexp2(b[1])}; }
            const f32x2 ps2 = (p[0] + p[1]) + (p[2] + p[3]);
            st.l[rt] = st.l[rt] * alpha + (ps2[0] + ps2[1]);
            if (PV) {
                if (__ballot(alpha != 1.0f) != 0ull) {
#pragma unroll
                    for (int dt = 0; dt < 4; ++dt) st.o[dt][rt] *= alpha; }
                u32x4 w; w[0] = cvtpk(p[0][0], p[0][1]); w[1] = cvtpk(p[1][0], p[1][1]); w[2] = cvtpk(p[2][0], p[2][1]); w[3] = cvtpk(p[3][0], p[3][1]);
                Y[rt] = __builtin_bit_cast(bf16x8, w);
            }
        } else if (PV) {
            Y[rt] = (bf16x8){0, 0, 0, 0, 0, 0, 0, 0};
        }
    }
    if (PV) {
        const unsigned a0 = (unsigned)(size_t)vp_, a1 = a0 ^ 32u, a2 = a0 ^ 64u, a3 = a0 ^ 96u;
        s16x4 t0, t1, t2, t3, t4, t5, t6, t7;
        asm volatile("ds_read_b64_tr_b16 %0, %8\n\tds_read_b64_tr_b16 %1, %8 offset:2048\n\tds_read_b64_tr_b16 %2, %9\n\tds_read_b64_tr_b16 %3, %9 offset:2048\n\t"
                     "ds_read_b64_tr_b16 %4, %10\n\tds_read_b64_tr_b16 %5, %10 offset:2048\n\tds_read_b64_tr_b16 %6, %11\n\tds_read_b64_tr_b16 %7, %11 offset:2048\n\ts_waitcnt lgkmcnt(0)"
                     : "=&v"(t0), "=&v"(t1), "=&v"(t2), "=&v"(t3), "=&v"(t4), "=&v"(t5), "=&v"(t6), "=&v"(t7) : "v"(a0), "v"(a1), "v"(a2), "v"(a3) : "memory");
        const bf16x8 Xv[4] = {__builtin_shufflevector(t0, t1, 0, 1, 2, 3, 4, 5, 6, 7), __builtin_shufflevector(t2, t3, 0, 1, 2, 3, 4, 5, 6, 7), __builtin_shufflevector(t4, t5, 0, 1, 2, 3, 4, 5, 6, 7), __builtin_shufflevector(t6, t7, 0, 1, 2, 3, 4, 5, 6, 7)};
#pragma unroll
        for (int dt = 0; dt < 4; ++dt)
#pragma unroll
            for (int rt = 0; rt < 4; ++rt) st.o[dt][rt] = MFMA16(Xv[dt], Y[rt], st.o[dt][rt]);
    }
}
DI void ns_reset(FState& st) {
#pragma unroll
    for (int rt = 0; rt < 4; ++rt) { st.m[rt] = -1e30f; st.l[rt] = 0.f;
#pragma unroll
        for (int dt = 0; dt < 4; ++dt) st.o[dt][rt] = (f32x4){0.f, 0.f, 0.f, 0.f}; }
}


DI void ns_vtr8(const LAS unsigned char* vp_, bf16x8 (&Xv)[4]) {
    const unsigned a0 = (unsigned)(size_t)vp_, a1 = a0 ^ 32u, a2 = a0 ^ 64u, a3 = a0 ^ 96u;
    s16x4 t0, t1, t2, t3, t4, t5, t6, t7;
    asm volatile("ds_read_b64_tr_b16 %0, %8\n\tds_read_b64_tr_b16 %1, %8 offset:2048\n\tds_read_b64_tr_b16 %2, %9\n\tds_read_b64_tr_b16 %3, %9 offset:2048\n\t"
                 "ds_read_b64_tr_b16 %4, %10\n\tds_read_b64_tr_b16 %5, %10 offset:2048\n\tds_read_b64_tr_b16 %6, %11\n\tds_read_b64_tr_b16 %7, %11 offset:2048\n\ts_waitcnt lgkmcnt(0)"
                 : "=&v"(t0), "=&v"(t1), "=&v"(t2), "=&v"(t3), "=&v"(t4), "=&v"(t5), "=&v"(t6), "=&v"(t7) : "v"(a0), "v"(a1), "v"(a2), "v"(a3) : "memory");
    Xv[0] = __builtin_shufflevector(t0, t1, 0, 1, 2, 3, 4, 5, 6, 7); Xv[1] = __builtin_shufflevector(t2, t3, 0, 1, 2, 3, 4, 5, 6, 7);
    Xv[2] = __builtin_shufflevector(t4, t5, 0, 1, 2, 3, 4, 5, 6, 7); Xv[3] = __builtin_shufflevector(t6, t7, 0, 1, 2, 3, 4, 5, 6, 7);
}

namespace nsb {
typedef float f32x16 __attribute__((ext_vector_type(16)));
constexpr int NSLOT = 3, SLOTB = 8192, LDS_K = 0, LDS_V = NSLOT * SLOTB, LDS_WS = 2 * NSLOT * SLOTB, LDS_OST = LDS_WS + 8 * 64 * 4, LDS_BYTES = LDS_OST + 8 * 4096;
constexpr int PITCH = 1536;
DI int crow(int r, int hi) { return (r & 3) + 8 * (r >> 2) + 4 * hi; }
#define NSB_SBAR() __builtin_amdgcn_sched_barrier(0)
DI void glds16(const void* sbase_, unsigned voff, unsigned lds_dst) { unsigned keep;
    const unsigned long long a_ = (unsigned long long)sbase_;
    const unsigned long long sbase = ((unsigned long long)(unsigned)__builtin_amdgcn_readfirstlane((int)(a_ >> 32)) << 32) | (unsigned)__builtin_amdgcn_readfirstlane((int)a_);
    asm volatile("s_mov_b32 %0, m0\n\ts_mov_b32 m0, %3\n\ts_nop 0\n\tglobal_load_lds_dwordx4 %1, %2\n\ts_mov_b32 m0, %0" : "=&s"(keep) : "v"(voff), "s"(sbase), "s"(lds_dst) : "memory"); }
DI float max3f(float a, float b, float c) { float r; asm("v_max3_f32 %0, %1, %2, %3" : "=v"(r) : "v"(a), "v"(b), "v"(c)); return r; }
DI float max2f(float a, float b) { float r; asm("v_max_f32_e32 %0, %1, %2" : "=v"(r) : "v"(a), "v"(b)); return r; }
DI float fadd_s(float a, float b) { float r; asm("v_add_f32_e32 %0, %1, %2" : "=v"(r) : "v"(a), "v"(b)); return r; }
DI float fsub_s(float a, float b) { float r; asm("v_sub_f32_e32 %0, %1, %2" : "=v"(r) : "v"(a), "v"(b)); return r; }
#define NSB_WAIT_BAR(N) asm volatile("s_waitcnt vmcnt(" #N ") lgkmcnt(0)\n\ts_barrier" ::: "memory")
typedef LAS const char* lds_cptr;
DI void qkt(f32x16& p0, f32x16& p1, lds_cptr Kslot, const bf16x8* qr, const f32x16& negm, int r32, int hi) {
    lds_cptr kb = Kslot + hi * 1024 + r32 * 16;
#pragma unroll
    for (int d0 = 0; d0 < 4; ++d0) {
        const bf16x8 b0 = *(const LAS bf16x8*)(kb + d0 * 2048), b1 = *(const LAS bf16x8*)(kb + d0 * 2048 + 512);
        if (d0 == 0) { p0 = __builtin_amdgcn_mfma_f32_32x32x16_bf16(b0, qr[0], negm, 0, 0, 0); p1 = __builtin_amdgcn_mfma_f32_32x32x16_bf16(b1, qr[0], negm, 0, 0, 0); }
        else { p0 = __builtin_amdgcn_mfma_f32_32x32x16_bf16(b0, qr[d0], p0, 0, 0, 0); p1 = __builtin_amdgcn_mfma_f32_32x32x16_bf16(b1, qr[d0], p1, 0, 0, 0); } }
}
DI void kload8(bf16x8* kf, lds_cptr kp) {
    kf[0] = *(const LAS bf16x8*)(kp);        kf[1] = *(const LAS bf16x8*)(kp + 512);
    kf[2] = *(const LAS bf16x8*)(kp + 2048); kf[3] = *(const LAS bf16x8*)(kp + 2560);
    kf[4] = *(const LAS bf16x8*)(kp + 4096); kf[5] = *(const LAS bf16x8*)(kp + 4608);
    kf[6] = *(const LAS bf16x8*)(kp + 6144); kf[7] = *(const LAS bf16x8*)(kp + 6656);
}
DI void kload2(bf16x8* kf, lds_cptr kp, int j) { kf[2 * j] = *(const LAS bf16x8*)(kp + j * 2048); kf[2 * j + 1] = *(const LAS bf16x8*)(kp + j * 2048 + 512); }
DI s16x4 vtr(lds_cptr p) { return __builtin_amdgcn_ds_read_tr16_b64_v4i16((LAS s16x4*)p); }
DI float rowmax(const f32x16& p0, const f32x16& p1) {
    float a = max3f(p0[0], p0[1], p1[0]), b = max3f(p0[2], p0[3], p1[1]); a = max3f(a, p1[2], p1[3]);
#pragma unroll
    for (int r = 4; r < 16; r += 4) { a = max3f(a, p0[r], p0[r + 1]); b = max3f(b, p0[r + 2], p0[r + 3]); a = max3f(a, p1[r], p1[r + 1]); b = max3f(b, p1[r + 2], p1[r + 3]); }
    const float m = max2f(a, b);
    auto rr = __builtin_amdgcn_permlane32_swap(__float_as_uint(m), __float_as_uint(m), false, false);
    return max2f(__uint_as_float(rr[0]), __uint_as_float(rr[1]));
}
DI void pv(f32x16* o, int vb, bf16x8 pa0, bf16x8 pa1, bf16x8 pa2, bf16x8 pa3) {
#pragma unroll
    for (int d0 = 0; d0 < 2; ++d0) { s16x4 lo[4], hi[4];
#pragma unroll
        for (int ks = 0; ks < 4; ++ks) {
            asm volatile("ds_read_b64_tr_b16 %0,%1 offset:%c2" : "=&v"(lo[ks]) : "v"(vb), "i"(d0 * 4096 + ks * 1024) : "memory");
            asm volatile("ds_read_b64_tr_b16 %0,%1 offset:%c2" : "=&v"(hi[ks]) : "v"(vb), "i"(d0 * 4096 + ks * 1024 + 512) : "memory"); }
        asm volatile("s_waitcnt lgkmcnt(0)" ::: "memory"); NSB_SBAR();
#define NSB_PK(k) (bf16x8){lo[k][0], lo[k][1], lo[k][2], lo[k][3], hi[k][0], hi[k][1], hi[k][2], hi[k][3]}
        o[d0] = __builtin_amdgcn_mfma_f32_32x32x16_bf16(pa0, NSB_PK(0), o[d0], 0, 0, 0);
        o[d0] = __builtin_amdgcn_mfma_f32_32x32x16_bf16(pa1, NSB_PK(1), o[d0], 0, 0, 0);
        o[d0] = __builtin_amdgcn_mfma_f32_32x32x16_bf16(pa2, NSB_PK(2), o[d0], 0, 0, 0);
        o[d0] = __builtin_amdgcn_mfma_f32_32x32x16_bf16(pa3, NSB_PK(3), o[d0], 0, 0, 0);
#undef NSB_PK
    }
}
DI void tmask(f32x16& p0, f32x16& p1, int mode, int tl, int hi) {
    const float NEG = -__builtin_inff();
#pragma unroll
    for (int r = 0; r < 16; ++r) { const int k0 = crow(r, hi), k1 = k0 + 32;
        const bool m0 = mode == 3 || (mode == 1 ? k0 > tl : (mode == 2 && k0 <= tl)), m1 = mode == 3 || (mode == 1 ? k1 > tl : (mode == 2 && k1 <= tl));
        if (m0) p0[r] = NEG; if (m1) p1[r] = NEG; }
}
template <int THRL, int BR>
DI void unit(const Frame& F, int b, int g, int tok0, const bf16_t* PN, bf16_t* O0, LAS char* shm, const LAS unsigned* selm_tok0, const bool do_store = true) {
    const int lane = F.lane, r32 = lane & 31, hi = lane >> 5, wid = F.wave;
    const long rowbase = (long)b * SEQ; const int jq = tok0 >> 6;
    const int tl = 8 * wid + (r32 >> 2);
    const bf16_t* Qw = PN + (rowbase + tok0 + tl) * PITCH + (g * 4 + (r32 & 3)) * 64;
    const bf16_t* Kh = PN + rowbase * PITCH + 512 + (BR == 1 ? 2 : 4) * 128 + g * 64; const bf16_t* Vh = PN + rowbase * PITCH + 512 + (BR == 1 ? 3 : 5) * 128 + g * 64;
    const unsigned lds0 = (unsigned)(size_t)shm;
    LAS float* wsf = (LAS float*)(shm + LDS_WS) + wid * 64;
    const int NTreal = BR == 1 ? jq + 1 : (jq + 1 < 9 ? jq + 1 : 9);
    int NT = (NTreal + 1) & ~1; if (NT < 4) NT = 4;
#define NSB_TILE(t) (((t) < NTreal) ? (jq - (t)) : 0)
    const bf16_t* ksrc = Kh + wid * 8; const unsigned koff = (unsigned)lane * (PITCH * 2);
    const bf16_t* vsrc = Vh + (long)(16 * (wid & 3)) * PITCH + (wid >> 2) * 32; const unsigned voff = (unsigned)(lane >> 2) * (PITCH * 2) + (lane & 3) * 16;
    const unsigned kdst = lds0 + LDS_K + wid * 1024, vdst = lds0 + LDS_V + wid * 1024;
#define NSB_DMA_K(t, slot) glds16(ksrc + (long)NSB_TILE(t) * 64 * PITCH, koff, (unsigned)__builtin_amdgcn_readfirstlane(kdst + (slot)))
#define NSB_DMA_V(t, slot) glds16(vsrc + (long)NSB_TILE(t) * 64 * PITCH, voff, (unsigned)__builtin_amdgcn_readfirstlane(vdst + (slot)))
    const int vb0 = (int)(lds0 + LDS_V) + ((lane >> 4) & 1) * 32 + (lane & 3) * 8 + (4 * hi + ((lane & 15) >> 2)) * 64;
    const lds_cptr shm3 = (lds_cptr)shm; const lds_cptr Kbase = shm3 + LDS_K; bf16x8 kf[8];
    const lds_cptr kp0 = shm3 + LDS_K + hi * 1024 + r32 * 16; const lds_cptr vp0 = shm3 + LDS_V + ((lane >> 4) & 1) * 32 + (lane & 3) * 8 + (4 * hi + ((lane & 15) >> 2)) * 64;
    NSB_DMA_K(0, 0); NSB_DMA_V(0, 0); NSB_DMA_K(1, SLOTB);
    bf16x8 qr[4];
#pragma unroll
    for (int d0 = 0; d0 < 4; ++d0) qr[d0] = *(const bf16x8*)(Qw + d0 * 16 + hi * 8);
    unsigned selw[4] = {0xFFFFFFFFu, 0xFFFFFFFFu, 0xFFFFFFFFu, 0xFFFFFFFFu};
    if (BR == 1) {
#pragma unroll
        for (int i = 0; i < 4; ++i) selw[i] = selm_tok0[tl * 4 + i]; }
    float mhat = 0.f, l_reg = 0.f; f32x16 o[2]; o[0] = f32x16{}; o[1] = f32x16{}; f32x16 negm = f32x16{}; asm volatile("" : "+v"(negm));
#define NSB_CMASK(P0, P1, t) do { const int t_ = (t); if (t_ == 0) tmask(P0, P1, 1, tl, hi); else if (t_ >= NTreal) tmask(P0, P1, 3, tl, hi); else if (BR == 2 && t_ == 8) tmask(P0, P1, 2, tl, hi); } while (0)
#define NSB_NEGM(t) do { if (BR == 1) { const int j_ = NSB_TILE(t); const unsigned wq_ = (j_ >> 5) == 0 ? selw[0] : ((j_ >> 5) == 1 ? selw[1] : ((j_ >> 5) == 2 ? selw[2] : selw[3])); const float nm_ = ((wq_ >> (j_ & 31)) & 1u) ? -mhat : -__builtin_inff(); \
        _Pragma("unroll") for (int r = 0; r < 16; ++r) negm[r] = nm_; asm volatile("" : "+v"(negm)); } } while (0)
    bool resc = false;
#define NSB_START(P0, P1) do { const float rm = rowmax(P0, P1); resc = false; \
    { const float dl = rm; mhat = fadd_s(mhat, dl); \
      _Pragma("unroll") for (int r = 0; r < 16; ++r) { P0[r] = fsub_s(P0[r], dl); P1[r] = fsub_s(P1[r], dl); } \
      if (BR != 1) { _Pragma("unroll") for (int r = 0; r < 16; ++r) negm[r] = -mhat; asm volatile("" : "+v"(negm)); } } \
    _Pragma("unroll") for (int r = 0; r < 16; ++r) P0[r] = __builtin_amdgcn_exp2f(P0[r]); } while (0)
#define NSB_RESC() do { if (resc) { asm volatile("s_waitcnt lgkmcnt(0)" ::: "memory"); \
      _Pragma("unroll") for (int d_ = 0; d_ < 2; ++d_) _Pragma("unroll") for (int r = 0; r < 16; ++r) o[d_][r] *= wsf[crow(r, hi)]; } } while (0)
    f32x16 pA0, pA1, pB0, pB1;
    int sl_prev = 0, sl_cur = 0, sl_next = SLOTB;
#define NSB_ROT() do { sl_prev = sl_cur; sl_cur = sl_next; sl_next = (sl_next == (NSLOT - 1) * SLOTB) ? 0 : sl_next + SLOTB; } while (0)
    NSB_DMA_K(2, 2 * SLOTB);
    NSB_WAIT_BAR(3);
    qkt(pA0, pA1, Kbase, qr, negm, r32, hi); asm volatile("s_nop 15\n\ts_nop 7" : "+v"(pA0), "+v"(pA1)); NSB_CMASK(pA0, pA1, 0);
    NSB_START(pA0, pA1);
#pragma unroll
    for (int r = 0; r < 16; ++r) pA1[r] = __builtin_amdgcn_exp2f(pA1[r]);
    NSB_WAIT_BAR(0);
    NSB_DMA_K(3, 0); NSB_DMA_V(1, SLOTB);
    NSB_ROT();
    kload8(kf, kp0 + sl_cur);
    NSB_WAIT_BAR(2);
    s16x4 vlo[8], vhi[8]; u32x4 pw0, pw1, pw2, pw3;
#define NSB_PKW(P, B) pack2(P[B], P[B + 1])
#define NSB_PAF(k) __builtin_bit_cast(bf16x8, pw##k)
#define NSB_VFR(i) (bf16x8){vlo[i][0], vlo[i][1], vlo[i][2], vlo[i][3], vhi[i][0], vhi[i][1], vhi[i][2], vhi[i][3]}
#define NSB_PIN(x) asm volatile("" : "+v"(x))
#define NSB_MX3(a, b, c) __builtin_fmaxf(__builtin_fmaxf((a), (b)), (c))
#define NSB_GAPA(MF, A0, A1, A2, A3, W0, W1, PW) do { MF; sacc += A0; sacc += A1; sacc += A2; sacc += A3; NSB_PIN(sacc); W0; W1; NSB_PIN(PW); NSB_SBAR(); } while (0)
#define NSB_EX(v) __builtin_amdgcn_exp2f(v)
#define NSB_GAPB(MF, X, B) do { MF; X[B] = NSB_EX(X[B]); X[B + 1] = NSB_EX(X[B + 1]); X[B + 2] = NSB_EX(X[B + 2]); X[B + 3] = NSB_EX(X[B + 3]); NSB_PIN(X); NSB_SBAR(); } while (0)
#define NSB_VRD(i) do { vlo[i] = vtr(vp_ + (((i) >> 2) * 4096 + ((i) & 3) * 1024)); vhi[i] = vtr(vp_ + (((i) >> 2) * 4096 + ((i) & 3) * 1024 + 512)); } while (0)
#define NSB_KRD(G, j) do { if (G) { kload2(kf, kp0 + sl_next, j); NSB_SBAR(); } } while (0)
#define NSB_STEP(C0, C1, P0, P1, t, GK, GV, GL) do { NSB_SBAR(); \
    const lds_cptr vp_ = vp0 + sl_prev; NSB_NEGM(t); \
    NSB_VRD(0); NSB_SBAR(); float sacc = (P0[0] + P0[1]); \
    NSB_GAPA(C0 = __builtin_amdgcn_mfma_f32_32x32x16_bf16(kf[0], qr[0], negm, 0, 0, 0), P0[2], P0[3], P0[4], P0[5],     pw0[0] = NSB_PKW(P0, 0), pw0[1] = NSB_PKW(P0, 2), pw0); \
    NSB_VRD(4); NSB_SBAR(); NSB_GAPA(C1 = __builtin_amdgcn_mfma_f32_32x32x16_bf16(kf[1], qr[0], negm, 0, 0, 0), P0[6], P0[7], P0[8], P0[9],     pw0[2] = NSB_PKW(P0, 4), pw0[3] = NSB_PKW(P0, 6), pw0); \
    NSB_VRD(1); NSB_SBAR(); NSB_GAPA(C0 = __builtin_amdgcn_mfma_f32_32x32x16_bf16(kf[2], qr[1], C0, 0, 0, 0),   P0[10], P0[11], P0[12], P0[13], pw1[0] = NSB_PKW(P0, 8), pw1[1] = NSB_PKW(P0, 10), pw1); \
    NSB_VRD(5); NSB_SBAR(); NSB_GAPA(C1 = __builtin_amdgcn_mfma_f32_32x32x16_bf16(kf[3], qr[1], C1, 0, 0, 0),   P0[14], P0[15], P1[0], P1[1],   pw1[2] = NSB_PKW(P0, 12), pw1[3] = NSB_PKW(P0, 14), pw1); \
    NSB_VRD(2); NSB_SBAR(); NSB_GAPA(C0 = __builtin_amdgcn_mfma_f32_32x32x16_bf16(kf[4], qr[2], C0, 0, 0, 0),   P1[2], P1[3], P1[4], P1[5],     pw2[0] = NSB_PKW(P1, 0), pw2[1] = NSB_PKW(P1, 2), pw2); \
    NSB_VRD(6); NSB_SBAR(); NSB_GAPA(C1 = __builtin_amdgcn_mfma_f32_32x32x16_bf16(kf[5], qr[2], C1, 0, 0, 0),   P1[6], P1[7], P1[8], P1[9],     pw2[2] = NSB_PKW(P1, 4), pw2[3] = NSB_PKW(P1, 6), pw2); \
    NSB_VRD(3); NSB_SBAR(); NSB_GAPA(C0 = __builtin_amdgcn_mfma_f32_32x32x16_bf16(kf[6], qr[3], C0, 0, 0, 0),   P1[10], P1[11], P1[12], P1[13], pw3[0] = NSB_PKW(P1, 8), pw3[1] = NSB_PKW(P1, 10), pw3); \
    NSB_VRD(7); NSB_SBAR(); NSB_GAPA(C1 = __builtin_amdgcn_mfma_f32_32x32x16_bf16(kf[7], qr[3], C1, 0, 0, 0),   P1[14], P1[15], 0.f, 0.f,       pw3[2] = NSB_PKW(P1, 12), pw3[3] = NSB_PKW(P1, 14), pw3); \
    l_reg += sacc; \
    if (GK) { NSB_DMA_K((t) + 3, sl_cur); } if (GV) { NSB_DMA_V((t) + 1, sl_next); } \
    NSB_CMASK2(C0, C1, t); \
    { float a = NSB_MX3(C0[0], C0[1], C1[0]), b_ = NSB_MX3(C0[2], C0[3], C1[1]); a = NSB_MX3(a, C1[2], C1[3]); \
      _Pragma("unroll") for (int r = 4; r < 16; r += 4) { a = NSB_MX3(a, C0[r], C0[r + 1]); b_ = NSB_MX3(b_, C0[r + 2], C0[r + 3]); a = NSB_MX3(a, C1[r], C1[r + 1]); b_ = NSB_MX3(b_, C1[r + 2], C1[r + 3]); } \
      float rm = __builtin_fmaxf(a, b_); { auto rr = __builtin_amdgcn_permlane32_swap(__float_as_uint(rm), __float_as_uint(rm), false, false); rm = __builtin_fmaxf(__uint_as_float(rr[0]), __uint_as_float(rr[1])); } \
      resc = false; \
      if (__builtin_expect(__any(rm > (float)THRL), 0)) { const float dl = __builtin_fmaxf(rm, 0.f); mhat += dl; \
        _Pragma("unroll") for (int r = 0; r < 16; ++r) { C0[r] -= dl; C1[r] -= dl; } \
        if (BR != 1) { _Pragma("unroll") for (int r = 0; r < 16; ++r) negm[r] = -mhat; asm volatile("" : "+v"(negm)); } \
        const float f = __builtin_amdgcn_exp2f(-dl); l_reg *= f; if (hi == 0) wsf[r32] = f; resc = true; } } \
    NSB_SBAR(); \
    NSB_GAPB(o[0] = __builtin_amdgcn_mfma_f32_32x32x16_bf16(NSB_PAF(0), NSB_VFR(0), o[0], 0, 0, 0), C0, 0); \
    NSB_GAPB(o[1] = __builtin_amdgcn_mfma_f32_32x32x16_bf16(NSB_PAF(0), NSB_VFR(4), o[1], 0, 0, 0), C0, 4); \
    NSB_KRD(GL, 0); NSB_GAPB(o[0] = __builtin_amdgcn_mfma_f32_32x32x16_bf16(NSB_PAF(1), NSB_VFR(1), o[0], 0, 0, 0), C0, 8); \
    NSB_KRD(GL, 1); NSB_GAPB(o[1] = __builtin_amdgcn_mfma_f32_32x32x16_bf16(NSB_PAF(1), NSB_VFR(5), o[1], 0, 0, 0), C0, 12); \
    NSB_KRD(GL, 2); NSB_GAPB(o[0] = __builtin_amdgcn_mfma_f32_32x32x16_bf16(NSB_PAF(2), NSB_VFR(2), o[0], 0, 0, 0), C1, 0); \
    NSB_KRD(GL, 3); NSB_GAPB(o[1] = __builtin_amdgcn_mfma_f32_32x32x16_bf16(NSB_PAF(2), NSB_VFR(6), o[1], 0, 0, 0), C1, 4); \
    NSB_GAPB(o[0] = __builtin_amdgcn_mfma_f32_32x32x16_bf16(NSB_PAF(3), NSB_VFR(3), o[0], 0, 0, 0), C1, 8); \
    NSB_GAPB(o[1] = __builtin_amdgcn_mfma_f32_32x32x16_bf16(NSB_PAF(3), NSB_VFR(7), o[1], 0, 0, 0), C1, 12); \
    } while (0)
    int t = 1;
#define NSB_CMASK2(P0, P1, t) do {} while (0)
    for (; t + 5 < NT; t += 2) {
        NSB_STEP(pB0, pB1, pA0, pA1, t, true, true, true);     NSB_WAIT_BAR(2); NSB_RESC(); NSB_ROT();
        NSB_STEP(pA0, pA1, pB0, pB1, t + 1, true, true, true); NSB_WAIT_BAR(2); NSB_RESC(); NSB_ROT();
    }
#undef NSB_CMASK2
#define NSB_CMASK2(P0, P1, t) NSB_CMASK(P0, P1, t)
#define NSB_ENDW(tt) do { if ((tt) + 3 < NT) { NSB_WAIT_BAR(2); } else if ((tt) + 2 < NT) { NSB_WAIT_BAR(1); } else { NSB_WAIT_BAR(0); } } while (0)
    for (; t + 1 < NT; t += 2) {
        NSB_STEP(pB0, pB1, pA0, pA1, t, (t + 3 < NT), (t + 1 < NT), (t + 1 < NT));         NSB_ENDW(t);     NSB_RESC(); NSB_ROT();
        NSB_STEP(pA0, pA1, pB0, pB1, t + 1, (t + 4 < NT), (t + 2 < NT), (t + 2 < NT));     NSB_ENDW(t + 1); NSB_RESC(); NSB_ROT();
    }
    NSB_STEP(pB0, pB1, pA0, pA1, NT - 1, false, false, false); NSB_RESC();
    { float sacc = pB0[0] + pB0[1];
#pragma unroll
      for (int r = 2; r < 16; ++r) sacc += pB0[r];
#pragma unroll
      for (int r = 0; r < 16; ++r) sacc += pB1[r];
      l_reg += sacc;
      pw0 = (u32x4){NSB_PKW(pB0, 0), NSB_PKW(pB0, 2), NSB_PKW(pB0, 4), NSB_PKW(pB0, 6)}; pw1 = (u32x4){NSB_PKW(pB0, 8), NSB_PKW(pB0, 10), NSB_PKW(pB0, 12), NSB_PKW(pB0, 14)};
      pw2 = (u32x4){NSB_PKW(pB1, 0), NSB_PKW(pB1, 2), NSB_PKW(pB1, 4), NSB_PKW(pB1, 6)}; pw3 = (u32x4){NSB_PKW(pB1, 8), NSB_PKW(pB1, 10), NSB_PKW(pB1, 12), NSB_PKW(pB1, 14)};
      NSB_SBAR(); pv(o, vb0 + sl_cur, NSB_PAF(0), NSB_PAF(1), NSB_PAF(2), NSB_PAF(3)); }
    { auto rr = __builtin_amdgcn_permlane32_swap(__float_as_uint(l_reg), __float_as_uint(l_reg), false, false); l_reg = __uint_as_float(rr[0]) + __uint_as_float(rr[1]); }
    const int lane2 = lane_id(), r32b = lane2 & 31, hib = lane2 >> 5;
    if (hib == 0) { const float gt = sigmoidf_(bf2f(PN[(rowbase + tok0 + 8 * wid + (r32b >> 2)) * PITCH + 1280 + BR * 8 + g * 4 + (r32b & 3)])); wsf[32 + r32b] = l_reg > 0.f ? gt * rcpf_(l_reg) : 0.f; }
    asm volatile("s_waitcnt lgkmcnt(0)" ::: "memory");
    float rli[16];
#pragma unroll
    for (int r = 0; r < 16; ++r) rli[r] = wsf[32 + crow(r, hib)];
    { LAS bf16_t* stg = (LAS bf16_t*)(shm + LDS_OST) + wid * 2048;
#pragma unroll
      for (int r = 0; r < 16; ++r) { const int orow = crow(r, hib);
#pragma unroll
          for (int d0 = 0; d0 < 2; ++d0) stg[orow * 64 + d0 * 32 + r32b] = f2bf(o[d0][r] * rli[r]); }
      asm volatile("s_waitcnt lgkmcnt(0)" ::: "memory");
#pragma unroll
      for (int i = 0; i < 4; ++i) { const int row = i * 8 + (lane2 >> 3), ch = lane2 & 7; const u32x4 v = *(const LAS u32x4*)(stg + row * 64 + ch * 8);
          bf16_t* op = O0 + (rowbase + tok0 + 8 * wid + (row >> 2)) * 1024 + 512 + (g * 4 + (row & 3)) * 64 + ch * 8;
          if (do_store) { float a8[8], b8[8]; unpack8(*(const u32x4*)op, a8); unpack8(v, b8);
#pragma unroll
              for (int e = 0; e < 8; ++e) a8[e] += b8[e];
              *(u32x4*)op = pack8(a8); }
          else asm volatile("" :: "v"(v)); } }
    asm volatile("s_waitcnt vmcnt(0) lgkmcnt(0)\n\ts_barrier" ::: "memory");
#undef NSB_TILE
#undef NSB_DMA_K
#undef NSB_DMA_V
#undef NSB_CMASK
#undef NSB_CMASK2
#undef NSB_NEGM
#undef NSB_START
#undef NSB_RESC
#undef NSB_ROT
#undef NSB_PKW
#undef NSB_PAF
#undef NSB_VFR
#undef NSB_PIN
#undef NSB_MX3
#undef NSB_GAPA
#undef NSB_GAPB
#undef NSB_EX
#undef NSB_VRD
#undef NSB_KRD
#undef NSB_STEP
#undef NSB_ENDW
}
#undef NSB_SBAR
#undef NSB_WAIT_BAR
}

DI void nsa_unit(const Frame& F0, int unit, const int mode = 0x3F) {
    Frame F = F0; F.tid = F.wave * 64 + lane_id(); asm volatile("" : "+v"(F.tid)); F.lane = F.tid & 63;
    const int qt = 63 - (unit >> 4), b = (unit >> 1) & 7, g = unit & 1;
    const int t0 = qt * 128, tw = t0 + 16 * F.wave;
    const size_t tokb = (size_t)b * SEQ;
    const int lane = F.lane, fr = lane & 15, fq = lane >> 4, q = fr >> 2, pp = lane & 3;
    const bf16_t* PN = (const bf16_t*)(F.ws + OFF_PN);
    LAS float* imp = (LAS float*)(F.lds + NS_OFF_IMP); LAS unsigned* selm = (LAS unsigned*)(F.lds + NS_OFF_SEL);
    const int hd = fr & 3, posl = tw + (fr >> 2);
    bf16x8 Qf[4][2];
#pragma unroll
    for (int rt = 0; rt < 4; ++rt)
#pragma unroll
        for (int ks = 0; ks < 2; ++ks) { float v[8]; unpack8(*(const u32x4*)(PN + (tokb + posl + 4 * rt) * 1536 + (g * 4 + hd) * 64 + 32 * ks + 8 * fq), v);
            u32x4 w; w[0] = cvtpk(v[0], v[1]); w[1] = cvtpk(v[2], v[3]); w[2] = cvtpk(v[4], v[5]); w[3] = cvtpk(v[6], v[7]);
            Qf[rt][ks] = __builtin_bit_cast(bf16x8, w); }
    __syncthreads();
    for (int i = F.tid; i < 128 * 128; i += NTH) imp[i] = 0.f;
    FState st;
    bf16_t* O0 = (bf16_t*)(F.ws + OFF_O0);
    if (mode & 1) {
        TileSrc S{(const bf16_t*)(F.ws + SM_KCMP) + ((size_t)b * 512 * 2 + g) * 64, (const bf16_t*)(F.ws + SM_VCMPT) + ((size_t)b * 512 * 2 + g) * 64, 128};
        int nmax = (t0 + 96) >> 4; if (nmax > 510) nmax = 510;
        const int ntl = (nmax >> 6) + 1;
        const int nfull = (tw - 31) >> 4;
        ns_reset(st);
        asm volatile("s_waitcnt vmcnt(0)" ::: "memory"); __syncthreads();
        for (int p_ = 0; p_ < 3 && p_ < ntl; ++p_) ns_dma(F, S, p_, p_);
#pragma unroll 1
        for (int j = 0; j < ntl; ++j) {
            ns_wait(ntl - 1 - j);
            if (j + 3 < ntl) ns_dma(F, S, j + 3, (j + 3) & 3);
            const LAS unsigned char* tb0 = F.lds + (j & 3) * NS_STG;
#pragma unroll 1
            for (int koff = 0; koff < 64; koff += 32) {
                const int nb = j * 64 + koff;
                if (16 * nb + 31 > tw + 15) continue;
                if (nb + 31 <= nfull) ns_step<0, false, true>(tb0 + koff * 128, nb, Qf, st, 0xFu, 0xFu, posl, 0, fr, fq, q, pp);
                else ns_step<1, false, true>(tb0 + koff * 128, nb, Qf, st, 0xFu, 0xFu, posl, 0, fr, fq, q, pp);
            }
        }
        float il[4];
#pragma unroll
        for (int rt = 0; rt < 4; ++rt) { float l = st.l[rt]; l += shx(l, 16); l += shx(l, 32); il[rt] = l > 0.f ? rcpf_(l) : 0.f; }
        __syncthreads();
        float carry[4] = {0.f, 0.f, 0.f, 0.f}; const int bpa = ((lane + 48) & 63) << 2;
        for (int p_ = 0; p_ < 3 && p_ < ntl; ++p_) ns_dma(F, S, p_, p_);
#pragma unroll 1
        for (int j = 0; j < ntl; ++j) {
            ns_wait(ntl - 1 - j);
            if (j + 3 < ntl) ns_dma(F, S, j + 3, (j + 3) & 3);
            const LAS unsigned char* tb0 = F.lds + (j & 3) * NS_STG;
#pragma unroll 1
            for (int koff = 0; koff < 64; koff += 32) {
                const int nb = j * 64 + koff;
                if (16 * nb + 31 > tw + 15) continue;
                const LAS unsigned char* tb = tb0 + koff * 128;
                const int lk = fr * 128 + ((fq ^ (fr & 7)) << 4);
                const int m_ = (4 * fq + q) & 7, vbl = (4 * fq + q) * 128 + ((((pp >> 1) ^ (m_ & 1))) << 4) + (pp & 1) * 8 + ((m_ >> 1) << 5);
                const LAS unsigned char* kp0 = tb + lk; const LAS unsigned char* kp1 = tb + (lk ^ 64); const LAS unsigned char* vp_ = tb + 8192 + vbl;
                asm volatile("" : "+v"(kp0), "+v"(kp1), "+v"(vp_));
                f32x4 s[2][4];
#pragma unroll
                for (int rt = 0; rt < 4; ++rt) { s[0][rt] = (f32x4){0.f, 0.f, 0.f, 0.f}; s[1][rt] = s[0][rt]; }
#pragma unroll
                for (int ks = 0; ks < 2; ++ks)
#pragma unroll
                    for (int kt = 0; kt < 2; ++kt) { const bf16x8 X = *(const LAS bf16x8*)((ks ? kp1 : kp0) + kt * 2048);
#pragma unroll
                        for (int rt = 0; rt < 4; ++rt) s[kt][rt] = MFMA16(X, Qf[rt][ks], s[kt][rt]); }
                bf16x8 Y[4];
#pragma unroll
                for (int rt = 0; rt < 4; ++rt) {
#pragma unroll
                    for (int kt = 0; kt < 2; ++kt) {
#pragma unroll
                        for (int r = 0; r < 4; ++r) { const int n = nb + 16 * kt + 4 * fq + r; s[kt][rt][r] = (n <= ((posl + 4 * rt - 31) >> 4)) ? fexp2(s[kt][rt][r] - st.m[rt]) * il[rt] : 0.f; }
                        float a = s[kt][rt][0] + s[kt][rt][1] + s[kt][rt][2] + 0.5f * s[kt][rt][3], bb = 0.5f * s[kt][rt][3];
                        a += dpp_mov<0xB1>(a); a += dpp_mov<0x4E>(a); bb += dpp_mov<0xB1>(bb); bb += dpp_mov<0x4E>(bb);
                        const float pull = __int_as_float(__builtin_amdgcn_ds_bpermute(bpa, __float_as_int(bb)));
                        const float val = a + (fq > 0 ? pull : carry[rt]); carry[rt] = pull;
                        if (hd == 0) { const int jj = (nb >> 2) + 4 * kt + fq; const int tl = 16 * F.wave + 4 * rt + (fr >> 2);
                            asm volatile("ds_write_b32 %0, %1" :: "v"((unsigned)(size_t)imp + (unsigned)(tl * 128 + jj) * 4u), "v"(val) : "memory"); }
                    }
                    u32x4 w; w[0] = cvtpk(s[0][rt][0], s[0][rt][1]); w[1] = cvtpk(s[0][rt][2], s[0][rt][3]); w[2] = cvtpk(s[1][rt][0], s[1][rt][1]); w[3] = cvtpk(s[1][rt][2], s[1][rt][3]);
                    Y[rt] = __builtin_bit_cast(bf16x8, w);
                }
                bf16x8 Xv[4]; ns_vtr8(vp_, Xv);
#pragma unroll
                for (int dt = 0; dt < 4; ++dt)
#pragma unroll
                    for (int rt = 0; rt < 4; ++rt) st.o[dt][rt] = MFMA16(Xv[dt], Y[rt], st.o[dt][rt]);
            }
        }
        int pl_ = posl; asm volatile("" : "+v"(pl_));
#pragma unroll
        for (int rt = 0; rt < 4; ++rt) { const float gt = sigmoidf_(bf2f(PN[(tokb + pl_ + 4 * rt) * 1536 + 1280 + 0 * 8 + g * 4 + hd]));
#pragma unroll
            for (int dt = 0; dt < 4; ++dt) { const f32x4 v = st.o[dt][rt] * gt; u32x2 o; o[0] = cvtpk(v[0], v[1]); o[1] = cvtpk(v[2], v[3]);
                if (mode & 16) *(u32x2*)(O0 + (tokb + pl_ + 4 * rt) * 1024 + 512 + (g * 4 + hd) * 64 + 16 * dt + 4 * fq) = o; } }
    }
    __syncthreads();
#pragma unroll 1
    for (int tl = 0; tl < ((mode & 2) ? 16 : 0); ++tl) {
        const int pos = tw + tl, cur = pos >> 6; const int tg = 16 * F.wave + tl;
        const int j0 = lane, j1 = lane + 64;
        bool s0, s1;
        if (cur < 16) { s0 = j0 <= cur; s1 = false; }
        else {
            const bool c0 = j0 >= 1 && j0 <= cur - 2, c1 = j1 <= cur - 2;
            const unsigned v0 = c0 ? __float_as_uint(imp[tg * 128 + j0]) : 0u, v1 = c1 ? __float_as_uint(imp[tg * 128 + j1]) : 0u;
            unsigned thr = 0u; bool exact = false;
#pragma unroll 1
            for (int bit = 30; bit >= 0; --bit) {
                const unsigned cand = thr | (1u << bit);
                const int cnt = __popcll(__ballot(c0 && v0 >= cand)) + __popcll(__ballot(c1 && v1 >= cand));
                if (cnt >= 13) { thr = cand; if (cnt == 13) { exact = true; break; } }
            }
            if (exact) { s0 = c0 && v0 >= thr; s1 = c1 && v1 >= thr; }
            else {
                const unsigned long long g0 = __ballot(c0 && v0 > thr), g1 = __ballot(c1 && v1 > thr), e0 = __ballot(c0 && v0 == thr), e1 = __ballot(c1 && v1 == thr);
                const int need = 13 - __popcll(g0) - __popcll(g1);
                const unsigned long long lt = (1ull << lane) - 1ull;
                s0 = c0 && (v0 > thr || (v0 == thr && __popcll(e0 & lt) < need));
                s1 = c1 && (v1 > thr || (v1 == thr && __popcll(e0) + __popcll(e1 & lt) < need));
            }
            s0 = s0 || j0 == 0 || j0 == cur - 1 || j0 == cur; s1 = s1 || j1 == cur - 1 || j1 == cur;
        }
        const unsigned long long m0 = __ballot(s0), m1 = __ballot(s1);
        if (lane == 0) { selm[tg * 4 + 0] = (unsigned)m0; selm[tg * 4 + 1] = (unsigned)(m0 >> 32); selm[tg * 4 + 2] = (unsigned)m1; selm[tg * 4 + 3] = (unsigned)(m1 >> 32); }
    }
    __syncthreads();
    if (mode & 4) {
#pragma unroll 1
        for (int half = 0; half < 2; ++half) {
            nsb::unit<8, 1>(F, b, g, t0 + 64 * half, PN, O0, (LAS char*)F.lds, selm + 64 * half * 4, (mode & 16) != 0);
            if (mode & 8) nsb::unit<8, 2>(F, b, g, t0 + 64 * half, PN, O0, (LAS char*)F.lds, selm, (mode & 16) != 0);
        }
    }
}
DI void nsa_phase(const Frame& F0, int qi = 0, const int mode = 0x3F) {
    Frame F = F0; F.tid = F.wave * 64 + lane_id(); F.lane = F.tid & 63;
    LAS int* uw = (LAS int*)(F.lds + NS_OFF_U);
    unsigned* qh = (unsigned*)(F.ws + CTL_Q) + 64 * qi;
    for (;;) {
        __syncthreads();
        if (F.tid == 0) *uw = (int)__hip_atomic_fetch_add(qh, 1u, __ATOMIC_RELAXED, __HIP_MEMORY_SCOPE_AGENT);
        __syncthreads();
        const int u = *uw;
        if (u >= 1024) break;
        nsa_unit(F, u, mode);
    }
}

__global__ void __launch_bounds__(NTH, 2) fwd_kernel(Args args) {
    extern __shared__ __attribute__((aligned(16))) unsigned char lds_raw[];
    Frame F;
    F.lds = (LAS unsigned char*)lds_raw + LDS_SCR; F.tid = threadIdx.x; F.lane = F.tid & 63; F.wave = __builtin_amdgcn_readfirstlane(F.tid >> 6); F.wg = blockIdx.x;
    F.ws = args.ws; F.out = args.out; F.in = args.in;
    volatile LAS unsigned* misc = (volatile LAS unsigned*)((LAS unsigned char*)lds_raw);
    if (F.tid < 64) misc[F.tid] = 0u;
    __syncthreads();
    XcdBarrier bar = xcd_barrier_post((unsigned*)(F.ws + CTL_BAR), misc);
    LAS int* tile_start = (LAS int*)((LAS unsigned char*)lds_raw + 256);
    const int lo = args.ph_lo, hi = args.ph_hi;
#define IN(k) (lo <= (k) && (k) < hi)
#define SEAM(k) do { if (IN(k) && IN((k) + 1)) xcd_barrier(bar); } while (0)
    const float* ln = F.in[27];

    if (IN(0)) {
        tr_job(F, F.in[1], 3352, 1024, 3352, 3584, (bf16_t*)(F.ws + W_IN0), 1024, 0);
        tr_job(F, F.in[2], 1024, 1024, 1024, 1024, (bf16_t*)(F.ws + W_OUT0), 1024, 0);
        {
          const float* x = F.in[0]; bf16_t* xb = (bf16_t*)(F.ws + OFF_XB);
          for (size_t i0 = (size_t)F.wg * NTH + F.tid; i0 < (size_t)T * D / 8; i0 += (size_t)GRID * NTH * 4) {
              f32x4 a[4], b[4];
#pragma unroll
              for (int k = 0; k < 4; ++k) { const size_t i = i0 + (size_t)k * GRID * NTH; a[k] = *(const f32x4*)(x + i * 8); b[k] = *(const f32x4*)(x + i * 8 + 4); }
#pragma unroll
              for (int k = 0; k < 4; ++k) { const size_t i = i0 + (size_t)k * GRID * NTH; u32x4 o; o[0] = pack2(a[k][0], a[k][1]); o[1] = pack2(a[k][2], a[k][3]); o[2] = pack2(b[k][0], b[k][1]); o[3] = pack2(b[k][2], b[k][3]);
                  *(u32x4*)(xb + i * 8) = o; } } }
        {
          bf16_t* wl1 = (bf16_t*)(F.ws + W_L1); const float* mu = F.in[3];
          for (int i = F.wg * NTH + F.tid; i < 256 * 1024; i += GRID * NTH) { const int n = i >> 10, k = i & 1023, kk = k & 511;
              const int which = n < 64 ? 0 : (n < 128 ? 1 : 2); const int j = n - (which == 0 ? 0 : (which == 1 ? 64 : 128));
              const float* X1 = which == 0 ? F.in[5] : (which == 1 ? F.in[8] : F.in[10]); const int ldx = which == 2 ? 128 : 64;
              const float m = mu[(3 + which) * 512 + kk]; wl1[i] = f2bf((k < 512 ? (1.0f - m) : m) * X1[kk * ldx + j]); }
          bf16_t* wl2 = (bf16_t*)(F.ws + W_L2);
          for (int i = F.wg * NTH + F.tid; i < 1536 * 256; i += GRID * NTH) { const int n = i >> 8, k = i & 255; float v = 0.f;
              if (n < 512) { if (k < 64) v = F.in[6][k * 512 + n]; } else if (n < 1024) { if (k >= 64 && k < 128) v = F.in[9][(k - 64) * 512 + n - 512]; } else { if (k >= 128) v = F.in[11][(k - 128) * 512 + n - 1024]; }
              wl2[i] = f2bf(v); }
          bf16_t* pr = (bf16_t*)(F.ws + OFF_PR);
          for (int i = F.wg * NTH + F.tid; i < 8 * 2048; i += GRID * NTH) pr[(size_t)(i >> 11) * 8193 * 2048 + (i & 2047)] = 0; }
        tr_job(F, F.in[17], 128, 2048, 128, 256, (bf16_t*)(F.ws + W_C1), 2048, 0);
        tr_job(F, F.in[17] + 2048 * 128, 128, 2048, 128, 256, (bf16_t*)(F.ws + W_C1) + 256 * 2048, 2048, 0);
        {
          bf16_t* wc2 = (bf16_t*)(F.ws + W_C2);
          for (int i = F.wg * NTH + F.tid; i < 2 * 256 * 256; i += GRID * NTH) { const int kv = i >> 16, n = (i >> 8) & 255, k = i & 255;
              wc2[i] = f2bf((n < 64 && k < 128) ? F.in[18][(size_t)kv * 128 * 64 + k * 64 + n] : 0.f); }
          float* cb = (float*)(F.ws + SM_CBIAS);
          { const int i = F.wg * 8 + F.wave; if (i < 512) { const int kv = i >> 8, n = i & 255; float acc = 0.f;
              if (n < 128) { for (int k = F.tid & 63; k < 2048; k += 64) acc += F.in[16][kv * 2048 + k] * F.in[17][((size_t)kv * 2048 + k) * 128 + n]; acc = wave_sum(acc); }
              if ((F.tid & 63) == 0) cb[i] = acc; } }
          float* rn = (float*)(F.ws + SM_ROPEN);
          for (int i = F.wg * NTH + F.tid; i < 8192 * 8; i += GRID * NTH) { const int p = i >> 3, k = i & 7;
              const double ang = (double)p * exp(-13.122363377404328 * (double)k / 8.0); rn[2 * i] = (float)cos(ang); rn[2 * i + 1] = (float)sin(ang); } }
        tr_job(F, F.in[19], 6144, 1024, 6144, 6144, (bf16_t*)(F.ws + W_RTIN), 1024, 3, RTI8 ? F8_SW : 0.f);
        tr_job(F, F.in[20], 1024, 2048, 1024, 1024, (bf16_t*)(F.ws + W_RTOUT), 2048, 0, RTO8 ? F8_SWO : 0.f);
        __syncthreads();
    }
    SEAM(0);
#if PROBE == 11
    {
        tr_job(F, F.in[1], 3352, 1024, 3352, 3584, (bf16_t*)(F.ws + W_IN0), 1024, 0);
        tr_job(F, F.in[2], 1024, 1024, 1024, 1024, (bf16_t*)(F.ws + W_OUT0), 1024, 0);
        {
          const float* x = F.in[0]; bf16_t* xb = (bf16_t*)(F.ws + OFF_XB);
          for (size_t i0 = (size_t)F.wg * NTH + F.tid; i0 < (size_t)T * D / 8; i0 += (size_t)GRID * NTH * 4) {
              f32x4 a[4], b[4];
#pragma unroll
              for (int k = 0; k < 4; ++k) { const size_t i = i0 + (size_t)k * GRID * NTH; a[k] = *(const f32x4*)(x + i * 8); b[k] = *(const f32x4*)(x + i * 8 + 4); }
#pragma unroll
              for (int k = 0; k < 4; ++k) { const size_t i = i0 + (size_t)k * GRID * NTH; u32x4 o; o[0] = pack2(a[k][0], a[k][1]); o[1] = pack2(a[k][2], a[k][3]); o[2] = pack2(b[k][0], b[k][1]); o[3] = pack2(b[k][2], b[k][3]);
                  *(u32x4*)(xb + i * 8) = o; } } }
        {
          bf16_t* wl1 = (bf16_t*)(F.ws + W_L1); const float* mu = F.in[3];
          for (int i = F.wg * NTH + F.tid; i < 256 * 1024; i += GRID * NTH) { const int n = i >> 10, k = i & 1023, kk = k & 511;
              const int which = n < 64 ? 0 : (n < 128 ? 1 : 2); const int j = n - (which == 0 ? 0 : (which == 1 ? 64 : 128));
              const float* X1 = which == 0 ? F.in[5] : (which == 1 ? F.in[8] : F.in[10]); const int ldx = which == 2 ? 128 : 64;
              const float m = mu[(3 + which) * 512 + kk]; wl1[i] = f2bf((k < 512 ? (1.0f - m) : m) * X1[kk * ldx + j]); }
          bf16_t* wl2 = (bf16_t*)(F.ws + W_L2);
          for (int i = F.wg * NTH + F.tid; i < 1536 * 256; i += GRID * NTH) { const int n = i >> 8, k = i & 255; float v = 0.f;
              if (n < 512) { if (k < 64) v = F.in[6][k * 512 + n]; } else if (n < 1024) { if (k >= 64 && k < 128) v = F.in[9][(k - 64) * 512 + n - 512]; } else { if (k >= 128) v = F.in[11][(k - 128) * 512 + n - 1024]; }
              wl2[i] = f2bf(v); }
          bf16_t* pr = (bf16_t*)(F.ws + OFF_PR);
          for (int i = F.wg * NTH + F.tid; i < 8 * 2048; i += GRID * NTH) pr[(size_t)(i >> 11) * 8193 * 2048 + (i & 2047)] = 0; }
        tr_job(F, F.in[17], 128, 2048, 128, 256, (bf16_t*)(F.ws + W_C1), 2048, 0);
        tr_job(F, F.in[17] + 2048 * 128, 128, 2048, 128, 256, (bf16_t*)(F.ws + W_C1) + 256 * 2048, 2048, 0);
        {
          bf16_t* wc2 = (bf16_t*)(F.ws + W_C2);
          for (int i = F.wg * NTH + F.tid; i < 2 * 256 * 256; i += GRID * NTH) { const int kv = i >> 16, n = (i >> 8) & 255, k = i & 255;
              wc2[i] = f2bf((n < 64 && k < 128) ? F.in[18][(size_t)kv * 128 * 64 + k * 64 + n] : 0.f); }
          float* cb = (float*)(F.ws + SM_CBIAS);
          { const int i = F.wg * 8 + F.wave; if (i < 512) { const int kv = i >> 8, n = i & 255; float acc = 0.f;
              if (n < 128) { for (int k = F.tid & 63; k < 2048; k += 64) acc += F.in[16][kv * 2048 + k] * F.in[17][((size_t)kv * 2048 + k) * 128 + n]; acc = wave_sum(acc); }
              if ((F.tid & 63) == 0) cb[i] = acc; } }
          float* rn = (float*)(F.ws + SM_ROPEN);
          for (int i = F.wg * NTH + F.tid; i < 8192 * 8; i += GRID * NTH) { const int p = i >> 3, k = i & 7;
              const double ang = (double)p * exp(-13.122363377404328 * (double)k / 8.0); rn[2 * i] = (float)cos(ang); rn[2 * i + 1] = (float)sin(ang); } }
        tr_job(F, F.in[19], 6144, 1024, 6144, 6144, (bf16_t*)(F.ws + W_RTIN), 1024, 3, RTI8 ? F8_SW : 0.f);
        tr_job(F, F.in[20], 1024, 2048, 1024, 1024, (bf16_t*)(F.ws + W_RTOUT), 2048, 0, RTO8 ? F8_SWO : 0.f);
        __syncthreads();
        { float* rr = (float*)(F.ws + SM_ROPER);
          for (int i = F.wg * NTH + F.tid; i < 8192 * 64; i += GRID * NTH) { const int p = i >> 6, k = i & 63;
              const double ang = (double)p * exp(-9.210340371976184 * (double)k / 63.0); rr[2 * i] = (float)cos(ang); rr[2 * i + 1] = (float)sin(ang); } }
    }
    xcd_barrier(bar);
#endif
    if (IN(1)) {
        pg8::GemmK g{1024, 1024, 1024, 128, 1 << 30, 0};
        pg8::DenseSched S; S.init(F.ws + OFF_XB, 1024, F.ws + W_IN0, 1024, T, 3584, GRID, F.wg);
        bf16_t* PR = (bf16_t*)(F.ws + OFF_PR); bf16_t* PN = (bf16_t*)(F.ws + OFF_PN);
        auto f = [PR, PN](const pg8::Unit&, int row, int col, const float (&v)[8]) {
            if (col < 2048) store8(PR + ((size_t)row + (row >> 13) + 1) * 2048 + col, v);
            else if (col < 2560) { float o[8];
#pragma unroll
                for (int i = 0; i < 8; ++i) o[i] = v[i] * NS_C;
                store8(PN + (size_t)row * 1536 + (col - 2048), o); }
            else store8(PN + (size_t)row * 1536 + (col - 2048), v); };
        pg8::EpiRow8<decltype(f)> E{f};
        pg8::gemm_phase(F.lds, F.wave, g, S, E);
    }
    SEAM(1);
#if PROBE == 6
    {
        pg8::GemmK g{1024, 1024, 1024, 128, 1 << 30, 0};
        pg8::DenseSched S; S.init(F.ws + OFF_XB, 1024, F.ws + W_IN0, 1024, T, 3584, GRID, F.wg);
        bf16_t* PR = (bf16_t*)(F.ws + OFF_PR); bf16_t* PN = (bf16_t*)(F.ws + OFF_PN);
        auto f = [PR, PN](const pg8::Unit&, int row, int col, const float (&v)[8]) {
            if (col < 2048) store8(PR + ((size_t)row + (row >> 13) + 1) * 2048 + col, v);
            else if (col < 2560) { float o[8];
#pragma unroll
                for (int i = 0; i < 8; ++i) o[i] = v[i] * NS_C;
                store8(PN + (size_t)row * 1536 + (col - 2048), o); }
            else store8(PN + (size_t)row * 1536 + (col - 2048), v); };
        pg8::EpiRow8<decltype(f)> E{f};
        pg8::gemm_phase(F.lds, F.wave, g, S, E);
        xcd_barrier(bar);
    }
#endif
    if (IN(2)) {
        rwkv_e1_phase(F);
        nsa_rope_phase(F);
        pg8::GemmK g{2048, 1024, 1024, 128, 8, -5120};
        pg8::DenseSched S; S.init(F.ws + OFF_PR + 1536 * 2, 2048, F.ws + W_L1, 1024, T, 256, GRID, F.wg, 1);
        bf16_t* HID = (bf16_t*)(F.ws + OFF_O0) + 512;
        auto f = [HID](const pg8::Unit&, int row, int col, const float (&v)[8]) {
            float o[8];
#pragma unroll
            for (int i = 0; i < 8; ++i) o[i] = col < 64 ? tanhf_(v[i]) : (col < 128 ? v[i] : sigmoidf_(v[i]));
            store8(HID + (size_t)row * 1024 + col, o); };
        pg8::EpiRow8<decltype(f)> E{f};
        pg8::gemm_phase(F.lds, F.wave, g, S, E);
    }
    SEAM(2);
    if (IN(3) && F.wg >= 64) {
        pg8::GemmK g{1024, 256, 256, 128, 1 << 30, 0};
        pg8::DenseSched S; S.init(F.ws + OFF_O0 + 512 * 2, 1024, F.ws + W_L2, 256, T, 1536, GRID - 64, F.wg - 64);
        bf16_t* SW = st_w(F); bf16_t* SKK = st_kk(F); bf16_t* SB = st_b(F); bf16_t* SKP = st_kp(F); bf16_t* O0 = (bf16_t*)(F.ws + OFF_O0);
        const float* w0 = F.in[4]; const float* a0 = F.in[7]; const float* kkw = F.in[12]; const float* kaw = F.in[13]; const float* rn = (const float*)(F.ws + SM_RNORM);
        auto f = [=](const pg8::Unit&, int row, int col, const float (&v)[8]) {
            float o[8];
            if (col < 512) {
#pragma unroll
                for (int i = 0; i < 8; ++i) o[i] = __builtin_amdgcn_exp2f(-0.606531f * 1.44269504088896341f * sigmoidf_(w0[col + i] + v[i]));
                store8(SW + (size_t)row * 512 + col, o);
            } else if (col < 1024) {
                const int c = col - 512; float k[8], kk[8], bb[8];
                unpack8(*(const u32x4*)(SKP + (size_t)row * 512 + c), k);
                const float r = rn[(size_t)row * 8 + (c >> 6)];
#pragma unroll
                for (int i = 0; i < 8; ++i) { const float a = sigmoidf_(a0[c + i] + v[i]); kk[i] = k[i] * kkw[c + i] * r; bb[i] = kk[i] * a; o[i] = k[i] * (1.0f + (a - 1.0f) * kaw[c + i]); }
                store8(SKK + (size_t)row * 512 + c, kk); store8(SB + (size_t)row * 512 + c, bb); store8(SKP + (size_t)row * 512 + c, o);
            } else {
                store8(O0 + (size_t)row * 1024 + (col - 1024), v);
            } };
        pg8::EpiRow8<decltype(f)> E{f};
        pg8::gemm_phase(F.lds, F.wave, g, S, E);
    }
    if (IN(3)) {
        pg8::GemmK g{16 * 1536, 2048, 2048, 1536 * 2, 1 << 30, 0};
        pg8::CmpSched S{(const char*)(F.ws + OFF_PN + 512 * 2), (const char*)(F.ws + W_C1), (size_t)128, (size_t)256 * 16 * 1536 * 2, (size_t)256 * 2048 * 2, GRID, F.wg};
        bf16_t* HC = (bf16_t*)(F.ws + OFF_HC); const float* cb = (const float*)(F.ws + SM_CBIAS);
        auto f = [HC, cb](const pg8::Unit& u, int row, int col, const float (&v)[8]) {
            float o[8];
#pragma unroll
            for (int i = 0; i < 8; ++i) { const float x = v[i] + cb[(u.aux >> 1) * 256 + col + i]; o[i] = 0.5f * x * (1.0f + tanhf(0.7978845608028654f * (x + 0.044715f * x * x * x))); }
            store8(HC + ((size_t)u.aux * 4096 + row) * 256 + col, o); };
        pg8::EpiRow8<decltype(f)> E{f};
        pg8::gemm_phase(F.lds, F.wave, g, S, E);
        __threadfence(); __syncthreads();
    }
    if (IN(3)) {
        pg8::GemmK g{256, 256, 256, 128, 1 << 30, 0};
        pg8::CmpSched S{(const char*)(F.ws + OFF_HC), (const char*)(F.ws + W_C2), (size_t)4096 * 256 * 2, (size_t)256 * 256 * 2, (size_t)256 * 256 * 2, GRID, F.wg};
        bf16_t* KC = (bf16_t*)(F.ws + SM_KCMP); bf16_t* VC = (bf16_t*)(F.ws + SM_VCMPT);
        auto f = [KC, VC](const pg8::Unit& u, int row, int col, const float (&v)[8]) {
            if (col < 64) store8((u.aux < 2 ? KC : VC) + ((size_t)row * 2 + (u.aux & 1)) * 64 + col, v); };
        pg8::EpiRow8<decltype(f)> E{f};
        pg8::gemm_phase(F.lds, F.wave, g, S, E);
    }
    SEAM(3);
    if (IN(5)) { if (F.wg < SC_WGS) rwkv_scan(F); else nsa_phase(F); }
    SEAM(5);
#if PROBE == 1
    if (F.wg < SC_WGS) rwkv_scan(F, false);
    xcd_barrier(bar);
#elif PROBE == 2
    nsa_phase(F, 1);
    xcd_barrier(bar);
#elif PROBE >= 20 && PROBE < 30
    nsa_phase(F, 1, PROBE == 20 ? 0x01 : PROBE == 21 ? 0x03 : PROBE == 22 ? 0x07 : PROBE == 23 ? 0x27 : PROBE == 24 ? 0x2B : PROBE == 25 ? 0x0B : 0x2F);
    xcd_barrier(bar);
#endif
    if (IN(7)) {
        pg8::GemmK g{1024, 1024, 1024, 128, 1 << 30, 0};
        pg8::DenseSched S; S.init(F.ws + OFF_O0, 1024, F.ws + W_OUT0, 1024, T, 1024, GRID, F.wg);
        bf16_t* MX = (bf16_t*)(F.ws + OFF_MIX);
        auto f = [MX](const pg8::Unit&, int row, int col, const float (&v)[8]) { store8(MX + (size_t)row * 1024 + col, v); };
        pg8::EpiRow8<decltype(f)> E{f};
        pg8::gemm_phase(F.lds, F.wave, g, S, E);
    }
    SEAM(7);
    if (IN(10)) { ln1_router_phase(F, nullptr  , (const bf16_t*)(F.ws + OFF_MIX), (bf16_t*)(F.ws + OFF_XB), ln + 0 * 1024, ln + 1 * 1024, 0, MOE8_L0 ? F.ws + OFF_XB8 : nullptr); moe_weights(F, 0, MOE8_L0); }
    SEAM(10);
#if PROBE == 5
    ln1_router_phase(F, F.in[0], (const bf16_t*)(F.ws + OFF_MIX), (bf16_t*)(F.ws + OFF_XB), ln + 0 * 1024, ln + 1 * 1024, 0); moe_weights(F, 0);
    xcd_barrier(bar);
#endif
    if (IN(11)) moe_scatter_phase(F, nullptr, 0);
    SEAM(11);
#if PROBE == 7
    moe_scatter_phase(F, nullptr, 0);
    xcd_barrier(bar);
#endif
    if (IN(12)) {
        { const int kt_ = F.wave * 64 + lane_id(); if (kt_ < 17) tile_start[kt_] = ((const int*)(F.ws + CTL_TILES))[kt_]; }
        __syncthreads();
        if (MOE8_L0) {
            pg8::GemmK g{512, 512, 512, 128, 1 << 30, 0};
            pg8::MoeSched S{(const char*)(F.ws + OFF_XB8), (const char*)(F.ws + OFF_WMOE), (size_t)0, (size_t)256 * 1024, tile_start, 8, GRID, F.wg, (const int*)(F.ws + SM_ROWTOK)};
            pg8::EpiGU8 E{F.ws + OFF_H};
            pg8::gemm_phase<pg8::EpiGU8, pg8::MoeSched, true, true>(F.lds, F.wave, g, S, E);
        } else {
        pg8::GemmK g{1024, 1024, 1024, 128, 1 << 30, 0};
        pg8::MoeSched S{(const char*)(F.ws + OFF_XB), (const char*)(F.ws + OFF_WMOE), (size_t)0, (size_t)256 * 1024 * 2, tile_start, 8, GRID, F.wg, (const int*)(F.ws + SM_ROWTOK)};
        pg8::EpiGU E{(bf16_t*)(F.ws + OFF_H)};
        pg8::gemm_phase<pg8::EpiGU, pg8::MoeSched, true>(F.lds, F.wave, g, S, E);
        }
    }
    SEAM(12);
    if (IN(13)) {
        { const int kt_ = F.wave * 64 + lane_id(); if (kt_ < 17) tile_start[kt_] = ((const int*)(F.ws + CTL_TILES))[kt_]; }
        __syncthreads();
        bf16_t* Y = (bf16_t*)(F.ws + OFF_XS);
        if (MOE8_L0) {
            pg8::GemmK g{512, 512, 512, 128, 1 << 30, 0};
            pg8::MoeSched S{(const char*)(F.ws + OFF_H), (const char*)(F.ws + OFF_WMOE + (size_t)16 * 2048 * 1024), (size_t)256 * 1024, (size_t)256 * 1024, tile_start, 4, GRID, F.wg};
            auto f = [Y](const pg8::Unit&, int row, int col, const float (&v)[8]) { float o[8];
#pragma unroll
                for (int i = 0; i < 8; ++i) o[i] = v[i] * (1.0f / (F8_SH * F8_SD));
                store8(Y + (size_t)row * 1024 + col, o); };
            pg8::EpiRow8<decltype(f)> E{f};
            pg8::gemm_phase<decltype(E), pg8::MoeSched, false, true>(F.lds, F.wave, g, S, E);
        } else {
        pg8::GemmK g{1024, 1024, 1024, 128, 1 << 30, 0};
        pg8::MoeSched S{(const char*)(F.ws + OFF_H), (const char*)(F.ws + OFF_WMOE + (size_t)16 * 2048 * 1024 * 2), (size_t)256 * 1024 * 2, (size_t)256 * 1024 * 2, tile_start, 4, GRID, F.wg};
        auto f = [Y](const pg8::Unit&, int row, int col, const float (&v)[8]) { store8(Y + (size_t)row * 1024 + col, v); };
        pg8::EpiRow8<decltype(f)> E{f};
        pg8::gemm_phase(F.lds, F.wave, g, S, E);
        }
    }
    SEAM(13);
#if PROBE == 4
    {
        { const int kt_ = F.wave * 64 + lane_id(); if (kt_ < 17) tile_start[kt_] = ((const int*)(F.ws + CTL_TILES))[kt_]; }
        __syncthreads();
        pg8::GemmK g{1024, 1024, 1024, 128, 1 << 30, 0};
        pg8::MoeSched S{(const char*)(F.ws + OFF_XB), (const char*)(F.ws + OFF_WMOE), (size_t)0, (size_t)256 * 1024 * 2, tile_start, 8, GRID, F.wg, (const int*)(F.ws + SM_ROWTOK)};
        pg8::EpiGU E{(bf16_t*)(F.ws + OFF_H)};
        pg8::gemm_phase<pg8::EpiGU, pg8::MoeSched, true>(F.lds, F.wave, g, S, E);
        xcd_barrier(bar);
    }
#endif
    if (IN(14)) { ln2_phase(F, nullptr, ln + 2 * 1024, ln + 3 * 1024, (bf16_t*)(F.ws + OFF_XB), true, RTI8 ? F.ws + OFF_XB8B : nullptr); }
    SEAM(14);
#pragma unroll 1
    for (int k_ = 0; k_ < (PROBE == 12 ? 10 : 5); ++k_) { const int k = k_ % 5;
        if (IN(20)) {
#define PGB(j) ((bf16_t*)(F.ws + OFF_PG + (size_t)((j) & 1) * PG_BYTES))
#define KVB(j) ((bf16_t*)(F.ws + OFF_KV + (size_t)((j) & 1) * KV_BYTES))
            if (k >= 1) ret_r2_phase(F, KVB(k - 1));
            if (k <= 3) {
                pg8::GemmK g{RTI8 ? 512 : 1024, RTI8 ? 512 : 1024, RTI8 ? 512 : 1024, 128, 1 << 30, 0};
                pg8::DenseSched S; if (RTI8) S.init(F.ws + OFF_XB8B + (size_t)k * 16384 * 1024, 512, F.ws + W_RTIN, 512, 16384, 6144, GRID, F.wg); else S.init(F.ws + OFF_XB + (size_t)k * 16384 * 1024 * 2, 1024, F.ws + W_RTIN, 1024, 16384, 6144, GRID, F.wg);
                bf16_t* P = PGB(k);
                auto f = [P](const pg8::Unit&, int row, int col, const float (&v_)[8]) {
                    float v[8];
#pragma unroll
                    for (int i = 0; i < 8; ++i) v[i] = RTI8 ? v_[i] * (1.0f / (F8_SX * F8_SW)) : v_[i];
                    if (col < 2048) {
                        float o[8]; const float posf = (float)(row & 8191); const int m0 = (col & 127) >> 1;
#pragma unroll
                        for (int i = 0; i < 4; ++i) { const float rev = __builtin_amdgcn_fractf(posf * (__builtin_amdgcn_exp2f((float)(m0 + i) * (-13.287712379549449f / 63.0f)) * 0.15915494309189535f));
                            const float co = __builtin_amdgcn_cosf(rev), si = __builtin_amdgcn_sinf(rev); o[2 * i] = v[2 * i] * co - v[2 * i + 1] * si; o[2 * i + 1] = v[2 * i + 1] * co + v[2 * i] * si; }
                        store8(P + (size_t)row * PGLD + col, o);
                    } else if (PGV8) { u32x2 w8; w8[0] = pk_fp8x4(v[0] * F8_SX, v[1] * F8_SX, v[2] * F8_SX, v[3] * F8_SX); w8[1] = pk_fp8x4(v[4] * F8_SX, v[5] * F8_SX, v[6] * F8_SX, v[7] * F8_SX);
                        *(u32x2*)((unsigned char*)P + (size_t)row * 8192 + 4096 + (col - 2048)) = w8; }
                    else store8(P + (size_t)row * 6144 + col, v); };
                pg8::EpiRow8<decltype(f)> E{f};
                pg8::gemm_phase<decltype(E), pg8::DenseSched, false, RTI8>(F.lds, F.wave, g, S, E);
            }
            xcd_barrier(bar);
            if (k >= 1) ret_r3_phase(F, PGB(k - 1), KVB(k - 1), (bf16_t*)(F.ws + OFF_O1), k - 1, F.in[21]);
            if (k <= 3) { for (int u = F.wg; u < 1024; u += GRID) ret_r1_unit(F, PGB(k), KVB(k), u); }
            xcd_barrier(bar);
#undef PGB
#undef KVB
        }
    }
    if (IN(20)) {
        bf16_t* MX = (bf16_t*)(F.ws + OFF_MIX1);
        if (RTO8) {
            pg8::GemmK g{1024, 1024, 1024, 128, 1 << 30, 0};
            pg8::DenseSched S; S.init(F.ws + OFF_O1, 1024, F.ws + W_RTOUT, 1024, T, 1024, GRID, F.wg);
            auto f = [MX](const pg8::Unit&, int row, int col, const float (&v)[8]) { float o[8];
#pragma unroll
                for (int i = 0; i < 8; ++i) o[i] = v[i] * (1.0f / (F8_SO * F8_SWO));
                store8(MX + (size_t)row * 1024 + col, o); };
            pg8::EpiRow8<decltype(f)> E{f};
            pg8::gemm_phase<decltype(E), pg8::DenseSched, false, true>(F.lds, F.wave, g, S, E);
        } else {
        pg8::GemmK g{2048, 2048, 2048, 128, 1 << 30, 0};
        pg8::DenseSched S; S.init(F.ws + OFF_O1, 2048, F.ws + W_RTOUT, 2048, T, 1024, GRID, F.wg);
        auto f = [MX](const pg8::Unit&, int row, int col, const float (&v)[8]) { store8(MX + (size_t)row * 1024 + col, v); };
        pg8::EpiRow8<decltype(f)> E{f};
        pg8::gemm_phase(F.lds, F.wave, g, S, E);
        }
        xcd_barrier(bar);
    }
    if (IN(30)) { ln1_router_phase(F, nullptr, (const bf16_t*)(F.ws + OFF_MIX1), (bf16_t*)(F.ws + OFF_XB), ln + 4 * 1024, ln + 5 * 1024, 1, MOE8_L1 ? F.ws + OFF_XB8 : nullptr); moe_weights(F, 1, MOE8_L1); }
    SEAM(30);
    if (IN(31)) moe_scatter_phase(F, nullptr, 1);
    SEAM(31);
    if (IN(32)) {
        { const int kt_ = F.wave * 64 + lane_id(); if (kt_ < 17) tile_start[kt_] = ((const int*)(F.ws + CTL_TILES))[32 + kt_]; }
        __syncthreads();
        if (MOE8_L1) {
            pg8::GemmK g{512, 512, 512, 128, 1 << 30, 0};
            pg8::MoeSched S{(const char*)(F.ws + OFF_XB8), (const char*)(F.ws + OFF_WMOE), (size_t)0, (size_t)256 * 1024, tile_start, 8, GRID, F.wg, (const int*)(F.ws + SM_ROWTOK)};
            pg8::EpiGU8 E{F.ws + OFF_H};
            pg8::gemm_phase<pg8::EpiGU8, pg8::MoeSched, true, true>(F.lds, F.wave, g, S, E);
        } else {
        pg8::GemmK g{1024, 1024, 1024, 128, 1 << 30, 0};
        pg8::MoeSched S{(const char*)(F.ws + OFF_XB), (const char*)(F.ws + OFF_WMOE), (size_t)0, (size_t)256 * 1024 * 2, tile_start, 8, GRID, F.wg, (const int*)(F.ws + SM_ROWTOK)};
        pg8::EpiGU E{(bf16_t*)(F.ws + OFF_H)};
        pg8::gemm_phase<pg8::EpiGU, pg8::MoeSched, true>(F.lds, F.wave, g, S, E);
        }
    }
    SEAM(32);
    if (IN(33)) {
        { const int kt_ = F.wave * 64 + lane_id(); if (kt_ < 17) tile_start[kt_] = ((const int*)(F.ws + CTL_TILES))[32 + kt_]; }
        __syncthreads();
        bf16_t* Y = (bf16_t*)(F.ws + OFF_XS);
        if (MOE8_L1) {
            pg8::GemmK g{512, 512, 512, 128, 1 << 30, 0};
            pg8::MoeSched S{(const char*)(F.ws + OFF_H), (const char*)(F.ws + OFF_WMOE + (size_t)16 * 2048 * 1024), (size_t)256 * 1024, (size_t)256 * 1024, tile_start, 4, GRID, F.wg};
            auto f = [Y](const pg8::Unit&, int row, int col, const float (&v)[8]) { float o[8];
#pragma unroll
                for (int i = 0; i < 8; ++i) o[i] = v[i] * (1.0f / (F8_SH * F8_SD));
                store8(Y + (size_t)row * 1024 + col, o); };
            pg8::EpiRow8<decltype(f)> E{f};
            pg8::gemm_phase<decltype(E), pg8::MoeSched, false, true>(F.lds, F.wave, g, S, E);
        } else {
        pg8::GemmK g{1024, 1024, 1024, 128, 1 << 30, 0};
        pg8::MoeSched S{(const char*)(F.ws + OFF_H), (const char*)(F.ws + OFF_WMOE + (size_t)16 * 2048 * 1024 * 2), (size_t)256 * 1024 * 2, (size_t)256 * 1024 * 2, tile_start, 4, GRID, F.wg};
        auto f = [Y](const pg8::Unit&, int row, int col, const float (&v)[8]) { store8(Y + (size_t)row * 1024 + col, v); };
        pg8::EpiRow8<decltype(f)> E{f};
        pg8::gemm_phase(F.lds, F.wave, g, S, E);
        }
    }
    SEAM(33);
    if (IN(34)) ln2_phase(F, F.out, ln + 6 * 1024, ln + 7 * 1024, (bf16_t*)(F.ws + OFF_XB), true);
#undef IN
#undef SEAM
}

extern "C" void kernel_launch(void* const* d_in, const int* in_sizes, int n_in, void* d_out, int out_size, void* d_ws, size_t ws_size, hipStream_t stream) {
    static int ready = 0;
    if (ready == 0) {
        if (n_in != 28 || out_size != T * D || ws_size < WS_END) { fprintf(stderr, "kernel_launch: unexpected shapes / workspace (%d inputs, out %d, ws %zu)\n", n_in, out_size, ws_size); ready = -1; return; }
        if (hipFuncSetAttribute((const void*)fwd_kernel, hipFuncAttributeMaxDynamicSharedMemorySize, LDS_BYTES) != hipSuccess) { fprintf(stderr, "kernel_launch: hipFuncSetAttribute failed\n"); ready = -1; return; }
        int per_cu = 0;
        if (hipOccupancyMaxActiveBlocksPerMultiprocessor(&per_cu, (const void*)fwd_kernel, NTH, LDS_BYTES) != hipSuccess || per_cu < 1) { fprintf(stderr, "kernel_launch: occupancy query says %d\n", per_cu); }
        (void)hipGetLastError();
        ready = 1;
    }
    if (ready < 0) return;
    (void)hipMemsetAsync((char*)d_ws + OFF_CTL, 0, CTL_BYTES, stream);
    Args a{};
    for (int i = 0; i < 28; ++i) a.in[i] = (const float*)d_in[i];
    a.out = (float*)d_out; a.ws = (unsigned char*)d_ws; a.ph_lo = 0; a.ph_hi = 1000;
    hipLaunchKernelGGL(fwd_kernel, dim3(GRID), dim3(NTH), LDS_BYTES, stream, a);
}
```

```cpp
#include <hip/hip_runtime.h>
#include <stdint.h>
#include <stdio.h>

#ifndef PROBE
#define PROBE 0
#endif
#define DI __device__ __forceinline__
#define LAS __attribute__((address_space(3)))
typedef unsigned short bf16_t;
typedef short bf16x8 __attribute__((ext_vector_type(8)));
typedef float f32x4 __attribute__((ext_vector_type(4)));
typedef unsigned u32x4 __attribute__((ext_vector_type(4)));
typedef unsigned u32x2 __attribute__((ext_vector_type(2)));
typedef int i32x4 __attribute__((ext_vector_type(4)));
typedef float f32x2 __attribute__((ext_vector_type(2)));

constexpr int T = 65536, D = 1024, SEQ = 8192, NB = 8;
constexpr int NTH = 512, GRID = 256;
constexpr float ALPHA = 1.41421356237309515f;
constexpr float LN_EPS = 1e-5f;
constexpr size_t MiB = (size_t)1 << 20;

constexpr size_t OFF_CTL = 0;
constexpr size_t CTL_BYTES = 256 * 1024;
constexpr size_t CTL_BAR = 0;
constexpr size_t CTL_Q = 16 * 1024;
constexpr size_t CTL_BLKCNT = 32 * 1024;
constexpr size_t CTL_TILES = 96 * 1024;
constexpr size_t OFF_SMALL = 1 * MiB;
constexpr size_t SM_ROPEN = OFF_SMALL + 0;
constexpr size_t SM_ROPER = OFF_SMALL + 1 * MiB;
constexpr size_t SM_CBIAS = OFF_SMALL + 5 * MiB;
constexpr size_t SM_TOKE = OFF_SMALL + 6 * MiB;
constexpr size_t SM_TOKW = OFF_SMALL + 7 * MiB;
constexpr size_t SM_TOKP = OFF_SMALL + 8 * MiB;
constexpr size_t SM_RNORM = OFF_SMALL + 9 * MiB;
constexpr size_t SM_KCMP = OFF_SMALL + 11 * MiB;
constexpr size_t SM_VCMPT = OFF_SMALL + 12 * MiB;
constexpr size_t SM_ROWTOK = OFF_SMALL + 13 * MiB;
constexpr size_t OFF_WSM = 16 * MiB;
constexpr size_t W_IN0 = OFF_WSM;
constexpr size_t W_OUT0 = OFF_WSM + 7 * MiB;
constexpr size_t W_RTIN = OFF_WSM + 9 * MiB;
constexpr size_t W_RTOUT = OFF_WSM + 21 * MiB;
constexpr size_t W_L1 = OFF_WSM + 25 * MiB;
constexpr size_t W_L2 = OFF_WSM + 25 * MiB + 512 * 1024;
constexpr size_t W_C1 = OFF_WSM + 27 * MiB;
constexpr size_t W_C2 = OFF_WSM + 29 * MiB;
constexpr size_t OFF_XB = 48 * MiB;
constexpr size_t OFF_BIG = 176 * MiB;
constexpr size_t OFF_MIX = OFF_BIG;
constexpr size_t OFF_H = OFF_BIG;
constexpr size_t OFF_WMOE = 448 * MiB;
constexpr size_t OFF_XS = 544 * MiB;
constexpr size_t OFF_PR = OFF_BIG;
constexpr size_t OFF_ORAW = OFF_BIG;
constexpr size_t OFF_PN = 433 * MiB;
constexpr size_t OFF_O0 = 625 * MiB;
constexpr size_t OFF_HC = 753 * MiB;
constexpr size_t OFF_PG = OFF_BIG;
constexpr size_t PG_BYTES = 192 * MiB;
constexpr size_t OFF_O1 = 560 * MiB;
constexpr size_t OFF_KV = 816 * MiB;
constexpr size_t KV_BYTES = 64 * MiB;
constexpr size_t OFF_MIX1 = OFF_BIG;
constexpr size_t OFF_XB8 = 816 * MiB;
constexpr size_t OFF_STR = 768 * MiB;
constexpr size_t OFF_XB8B = 944 * MiB;
constexpr size_t WS_END = 1008 * MiB;
constexpr bool MOE8_L0 = true, MOE8_L1 = true;
constexpr bool PGV8 = true;
constexpr int PGLD = PGV8 ? 4096 : 6144;
constexpr bool RTI8 = true;
constexpr bool RTO8 = true;
constexpr float F8_SO = 8.f, F8_SWO = 512.f;
constexpr float F8_SX = 16.f, F8_SW = 256.f, F8_SH = 8.f, F8_SD = 512.f;
constexpr int MOE_ROWS_MAX = 135168;

DI float bf2f(bf16_t b) { return __uint_as_float(((unsigned)b) << 16); }
DI bf16_t f2bf(float f) { unsigned u = __float_as_uint(f); u += 0x7FFFu + ((u >> 16) & 1u); return (bf16_t)(u >> 16); }
typedef __bf16 bf16v2_t __attribute__((ext_vector_type(2)));
DI unsigned pack2(float lo, float hi) { const bf16v2_t r = __builtin_convertvector((f32x2){lo, hi}, bf16v2_t); return __builtin_bit_cast(unsigned, r); }
DI int lane_id() { int l; asm volatile("v_mbcnt_lo_u32_b32 %0, -1, 0\n\tv_mbcnt_hi_u32_b32 %0, -1, %0" : "=v"(l)); return l; }
DI float shx(float v, int m) { const int l = lane_id(); return __int_as_float(__builtin_amdgcn_ds_bpermute((l ^ m) << 2, __float_as_int(v))); }
DI float f8sat(float x) { return __builtin_amdgcn_fmed3f(x, -448.f, 448.f); }
DI unsigned pk_fp8x4(float a, float b, float c, float d) {
    int p = __builtin_amdgcn_cvt_pk_fp8_f32(f8sat(a), f8sat(b), 0, false); p = __builtin_amdgcn_cvt_pk_fp8_f32(f8sat(c), f8sat(d), p, true); return (unsigned)p; }
DI float wave_sum(float v) {
#pragma unroll
    for (int o = 32; o; o >>= 1) v += shx(v, o);
    return v;
}
DI int lds_add(LAS int* p, int v) { return __hip_atomic_fetch_add(p, v, __ATOMIC_RELAXED, __HIP_MEMORY_SCOPE_WORKGROUP); }
DI float rcpf_(float x) { return __builtin_amdgcn_rcpf(x); }
DI float sigmoidf_(float x) { return rcpf_(1.0f + __builtin_amdgcn_exp2f(-1.44269504088896341f * x)); }
DI float siluf_(float x) { return x * sigmoidf_(x); }
DI float tanhf_(float x) { return 1.0f - 2.0f * rcpf_(1.0f + __builtin_amdgcn_exp2f(2.88539008177792681f * x)); }

#define XB_TMO      128
#define XB_XCNT(j)  (256  + 64 * (j))
#define XB_XSUB(j)  (1280 + 64 * (j))
#define XB_XGEN(j)  (2304 + 64 * (j))
#define XB_TOP      3328
#define XB_TOPGEN   3392
#define XCD_BAR_WORDS 3456
#define XB_SPIN_CAP (1u << 24)

DI unsigned xb_ld(unsigned* p)              { return __hip_atomic_load(p, __ATOMIC_RELAXED, __HIP_MEMORY_SCOPE_AGENT); }
DI unsigned xb_add(unsigned* p, unsigned v) { return __hip_atomic_fetch_add(p, v, __ATOMIC_RELAXED, __HIP_MEMORY_SCOPE_AGENT); }
DI unsigned xb_xcc_id() { return (unsigned)__builtin_amdgcn_s_getreg((3 << 11) | 20) & 0xFu; }
#define XB_SPIN(cond, bar) do { unsigned _sp = 0; while (cond) { __builtin_amdgcn_s_sleep(1); \
    if ((++_sp & 255u) == 0u) { if (xb_ld(&(bar)[XB_TMO])) break; if (_sp > XB_SPIN_CAP) { atomicAdd(&(bar)[XB_TMO], 1u); break; } } } } while (0)

struct XcdBarrier { unsigned* bar; unsigned x; volatile LAS unsigned* st; };

DI XcdBarrier xcd_barrier_post(unsigned* bar, volatile LAS unsigned* st) {
    XcdBarrier b; b.bar = bar; b.x = xb_xcc_id(); b.st = st;
    if (threadIdx.x == 0) (void)xb_add(&bar[XB_XCNT(b.x)], 1u);
    return b;
}
DI void xcd_barrier_complete(unsigned* bar, unsigned x, unsigned& nloc, unsigned& nx) {
    const unsigned G = gridDim.x * gridDim.y * gridDim.z;
    unsigned sum, cnt, mine, sp = 0u;
    for (;;) {
        sum = 0u; cnt = 0u; mine = 0u;
#pragma unroll
        for (unsigned j = 0; j < 16; ++j) { const unsigned c = xb_ld(&bar[XB_XCNT(j)]); sum += c; cnt += (c > 0u) ? 1u : 0u; mine = (j == x) ? c : mine; }
        if (sum == G) break;
        __builtin_amdgcn_s_sleep(1);
        if ((++sp & 255u) == 0u) { if (xb_ld(&bar[XB_TMO])) break; if (sp > XB_SPIN_CAP) { atomicAdd(&bar[XB_TMO], 1u); break; } }
    }
    nloc = mine > 0u ? mine : 1u; nx = cnt > 0u ? cnt : 1u;
}
DI void xcd_barrier(const XcdBarrier& b) {
    asm volatile("s_waitcnt vmcnt(0)" ::: "memory");
    __syncthreads();
    if (threadIdx.x == 0) {
        unsigned* bar = b.bar;
        __builtin_amdgcn_s_waitcnt(0);
        unsigned nloc = b.st[0], nx = b.st[1];
        if (nloc == 0u) { xcd_barrier_complete(bar, b.x, nloc, nx); b.st[0] = nloc; b.st[1] = nx; }
        const unsigned old = xb_add(&bar[XB_XSUB(b.x)], 1u);
        const unsigned gen = old / nloc;
        if (old + 1u == (gen + 1u) * nloc) {
            __builtin_amdgcn_fence(__ATOMIC_RELEASE, "agent");
            asm volatile("s_waitcnt vmcnt(0)" ::: "memory");
            const unsigned og = xb_add(&bar[XB_TOP], 1u);
            const unsigned tg = og / nx;
            if (og + 1u == (tg + 1u) * nx) xb_add(&bar[XB_TOPGEN], 1u);
            else XB_SPIN(xb_ld(&bar[XB_TOPGEN]) == tg, bar);
            __builtin_amdgcn_fence(__ATOMIC_ACQUIRE, "agent");
            xb_add(&bar[XB_XGEN(b.x)], 1u);
            asm volatile("s_waitcnt vmcnt(0)" ::: "memory");
        } else {
            XB_SPIN(xb_ld(&bar[XB_XGEN(b.x)]) == gen, bar);
            __builtin_amdgcn_fence(__ATOMIC_ACQUIRE, "agent");
            asm volatile("s_waitcnt vmcnt(0)" ::: "memory");
        }
    }
    __syncthreads();
}

namespace pg8 {
constexpr int BM = 256, BK = 64, HALF = 128, HTB = HALF * BK * 2, STAGE_BYTES = 8 * HTB, NXCD = 8, WGM = 8;
DI int lds_byte(int r, int c) { const int st = (r >> 4) * 2 + (c >> 5), rr = r & 15, cc = c & 31, ob = rr * 64 + cc * 2; return st * 1024 + (ob ^ (((ob >> 9) & 1) << 5)); }
DI void stage_rc(int b, int& R, int& C) { const int st = b / 1024, sb = b % 1024, swz = sb ^ (((sb >> 9) & 1) << 5); R = (st >> 1) * 16 + swz / 64; C = (st & 1) * 32 + (swz % 64) / 2; }
DI int perm32(int rho) { const int n = rho >> 4, i = rho & 15; return 8 * (i >> 2) + 4 * n + (i & 3); }

struct Unit { const char* a; const char* b; int pm, pn, aux; const int* rows; };
struct GemmK { int lda, ldb, K, kstepA, ksplit, kjump; };

template <class Epi, class Sched, bool GATHER = false, bool F8 = false>
DI void gemm_phase(LAS unsigned char* lds, int wave_, const GemmK g, const Sched& S, const Epi& E) {
    int tid = wave_ * 64 + lane_id(); asm volatile("" : "+v"(tid));
    const int wid = __builtin_amdgcn_readfirstlane(tid >> 6), lane = tid & 63, wr = wid >> 2, wc = wid & 3, fr = lane & 15, fq = lane >> 4;
    const int nt = g.K / BK;
    unsigned voffA[2], voffB[2], cA2[2]; int rA[2]; unsigned vgc[2][2], vgn[2][2];
#pragma unroll
    for (int i = 0; i < 2; ++i) { int R, C; stage_rc(tid * 16 + i * 8192, R, C); const int Rb = Epi::PERM ? ((R & ~31) + perm32(R & 31)) : R;
        voffA[i] = (unsigned)(R * g.lda + C) * 2u; voffB[i] = (unsigned)(Rb * g.ldb + C) * 2u; rA[i] = R; cA2[i] = (unsigned)C * 2u; }
    const size_t kstepA = (size_t)g.kstepA, kstepB = (size_t)(BK * 2);
    const size_t hstepA = (size_t)HALF * g.lda * 2, hstepB = (size_t)HALF * g.ldb * 2;
    const unsigned ldsw = (unsigned)wid * 1024u;
    const int aoff = lds_byte(wr * 64 + fr, fq * 8), boff = lds_byte(wc * 32 + fr, fq * 8);
#define PG8_AK(base, kt) ((base) + (size_t)(kt) * kstepA + (((kt) >= g.ksplit) ? (long)g.kjump : 0l))
#define PG8_SA(b, h) (((b) * 2 + (h)) * HTB)
#define PG8_SB(b, h) ((4 + (b) * 2 + (h)) * HTB)
#define PG8_STAGE(bufoff, gbase, voff) do { _Pragma("unroll") for (int _i = 0; _i < 2; ++_i) \
        __builtin_amdgcn_global_load_lds((const unsigned*)((const char*)(gbase) + (voff)[_i]), (LAS unsigned*)(lds + (bufoff) + ldsw + _i * 8192), 16, 0, 0); } while (0)
#define PG8_STAGE_A(bufoff, kbase, h, nx) do { if (GATHER) { _Pragma("unroll") for (int _i = 0; _i < 2; ++_i) { const unsigned _vo = (nx) ? vgn[h][_i] : vgc[h][_i]; \
        __builtin_amdgcn_global_load_lds((const unsigned*)((const char*)(kbase) + _vo), (LAS unsigned*)(lds + (bufoff) + ldsw + _i * 8192), 16, 0, 0); } } \
        else PG8_STAGE(bufoff, (kbase) + (h) * hstepA, voffA); } while (0)
#define PG8_ROWS(dst, u) do { if (GATHER) { _Pragma("unroll") for (int _h = 0; _h < 2; ++_h) _Pragma("unroll") for (int _i = 0; _i < 2; ++_i) dst[_h][_i] = (unsigned)(u).rows[128 * _h + rA[_i]] * (unsigned)(g.lda * 2) + cA2[_i]; } } while (0)
#define PG8_LDA(dst, b, h) do { _Pragma("unroll") for (int m = 0; m < 4; ++m) _Pragma("unroll") for (int k = 0; k < 2; ++k) dst[m][k] = *(const LAS bf16x8*)(lds + PG8_SA(b, h) + aoff + m * 2048 + k * 1024); } while (0)
#define PG8_LDB(dst, b, h) do { _Pragma("unroll") for (int n = 0; n < 2; ++n) _Pragma("unroll") for (int k = 0; k < 2; ++k) dst[n][k] = *(const LAS bf16x8*)(lds + PG8_SB(b, h) + boff + n * 2048 + k * 1024); } while (0)
#define PG8_CAT(x, y) __builtin_shufflevector(__builtin_bit_cast(i32x4, x), __builtin_bit_cast(i32x4, y), 0, 1, 2, 3, 4, 5, 6, 7)
#define PG8_MMA(ai, bj, At, Bt) do { __builtin_amdgcn_s_setprio(1); \
        if (F8) { _Pragma("unroll") for (int m = 0; m < 4; ++m) _Pragma("unroll") for (int n = 0; n < 2; ++n) \
            asm volatile("v_mfma_f32_16x16x128_f8f6f4 %0, %1, %2, %0" : "+v"(acc[ai][bj][m][n]) : "v"(PG8_CAT(Bt[n][0], Bt[n][1])), "v"(PG8_CAT(At[m][0], At[m][1]))); }     \
        else { _Pragma("unroll") for (int m = 0; m < 4; ++m) _Pragma("unroll") for (int n = 0; n < 2; ++n) _Pragma("unroll") for (int k = 0; k < 2; ++k) \
            acc[ai][bj][m][n] = __builtin_amdgcn_mfma_f32_16x16x32_bf16(Bt[n][k], At[m][k], acc[ai][bj][m][n], 0, 0, 0); } \
        __builtin_amdgcn_s_setprio(0); } while (0)
#define PG8_WAIT_V(n) asm volatile("s_waitcnt vmcnt(" #n ")" ::: "memory")
#define PG8_WAIT_L(n) asm volatile("s_waitcnt lgkmcnt(" #n ")" ::: "memory")
#define PG8_BAR __builtin_amdgcn_s_barrier()
#define PG8_SCHED __builtin_amdgcn_sched_barrier(0)
    Unit cur, nxt; int ui = 0;
    if (!S.next(0, cur)) return;
    f32x4 acc[2][2][4][2];
#pragma unroll
    for (int a = 0; a < 2; ++a)
#pragma unroll
        for (int b = 0; b < 2; ++b)
#pragma unroll
            for (int m = 0; m < 4; ++m)
#pragma unroll
                for (int n = 0; n < 2; ++n) acc[a][b][m][n] = (f32x4){0.f, 0.f, 0.f, 0.f};
    bf16x8 At[4][2], B0[2][2], B1[2][2];
    const char* cA = cur.a; const char* cB = cur.b;
    PG8_ROWS(vgc, cur);
    PG8_STAGE(PG8_SB(0, 0), cB, voffB); PG8_STAGE_A(PG8_SA(0, 0), cA, 0, false); PG8_STAGE(PG8_SB(0, 1), cB + hstepB, voffB); PG8_STAGE_A(PG8_SA(0, 1), cA, 1, false);
    if (wr == 1) PG8_BAR;
    PG8_WAIT_V(4); PG8_BAR;
    PG8_STAGE(PG8_SB(1, 0), cB + kstepB, voffB); PG8_STAGE_A(PG8_SA(1, 0), PG8_AK(cA, 1), 0, false); PG8_STAGE(PG8_SB(1, 1), cB + hstepB + kstepB, voffB);
    PG8_WAIT_V(6); PG8_BAR;
    for (;;) {
        const bool has_next = S.next(ui + 1, nxt);
        const char* nA = has_next ? nxt.a : cA; const char* nB = has_next ? nxt.b : cB;
        if (GATHER) { if (has_next) PG8_ROWS(vgn, nxt); else { _Pragma("unroll") for (int _h = 0; _h < 2; ++_h) _Pragma("unroll") for (int _i = 0; _i < 2; ++_i) vgn[_h][_i] = vgc[_h][_i]; } }
#pragma unroll 1
        for (int t = 0; t < nt; t += 2) {
            const bool last = (t == nt - 2);
            const char* a1 = PG8_AK(cA, t + 1);
            const char* a2 = last ? nA : PG8_AK(cA, t + 2); const char* b2 = last ? nB : cB + (size_t)(t + 2) * kstepB;
            const char* a3 = last ? PG8_AK(nA, 1) : PG8_AK(cA, t + 3); const char* b3 = b2 + kstepB;
            PG8_LDB(B0, 0, 0); PG8_SCHED; PG8_LDA(At, 0, 0); PG8_STAGE_A(PG8_SA(1, 1), a1, 1, false);
            PG8_WAIT_L(8); PG8_BAR; PG8_WAIT_L(0); PG8_MMA(0, 0, At, B0); PG8_BAR; PG8_SCHED;
            PG8_LDB(B1, 0, 1); PG8_STAGE(PG8_SB(0, 0), b2, voffB);
            PG8_BAR; PG8_WAIT_L(0); PG8_MMA(0, 1, At, B1); PG8_BAR;
            PG8_LDA(At, 0, 1); PG8_STAGE_A(PG8_SA(0, 0), a2, 0, last);
            PG8_BAR; PG8_WAIT_L(0); PG8_MMA(1, 0, At, B0); PG8_BAR; PG8_SCHED;
            PG8_STAGE(PG8_SB(0, 1), b2 + hstepB, voffB);
            PG8_WAIT_V(6); PG8_BAR; PG8_MMA(1, 1, At, B1); PG8_BAR;
            PG8_LDB(B0, 1, 0); PG8_SCHED; PG8_LDA(At, 1, 0); PG8_STAGE_A(PG8_SA(0, 1), a2, 1, last);
            PG8_WAIT_L(8); PG8_BAR; PG8_WAIT_L(0); PG8_MMA(0, 0, At, B0); PG8_BAR; PG8_SCHED;
            PG8_LDB(B1, 1, 1); PG8_STAGE(PG8_SB(1, 0), b3, voffB);
            PG8_BAR; PG8_WAIT_L(0); PG8_MMA(0, 1, At, B1); PG8_BAR;
            PG8_LDA(At, 1, 1); PG8_STAGE_A(PG8_SA(1, 0), a3, 0, last);
            PG8_BAR; PG8_WAIT_L(0); PG8_MMA(1, 0, At, B0); PG8_BAR; PG8_SCHED;
            PG8_STAGE(PG8_SB(1, 1), b3 + hstepB, voffB);
            PG8_WAIT_V(6); PG8_BAR; PG8_MMA(1, 1, At, B1); PG8_BAR;
        }
        if (F8) {
#pragma unroll
            for (int a = 0; a < 2; ++a)
#pragma unroll
                for (int b = 0; b < 2; ++b) {
                    if (a == 0 && b == 0) asm volatile("s_nop 15\n\ts_nop 15" : "+v"(acc[a][b][0][0]), "+v"(acc[a][b][0][1]), "+v"(acc[a][b][1][0]), "+v"(acc[a][b][1][1]), "+v"(acc[a][b][2][0]), "+v"(acc[a][b][2][1]), "+v"(acc[a][b][3][0]), "+v"(acc[a][b][3][1]));
                    else asm volatile("" : "+v"(acc[a][b][0][0]), "+v"(acc[a][b][0][1]), "+v"(acc[a][b][1][0]), "+v"(acc[a][b][1][1]), "+v"(acc[a][b][2][0]), "+v"(acc[a][b][2][1]), "+v"(acc[a][b][3][0]), "+v"(acc[a][b][3][1])); } }
        E(acc, cur, wr, wc, fr, fq);
        if (!has_next) break;
#pragma unroll
        for (int a = 0; a < 2; ++a)
#pragma unroll
            for (int b = 0; b < 2; ++b)
#pragma unroll
                for (int m = 0; m < 4; ++m)
#pragma unroll
                    for (int n = 0; n < 2; ++n) acc[a][b][m][n] = (f32x4){0.f, 0.f, 0.f, 0.f};
        cur = nxt; cA = nA; cB = nB; ++ui;
        if (GATHER) { _Pragma("unroll") for (int _h = 0; _h < 2; ++_h) _Pragma("unroll") for (int _i = 0; _i < 2; ++_i) vgc[_h][_i] = vgn[_h][_i]; }
    }
    PG8_WAIT_V(0);
    if (wr == 0) PG8_BAR;
    PG8_BAR;
#undef PG8_AK
#undef PG8_SA
#undef PG8_SB
#undef PG8_STAGE
#undef PG8_STAGE_A
#undef PG8_ROWS
#undef PG8_LDA
#undef PG8_LDB
#undef PG8_MMA
#undef PG8_CAT
#undef PG8_WAIT_V
#undef PG8_WAIT_L
#undef PG8_BAR
#undef PG8_SCHED
}

struct DenseSched {
    const char* A; const char* B; size_t tstepA, tstepB; int nM, nN, nwg, G, c; int prp;
    DI void init(const void* A_, int lda, const void* B_, int ldb, int M, int N, int G_, int c_, int prp_ = 0) {
        A = (const char*)A_; B = (const char*)B_; tstepA = (size_t)BM * lda * 2; tstepB = (size_t)BM * ldb * 2; nM = M / BM; nN = N / BM; nwg = nM * nN; G = G_; c = c_; prp = prp_; }
    DI bool next(int i, Unit& u) const {
        const long L = (long)i * G + c; if (L >= nwg) return false;
        int wgid = (int)L; { const int q = nwg / NXCD, r = nwg % NXCD, xcd = wgid % NXCD, off = wgid / NXCD; wgid = (xcd < r ? xcd * (q + 1) : r * (q + 1) + (xcd - r) * q) + off; }
        const int nig = WGM * nN, gid = wgid / nig, fm = gid * WGM, gsz = (nM - fm) < WGM ? (nM - fm) : WGM;
        u.pm = fm + ((wgid % nig) % gsz); u.pn = (wgid % nig) / gsz; u.aux = 0;
        u.a = A + (size_t)u.pm * tstepA + (prp ? (size_t)((u.pm >> 5) + 1) * (tstepA / BM) : (size_t)0);
        u.b = B + (size_t)u.pn * tstepB; u.rows = nullptr;
        return true;
    }
};
struct MoeSched {
    const char* A; const char* B; size_t tstepA, tstepB; const LAS int* ts; int nN, G, c; const int* rowtab;
    DI bool next(int i, Unit& u) const {
        const long L0 = (long)i * G + c; const int nwg = ts[16] * nN; if (L0 >= nwg) return false;
        int L = (int)L0; { const int q = nwg / NXCD, r = nwg % NXCD, xcd = L % NXCD, off = L / NXCD; L = (xcd < r ? xcd * (q + 1) : r * (q + 1) + (xcd - r) * q) + off; }
        const int rt = L / nN, pn = L % nN;
        int e = 0;
#pragma unroll
        for (int j = 1; j < 16; ++j) e += (rt >= ts[j]) ? 1 : 0;
        u.pm = rt; u.pn = pn; u.aux = e;
        u.a = rowtab ? A : A + (size_t)rt * tstepA; u.b = B + (size_t)(e * nN + pn) * tstepB; u.rows = rowtab ? rowtab + rt * 256 : nullptr;
        return true;
    }
};

template <class F> struct EpiRow8 {
    static constexpr bool PERM = true;
    F f;
    DI void operator()(const f32x4 (&acc)[2][2][4][2], const Unit& u, int wr, int wc, int fr, int fq) const {
#pragma unroll
        for (int ai = 0; ai < 2; ++ai)
#pragma unroll
            for (int m = 0; m < 4; ++m) {
                const int row = u.pm * BM + ai * HALF + wr * 64 + m * 16 + fr;
#pragma unroll
                for (int bj = 0; bj < 2; ++bj) {
                    const int col = u.pn * BM + bj * HALF + wc * 32 + 8 * fq;
                    float v[8];
#pragma unroll
                    for (int j = 0; j < 4; ++j) { v[j] = acc[ai][bj][m][0][j]; v[4 + j] = acc[ai][bj][m][1][j]; }
                    f(u, row, col, v);
                }
            }
    }
};
struct EpiF32 {
    static constexpr bool PERM = false;
    float* C; int ldc;
    DI void operator()(const f32x4 (&acc)[2][2][4][2], const Unit& u, int wr, int wc, int fr, int fq) const {
        const int row0 = u.pm * BM + wr * 64 + fr, col0 = u.pn * BM + wc * 32 + 4 * fq;
#pragma unroll
        for (int ai = 0; ai < 2; ++ai)
#pragma unroll
            for (int m = 0; m < 4; ++m) { float* rowp = C + (size_t)(row0 + ai * HALF + m * 16) * ldc + col0;
#pragma unroll
                for (int bj = 0; bj < 2; ++bj)
#pragma unroll
                    for (int n = 0; n < 2; ++n) *(f32x4*)(rowp + bj * HALF + n * 16) = acc[ai][bj][m][n]; }
    }
};
struct EpiGU {
    static constexpr bool PERM = true;
    bf16_t* H;
    DI void operator()(const f32x4 (&acc)[2][2][4][2], const Unit& u, int wr, int wc, int fr, int fq) const {
#pragma unroll
        for (int ai = 0; ai < 2; ++ai)
#pragma unroll
            for (int m = 0; m < 4; ++m) {
                const int row = u.pm * BM + ai * HALF + wr * 64 + m * 16 + fr;
                const int col = u.pn * HALF + wc * 32 + 8 * fq;
                float h[8];
#pragma unroll
                for (int j = 0; j < 4; ++j) {
                    const float g0 = acc[ai][0][m][0][j], u0 = acc[ai][1][m][0][j], g1 = acc[ai][0][m][1][j], u1 = acc[ai][1][m][1][j];
                    h[j] = siluf_(g0) * u0; h[4 + j] = siluf_(g1) * u1;
                }
                u32x4 o; o[0] = pack2(h[0], h[1]); o[1] = pack2(h[2], h[3]); o[2] = pack2(h[4], h[5]); o[3] = pack2(h[6], h[7]);
                *(u32x4*)(H + (size_t)row * 1024 + col) = o;
            }
    }
};
struct EpiGU8 {
    static constexpr bool PERM = true;
    unsigned char* H;
    DI void operator()(const f32x4 (&acc)[2][2][4][2], const Unit& u, int wr, int wc, int fr, int fq) const {
        constexpr float SI = 1.0f / (F8_SX * F8_SW);
#pragma unroll
        for (int ai = 0; ai < 2; ++ai)
#pragma unroll
            for (int m = 0; m < 4; ++m) {
                const int row = u.pm * BM + ai * HALF + wr * 64 + m * 16 + fr;
                const int col = u.pn * HALF + wc * 32 + 8 * fq;
                float h[8];
#pragma unroll
                for (int j = 0; j < 4; ++j) {
                    const float g0 = acc[ai][0][m][0][j] * SI, u0 = acc[ai][1][m][0][j] * (SI * F8_SH), g1 = acc[ai][0][m][1][j] * SI, u1 = acc[ai][1][m][1][j] * (SI * F8_SH);
                    h[j] = siluf_(g0) * u0; h[4 + j] = siluf_(g1) * u1;
                }
                u32x2 o; o[0] = pk_fp8x4(h[0], h[1], h[2], h[3]); o[1] = pk_fp8x4(h[4], h[5], h[6], h[7]);
                *(u32x2*)(H + (size_t)row * 1024 + col) = o;
            }
    }
};
}

DI void unpack8(const u32x4 a, float (&o)[8]) {
#pragma unroll
    for (int i = 0; i < 4; ++i) { o[2 * i] = __uint_as_float(a[i] << 16); o[2 * i + 1] = __uint_as_float(a[i] & 0xffff0000u); }
}
DI u32x4 pack8(const float (&v)[8]) { u32x4 o; o[0] = pack2(v[0], v[1]); o[1] = pack2(v[2], v[3]); o[2] = pack2(v[4], v[5]); o[3] = pack2(v[6], v[7]); return o; }
DI void store8(bf16_t* p, const float (&v)[8]) {
    u32x4 o; o[0] = pack2(v[0], v[1]); o[1] = pack2(v[2], v[3]); o[2] = pack2(v[4], v[5]); o[3] = pack2(v[6], v[7]);
    *(u32x4*)p = o;
}

struct Args { const float* in[28]; float* out; unsigned char* ws; int ph_lo, ph_hi; };
struct Frame {
    LAS unsigned char* lds; int tid, lane, wave, wg;
    unsigned char* ws; float* out; const float* const* in;
};

constexpr int LDS_SCR = 1024;
constexpr int LDS_BYTES = 1024 + 155 * 1024;

struct TrTile { const float* src; int ldsrc, N; bf16_t* dst; int ldd, rowmode, k0, n0; float f8; };
DI void tr_load(const Frame& F, const TrTile& d, f32x4 (&v)[2]) {
#pragma unroll
    for (int i = 0; i < 2; ++i) { const int kk = (F.tid >> 4) + 32 * i, n4 = (F.tid & 15) * 4;
        v[i] = (d.n0 + n4 < d.N) ? *(const f32x4*)(d.src + (size_t)(d.k0 + kk) * d.ldsrc + d.n0 + n4) : (f32x4){0.f, 0.f, 0.f, 0.f}; }
}
template <class Desc> DI void tr_run(const Frame& F, int ntiles, Desc desc) {
    LAS float* tile = (LAS float*)F.lds;
    const int nq = ntiles >> 2;
    int id = F.wg; if (id >= nq) return;
    TrTile d[4]; f32x4 v[4][2];
#pragma unroll
    for (int s4 = 0; s4 < 4; ++s4) { d[s4] = desc(4 * id + s4); tr_load(F, d[s4], v[s4]); }
    for (;;) {
        __syncthreads();
#pragma unroll
        for (int s4 = 0; s4 < 4; ++s4)
#pragma unroll
            for (int i = 0; i < 2; ++i) { const int kk = (F.tid >> 4) + 32 * i, n4 = (F.tid & 15) * 4;
#pragma unroll
                for (int e = 0; e < 4; ++e) tile[s4 * (64 * 65) + kk * 65 + n4 + e] = v[s4][i][e]; }
        __syncthreads();
        TrTile cur[4];
#pragma unroll
        for (int s4 = 0; s4 < 4; ++s4) cur[s4] = d[s4];
        const int nid = id + GRID; const bool more = nid < nq;
        if (more) {
#pragma unroll
            for (int s4 = 0; s4 < 4; ++s4) { d[s4] = desc(4 * nid + s4); tr_load(F, d[s4], v[s4]); } }
#pragma unroll
        for (int s4 = 0; s4 < 4; ++s4) { const TrTile& c = cur[s4]; const int nn = F.tid >> 3, kc = (F.tid & 7) * 8; const int n = c.n0 + nn;
          const int r = c.rowmode == 0 ? n : (c.rowmode == 3 ? (n < 2048 ? ((n & ~127) + 2 * (n & 63) + ((n >> 6) & 1)) : n) : ((n >> 7) * 256 + (n & 127) + (c.rowmode == 2 ? 128 : 0)));
          float o[8];
#pragma unroll
          for (int e = 0; e < 8; ++e) o[e] = tile[s4 * (64 * 65) + (kc + e) * 65 + nn];
          if (c.f8 != 0.f) { u32x2 w; w[0] = pk_fp8x4(o[0] * c.f8, o[1] * c.f8, o[2] * c.f8, o[3] * c.f8); w[1] = pk_fp8x4(o[4] * c.f8, o[5] * c.f8, o[6] * c.f8, o[7] * c.f8);
              *(u32x2*)((unsigned char*)c.dst + (size_t)r * c.ldd + c.k0 + kc) = w; }
          else store8(c.dst + (size_t)r * c.ldd + c.k0 + kc, o); }
        if (!more) break;
        id = nid;
    }
    __syncthreads();
}
DI void tr_job(const Frame& F, const float* src, int ldsrc, int K, int N, int Npad, bf16_t* dst, int ldd, int rowmode, float f8 = 0.f) {
    const int tn = Npad / 64, n = (K / 64) * tn;
    tr_run(F, n, [=](int i) { return TrTile{src, ldsrc, N, dst, ldd, rowmode, (i / tn) * 64, (i % tn) * 64, f8}; });
}
DI void moe_weights(const Frame& F0, int layer, const bool f8 = false) {
    Frame F = F0; F.tid = F.wave * 64 + lane_id(); asm volatile("" : "+v"(F.tid)); F.lane = F.tid & 63;
    const size_t esz = f8 ? 1 : 2;
    unsigned char* wgu = F.ws + OFF_WMOE; unsigned char* wd = wgu + (size_t)16 * 2048 * 1024 * esz;
    const size_t lo_ = (size_t)layer * 16 * 1024 * 1024;
    const float* g = F.in[24] + lo_; const float* u = F.in[25] + lo_; const float* dn = F.in[26] + lo_;
    const float sgu = f8 ? F8_SW : 0.f, sdn = f8 ? F8_SD : 0.f;
    tr_run(F, 16 * 256, [=](int id) { const int e = id >> 8, tl = id & 255; return TrTile{g + (size_t)e * 1024 * 1024, 1024, 1024, (bf16_t*)(wgu + (size_t)e * 2048 * 1024 * esz), 1024, 1, (tl >> 4) * 64, (tl & 15) * 64, sgu}; });
    tr_run(F, 16 * 256, [=](int id) { const int e = id >> 8, tl = id & 255; return TrTile{u + (size_t)e * 1024 * 1024, 1024, 1024, (bf16_t*)(wgu + (size_t)e * 2048 * 1024 * esz), 1024, 2, (tl >> 4) * 64, (tl & 15) * 64, sgu}; });
    tr_run(F, 16 * 256, [=](int id) { const int e = id >> 8, tl = id & 255; return TrTile{dn + (size_t)e * 1024 * 1024, 1024, 1024, (bf16_t*)(wd + (size_t)e * 1024 * 1024 * esz), 1024, 0, (tl >> 4) * 64, (tl & 15) * 64, sdn}; });
}

DI void ln1_router_phase(const Frame& F0, const float* xin  , const bf16_t* mix, bf16_t* xb, const float* lng, const float* lnb, int layer, unsigned char* xb8 = nullptr  ) {
    Frame F = F0; F.tid = F.wave * 64 + lane_id(); asm volatile("" : "+v"(F.tid)); F.lane = F.tid & 63;
    LAS float* tile = (LAS float*)F.lds;
    LAS float* part = (LAS float*)(F.lds + 16 * 1028 * 4);
    LAS float* lgt = part + 8 * 256;
    LAS float* scr = lgt + 256;
    LAS int* hist = (LAS int*)(scr + 256);
    const float* rw = F.in[22]; const float* rb = F.in[23];
    const int lane = F.lane, w = F.wave, fr = lane & 15, fq = lane >> 4;
    if (F.tid < 16) hist[F.tid] = 0;
    float bfrag[32];
#pragma unroll
    for (int s = 0; s < 32; ++s) bfrag[s] = rw[(size_t)(128 * w + 4 * s + fq) * 16 + fr];
    f32x4 gv[4], bv[4];
#pragma unroll
    for (int j = 0; j < 4; ++j) { gv[j] = *(const f32x4*)(lng + j * 256 + lane * 4); bv[j] = *(const f32x4*)(lnb + j * 256 + lane * 4); }
    int* tok_e = (int*)(F.ws + SM_TOKE); float* tok_w = (float*)(F.ws + SM_TOKW);
    const int t0 = F.wg * 256;
    f32x4 xv[2][4]; u32x2 mv[2][4];
    auto issue_rows = [&](int grp) {
#pragma unroll
        for (int rr = 0; rr < 2; ++rr) { const size_t t = (size_t)t0 + grp * 16 + 2 * w + rr;
#pragma unroll
            for (int j = 0; j < 4; ++j) {
                if (xin) xv[rr][j] = *(const f32x4*)(xin + t * D + j * 256 + lane * 4);
                else { const u32x2 xr = *(const u32x2*)(xb + t * D + j * 256 + lane * 4); xv[rr][j] = (f32x4){__uint_as_float(xr[0] << 16), __uint_as_float(xr[0] & 0xffff0000u), __uint_as_float(xr[1] << 16), __uint_as_float(xr[1] & 0xffff0000u)}; }
                if (mix) mv[rr][j] = *(const u32x2*)(mix + t * D + j * 256 + lane * 4); } }
    };
    issue_rows(0);
    for (int grp = 0; grp < 16; ++grp) {
        __syncthreads();
#pragma unroll
        for (int rr = 0; rr < 2; ++rr) {
            const int i = 2 * w + rr; const size_t t = (size_t)t0 + grp * 16 + i;
            f32x4 y[4]; float s = 0.f;
#pragma unroll
            for (int j = 0; j < 4; ++j) { y[j] = xv[rr][j] * ALPHA;
                if (mix) { const u32x2 m2 = mv[rr][j]; y[j] += (f32x4){__uint_as_float(m2[0] << 16), __uint_as_float(m2[0] & 0xffff0000u), __uint_as_float(m2[1] << 16), __uint_as_float(m2[1] & 0xffff0000u)}; }
                s += y[j][0] + y[j][1] + y[j][2] + y[j][3]; }
            const float mean = wave_sum(s) * (1.0f / D); float q = 0.f;
#pragma unroll
            for (int j = 0; j < 4; ++j) { y[j] -= mean; q += y[j][0] * y[j][0] + y[j][1] * y[j][1] + y[j][2] * y[j][2] + y[j][3] * y[j][3]; }
            const float rstd = rsqrtf(wave_sum(q) * (1.0f / D) + LN_EPS);
#pragma unroll
            for (int j = 0; j < 4; ++j) { f32x4 o = y[j] * rstd * gv[j] + bv[j];
                { u32x2 ob; ob[0] = pack2(o[0], o[1]); ob[1] = pack2(o[2], o[3]); *(u32x2*)(xb + t * D + j * 256 + lane * 4) = ob; }
                if (xb8) *(unsigned*)(xb8 + t * D + j * 256 + lane * 4) = pk_fp8x4(o[0] * F8_SX, o[1] * F8_SX, o[2] * F8_SX, o[3] * F8_SX);
                *(LAS f32x4*)(tile + i * 1028 + j * 256 + lane * 4) = o; }
        }
        if (grp + 1 < 16) issue_rows(grp + 1);
        __syncthreads();
        f32x4 acc = (f32x4){0.f, 0.f, 0.f, 0.f};
#pragma unroll
        for (int s = 0; s < 32; ++s) { const float a = tile[fr * 1028 + 128 * w + 4 * s + fq]; acc = __builtin_amdgcn_mfma_f32_16x16x4f32(a, bfrag[s], acc, 0, 0, 0); }
#pragma unroll
        for (int r = 0; r < 4; ++r) part[w * 256 + (4 * fq + r) * 16 + fr] = acc[r];
        __syncthreads();
        if (F.tid < 256) { float s = 0.f;
#pragma unroll
            for (int ww = 0; ww < 8; ++ww) s += part[ww * 256 + F.tid];
            const float aff = sigmoidf_(s); lgt[F.tid] = aff; scr[F.tid] = aff + rb[F.tid & 15]; }
        __syncthreads();
        if (F.tid < 16) {
            const int i = F.tid; const LAS float* sc = scr + i * 16; const LAS float* af = lgt + i * 16;
            int bg = 0; float bs = -1e30f;
#pragma unroll
            for (int gr = 0; gr < 4; ++gr) { const float a = sc[4 * gr], b = sc[4 * gr + 1], c = sc[4 * gr + 2], d = sc[4 * gr + 3];
                const float x = fmaxf(a, b), yv = fminf(a, b), z = fmaxf(c, d), u = fminf(c, d);
                const float top2 = fmaxf(x, z) + fmaxf(fminf(x, z), fmaxf(yv, u));
                if (top2 > bs) { bs = top2; bg = gr; } }
            const float v0 = sc[4 * bg], v1 = sc[4 * bg + 1], v2 = sc[4 * bg + 2], v3 = sc[4 * bg + 3];
            int l0 = 0; float m0 = v0; if (v1 > m0) { m0 = v1; l0 = 1; } if (v2 > m0) { m0 = v2; l0 = 2; } if (v3 > m0) { m0 = v3; l0 = 3; }
            int l1 = -1; float m1 = -1e30f;
            if (l0 != 0 && v0 > m1) { m1 = v0; l1 = 0; } if (l0 != 1 && v1 > m1) { m1 = v1; l1 = 1; } if (l0 != 2 && v2 > m1) { m1 = v2; l1 = 2; } if (l0 != 3 && v3 > m1) { m1 = v3; l1 = 3; }
            const int e0 = 4 * bg + l0, e1 = 4 * bg + l1; const float a0 = af[e0], a1 = af[e1], inv = rcpf_(a0 + a1);
            const size_t t = (size_t)t0 + grp * 16 + i;
            tok_e[2 * t] = e0; tok_e[2 * t + 1] = e1; tok_w[2 * t] = a0 * inv; tok_w[2 * t + 1] = a1 * inv;
            lds_add(&hist[e0], 1); lds_add(&hist[e1], 1);
        }
    }
    __syncthreads();
    if (F.tid < 16) ((int*)(F.ws + CTL_BLKCNT))[(layer * 256 + F.wg) * 16 + F.tid] = hist[F.tid];
    __syncthreads();
}

DI void moe_scatter_phase(const Frame& F0, const float* xa, int layer) {
    Frame F = F0; F.tid = F.wave * 64 + lane_id(); asm volatile("" : "+v"(F.tid)); F.lane = F.tid & 63;
    LAS int* tot = (LAS int*)F.lds; LAS int* before = tot + 16; LAS int* base = tot + 32; LAS int* lcnt = tot + 48;
    const int* blk = (const int*)(F.ws + CTL_BLKCNT) + layer * 256 * 16;
    __syncthreads();
    if (F.tid < 16) { int tt = 0, bb = 0; for (int g = 0; g < 256; ++g) { const int c = blk[g * 16 + F.tid]; tt += c; bb += (g < F.wg) ? c : 0; } tot[F.tid] = tt; before[F.tid] = bb; lcnt[F.tid] = 0; }
    __syncthreads();
    if (F.tid == 0) { int ts = 0; int* gts = (int*)(F.ws + CTL_TILES) + layer * 32;
        for (int e = 0; e < 16; ++e) { base[e] = ts * 256 + before[e]; if (F.wg == 0) gts[e] = ts; ts += (tot[e] + 255) >> 8; }
        if (F.wg == 0) gts[16] = ts; }
    __syncthreads();
    const int* tok_e = (const int*)(F.ws + SM_TOKE); int* tok_p = (int*)(F.ws + SM_TOKP); int* rowtok = (int*)(F.ws + SM_ROWTOK);
    const int t0 = F.wg * 256;
    { const int i = F.tid; const int e = tok_e[2 * t0 + i]; const int pos = base[e] + lds_add(&lcnt[e], 1); tok_p[2 * t0 + i] = pos; rowtok[pos] = t0 + (i >> 1); }
    if (F.wg == 0) {
        for (int e = 0; e < 16; ++e) { const int rs = base[e] - before[e], lo = rs + tot[e], hi = rs + (((tot[e] + 255) >> 8) << 8);
            for (int i = lo + F.tid; i < hi; i += NTH) rowtok[i] = 0; }
    }
    __syncthreads();
}

DI void ln2_phase(const Frame& F0, float* xout  , const float* lng, const float* lnb, bf16_t* xb, bool use_ffn, unsigned char* xb8 = nullptr  ) {
    Frame F = F0; F.tid = F.wave * 64 + lane_id(); asm volatile("" : "+v"(F.tid)); F.lane = F.tid & 63;
    const int lane = F.lane; const bf16_t* Y = (const bf16_t*)(F.ws + OFF_XS);
    const int* tok_p = (const int*)(F.ws + SM_TOKP); const float* tok_w = (const float*)(F.ws + SM_TOKW);
    f32x4 gv[4], bv[4];
#pragma unroll
    for (int j = 0; j < 4; ++j) { gv[j] = *(const f32x4*)(lng + j * 256 + lane * 4); bv[j] = *(const f32x4*)(lnb + j * 256 + lane * 4); }
    for (int r = F.wave; r < 256; r += 16) {
        size_t t[2]; int p0[2], p1[2]; float w0[2], w1[2]; f32x4 xv[2][4]; u32x2 ya[2][4], yb[2][4];
#pragma unroll
        for (int k = 0; k < 2; ++k) { t[k] = (size_t)F.wg * 256 + r + 8 * k; p0[k] = tok_p[2 * t[k]]; p1[k] = tok_p[2 * t[k] + 1]; w0[k] = tok_w[2 * t[k]]; w1[k] = tok_w[2 * t[k] + 1]; }
#pragma unroll
        for (int k = 0; k < 2; ++k)
#pragma unroll
            for (int j = 0; j < 4; ++j) { const u32x2 xr = *(const u32x2*)(xb + t[k] * D + j * 256 + lane * 4); xv[k][j] = (f32x4){__uint_as_float(xr[0] << 16), __uint_as_float(xr[0] & 0xffff0000u), __uint_as_float(xr[1] << 16), __uint_as_float(xr[1] & 0xffff0000u)}; }
        if (use_ffn) {
#pragma unroll
            for (int k = 0; k < 2; ++k)
#pragma unroll
                for (int j = 0; j < 4; ++j) { ya[k][j] = *(const u32x2*)(Y + (size_t)p0[k] * D + j * 256 + lane * 4); yb[k][j] = *(const u32x2*)(Y + (size_t)p1[k] * D + j * 256 + lane * 4); }
        }
#pragma unroll
        for (int k = 0; k < 2; ++k) {
            f32x4 y[4]; float s = 0.f;
#pragma unroll
            for (int j = 0; j < 4; ++j) { y[j] = xv[k][j] * ALPHA;
                if (use_ffn) { const u32x2 a = ya[k][j], b = yb[k][j];
                    y[j][0] += w0[k] * __uint_as_float(a[0] << 16) + w1[k] * __uint_as_float(b[0] << 16);
                    y[j][1] += w0[k] * __uint_as_float(a[0] & 0xffff0000u) + w1[k] * __uint_as_float(b[0] & 0xffff0000u);
                    y[j][2] += w0[k] * __uint_as_float(a[1] << 16) + w1[k] * __uint_as_float(b[1] << 16);
                    y[j][3] += w0[k] * __uint_as_float(a[1] & 0xffff0000u) + w1[k] * __uint_as_float(b[1] & 0xffff0000u); }
                s += y[j][0] + y[j][1] + y[j][2] + y[j][3]; }
            const float mean = wave_sum(s) * (1.0f / D); float q = 0.f;
#pragma unroll
            for (int j = 0; j < 4; ++j) { y[j] -= mean; q += y[j][0] * y[j][0] + y[j][1] * y[j][1] + y[j][2] * y[j][2] + y[j][3] * y[j][3]; }
            const float rstd = rsqrtf(wave_sum(q) * (1.0f / D) + LN_EPS);
#pragma unroll
            for (int j = 0; j < 4; ++j) { f32x4 o = y[j] * rstd * gv[j] + bv[j];
                if (xout) *(f32x4*)(xout + t[k] * D + j * 256 + lane * 4) = o;
                else { u32x2 ob; ob[0] = pack2(o[0], o[1]); ob[1] = pack2(o[2], o[3]); *(u32x2*)(xb + t[k] * D + j * 256 + lane * 4) = ob;
                    if (xb8) *(unsigned*)(xb8 + t[k] * D + j * 256 + lane * 4) = pk_fp8x4(o[0] * F8_SX, o[1] * F8_SX, o[2] * F8_SX, o[3] * F8_SX); } }
        }
    }
}

typedef short s16x4 __attribute__((ext_vector_type(4)));
#define MFMA16(a, b, c) __builtin_amdgcn_mfma_f32_16x16x32_bf16((a), (b), (c), 0, 0, 0)
DI bf16x8 ld_row(const LAS bf16_t* p) { return *(const LAS bf16x8*)p; }
DI bf16x8 ld_tr2(const LAS bf16_t* pa, const LAS bf16_t* pb) {
    const s16x4 lo = __builtin_amdgcn_ds_read_tr16_b64_v4i16((LAS s16x4*)pa), hi = __builtin_amdgcn_ds_read_tr16_b64_v4i16((LAS s16x4*)pb);
    return __builtin_shufflevector(lo, hi, 0, 1, 2, 3, 4, 5, 6, 7);
}

constexpr int R_LDK = 136, R_LDV = 264;
template <int NCOLS> DI void ret_copy(const Frame& F, const bf16_t* src, size_t gld, LAS bf16_t* dst, int lld) {
    constexpr int cpr = NCOLS >> 3, n = 128 * cpr;
    u32x4 v[n / NTH];
#pragma unroll
    for (int i = 0; i < n / NTH; ++i) { const int id = F.tid + i * NTH, r = id / cpr, ch = id % cpr; v[i] = *(const u32x4*)(src + (size_t)r * gld + ch * 8); }
#pragma unroll
    for (int i = 0; i < n / NTH; ++i) { const int id = F.tid + i * NTH, r = id / cpr, ch = id % cpr; *(LAS u32x4*)(dst + r * lld + ch * 8) = v[i]; }
}
template <int NCOLS> DI void blk_fetch(const Frame& F, const bf16_t* src, int gld, u32x4 (&v)[128 * (NCOLS >> 3) / NTH]) {
    constexpr int cpr = NCOLS >> 3;
    int t_ = F.tid; asm volatile("" : "+v"(t_));
#pragma unroll
    for (int i = 0; i < 128 * cpr / NTH; ++i) { const int id = t_ + i * NTH, r = id / cpr, ch = id % cpr; v[i] = *(const u32x4*)((const char*)src + (unsigned)(r * gld + ch * 8) * 2u); }
}
template <int NCOLS> DI void blk_put(const Frame& F, const u32x4 (&v)[128 * (NCOLS >> 3) / NTH], LAS bf16_t* dst, int lld) {
    constexpr int cpr = NCOLS >> 3;
    int t_ = F.tid; asm volatile("" : "+v"(t_));
#pragma unroll
    for (int i = 0; i < 128 * cpr / NTH; ++i) { const int id = t_ + i * NTH, r = id / cpr, ch = id % cpr; *(LAS u32x4*)(dst + r * lld + ch * 8) = v[i]; }
}
template <int NCOLS> DI void blk_fetch8(const Frame& F, const unsigned char* src, int gld, u32x4 (&v)[128 * (NCOLS >> 4) / NTH]) {
    constexpr int cpr = NCOLS >> 4;
    int t_ = F.tid; asm volatile("" : "+v"(t_));
#pragma unroll
    for (int i = 0; i < 128 * cpr / NTH; ++i) { const int id = t_ + i * NTH, r = id / cpr, ch = id % cpr; v[i] = *(const u32x4*)(src + (unsigned)(r * gld + ch * 16)); }
}
DI u32x2 fp8x4_bf16(unsigned d) { const auto a = __builtin_amdgcn_cvt_pk_f32_fp8((int)d, false), b = __builtin_amdgcn_cvt_pk_f32_fp8((int)d, true); u32x2 o; o[0] = pack2(a[0], a[1]); o[1] = pack2(b[0], b[1]); return o; }
template <int NCOLS> DI void blk_put8(const Frame& F, const u32x4 (&v)[128 * (NCOLS >> 4) / NTH], LAS bf16_t* dst, int lld) {
    constexpr int cpr = NCOLS >> 4;
    int t_ = F.tid; asm volatile("" : "+v"(t_));
#pragma unroll
    for (int i = 0; i < 128 * cpr / NTH; ++i) { const int id = t_ + i * NTH, r = id / cpr, ch = id % cpr; u32x4 lo, hi;
        const u32x2 c0 = fp8x4_bf16(v[i][0]), c1 = fp8x4_bf16(v[i][1]), c2 = fp8x4_bf16(v[i][2]), c3 = fp8x4_bf16(v[i][3]);
        lo = (u32x4){c0[0], c0[1], c1[0], c1[1]}; hi = (u32x4){c2[0], c2[1], c3[0], c3[1]};
        *(LAS u32x4*)(dst + r * lld + ch * 16) = lo; *(LAS u32x4*)(dst + r * lld + ch * 16 + 8) = hi; }
}
DI void ret_r1_unit(const Frame& F0, const bf16_t* Pg, bf16_t* KV, int unit) {
    Frame F = F0; F.tid = F.wave * 64 + lane_id(); asm volatile("" : "+v"(F.tid)); F.lane = F.tid & 63;
    const int c = unit & 63, h = (unit >> 6) & 7, bl = unit >> 9;
    LAS bf16_t* Kd = (LAS bf16_t*)F.lds; LAS bf16_t* Vs = Kd + 128 * R_LDK;
    const size_t row0 = (size_t)bl * 8192 + c * 128;
    const float l2g = log2f(1.0f - exp2f(-5.0f - (float)h));
    __syncthreads();
    { u32x4 kv_[4]; blk_fetch<128>(F, Pg + row0 * PGLD + 1024 + h * 128, PGLD, kv_);
#pragma unroll
      for (int i = 0; i < 4; ++i) { const int r_ = (F.tid + i * NTH) >> 4; const float sc = 0.08838834764831845f * __builtin_amdgcn_exp2f((float)(127 - r_) * l2g); float t8[8]; unpack8(kv_[i], t8);
#pragma unroll
          for (int e = 0; e < 8; ++e) t8[e] *= sc;
          kv_[i] = pack8(t8); }
      blk_put<128>(F, kv_, Kd, R_LDK); }
    if (PGV8) { u32x4 vv_[4]; blk_fetch8<256>(F, (const unsigned char*)Pg + row0 * 8192 + 4096 + h * 256, 8192, vv_); blk_put8<256>(F, vv_, Vs, R_LDV); }
    else ret_copy<256>(F, Pg + row0 * 6144 + 2048 + h * 256, 6144, Vs, R_LDV);
    __syncthreads();
    int w = F.wave; asm volatile("" : "+s"(w));
    const int lane = F.lane, fq = lane >> 4, q = (lane & 15) >> 2, pp = lane & 3;
    f32x4 acc[16];
#pragma unroll
    for (int i = 0; i < 16; ++i) acc[i] = (f32x4){0.f, 0.f, 0.f, 0.f};
#pragma unroll
    for (int ks = 0; ks < 4; ++ks) {
        const int ra = 32 * ks + 8 * fq + q, rb = ra + 4;
        const bf16x8 X = ld_tr2(Kd + ra * R_LDK + 16 * w + 4 * pp, Kd + rb * R_LDK + 16 * w + 4 * pp);
#pragma unroll
        for (int vt = 0; vt < 16; ++vt) { const bf16x8 Y = ld_tr2(Vs + ra * R_LDV + 16 * vt + 4 * pp, Vs + rb * R_LDV + 16 * vt + 4 * pp); acc[vt] = MFMA16(Y, X, acc[vt]); }
    }
    bf16_t* o = KV + (size_t)unit * 32768 + (16 * w + (lane & 15)) * 256 + 4 * fq;
#pragma unroll
    for (int vt = 0; vt < 16; ++vt) { u32x2 ov; ov[0] = pack2(acc[vt][0], acc[vt][1]); ov[1] = pack2(acc[vt][2], acc[vt][3]); *(u32x2*)(o + 16 * vt) = ov; }
}
DI void ret_r2_phase(const Frame& F0, bf16_t* KV) {
    Frame F = F0; F.tid = F.wave * 64 + lane_id(); asm volatile("" : "+v"(F.tid)); F.lane = F.tid & 63;
    const int gt = F.wg * NTH + F.tid;
    if (gt >= 65536) return;
    const int pair = gt >> 12, e8 = gt & 4095, h = pair & 7;
    const float cd = exp2f(128.0f * log2f(1.0f - exp2f(-5.0f - (float)h)));
    float st[8];
#pragma unroll
    for (int i = 0; i < 8; ++i) st[i] = 0.f;
#pragma unroll 8
    for (int c = 0; c < 64; ++c) {
        bf16_t* p = KV + ((size_t)(pair * 64 + c)) * 32768 + (size_t)e8 * 8;
        float kv[8]; unpack8(*(const u32x4*)p, kv);
        *(u32x4*)p = pack8(st);
#pragma unroll
        for (int i = 0; i < 8; ++i) st[i] = st[i] * cd + kv[i];
    }
}
DI void ret_r3_phase(const Frame& F0, const bf16_t* Pg, const bf16_t* RS, bf16_t* O1, int gq, const float* gn) {
    Frame F = F0; F.tid = F.wave * 64 + lane_id(); asm volatile("" : "+v"(F.tid)); F.lane = F.tid & 63;
    LAS bf16_t* Qs = (LAS bf16_t*)F.lds; LAS bf16_t* Ks = Qs + 128 * R_LDK; LAS bf16_t* Vh = Ks + 128 * R_LDK; LAS bf16_t* Rh = Vh + 128 * R_LDK;
    int w = F.wave; asm volatile("" : "+s"(w));
    u32x4 RQ[4], RK[4];
    { const int u0 = F.wg; const size_t r0 = (size_t)(u0 >> 9) * 8192 + (u0 & 63) * 128; const int h0 = (u0 >> 6) & 7;
      blk_fetch<128>(F, Pg + r0 * PGLD + h0 * 128, PGLD, RQ); blk_fetch<128>(F, Pg + r0 * PGLD + 1024 + h0 * 128, PGLD, RK); }
#pragma unroll 1
    for (int unit = F.wg; unit < 1024; unit += GRID) {
        const int c = unit & 63, h = (unit >> 6) & 7, bl = unit >> 9;
        const size_t row0 = (size_t)bl * 8192 + c * 128;
        const float l2g = log2f(1.0f - exp2f(-5.0f - (float)h));
        const bf16_t* rsu = RS + (size_t)unit * 32768;
        int lane = F.lane; asm volatile("" : "+v"(lane));
        const int fr = lane & 15, fq = lane >> 4, q = fr >> 2, pp = lane & 3;
        __syncthreads();
        blk_put<128>(F, RQ, Qs, R_LDK); blk_put<128>(F, RK, Ks, R_LDK);
        static_assert(PGV8, "the chunk-output phase reads v and g as e4m3");
        u32x4 RV[2], RR[4];
        const unsigned char* Pg8 = (const unsigned char*)Pg + row0 * 8192 + 4096 + h * 256;
        blk_fetch8<128>(F, Pg8, 8192, RV);
        blk_fetch<128>(F, rsu, 256, RR);
        __syncthreads();
        f32x4 sacc[8];
#pragma unroll
        for (int jt = 0; jt < 8; ++jt) sacc[jt] = (f32x4){0.f, 0.f, 0.f, 0.f};
#pragma unroll
        for (int ks = 0; ks < 4; ++ks) {
            const bf16x8 Yq = ld_row(Qs + (16 * w + fr) * R_LDK + 32 * ks + 8 * fq);
#pragma unroll
            for (int jt = 0; jt < 8; ++jt) { const bf16x8 Xk = ld_row(Ks + (16 * jt + fr) * R_LDK + 32 * ks + 8 * fq); sacc[jt] = MFMA16(Xk, Yq, sacc[jt]); }
        }
        __syncthreads();
        { const int i = 16 * w + fr;
#pragma unroll
          for (int jt = 0; jt < 8; ++jt) { float pv[4];
#pragma unroll
              for (int r = 0; r < 4; ++r) { const int j = 16 * jt + 4 * fq + r; pv[r] = (i >= j) ? sacc[jt][r] * (0.08838834764831845f * __builtin_amdgcn_exp2f((float)(i - j) * l2g)) : 0.f; }
              u32x2 o; o[0] = pack2(pv[0], pv[1]); o[1] = pack2(pv[2], pv[3]);
              *(LAS u32x2*)(Ks + i * R_LDK + 16 * jt + 4 * fq) = o; } }
        f32x4 acc[16];
#pragma unroll
        for (int i = 0; i < 16; ++i) acc[i] = (f32x4){0.f, 0.f, 0.f, 0.f};
        const float qdec = exp2f((float)(16 * w + fr + 1) * l2g);
        u32x4 RG[4];
#pragma unroll
        for (int half = 0; half < 2; ++half) {
            if (half) __syncthreads();
            blk_put8<128>(F, RV, Vh, R_LDK);
            blk_put<128>(F, RR, Rh, R_LDK);
            if (half == 0) { blk_fetch8<128>(F, Pg8 + 128, 8192, RV);
                blk_fetch<128>(F, rsu + 128, 256, RR); }
            else blk_fetch8<256>(F, Pg8 + 2048, 8192, RG);
            __syncthreads();
#pragma unroll
            for (int ks = 0; ks < 4; ++ks) {
                const bf16x8 Yq = ld_row(Qs + (16 * w + fr) * R_LDK + 32 * ks + 8 * fq);
                const int ra = 32 * ks + 8 * fq + q, rb = ra + 4;
#pragma unroll
                for (int vt = 0; vt < 8; ++vt) { const bf16x8 Xr = ld_tr2(Rh + ra * R_LDK + 16 * vt + 4 * pp, Rh + rb * R_LDK + 16 * vt + 4 * pp); acc[half * 8 + vt] = MFMA16(Xr, Yq, acc[half * 8 + vt]); }
            }
#pragma unroll
            for (int vt = 0; vt < 8; ++vt) acc[half * 8 + vt] *= qdec;
#pragma unroll
            for (int ks = 0; ks < 4; ++ks) {
                const bf16x8 Yp = ld_row(Ks + (16 * w + fr) * R_LDK + 32 * ks + 8 * fq);
                const int ra = 32 * ks + 8 * fq + q, rb = ra + 4;
#pragma unroll
                for (int vt = 0; vt < 8; ++vt) { const bf16x8 Xv = ld_tr2(Vh + ra * R_LDK + 16 * vt + 4 * pp, Vh + rb * R_LDK + 16 * vt + 4 * pp); acc[half * 8 + vt] = MFMA16(Xv, Yp, acc[half * 8 + vt]); }
            }
        }
        __syncthreads();
        LAS bf16_t* Gs = Vh;
        LAS float* gnl = (LAS float*)(Qs);
        blk_put8<256>(F, RG, Gs, R_LDV);
        if (F.tid < 256) { gnl[F.tid] = gn[h * 256 + F.tid]; gnl[256 + F.tid] = gn[2048 + h * 256 + F.tid]; }
        { const int un = unit + GRID; if (un < 1024) { const size_t rn = (size_t)(un >> 9) * 8192 + (un & 63) * 128; const int hn = (un >> 6) & 7;
            blk_fetch<128>(F, Pg + rn * PGLD + hn * 128, PGLD, RQ); blk_fetch<128>(F, Pg + rn * PGLD + 1024 + hn * 128, PGLD, RK); } }
        float s = 0.f;
#pragma unroll
        for (int vt = 0; vt < 16; ++vt) s += acc[vt][0] + acc[vt][1] + acc[vt][2] + acc[vt][3];
        s += shx(s, 16); s += shx(s, 32);
        const float mean = s * (1.0f / 256.0f); float qq = 0.f;
#pragma unroll
        for (int vt = 0; vt < 16; ++vt)
#pragma unroll
            for (int r = 0; r < 4; ++r) { const float d = acc[vt][r] - mean; qq += d * d; }
        qq += shx(qq, 16); qq += shx(qq, 32);
        const float rstd = rsqrtf(qq * (1.0f / 256.0f) + (PGV8 ? 1e-5f * F8_SX * F8_SX : 1e-5f));
        __syncthreads();
        const size_t trow = row0 + 16 * w + fr;
        bf16_t* op = O1 + ((size_t)gq * 16384 + trow) * 2048 + h * 256;
#pragma unroll
        for (int vt = 0; vt < 16; ++vt) {
            const int v0 = 16 * vt + 4 * fq;
            if ((vt & 3) == 0) asm volatile("" ::: "memory");
            const u32x2 gr = *(const LAS u32x2*)(Gs + (16 * w + fr) * R_LDV + v0);
            const f32x4 gg = *(const LAS f32x4*)(gnl + v0), gb = *(const LAS f32x4*)(gnl + 256 + v0);
            float gv[4] = {__uint_as_float(gr[0] << 16), __uint_as_float(gr[0] & 0xffff0000u), __uint_as_float(gr[1] << 16), __uint_as_float(gr[1] & 0xffff0000u)};
            if (PGV8) {
#pragma unroll
                for (int r = 0; r < 4; ++r) gv[r] *= (1.0f / F8_SX); }
            float o[4];
#pragma unroll
            for (int r = 0; r < 4; ++r) { const float nv = (acc[vt][r] - mean) * rstd * gg[r] + gb[r]; o[r] = siluf_(gv[r]) * nv; }
            if (RTO8) *(unsigned*)((unsigned char*)O1 + ((size_t)gq * 16384 + trow) * 2048 + h * 256 + v0) = pk_fp8x4(o[0] * F8_SO, o[1] * F8_SO, o[2] * F8_SO, o[3] * F8_SO);
            else { u32x2 ov; ov[0] = pack2(o[0], o[1]); ov[1] = pack2(o[2], o[3]);
            *(u32x2*)(op + v0) = ov; }
        }
    }
}

DI bf16_t* st_w(const Frame& F) { return (bf16_t*)(F.ws + OFF_STR); }
DI bf16_t* st_kk(const Frame& F) { return (bf16_t*)(F.ws + OFF_STR) + (size_t)T * 512; }
DI bf16_t* st_b(const Frame& F) { return (bf16_t*)F.out; }
DI bf16_t* st_kp(const Frame& F) { return (bf16_t*)F.out + (size_t)T * 512; }
DI bf16_t* st_r(const Frame& F) { return (bf16_t*)F.out + (size_t)T * 1024; }
DI bf16_t* st_v(const Frame& F) { return (bf16_t*)F.out + (size_t)T * 1536; }

DI void rwkv_e1_phase(const Frame& F0) {
    Frame F = F0; F.tid = F.wave * 64 + lane_id(); asm volatile("" : "+v"(F.tid)); F.lane = F.tid & 63;
    const bf16_t* PR = (const bf16_t*)(F.ws + OFF_PR); const float* mu = F.in[3]; const float* kkw = F.in[12];
    const int c = F.lane * 8;
    float m0[8], m1[8], m2[8], kw[8];
#pragma unroll
    for (int i = 0; i < 8; ++i) { m0[i] = mu[c + i]; m1[i] = mu[512 + c + i]; m2[i] = mu[1024 + c + i]; kw[i] = kkw[c + i]; }
    float* rn = (float*)(F.ws + SM_RNORM);
    for (int r = F.wave; r < 256; r += 16) {
        u32x4 ld[2][6]; size_t t[2];
#pragma unroll
        for (int k = 0; k < 2; ++k) { t[k] = (size_t)F.wg * 256 + r + 8 * k; const size_t row = t[k] + (t[k] >> 13) + 1;
            const bf16_t* cur = PR + row * 2048 + c; const bf16_t* prv = cur - 2048;
            ld[k][0] = *(const u32x4*)cur; ld[k][1] = *(const u32x4*)prv; ld[k][2] = *(const u32x4*)(cur + 512); ld[k][3] = *(const u32x4*)(prv + 512); ld[k][4] = *(const u32x4*)(cur + 1024); ld[k][5] = *(const u32x4*)(prv + 1024); }
#pragma unroll
        for (int k = 0; k < 2; ++k) {
            float a[8], p[8], o[8];
            unpack8(ld[k][0], a); unpack8(ld[k][1], p);
#pragma unroll
            for (int i = 0; i < 8; ++i) o[i] = a[i] + (p[i] - a[i]) * m0[i];
            *(u32x4*)(st_r(F) + t[k] * 512 + c) = pack8(o);
            unpack8(ld[k][2], a); unpack8(ld[k][3], p);
            float ss = 0.f;
#pragma unroll
            for (int i = 0; i < 8; ++i) { o[i] = a[i] + (p[i] - a[i]) * m1[i]; const float q = o[i] * kw[i]; ss += q * q; }
            *(u32x4*)(st_kp(F) + t[k] * 512 + c) = pack8(o);
            ss += shx(ss, 1); ss += shx(ss, 2); ss += shx(ss, 4);
            if ((F.lane & 7) == 0) rn[t[k] * 8 + (F.lane >> 3)] = rcpf_(fmaxf(__builtin_amdgcn_sqrtf(ss), 1e-12f));
            unpack8(ld[k][4], a); unpack8(ld[k][5], p);
#pragma unroll
            for (int i = 0; i < 8; ++i) o[i] = a[i] + (p[i] - a[i]) * m2[i];
            *(u32x4*)(st_v(F) + t[k] * 512 + c) = pack8(o);
        }
    }
}

DI float dpp_f(float v, int ctrl_qp1, int) { return v; }
template <int CTRL> DI float dpp_mov(float v) { return __int_as_float(__builtin_amdgcn_update_dpp(0, __float_as_int(v), CTRL, 0xf, 0xf, true)); }
DI float row_sum16(float v) {
    v += dpp_mov<0xB1>(v);
    v += dpp_mov<0x4E>(v);
    v += dpp_mov<0x141>(v);
    v += dpp_mov<0x140>(v);
    return v;
}

DI float row_sum8(float v) {
    v += dpp_mov<0xB1>(v);
    v += dpp_mov<0x4E>(v);
    v += dpp_mov<0x141>(v);
    return v;
}
typedef _Float16 h2_t __attribute__((ext_vector_type(2)));
typedef _Float16 h8_t __attribute__((ext_vector_type(8)));
constexpr int SC_STEPS = 32;
constexpr int SC_BUF = SC_STEPS * (5 * 64 + 64) * 2;
constexpr int SC_WGS = 64;
constexpr int SC_OBS = 260;
struct ScOp { u32x4 a0, a1, a2, a3, a4; unsigned v0, v1; };
template <int U> DI void sc_ld(ScOp& o, unsigned pb, unsigned pv) {
    asm volatile("ds_read_b128 %0, %1 offset:%c2" : "=v"(o.a0) : "v"(pb), "i"(U * 640) : "memory");
    asm volatile("ds_read_b128 %0, %1 offset:%c2" : "=v"(o.a1) : "v"(pb), "i"(U * 640 + 128) : "memory");
    asm volatile("ds_read_b128 %0, %1 offset:%c2" : "=v"(o.a2) : "v"(pb), "i"(U * 640 + 256) : "memory");
    asm volatile("ds_read_b128 %0, %1 offset:%c2" : "=v"(o.a3) : "v"(pb), "i"(U * 640 + 384) : "memory");
    asm volatile("ds_read_b128 %0, %1 offset:%c2" : "=v"(o.a4) : "v"(pb), "i"(U * 640 + 512) : "memory");
    asm volatile("ds_read_u16 %0, %1 offset:%c2" : "=v"(o.v0) : "v"(pv), "i"(U * 128) : "memory");
    asm volatile("ds_read_u16 %0, %1 offset:%c2" : "=v"(o.v1) : "v"(pv), "i"(U * 128 + 2) : "memory");
}
DI void sc_wait(ScOp& o) { asm volatile("s_waitcnt lgkmcnt(0)" : "+v"(o.a0), "+v"(o.a1), "+v"(o.a2), "+v"(o.a3), "+v"(o.a4), "+v"(o.v0), "+v"(o.v1) :: "memory"); }
DI h2_t h2of(unsigned x) { return __builtin_bit_cast(h2_t, x); }
DI float dot2z(h2_t a, h2_t b) { float r; asm("v_dot2_f32_f16 %0, %1, %2, 0" : "=v"(r) : "v"(a), "v"(b)); return r; }
DI float sc_dot(const h2_t (&S)[4], const u32x4& x) {
    float o = dot2z(S[0], h2of(x[0])); o = __builtin_amdgcn_fdot2(S[1], h2of(x[1]), o, false); o = __builtin_amdgcn_fdot2(S[2], h2of(x[2]), o, false); return __builtin_amdgcn_fdot2(S[3], h2of(x[3]), o, false); }
DI unsigned sc_readout(const h2_t (&S)[2][4], const u32x4& rp) {
    const float o0 = sc_dot(S[0], rp), o1 = sc_dot(S[1], rp);
    return __builtin_bit_cast(unsigned, __builtin_amdgcn_cvt_pkrtz(o0, o1));
}
template <int U> DI void sc_step(h2_t (&S)[2][4], ScOp& cur, u32x4& rp, LAS unsigned* obw, unsigned pb, unsigned pv) {
    ScOp nxt; sc_ld<U + 1>(nxt, pb, pv);
    __builtin_amdgcn_sched_barrier(0);
    const float sa0 = sc_dot(S[0], cur.a1), sa1 = sc_dot(S[1], cur.a1);
    obw[U * SC_OBS] = sc_readout(S, rp);
    const _Float16 sh0 = (_Float16)(-row_sum8(sa0)), sh1 = (_Float16)(-row_sum8(sa1));
    const h2_t sav[2] = {(h2_t){sh0, sh0}, (h2_t){sh1, sh1}};
    const _Float16 vh0 = h2of(cur.v0)[0], vh1 = h2of(cur.v1)[0];
    const h2_t vv2[2] = {(h2_t){vh0, vh0}, (h2_t){vh1, vh1}};
#pragma unroll
    for (int rw = 0; rw < 2; ++rw)
#pragma unroll
        for (int i = 0; i < 4; ++i) S[rw][i] = S[rw][i] * h2of(cur.a0[i]) + (sav[rw] * h2of(cur.a2[i]) + vv2[rw] * h2of(cur.a3[i]));
    rp = cur.a4;
    __builtin_amdgcn_sched_barrier(0);
    sc_wait(nxt); cur = nxt;
}
DI void rwkv_scan(const Frame& F0, const bool do_post = true) {
    Frame F = F0; F.tid = F.wave * 64 + lane_id(); asm volatile("" : "+v"(F.tid)); F.lane = F.tid & 63;
    const int stream = F.wg, b = stream >> 3, h = stream & 7;
    const int rloc = 16 * F.wave + 2 * (F.lane >> 3), cg = F.lane & 7;
    const size_t tb = (size_t)b * SEQ;
    LAS unsigned* OBP = (LAS unsigned*)(F.lds + 2 * SC_BUF);
    const bf16_t* arrs[6] = {st_w(F), st_kk(F), st_b(F), st_kp(F), st_r(F), st_v(F)};
    u32x4 stage[3];
    auto issue = [&](int chunk) {
#pragma unroll
        for (int i = 0; i < 3; ++i) { const int id = F.tid + NTH * i, arr = id >> 8, rem = id & 255, step = rem >> 3, ch = rem & 7;
            const bf16_t* base = arr == 0 ? arrs[0] : arr == 1 ? arrs[1] : arr == 2 ? arrs[2] : arr == 3 ? arrs[3] : arr == 4 ? arrs[4] : arrs[5];
            stage[i] = *(const u32x4*)(base + (tb + (size_t)chunk * SC_STEPS + step) * 512 + h * 64 + ch * 8); }
    };
    auto commit = [&](int buf) {
        LAS _Float16* L = (LAS _Float16*)(F.lds + buf * SC_BUF);
#pragma unroll
        for (int i = 0; i < 3; ++i) { const int id = F.tid + NTH * i, arr = id >> 8, rem = id & 255, step = rem >> 3, ch = rem & 7;
            float v[8]; unpack8(stage[i], v);
            h8_t hv;
#pragma unroll
            for (int e = 0; e < 8; ++e) hv[e] = (_Float16)v[e];
            LAS _Float16* d = arr < 5 ? (L + step * 320 + arr * 64 + ch * 8) : (L + SC_STEPS * 320 + step * 64 + ch * 8);
            *(LAS h8_t*)d = hv; }
    };
    const int pstep = (F.tid - 256) >> 3, pc = h * 64 + 8 * (F.tid & 7);
    float lg[8], lb[8], rk[8];
    if (F.wave >= 4) {
#pragma unroll
        for (int i = 0; i < 8; ++i) { lg[i] = F.in[15][pc + i]; lb[i] = F.in[15][512 + pc + i]; rk[i] = F.in[14][pc + i]; } }
    bf16_t* O0 = (bf16_t*)(F.ws + OFF_O0);
    auto post = [&](int chunk) {
        const size_t t = tb + (size_t)chunk * SC_STEPS + pstep;
        const LAS unsigned* ob = OBP + ((chunk & 1) * (SC_STEPS + 1) + pstep + 1) * SC_OBS + 32 * (F.tid & 7);
        float o[8];
#pragma unroll
        for (int p = 0; p < 4; ++p) { float s0 = 0.f, s1 = 0.f;
#pragma unroll
            for (int hf = 0; hf < 2; ++hf) { const u32x4 q = *(const LAS u32x4*)(ob + p * 8 + hf * 4);
#pragma unroll
                for (int e = 0; e < 4; ++e) { const h2_t hv = h2of(q[e]); s0 += (float)hv[0]; s1 += (float)hv[1]; } }
            o[2 * p] = s0; o[2 * p + 1] = s1; }
        float rr[8], kp[8], vv[8], gg[8];
        unpack8(*(const u32x4*)(st_r(F) + t * 512 + pc), rr); unpack8(*(const u32x4*)(st_kp(F) + t * 512 + pc), kp); unpack8(*(const u32x4*)(st_v(F) + t * 512 + pc), vv);
        unpack8(*(const u32x4*)(O0 + t * 1024 + pc), gg);
        float s = 0.f, bs = 0.f;
#pragma unroll
        for (int i = 0; i < 8; ++i) { s += o[i]; bs += rr[i] * kp[i] * rk[i]; }
        s += shx(s, 1); s += shx(s, 2); s += shx(s, 4);
        bs += shx(bs, 1); bs += shx(bs, 2); bs += shx(bs, 4);
        const float mean = s * (1.0f / 64.0f); float q = 0.f;
#pragma unroll
        for (int i = 0; i < 8; ++i) { const float d = o[i] - mean; q += d * d; }
        q += shx(q, 1); q += shx(q, 2); q += shx(q, 4);
        const float rstd = rsqrtf(q * (1.0f / 64.0f) + 64e-5f);
        float res[8];
#pragma unroll
        for (int i = 0; i < 8; ++i) res[i] = ((o[i] - mean) * rstd * lg[i] + lb[i] + bs * vv[i]) * gg[i];
        *(u32x4*)(O0 + t * 1024 + pc) = pack8(res);
    };
    h2_t S[2][4];
#pragma unroll
    for (int i = 0; i < 4; ++i) { S[0][i] = (h2_t){(_Float16)0.f, (_Float16)0.f}; S[1][i] = S[0][i]; }
    __syncthreads();
    issue(0); commit(0);
    __syncthreads();
    constexpr int NCH = SEQ / SC_STEPS;
    for (int chunk = 0; chunk < NCH; ++chunk) {
        if (chunk + 1 < NCH) issue(chunk + 1);
        const LAS _Float16* L = (const LAS _Float16*)(F.lds + (chunk & 1) * SC_BUF);
        if (F.wave < 4) {
            LAS unsigned* obw = OBP + (chunk & 1) * (SC_STEPS + 1) * SC_OBS + F.tid;
            unsigned pb = (unsigned)(size_t)(F.lds + (chunk & 1) * SC_BUF) + 16 * cg, pv = (unsigned)(size_t)(F.lds + (chunk & 1) * SC_BUF) + SC_STEPS * 640 + 2 * rloc;
            ScOp cur; sc_ld<0>(cur, pb, pv); sc_wait(cur);
            u32x4 rp = cur.a4;
#pragma unroll 1
            for (int g8 = 0; g8 < SC_STEPS / 8; ++g8) {
                sc_step<0>(S, cur, rp, obw, pb, pv); sc_step<1>(S, cur, rp, obw, pb, pv); sc_step<2>(S, cur, rp, obw, pb, pv); sc_step<3>(S, cur, rp, obw, pb, pv);
                sc_step<4>(S, cur, rp, obw, pb, pv); sc_step<5>(S, cur, rp, obw, pb, pv); sc_step<6>(S, cur, rp, obw, pb, pv); sc_step<7>(S, cur, rp, obw, pb, pv);
                pb += 8 * 640; pv += 8 * 128; obw += 8 * SC_OBS;
            }
            obw[0] = sc_readout(S, rp);
        } else if (chunk > 0 && do_post) post(chunk - 1);
        if (chunk + 1 < NCH) commit((chunk + 1) & 1);
        __syncthreads();
    }
    if (F.wave >= 4 && do_post) post(NCH - 1);
}

DI void nsa_rope_phase(const Frame& F0) {
    Frame F = F0; F.tid = F.wave * 64 + lane_id(); asm volatile("" : "+v"(F.tid)); F.lane = F.tid & 63;
    bf16_t* PN = (bf16_t*)(F.ws + OFF_PN); const float* tab = (const float*)(F.ws + SM_ROPEN);
    const int hh = F.lane >> 2, j0 = (F.lane & 3) * 2;
    const int col = hh < 8 ? hh * 64 : 512 + ((hh - 8) >> 1) * 256 + ((hh - 8) & 1) * 64;
    if (hh >= 14) return;
    for (int r = F.wave; r < 256; r += 8) {
        const size_t t = (size_t)F.wg * 256 + r; const int pos = (int)(t & 8191);
        bf16_t* p = PN + t * 1536 + col + j0;
        const unsigned a = *(const unsigned*)p, bq = *(const unsigned*)(p + 8);
        const f32x4 cs = *(const f32x4*)(tab + ((size_t)pos * 8 + j0) * 2);
        const float x10 = __uint_as_float(a << 16), x11 = __uint_as_float(a & 0xffff0000u), x20 = __uint_as_float(bq << 16), x21 = __uint_as_float(bq & 0xffff0000u);
        *(unsigned*)p = pack2(x10 * cs[0] - x20 * cs[1], x11 * cs[2] - x21 * cs[3]);
        *(unsigned*)(p + 8) = pack2(x20 * cs[0] + x10 * cs[1], x21 * cs[2] + x11 * cs[3]);
    }
}
namespace pg8 {
struct CmpSched {
    const char* A; const char* B; size_t slotstepA, tstepA, bstride; int G, c;
    DI bool next(int i, Unit& u) const {
        const int L = i * G + c; if (L >= 64) return false;
        const int slot = L >> 4, pm = L & 15; u.pm = pm; u.pn = 0; u.aux = slot;
        u.a = A + (size_t)slot * slotstepA + (size_t)pm * tstepA; u.b = B + (size_t)(slot >> 1) * bstride; u.rows = nullptr; return true;
    }
};
}
constexpr int NS_STG = 16384, NS_NSTG = 4;
constexpr int NS_OFF_IMP = NS_NSTG * NS_STG, NS_OFF_SEL = NS_OFF_IMP + 128 * 128 * 4, NS_OFF_U = NS_OFF_SEL + 2048;
constexpr float NS_C = 0.125f * 1.44269504088896341f;
struct FState { f32x4 o[4][4]; float m[4], l[4]; };
struct TileSrc { const bf16_t* k; const bf16_t* v; size_t rstride; };
DI void ns_dma(const Frame& F, const TileSrc& S, int j, int stage) {
    int l_ = F.lane; asm volatile("" : "+v"(l_));
    const int row = 8 * F.wave + (l_ >> 3), c = (l_ & 7) ^ (l_ >> 3);
    const unsigned off = ((unsigned)(j * 64 + row) * (unsigned)S.rstride + c * 8) * 2u;
    LAS unsigned char* base = F.lds + stage * NS_STG + F.wave * 1024;
    __builtin_amdgcn_global_load_lds((const unsigned*)((const char*)S.k + off), (LAS unsigned*)base, 16, 0, 0);
    __builtin_amdgcn_global_load_lds((const unsigned*)((const char*)S.v + off), (LAS unsigned*)(base + 8192), 16, 0, 0);
}
DI void ns_wait(int after) {
    if (after >= 2) asm volatile("s_waitcnt vmcnt(4)" ::: "memory"); else if (after == 1) asm volatile("s_waitcnt vmcnt(2)" ::: "memory"); else asm volatile("s_waitcnt vmcnt(0)" ::: "memory");
    __builtin_amdgcn_s_barrier(); asm volatile("" ::: "memory");
}
DI float fexp2(float x) { return __builtin_amdgcn_exp2f(x); }
DI unsigned cvtpk(float lo, float hi) { return pack2(lo, hi); }
constexpr float NS_NINF = -__builtin_inff();
DI float vmax(float a, float b) { return __builtin_fmaxf(a, b); }
DI float vmax3(float a, float b, float c) { return __builtin_fmaxf(__builtin_fmaxf(a, b), c); }
DI float xquad_max(float v) {
    u32x2 r = __builtin_amdgcn_permlane16_swap(__float_as_uint(v), __float_as_uint(v), false, false);
    v = vmax(__uint_as_float(r[0]), __uint_as_float(r[1]));
    r = __builtin_amdgcn_permlane32_swap(__float_as_uint(v), __float_as_uint(v), false, false);
    return vmax(__uint_as_float(r[0]), __uint_as_float(r[1]));
}
template <int MM, bool PV, bool CMPHI = false, bool QL = false>
DI void ns_step(const LAS unsigned char* tb  , int kabs, const bf16x8 (&Qf)[4][2], FState& st, unsigned rtm, unsigned sb, int posl, int lod, int fr, int fq, int q, int pp, const LAS bf16_t* qb = nullptr) {
    const int lk = fr * 128 + ((fq ^ (fr & 7)) << 4);
    const int m_ = (4 * fq + q) & 7, vbl = (4 * fq + q) * 128 + ((((pp >> 1) ^ (m_ & 1))) << 4) + (pp & 1) * 8 + ((m_ >> 1) << 5);
    const LAS unsigned char* kp0 = tb + lk; const LAS unsigned char* kp1 = tb + (lk ^ 64); const LAS unsigned char* vp_ = tb + 8192 + vbl;
    asm volatile("" : "+v"(kp0), "+v"(kp1), "+v"(vp_));
    f32x4 s[2][4];
    bf16x8 X[2][2];
#pragma unroll
    for (int kt = 0; kt < 2; ++kt) { X[kt][0] = *(const LAS bf16x8*)(kp0 + kt * 2048); X[kt][1] = *(const LAS bf16x8*)(kp1 + kt * 2048); }
#pragma unroll
    for (int rt = 0; rt < 4; ++rt) if ((rtm >> rt) & 1u) {
        const bf16x8 q0 = QL ? ld_row(qb + (rt * 2 + 0) * 512) : Qf[rt][0], q1 = QL ? ld_row(qb + (rt * 2 + 1) * 512) : Qf[rt][1];
#pragma unroll
        for (int kt = 0; kt < 2; ++kt) { s[kt][rt] = MFMA16(X[kt][0], q0, ((f32x4){0.f, 0.f, 0.f, 0.f})); s[kt][rt] = MFMA16(X[kt][1], q1, s[kt][rt]); }
    }
    bf16x8 Y[4];
#pragma unroll
    for (int rt = 0; rt < 4; ++rt) {
        if ((rtm >> rt) & 1u) {
            if (MM) {
#pragma unroll
                for (int kt = 0; kt < 2; ++kt)
#pragma unroll
                    for (int r = 0; r < 4; ++r) { const int key = kabs + 16 * kt + 4 * fq + r; const int hi_ = CMPHI ? ((posl + 4 * rt - 31) >> 4) : (posl + 4 * rt);
                        const bool ok = MM == 1 ? (key <= hi_) : (key <= hi_ && key > hi_ - lod);
                        s[kt][rt][r] = ok ? s[kt][rt][r] : NS_NINF; }
            }
            const float rowneg = ((sb >> rt) & 1u) ? 0.f : NS_NINF;
            float mx = vmax3(s[0][rt][0], s[0][rt][1], s[0][rt][2]); mx = vmax3(mx, s[0][rt][3], s[1][rt][0]); mx = vmax3(mx, s[1][rt][1], s[1][rt][2]); mx = vmax(mx, s[1][rt][3]);
            mx = vmax(mx + rowneg, st.m[rt]);
            mx = xquad_max(mx);
            const float alpha = fexp2(st.m[rt] - mx); st.m[rt] = mx;
            const float c = rowneg - mx; const f32x2 c2 = (f32x2){c, c};
            f32x2 p[4];
#pragma unroll
            for (int kt = 0; kt < 2; ++kt) { const f32x2 a = (f32x2){s[kt][rt][0], s[kt][rt][1]} + c2, b = (f32x2){s[kt][rt][2], s[kt][rt][3]} + c2;
                p[2 * kt] = (f32x2){fexp2(a[0]), fexp2(a[1])}; p[2 * kt + 1] = (f32x2){fexp2(b[0]), fexp2(b[1])}; }
            const f32x2 ps2 = (p[0] + p[1]) + (p[2] + p[3]);
            st.l[rt] = st.l[rt] * alpha + (ps2[0] + ps2[1]);
            if (PV) {
                if (__ballot(alpha != 1.0f) != 0ull) {
#pragma unroll
                    for (int dt = 0; dt < 4; ++dt) st.o[dt][rt] *= alpha; }
                u32x4 w; w[0] = cvtpk(p[0][0], p[0][1]); w[1] = cvtpk(p[1][0], p[1][1]); w[2] = cvtpk(p[2][0], p[2][1]); w[3] = cvtpk(p[3][0], p[3][1]);
                Y[rt] = __builtin_bit_cast(bf16x8, w);
            }
        } else if (PV) {
            Y[rt] = (bf16x8){0, 0, 0, 0, 0, 0, 0, 0};
        }
    }
    if (PV) {
        const unsigned a0 = (unsigned)(size_t)vp_, a1 = a0 ^ 32u, a2 = a0 ^ 64u, a3 = a0 ^ 96u;
        s16x4 t0, t1, t2, t3, t4, t5, t6, t7;
        asm volatile("ds_read_b64_tr_b16 %0, %8\n\tds_read_b64_tr_b16 %1, %8 offset:2048\n\tds_read_b64_tr_b16 %2, %9\n\tds_read_b64_tr_b16 %3, %9 offset:2048\n\t"
                     "ds_read_b64_tr_b16 %4, %10\n\tds_read_b64_tr_b16 %5, %10 offset:2048\n\tds_read_b64_tr_b16 %6, %11\n\tds_read_b64_tr_b16 %7, %11 offset:2048\n\ts_waitcnt lgkmcnt(0)"
                     : "=&v"(t0), "=&v"(t1), "=&v"(t2), "=&v"(t3), "=&v"(t4), "=&v"(t5), "=&v"(t6), "=&v"(t7) : "v"(a0), "v"(a1), "v"(a2), "v"(a3) : "memory");
        const bf16x8 Xv[4] = {__builtin_shufflevector(t0, t1, 0, 1, 2, 3, 4, 5, 6, 7), __builtin_shufflevector(t2, t3, 0, 1, 2, 3, 4, 5, 6, 7), __builtin_shufflevector(t4, t5, 0, 1, 2, 3, 4, 5, 6, 7), __builtin_shufflevector(t6, t7, 0, 1, 2, 3, 4, 5, 6, 7)};
#pragma unroll
        for (int dt = 0; dt < 4; ++dt)
#pragma unroll
            for (int rt = 0; rt < 4; ++rt) st.o[dt][rt] = MFMA16(Xv[dt], Y[rt], st.o[dt][rt]);
    }
}
DI void ns_reset(FState& st) {
#pragma unroll
    for (int rt = 0; rt < 4; ++rt) { st.m[rt] = -1e30f; st.l[rt] = 0.f;
#pragma unroll
        for (int dt = 0; dt < 4; ++dt) st.o[dt][rt] = (f32x4){0.f, 0.f, 0.f, 0.f}; }
}


DI void ns_vtr8(const LAS unsigned char* vp_, bf16x8 (&Xv)[4]) {
    const unsigned a0 = (unsigned)(size_t)vp_, a1 = a0 ^ 32u, a2 = a0 ^ 64u, a3 = a0 ^ 96u;
    s16x4 t0, t1, t2, t3, t4, t5, t6, t7;
    asm volatile("ds_read_b64_tr_b16 %0, %8\n\tds_read_b64_tr_b16 %1, %8 offset:2048\n\tds_read_b64_tr_b16 %2, %9\n\tds_read_b64_tr_b16 %3, %9 offset:2048\n\t"
                 "ds_read_b64_tr_b16 %4, %10\n\tds_read_b64_tr_b16 %5, %10 offset:2048\n\tds_read_b64_tr_b16 %6, %11\n\tds_read_b64_tr_b16 %7, %11 offset:2048\n\ts_waitcnt lgkmcnt(0)"
                 : "=&v"(t0), "=&v"(t1), "=&v"(t2), "=&v"(t3), "=&v"(t4), "=&v"(t5), "=&v"(t6), "=&v"(t7) : "v"(a0), "v"(a1), "v"(a2), "v"(a3) : "memory");
    Xv[0] = __builtin_shufflevector(t0, t1, 0, 1, 2, 3, 4, 5, 6, 7); Xv[1] = __builtin_shufflevector(t2, t3, 0, 1, 2, 3, 4, 5, 6, 7);
    Xv[2] = __builtin_shufflevector(t4, t5, 0, 1, 2, 3, 4, 5, 6, 7); Xv[3] = __builtin_shufflevector(t6, t7, 0, 1, 2, 3, 4, 5, 6, 7);
}

namespace nsb {
typedef float f32x16 __attribute__((ext_vector_type(16)));
constexpr int NSLOT = 3, SLOTB = 8192, LDS_K = 0, LDS_V = NSLOT * SLOTB, LDS_WS = 2 * NSLOT * SLOTB, LDS_OST = LDS_WS + 8 * 64 * 4, LDS_BYTES = LDS_OST + 8 * 4096;
constexpr int PITCH = 1536;
DI int crow(int r, int hi) { return (r & 3) + 8 * (r >> 2) + 4 * hi; }
#define NSB_SBAR() __builtin_amdgcn_sched_barrier(0)
DI void glds16(const void* sbase_, unsigned voff, unsigned lds_dst) { unsigned keep;
    const unsigned long long a_ = (unsigned long long)sbase_;
    const unsigned long long sbase = ((unsigned long long)(unsigned)__builtin_amdgcn_readfirstlane((int)(a_ >> 32)) << 32) | (unsigned)__builtin_amdgcn_readfirstlane((int)a_);
    asm volatile("s_mov_b32 %0, m0\n\ts_mov_b32 m0, %3\n\ts_nop 0\n\tglobal_load_lds_dwordx4 %1, %2\n\ts_mov_b32 m0, %0" : "=&s"(keep) : "v"(voff), "s"(sbase), "s"(lds_dst) : "memory"); }
DI float max3f(float a, float b, float c) { float r; asm("v_max3_f32 %0, %1, %2, %3" : "=v"(r) : "v"(a), "v"(b), "v"(c)); return r; }
DI float max2f(float a, float b) { float r; asm("v_max_f32_e32 %0, %1, %2" : "=v"(r) : "v"(a), "v"(b)); return r; }
DI float fadd_s(float a, float b) { float r; asm("v_add_f32_e32 %0, %1, %2" : "=v"(r) : "v"(a), "v"(b)); return r; }
DI float fsub_s(float a, float b) { float r; asm("v_sub_f32_e32 %0, %1, %2" : "=v"(r) : "v"(a), "v"(b)); return r; }
#define NSB_WAIT_BAR(N) asm volatile("s_waitcnt vmcnt(" #N ") lgkmcnt(0)\n\ts_barrier" ::: "memory")
typedef LAS const char* lds_cptr;
DI void qkt(f32x16& p0, f32x16& p1, lds_cptr Kslot, const bf16x8* qr, const f32x16& negm, int r32, int hi) {
    lds_cptr kb = Kslot + hi * 1024 + r32 * 16;
#pragma unroll
    for (int d0 = 0; d0 < 4; ++d0) {
        const bf16x8 b0 = *(const LAS bf16x8*)(kb + d0 * 2048), b1 = *(const LAS bf16x8*)(kb + d0 * 2048 + 512);
        if (d0 == 0) { p0 = __builtin_amdgcn_mfma_f32_32x32x16_bf16(b0, qr[0], negm, 0, 0, 0); p1 = __builtin_amdgcn_mfma_f32_32x32x16_bf16(b1, qr[0], negm, 0, 0, 0); }
        else { p0 = __builtin_amdgcn_mfma_f32_32x32x16_bf16(b0, qr[d0], p0, 0, 0, 0); p1 = __builtin_amdgcn_mfma_f32_32x32x16_bf16(b1, qr[d0], p1, 0, 0, 0); } }
}
DI void kload8(bf16x8* kf, lds_cptr kp) {
    kf[0] = *(const LAS bf16x8*)(kp);        kf[1] = *(const LAS bf16x8*)(kp + 512);
    kf[2] = *(const LAS bf16x8*)(kp + 2048); kf[3] = *(const LAS bf16x8*)(kp + 2560);
    kf[4] = *(const LAS bf16x8*)(kp + 4096); kf[5] = *(const LAS bf16x8*)(kp + 4608);
    kf[6] = *(const LAS bf16x8*)(kp + 6144); kf[7] = *(const LAS bf16x8*)(kp + 6656);
}
DI void kload2(bf16x8* kf, lds_cptr kp, int j) { kf[2 * j] = *(const LAS bf16x8*)(kp + j * 2048); kf[2 * j + 1] = *(const LAS bf16x8*)(kp + j * 2048 + 512); }
DI s16x4 vtr(lds_cptr p) { return __builtin_amdgcn_ds_read_tr16_b64_v4i16((LAS s16x4*)p); }
DI float rowmax(const f32x16& p0, const f32x16& p1) {
    float a = max3f(p0[0], p0[1], p1[0]), b = max3f(p0[2], p0[3], p1[1]); a = max3f(a, p1[2], p1[3]);
#pragma unroll
    for (int r = 4; r < 16; r += 4) { a = max3f(a, p0[r], p0[r + 1]); b = max3f(b, p0[r + 2], p0[r + 3]); a = max3f(a, p1[r], p1[r + 1]); b = max3f(b, p1[r + 2], p1[r + 3]); }
    const float m = max2f(a, b);
    auto rr = __builtin_amdgcn_permlane32_swap(__float_as_uint(m), __float_as_uint(m), false, false);
    return max2f(__uint_as_float(rr[0]), __uint_as_float(rr[1]));
}
DI void pv(f32x16* o, int vb, bf16x8 pa0, bf16x8 pa1, bf16x8 pa2, bf16x8 pa3) {
#pragma unroll
    for (int d0 = 0; d0 < 2; ++d0) { s16x4 lo[4], hi[4];
#pragma unroll
        for (int ks = 0; ks < 4; ++ks) {
            asm volatile("ds_read_b64_tr_b16 %0,%1 offset:%c2" : "=&v"(lo[ks]) : "v"(vb), "i"(d0 * 4096 + ks * 1024) : "memory");
            asm volatile("ds_read_b64_tr_b16 %0,%1 offset:%c2" : "=&v"(hi[ks]) : "v"(vb), "i"(d0 * 4096 + ks * 1024 + 512) : "memory"); }
        asm volatile("s_waitcnt lgkmcnt(0)" ::: "memory"); NSB_SBAR();
#define NSB_PK(k) (bf16x8){lo[k][0], lo[k][1], lo[k][2], lo[k][3], hi[k][0], hi[k][1], hi[k][2], hi[k][3]}
        o[d0] = __builtin_amdgcn_mfma_f32_32x32x16_bf16(pa0, NSB_PK(0), o[d0], 0, 0, 0);
        o[d0] = __builtin_amdgcn_mfma_f32_32x32x16_bf16(pa1, NSB_PK(1), o[d0], 0, 0, 0);
        o[d0] = __builtin_amdgcn_mfma_f32_32x32x16_bf16(pa2, NSB_PK(2), o[d0], 0, 0, 0);
        o[d0] = __builtin_amdgcn_mfma_f32_32x32x16_bf16(pa3, NSB_PK(3), o[d0], 0, 0, 0);
#undef NSB_PK
    }
}
DI void tmask(f32x16& p0, f32x16& p1, int mode, int tl, int hi) {
    const float NEG = -__builtin_inff();
#pragma unroll
    for (int r = 0; r < 16; ++r) { const int k0 = crow(r, hi), k1 = k0 + 32;
        const bool m0 = mode == 3 || (mode == 1 ? k0 > tl : (mode == 2 && k0 <= tl)), m1 = mode == 3 || (mode == 1 ? k1 > tl : (mode == 2 && k1 <= tl));
        if (m0) p0[r] = NEG; if (m1) p1[r] = NEG; }
}
template <int THRL, int BR>
DI void unit(const Frame& F, int b, int g, int tok0, const bf16_t* PN, bf16_t* O0, LAS char* shm, const LAS unsigned* selm_tok0, const bool do_store = true) {
    const int lane = F.lane, r32 = lane & 31, hi = lane >> 5, wid = F.wave;
    const long rowbase = (long)b * SEQ; const int jq = tok0 >> 6;
    const int tl = 8 * wid + (r32 >> 2);
    const bf16_t* Qw = PN + (rowbase + tok0 + tl) * PITCH + (g * 4 + (r32 & 3)) * 64;
    const bf16_t* Kh = PN + rowbase * PITCH + 512 + (BR == 1 ? 2 : 4) * 128 + g * 64; const bf16_t* Vh = PN + rowbase * PITCH + 512 + (BR == 1 ? 3 : 5) * 128 + g * 64;
    const unsigned lds0 = (unsigned)(size_t)shm;
    LAS float* wsf = (LAS float*)(shm + LDS_WS) + wid * 64;
    const int NTreal = BR == 1 ? jq + 1 : (jq + 1 < 9 ? jq + 1 : 9);
    int NT = (NTreal + 1) & ~1; if (NT < 4) NT = 4;
#define NSB_TILE(t) (((t) < NTreal) ? (jq - (t)) : 0)
    const bf16_t* ksrc = Kh + wid * 8; const unsigned koff = (unsigned)lane * (PITCH * 2);
    const bf16_t* vsrc = Vh + (long)(16 * (wid & 3)) * PITCH + (wid >> 2) * 32; const unsigned voff = (unsigned)(lane >> 2) * (PITCH * 2) + (lane & 3) * 16;
    const unsigned kdst = lds0 + LDS_K + wid * 1024, vdst = lds0 + LDS_V + wid * 1024;
#define NSB_DMA_K(t, slot) glds16(ksrc + (long)NSB_TILE(t) * 64 * PITCH, koff, (unsigned)__builtin_amdgcn_readfirstlane(kdst + (slot)))
#define NSB_DMA_V(t, slot) glds16(vsrc + (long)NSB_TILE(t) * 64 * PITCH, voff, (unsigned)__builtin_amdgcn_readfirstlane(vdst + (slot)))
    const int vb0 = (int)(lds0 + LDS_V) + ((lane >> 4) & 1) * 32 + (lane & 3) * 8 + (4 * hi + ((lane & 15) >> 2)) * 64;
    const lds_cptr shm3 = (lds_cptr)shm; const lds_cptr Kbase = shm3 + LDS_K; bf16x8 kf[8];
    const lds_cptr kp0 = shm3 + LDS_K + hi * 1024 + r32 * 16; const lds_cptr vp0 = shm3 + LDS_V + ((lane >> 4) & 1) * 32 + (lane & 3) * 8 + (4 * hi + ((lane & 15) >> 2)) * 64;
    NSB_DMA_K(0, 0); NSB_DMA_V(0, 0); NSB_DMA_K(1, SLOTB);
    bf16x8 qr[4];
#pragma unroll
    for (int d0 = 0; d0 < 4; ++d0) qr[d0] = *(const bf16x8*)(Qw + d0 * 16 + hi * 8);
    unsigned selw[4] = {0xFFFFFFFFu, 0xFFFFFFFFu, 0xFFFFFFFFu, 0xFFFFFFFFu};
    if (BR == 1) {
#pragma unroll
        for (int i = 0; i < 4; ++i) selw[i] = selm_tok0[tl * 4 + i]; }
    float mhat = 0.f, l_reg = 0.f; f32x16 o[2]; o[0] = f32x16{}; o[1] = f32x16{}; f32x16 negm = f32x16{}; asm volatile("" : "+v"(negm));
#define NSB_CMASK(P0, P1, t) do { const int t_ = (t); if (t_ == 0) tmask(P0, P1, 1, tl, hi); else if (t_ >= NTreal) tmask(P0, P1, 3, tl, hi); else if (BR == 2 && t_ == 8) tmask(P0, P1, 2, tl, hi); } while (0)
#define NSB_NEGM(t) do { if (BR == 1) { const int j_ = NSB_TILE(t); const unsigned wq_ = (j_ >> 5) == 0 ? selw[0] : ((j_ >> 5) == 1 ? selw[1] : ((j_ >> 5) == 2 ? selw[2] : selw[3])); const float nm_ = ((wq_ >> (j_ & 31)) & 1u) ? -mhat : -__builtin_inff(); \
        _Pragma("unroll") for (int r = 0; r < 16; ++r) negm[r] = nm_; asm volatile("" : "+v"(negm)); } } while (0)
    bool resc = false;
#define NSB_START(P0, P1) do { const float rm = rowmax(P0, P1); resc = false; \
    { const float dl = rm; mhat = fadd_s(mhat, dl); \
      _Pragma("unroll") for (int r = 0; r < 16; ++r) { P0[r] = fsub_s(P0[r], dl); P1[r] = fsub_s(P1[r], dl); } \
      if (BR != 1) { _Pragma("unroll") for (int r = 0; r < 16; ++r) negm[r] = -mhat; asm volatile("" : "+v"(negm)); } } \
    _Pragma("unroll") for (int r = 0; r < 16; ++r) P0[r] = __builtin_amdgcn_exp2f(P0[r]); } while (0)
#define NSB_RESC() do { if (resc) { asm volatile("s_waitcnt lgkmcnt(0)" ::: "memory"); \
      _Pragma("unroll") for (int d_ = 0; d_ < 2; ++d_) _Pragma("unroll") for (int r = 0; r < 16; ++r) o[d_][r] *= wsf[crow(r, hi)]; } } while (0)
    f32x16 pA0, pA1, pB0, pB1;
    int sl_prev = 0, sl_cur = 0, sl_next = SLOTB;
#define NSB_ROT() do { sl_prev = sl_cur; sl_cur = sl_next; sl_next = (sl_next == (NSLOT - 1) * SLOTB) ? 0 : sl_next + SLOTB; } while (0)
    NSB_DMA_K(2, 2 * SLOTB);
    NSB_WAIT_BAR(3);
    qkt(pA0, pA1, Kbase, qr, negm, r32, hi); asm volatile("s_nop 15\n\ts_nop 7" : "+v"(pA0), "+v"(pA1)); NSB_CMASK(pA0, pA1, 0);
    NSB_START(pA0, pA1);
#pragma unroll
    for (int r = 0; r < 16; ++r) pA1[r] = __builtin_amdgcn_exp2f(pA1[r]);
    NSB_WAIT_BAR(0);
    NSB_DMA_K(3, 0); NSB_DMA_V(1, SLOTB);
    NSB_ROT();
    kload8(kf, kp0 + sl_cur);
    NSB_WAIT_BAR(2);
    s16x4 vlo[8], vhi[8]; u32x4 pw0, pw1, pw2, pw3;
#define NSB_PKW(P, B) pack2(P[B], P[B + 1])
#define NSB_PAF(k) __builtin_bit_cast(bf16x8, pw##k)
#define NSB_VFR(i) (bf16x8){vlo[i][0], vlo[i][1], vlo[i][2], vlo[i][3], vhi[i][0], vhi[i][1], vhi[i][2], vhi[i][3]}
#define NSB_PIN(x) asm volatile("" : "+v"(x))
#define NSB_MX3(a, b, c) __builtin_fmaxf(__builtin_fmaxf((a), (b)), (c))
#define NSB_GAPA(MF, A0, A1, A2, A3, W0, W1, PW) do { MF; sacc += A0; sacc += A1; sacc += A2; sacc += A3; NSB_PIN(sacc); W0; W1; NSB_PIN(PW); NSB_SBAR(); } while (0)
#define NSB_EX(v) __builtin_amdgcn_exp2f(v)
#define NSB_GAPB(MF, X, B) do { MF; X[B] = NSB_EX(X[B]); X[B + 1] = NSB_EX(X[B + 1]); X[B + 2] = NSB_EX(X[B + 2]); X[B + 3] = NSB_EX(X[B + 3]); NSB_PIN(X); NSB_SBAR(); } while (0)
#define NSB_VRD(i) do { vlo[i] = vtr(vp_ + (((i) >> 2) * 4096 + ((i) & 3) * 1024)); vhi[i] = vtr(vp_ + (((i) >> 2) * 4096 + ((i) & 3) * 1024 + 512)); } while (0)
#define NSB_KRD(G, j) do { if (G) { kload2(kf, kp0 + sl_next, j); NSB_SBAR(); } } while (0)
#define NSB_STEP(C0, C1, P0, P1, t, GK, GV, GL) do { NSB_SBAR(); \
    const lds_cptr vp_ = vp0 + sl_prev; NSB_NEGM(t); \
    NSB_VRD(0); NSB_SBAR(); float sacc = (P0[0] + P0[1]); \
    NSB_GAPA(C0 = __builtin_amdgcn_mfma_f32_32x32x16_bf16(kf[0], qr[0], negm, 0, 0, 0), P0[2], P0[3], P0[4], P0[5],     pw0[0] = NSB_PKW(P0, 0), pw0[1] = NSB_PKW(P0, 2), pw0); \
    NSB_VRD(4); NSB_SBAR(); NSB_GAPA(C1 = __builtin_amdgcn_mfma_f32_32x32x16_bf16(kf[1], qr[0], negm, 0, 0, 0), P0[6], P0[7], P0[8], P0[9],     pw0[2] = NSB_PKW(P0, 4), pw0[3] = NSB_PKW(P0, 6), pw0); \
    NSB_VRD(1); NSB_SBAR(); NSB_GAPA(C0 = __builtin_amdgcn_mfma_f32_32x32x16_bf16(kf[2], qr[1], C0, 0, 0, 0),   P0[10], P0[11], P0[12], P0[13], pw1[0] = NSB_PKW(P0, 8), pw1[1] = NSB_PKW(P0, 10), pw1); \
    NSB_VRD(5); NSB_SBAR(); NSB_GAPA(C1 = __builtin_amdgcn_mfma_f32_32x32x16_bf16(kf[3], qr[1], C1, 0, 0, 0),   P0[14], P0[15], P1[0], P1[1],   pw1[2] = NSB_PKW(P0, 12), pw1[3] = NSB_PKW(P0, 14), pw1); \
    NSB_VRD(2); NSB_SBAR(); NSB_GAPA(C0 = __builtin_amdgcn_mfma_f32_32x32x16_bf16(kf[4], qr[2], C0, 0, 0, 0),   P1[2], P1[3], P1[4], P1[5],     pw2[0] = NSB_PKW(P1, 0), pw2[1] = NSB_PKW(P1, 2), pw2); \
    NSB_VRD(6); NSB_SBAR(); NSB_GAPA(C1 = __builtin_amdgcn_mfma_f32_32x32x16_bf16(kf[5], qr[2], C1, 0, 0, 0),   P1[6], P1[7], P1[8], P1[9],     pw2[2] = NSB_PKW(P1, 4), pw2[3] = NSB_PKW(P1, 6), pw2); \
    NSB_VRD(3); NSB_SBAR(); NSB_GAPA(C0 = __builtin_amdgcn_mfma_f32_32x32x16_bf16(kf[6], qr[3], C0, 0, 0, 0),   P1[10], P1[11], P1[12], P1[13], pw3[0] = NSB_PKW(P1, 8), pw3[1] = NSB_PKW(P1, 10), pw3); \
    NSB_VRD(7); NSB_SBAR(); NSB_GAPA(C1 = __builtin_amdgcn_mfma_f32_32x32x16_bf16(kf[7], qr[3], C1, 0, 0, 0),   P1[14], P1[15], 0.f, 0.f,       pw3[2] = NSB_PKW(P1, 12), pw3[3] = NSB_PKW(P1, 14), pw3); \
    l_reg += sacc; \
    if (GK) { NSB_DMA_K((t) + 3, sl_cur); } if (GV) { NSB_DMA_V((t) + 1, sl_next); } \
    NSB_CMASK2(C0, C1, t); \
    { float a = NSB_MX3(C0[0], C0[1], C1[0]), b_ = NSB_MX3(C0[2], C0[3], C1[1]); a = NSB_MX3(a, C1[2], C1[3]); \
      _Pragma("unroll") for (int r = 4; r < 16; r += 4) { a = NSB_MX3(a, C0[r], C0[r + 1]); b_ = NSB_MX3(b_, C0[r + 2], C0[r + 3]); a = NSB_MX3(a, C1[r], C1[r + 1]); b_ = NSB_MX3(b_, C1[r + 2], C1[r + 3]); } \
      float rm = __builtin_fmaxf(a, b_); { auto rr = __builtin_amdgcn_permlane32_swap(__float_as_uint(rm), __float_as_uint(rm), false, false); rm = __builtin_fmaxf(__uint_as_float(rr[0]), __uint_as_float(rr[1])); } \
      resc = false; \
      if (__builtin_expect(__any(rm > (float)THRL), 0)) { const float dl = __builtin_fmaxf(rm, 0.f); mhat += dl; \
        _Pragma("unroll") for (int r = 0; r < 16; ++r) { C0[r] -= dl; C1[r] -= dl; } \
        if (BR != 1) { _Pragma("unroll") for (int r = 0; r < 16; ++r) negm[r] = -mhat; asm volatile("" : "+v"(negm)); } \
        const float f = __builtin_amdgcn_exp2f(-dl); l_reg *= f; if (hi == 0) wsf[r32] = f; resc = true; } } \
    NSB_SBAR(); \
    NSB_GAPB(o[0] = __builtin_amdgcn_mfma_f32_32x32x16_bf16(NSB_PAF(0), NSB_VFR(0), o[0], 0, 0, 0), C0, 0); \
    NSB_GAPB(o[1] = __builtin_amdgcn_mfma_f32_32x32x16_bf16(NSB_PAF(0), NSB_VFR(4), o[1], 0, 0, 0), C0, 4); \
    NSB_KRD(GL, 0); NSB_GAPB(o[0] = __builtin_amdgcn_mfma_f32_32x32x16_bf16(NSB_PAF(1), NSB_VFR(1), o[0], 0, 0, 0), C0, 8); \
    NSB_KRD(GL, 1); NSB_GAPB(o[1] = __builtin_amdgcn_mfma_f32_32x32x16_bf16(NSB_PAF(1), NSB_VFR(5), o[1], 0, 0, 0), C0, 12); \
    NSB_KRD(GL, 2); NSB_GAPB(o[0] = __builtin_amdgcn_mfma_f32_32x32x16_bf16(NSB_PAF(2), NSB_VFR(2), o[0], 0, 0, 0), C1, 0); \
    NSB_KRD(GL, 3); NSB_GAPB(o[1] = __builtin_amdgcn_mfma_f32_32x32x16_bf16(NSB_PAF(2), NSB_VFR(6), o[1], 0, 0, 0), C1, 4); \
    NSB_GAPB(o[0] = __builtin_amdgcn_mfma_f32_32x32x16_bf16(NSB_PAF(3), NSB_VFR(3), o[0], 0, 0, 0), C1, 8); \
    NSB_GAPB(o[1] = __builtin_amdgcn_mfma_f32_32x32x16_bf16(NSB_PAF(3), NSB_VFR(7), o[1], 0, 0, 0), C1, 12); \
    } while (0)
    int t = 1;
#define NSB_CMASK2(P0, P1, t) do {} while (0)
    for (; t + 5 < NT; t += 2) {
        NSB_STEP(pB0, pB1, pA0, pA1, t, true, true, true);     NSB_WAIT_BAR(2); NSB_RESC(); NSB_ROT();
        NSB_STEP(pA0, pA1, pB0, pB1, t + 1, true, true, true); NSB_WAIT_BAR(2); NSB_RESC(); NSB_ROT();
    }
#undef NSB_CMASK2
#define NSB_CMASK2(P0, P1, t) NSB_CMASK(P0, P1, t)
#define NSB_ENDW(tt) do { if ((tt) + 3 < NT) { NSB_WAIT_BAR(2); } else if ((tt) + 2 < NT) { NSB_WAIT_BAR(1); } else { NSB_WAIT_BAR(0); } } while (0)
    for (; t + 1 < NT; t += 2) {
        NSB_STEP(pB0, pB1, pA0, pA1, t, (t + 3 < NT), (t + 1 < NT), (t + 1 < NT));         NSB_ENDW(t);     NSB_RESC(); NSB_ROT();
        NSB_STEP(pA0, pA1, pB0, pB1, t + 1, (t + 4 < NT), (t + 2 < NT), (t + 2 < NT));     NSB_ENDW(t + 1); NSB_RESC(); NSB_ROT();
    }
    NSB_STEP(pB0, pB1, pA0, pA1, NT - 1, false, false, false); NSB_RESC();
    { float sacc = pB0[0] + pB0[1];
#pragma unroll
      for (int r = 2; r < 16; ++r) sacc += pB0[r];
#pragma unroll
      for (int r = 0; r < 16; ++r) sacc += pB1[r];
      l_reg += sacc;
      pw0 = (u32x4){NSB_PKW(pB0, 0), NSB_PKW(pB0, 2), NSB_PKW(pB0, 4), NSB_PKW(pB0, 6)}; pw1 = (u32x4){NSB_PKW(pB0, 8), NSB_PKW(pB0, 10), NSB_PKW(pB0, 12), NSB_PKW(pB0, 14)};
      pw2 = (u32x4){NSB_PKW(pB1, 0), NSB_PKW(pB1, 2), NSB_PKW(pB1, 4), NSB_PKW(pB1, 6)}; pw3 = (u32x4){NSB_PKW(pB1, 8), NSB_PKW(pB1, 10), NSB_PKW(pB1, 12), NSB_PKW(pB1, 14)};
      NSB_SBAR(); pv(o, vb0 + sl_cur, NSB_PAF(0), NSB_PAF(1), NSB_PAF(2), NSB_PAF(3)); }
    { auto rr = __builtin_amdgcn_permlane32_swap(__float_as_uint(l_reg), __float_as_uint(l_reg), false, false); l_reg = __uint_as_float(rr[0]) + __uint_as_float(rr[1]); }
    const int lane2 = lane_id(), r32b = lane2 & 31, hib = lane2 >> 5;
    if (hib == 0) { const float gt = sigmoidf_(bf2f(PN[(rowbase + tok0 + 8 * wid + (r32b >> 2)) * PITCH + 1280 + BR * 8 + g * 4 + (r32b & 3)])); wsf[32 + r32b] = l_reg > 0.f ? gt * rcpf_(l_reg) : 0.f; }
    asm volatile("s_waitcnt lgkmcnt(0)" ::: "memory");
    float rli[16];
#pragma unroll
    for (int r = 0; r < 16; ++r) rli[r] = wsf[32 + crow(r, hib)];
    { LAS bf16_t* stg = (LAS bf16_t*)(shm + LDS_OST) + wid * 2048;
#pragma unroll
      for (int r = 0; r < 16; ++r) { const int orow = crow(r, hib);
#pragma unroll
          for (int d0 = 0; d0 < 2; ++d0) stg[orow * 64 + d0 * 32 + r32b] = f2bf(o[d0][r] * rli[r]); }
      asm volatile("s_waitcnt lgkmcnt(0)" ::: "memory");
#pragma unroll
      for (int i = 0; i < 4; ++i) { const int row = i * 8 + (lane2 >> 3), ch = lane2 & 7; const u32x4 v = *(const LAS u32x4*)(stg + row * 64 + ch * 8);
          bf16_t* op = O0 + (rowbase + tok0 + 8 * wid + (row >> 2)) * 1024 + 512 + (g * 4 + (row & 3)) * 64 + ch * 8;
          if (do_store) { float a8[8], b8[8]; unpack8(*(const u32x4*)op, a8); unpack8(v, b8);
#pragma unroll
              for (int e = 0; e < 8; ++e) a8[e] += b8[e];
              *(u32x4*)op = pack8(a8); }
          else asm volatile("" :: "v"(v)); } }
    asm volatile("s_waitcnt vmcnt(0) lgkmcnt(0)\n\ts_barrier" ::: "memory");
#undef NSB_TILE
#undef NSB_DMA_K
#undef NSB_DMA_V
#undef NSB_CMASK
#undef NSB_CMASK2
#undef NSB_NEGM
#undef NSB_START
#undef NSB_RESC
#undef NSB_ROT
#undef NSB_PKW
#undef NSB_PAF
#undef NSB_VFR
#undef NSB_PIN
#undef NSB_MX3
#undef NSB_GAPA
#undef NSB_GAPB
#undef NSB_EX
#undef NSB_VRD
#undef NSB_KRD
#undef NSB_STEP
#undef NSB_ENDW
}
#undef NSB_SBAR
#undef NSB_WAIT_BAR
}

DI void nsa_unit(const Frame& F0, int unit, const int mode = 0x3F) {
    Frame F = F0; F.tid = F.wave * 64 + lane_id(); asm volatile("" : "+v"(F.tid)); F.lane = F.tid & 63;
    const int qt = 63 - (unit >> 4), b = (unit >> 1) & 7, g = unit & 1;
    const int t0 = qt * 128, tw = t0 + 16 * F.wave;
    const size_t tokb = (size_t)b * SEQ;
    const int lane = F.lane, fr = lane & 15, fq = lane >> 4, q = fr >> 2, pp = lane & 3;
    const bf16_t* PN = (const bf16_t*)(F.ws + OFF_PN);
    LAS float* imp = (LAS float*)(F.lds + NS_OFF_IMP); LAS unsigned* selm = (LAS unsigned*)(F.lds + NS_OFF_SEL);
    const int hd = fr & 3, posl = tw + (fr >> 2);
    bf16x8 Qf[4][2];
#pragma unroll
    for (int rt = 0; rt < 4; ++rt)
#pragma unroll
        for (int ks = 0; ks < 2; ++ks) { float v[8]; unpack8(*(const u32x4*)(PN + (tokb + posl + 4 * rt) * 1536 + (g * 4 + hd) * 64 + 32 * ks + 8 * fq), v);
            u32x4 w; w[0] = cvtpk(v[0], v[1]); w[1] = cvtpk(v[2], v[3]); w[2] = cvtpk(v[4], v[5]); w[3] = cvtpk(v[6], v[7]);
            Qf[rt][ks] = __builtin_bit_cast(bf16x8, w); }
    __syncthreads();
    for (int i = F.tid; i < 128 * 128; i += NTH) imp[i] = 0.f;
    FState st;
    bf16_t* O0 = (bf16_t*)(F.ws + OFF_O0);
    if (mode & 1) {
        TileSrc S{(const bf16_t*)(F.ws + SM_KCMP) + ((size_t)b * 512 * 2 + g) * 64, (const bf16_t*)(F.ws + SM_VCMPT) + ((size_t)b * 512 * 2 + g) * 64, 128};
        int nmax = (t0 + 96) >> 4; if (nmax > 510) nmax = 510;
        const int ntl = (nmax >> 6) + 1;
        const int nfull = (tw - 31) >> 4;
        ns_reset(st);
        asm volatile("s_waitcnt vmcnt(0)" ::: "memory"); __syncthreads();
        for (int p_ = 0; p_ < 3 && p_ < ntl; ++p_) ns_dma(F, S, p_, p_);
#pragma unroll 1
        for (int j = 0; j < ntl; ++j) {
            ns_wait(ntl - 1 - j);
            if (j + 3 < ntl) ns_dma(F, S, j + 3, (j + 3) & 3);
            const LAS unsigned char* tb0 = F.lds + (j & 3) * NS_STG;
#pragma unroll 1
            for (int koff = 0; koff < 64; koff += 32) {
                const int nb = j * 64 + koff;
                if (16 * nb + 31 > tw + 15) continue;
                if (nb + 31 <= nfull) ns_step<0, false, true>(tb0 + koff * 128, nb, Qf, st, 0xFu, 0xFu, posl, 0, fr, fq, q, pp);
                else ns_step<1, false, true>(tb0 + koff * 128, nb, Qf, st, 0xFu, 0xFu, posl, 0, fr, fq, q, pp);
            }
        }
        float il[4];
#pragma unroll
        for (int rt = 0; rt < 4; ++rt) { float l = st.l[rt]; l += shx(l, 16); l += shx(l, 32); il[rt] = l > 0.f ? rcpf_(l) : 0.f; }
        __syncthreads();
        float carry[4] = {0.f, 0.f, 0.f, 0.f}; const int bpa = ((lane + 48) & 63) << 2;
        for (int p_ = 0; p_ < 3 && p_ < ntl; ++p_) ns_dma(F, S, p_, p_);
#pragma unroll 1
        for (int j = 0; j < ntl; ++j) {
            ns_wait(ntl - 1 - j);
            if (j + 3 < ntl) ns_dma(F, S, j + 3, (j + 3) & 3);
            const LAS unsigned char* tb0 = F.lds + (j & 3) * NS_STG;
#pragma unroll 1
            for (int koff = 0; koff < 64; koff += 32) {
                const int nb = j * 64 + koff;
                if (16 * nb + 31 > tw + 15) continue;
                const LAS unsigned char* tb = tb0 + koff * 128;
                const int lk = fr * 128 + ((fq ^ (fr & 7)) << 4);
                const int m_ = (4 * fq + q) & 7, vbl = (4 * fq + q) * 128 + ((((pp >> 1) ^ (m_ & 1))) << 4) + (pp & 1) * 8 + ((m_ >> 1) << 5);
                const LAS unsigned char* kp0 = tb + lk; const LAS unsigned char* kp1 = tb + (lk ^ 64); const LAS unsigned char* vp_ = tb + 8192 + vbl;
                asm volatile("" : "+v"(kp0), "+v"(kp1), "+v"(vp_));
                f32x4 s[2][4];
#pragma unroll
                for (int rt = 0; rt < 4; ++rt) { s[0][rt] = (f32x4){0.f, 0.f, 0.f, 0.f}; s[1][rt] = s[0][rt]; }
#pragma unroll
                for (int ks = 0; ks < 2; ++ks)
#pragma unroll
                    for (int kt = 0; kt < 2; ++kt) { const bf16x8 X = *(const LAS bf16x8*)((ks ? kp1 : kp0) + kt * 2048);
#pragma unroll
                        for (int rt = 0; rt < 4; ++rt) s[kt][rt] = MFMA16(X, Qf[rt][ks], s[kt][rt]); }
                bf16x8 Y[4];
#pragma unroll
                for (int rt = 0; rt < 4; ++rt) {
#pragma unroll
                    for (int kt = 0; kt < 2; ++kt) {
#pragma unroll
                        for (int r = 0; r < 4; ++r) { const int n = nb + 16 * kt + 4 * fq + r; s[kt][rt][r] = (n <= ((posl + 4 * rt - 31) >> 4)) ? fexp2(s[kt][rt][r] - st.m[rt]) * il[rt] : 0.f; }
                        float a = s[kt][rt][0] + s[kt][rt][1] + s[kt][rt][2] + 0.5f * s[kt][rt][3], bb = 0.5f * s[kt][rt][3];
                        a += dpp_mov<0xB1>(a); a += dpp_mov<0x4E>(a); bb += dpp_mov<0xB1>(bb); bb += dpp_mov<0x4E>(bb);
                        const float pull = __int_as_float(__builtin_amdgcn_ds_bpermute(bpa, __float_as_int(bb)));
                        const float val = a + (fq > 0 ? pull : carry[rt]); carry[rt] = pull;
                        if (hd == 0) { const int jj = (nb >> 2) + 4 * kt + fq; const int tl = 16 * F.wave + 4 * rt + (fr >> 2);
                            asm volatile("ds_write_b32 %0, %1" :: "v"((unsigned)(size_t)imp + (unsigned)(tl * 128 + jj) * 4u), "v"(val) : "memory"); }
                    }
                    u32x4 w; w[0] = cvtpk(s[0][rt][0], s[0][rt][1]); w[1] = cvtpk(s[0][rt][2], s[0][rt][3]); w[2] = cvtpk(s[1][rt][0], s[1][rt][1]); w[3] = cvtpk(s[1][rt][2], s[1][rt][3]);
                    Y[rt] = __builtin_bit_cast(bf16x8, w);
                }
                bf16x8 Xv[4]; ns_vtr8(vp_, Xv);
#pragma unroll
                for (int dt = 0; dt < 4; ++dt)
#pragma unroll
                    for (int rt = 0; rt < 4; ++rt) st.o[dt][rt] = MFMA16(Xv[dt], Y[rt], st.o[dt][rt]);
            }
        }
        int pl_ = posl; asm volatile("" : "+v"(pl_));
#pragma unroll
        for (int rt = 0; rt < 4; ++rt) { const float gt = sigmoidf_(bf2f(PN[(tokb + pl_ + 4 * rt) * 1536 + 1280 + 0 * 8 + g * 4 + hd]));
#pragma unroll
            for (int dt = 0; dt < 4; ++dt) { const f32x4 v = st.o[dt][rt] * gt; u32x2 o; o[0] = cvtpk(v[0], v[1]); o[1] = cvtpk(v[2], v[3]);
                if (mode & 16) *(u32x2*)(O0 + (tokb + pl_ + 4 * rt) * 1024 + 512 + (g * 4 + hd) * 64 + 16 * dt + 4 * fq) = o; } }
    }
    __syncthreads();
    {
        const int cur = tw >> 6; const int j0 = lane, j1 = lane + 64;
        const bool c0 = j0 >= 1 && j0 <= cur - 2, c1 = j1 <= cur - 2;
#pragma unroll 1
        for (int tl0 = 0; tl0 < ((mode & 2) ? 16 : 0); tl0 += 4) {
            bool s0[4], s1[4];
            if (cur < 16) {
#pragma unroll
                for (int i = 0; i < 4; ++i) { s0[i] = j0 <= cur; s1[i] = false; }
            } else {
                unsigned v0[4], v1[4], thr[4]; bool ex[4];
#pragma unroll
                for (int i = 0; i < 4; ++i) { const int tg = 16 * F.wave + tl0 + i;
                    v0[i] = c0 ? __float_as_uint(imp[tg * 128 + j0]) : 0u; v1[i] = c1 ? __float_as_uint(imp[tg * 128 + j1]) : 0u;
                    thr[i] = 0u; ex[i] = false; }
#pragma unroll 1
                for (int bit = 30; bit >= 0; --bit) {
#pragma unroll
                    for (int i = 0; i < 4; ++i) {
                        const unsigned cand = thr[i] | (1u << bit);
                        const int cnt = __popcll(__ballot(v0[i] >= cand)) + __popcll(__ballot(v1[i] >= cand));
                        thr[i] = (!ex[i] && cnt >= 13) ? cand : thr[i]; ex[i] = ex[i] || cnt == 13;
                    }
                    if (ex[0] && ex[1] && ex[2] && ex[3]) break;
                }
#pragma unroll
                for (int i = 0; i < 4; ++i) {
                    if (ex[i]) { s0[i] = c0 && v0[i] >= thr[i]; s1[i] = c1 && v1[i] >= thr[i]; }
                    else {
                        const unsigned long long g0 = __ballot(c0 && v0[i] > thr[i]), g1 = __ballot(c1 && v1[i] > thr[i]), e0 = __ballot(c0 && v0[i] == thr[i]), e1 = __ballot(c1 && v1[i] == thr[i]);
                        const int need = 13 - __popcll(g0) - __popcll(g1);
                        const unsigned long long lt = (1ull << lane) - 1ull;
                        s0[i] = c0 && (v0[i] > thr[i] || (v0[i] == thr[i] && __popcll(e0 & lt) < need));
                        s1[i] = c1 && (v1[i] > thr[i] || (v1[i] == thr[i] && __popcll(e0) + __popcll(e1 & lt) < need));
                    }
                    s0[i] = s0[i] || j0 == 0 || j0 == cur - 1 || j0 == cur; s1[i] = s1[i] || j1 == cur - 1 || j1 == cur;
                }
            }
#pragma unroll
            for (int i = 0; i < 4; ++i) { const int tg = 16 * F.wave + tl0 + i;
                const unsigned long long m0 = __ballot(s0[i]), m1 = __ballot(s1[i]);
                if (lane == 0) { selm[tg * 4 + 0] = (unsigned)m0; selm[tg * 4 + 1] = (unsigned)(m0 >> 32); selm[tg * 4 + 2] = (unsigned)m1; selm[tg * 4 + 3] = (unsigned)(m1 >> 32); } }
        }
    }
    __syncthreads();
    if (mode & 4) {
#pragma unroll 1
        for (int half = 0; half < 2; ++half) {
            nsb::unit<8, 1>(F, b, g, t0 + 64 * half, PN, O0, (LAS char*)F.lds, selm + 64 * half * 4, (mode & 16) != 0);
            if (mode & 8) nsb::unit<8, 2>(F, b, g, t0 + 64 * half, PN, O0, (LAS char*)F.lds, selm, (mode & 16) != 0);
        }
    }
}
DI void nsa_phase(const Frame& F0, int qi = 0, const int mode = 0x3F) {
    Frame F = F0; F.tid = F.wave * 64 + lane_id(); F.lane = F.tid & 63;
    LAS int* uw = (LAS int*)(F.lds + NS_OFF_U);
    unsigned* qh = (unsigned*)(F.ws + CTL_Q) + 64 * qi;
    for (;;) {
        __syncthreads();
        if (F.tid == 0) *uw = (int)__hip_atomic_fetch_add(qh, 1u, __ATOMIC_RELAXED, __HIP_MEMORY_SCOPE_AGENT);
        __syncthreads();
        const int u = *uw;
        if (u >= 1024) break;
        nsa_unit(F, u, mode);
    }
}

__global__ void __launch_bounds__(NTH, 2) fwd_kernel(Args args) {
    extern __shared__ __attribute__((aligned(16))) unsigned char lds_raw[];
    Frame F;
    F.lds = (LAS unsigned char*)lds_raw + LDS_SCR; F.tid = threadIdx.x; F.lane = F.tid & 63; F.wave = __builtin_amdgcn_readfirstlane(F.tid >> 6); F.wg = blockIdx.x;
    F.ws = args.ws; F.out = args.out; F.in = args.in;
    volatile LAS unsigned* misc = (volatile LAS unsigned*)((LAS unsigned char*)lds_raw);
    if (F.tid < 64) misc[F.tid] = 0u;
    __syncthreads();
    XcdBarrier bar = xcd_barrier_post((unsigned*)(F.ws + CTL_BAR), misc);
    LAS int* tile_start = (LAS int*)((LAS unsigned char*)lds_raw + 256);
    const int lo = args.ph_lo, hi = args.ph_hi;
#define IN(k) (lo <= (k) && (k) < hi)
#define SEAM(k) do { if (IN(k) && IN((k) + 1)) xcd_barrier(bar); } while (0)
    const float* ln = F.in[27];

    if (IN(0)) {
        tr_job(F, F.in[1], 3352, 1024, 3352, 3584, (bf16_t*)(F.ws + W_IN0), 1024, 0);
        tr_job(F, F.in[2], 1024, 1024, 1024, 1024, (bf16_t*)(F.ws + W_OUT0), 1024, 0);
        {
          const float* x = F.in[0]; bf16_t* xb = (bf16_t*)(F.ws + OFF_XB);
          for (size_t i0 = (size_t)F.wg * NTH + F.tid; i0 < (size_t)T * D / 8; i0 += (size_t)GRID * NTH * 4) {
              f32x4 a[4], b[4];
#pragma unroll
              for (int k = 0; k < 4; ++k) { const size_t i = i0 + (size_t)k * GRID * NTH; a[k] = *(const f32x4*)(x + i * 8); b[k] = *(const f32x4*)(x + i * 8 + 4); }
#pragma unroll
              for (int k = 0; k < 4; ++k) { const size_t i = i0 + (size_t)k * GRID * NTH; u32x4 o; o[0] = pack2(a[k][0], a[k][1]); o[1] = pack2(a[k][2], a[k][3]); o[2] = pack2(b[k][0], b[k][1]); o[3] = pack2(b[k][2], b[k][3]);
                  *(u32x4*)(xb + i * 8) = o; } } }
        {
          bf16_t* wl1 = (bf16_t*)(F.ws + W_L1); const float* mu = F.in[3];
          for (int i = F.wg * NTH + F.tid; i < 256 * 1024; i += GRID * NTH) { const int n = i >> 10, k = i & 1023, kk = k & 511;
              const int which = n < 64 ? 0 : (n < 128 ? 1 : 2); const int j = n - (which == 0 ? 0 : (which == 1 ? 64 : 128));
              const float* X1 = which == 0 ? F.in[5] : (which == 1 ? F.in[8] : F.in[10]); const int ldx = which == 2 ? 128 : 64;
              const float m = mu[(3 + which) * 512 + kk]; wl1[i] = f2bf((k < 512 ? (1.0f - m) : m) * X1[kk * ldx + j]); }
          bf16_t* wl2 = (bf16_t*)(F.ws + W_L2);
          for (int i = F.wg * NTH + F.tid; i < 1536 * 256; i += GRID * NTH) { const int n = i >> 8, k = i & 255; float v = 0.f;
              if (n < 512) { if (k < 64) v = F.in[6][k * 512 + n]; } else if (n < 1024) { if (k >= 64 && k < 128) v = F.in[9][(k - 64) * 512 + n - 512]; } else { if (k >= 128) v = F.in[11][(k - 128) * 512 + n - 1024]; }
              wl2[i] = f2bf(v); }
          bf16_t* pr = (bf16_t*)(F.ws + OFF_PR);
          for (int i = F.wg * NTH + F.tid; i < 8 * 2048; i += GRID * NTH) pr[(size_t)(i >> 11) * 8193 * 2048 + (i & 2047)] = 0; }
        tr_job(F, F.in[17], 128, 2048, 128, 256, (bf16_t*)(F.ws + W_C1), 2048, 0);
        tr_job(F, F.in[17] + 2048 * 128, 128, 2048, 128, 256, (bf16_t*)(F.ws + W_C1) + 256 * 2048, 2048, 0);
        {
          bf16_t* wc2 = (bf16_t*)(F.ws + W_C2);
          for (int i = F.wg * NTH + F.tid; i < 2 * 256 * 256; i += GRID * NTH) { const int kv = i >> 16, n = (i >> 8) & 255, k = i & 255;
              wc2[i] = f2bf((n < 64 && k < 128) ? F.in[18][(size_t)kv * 128 * 64 + k * 64 + n] : 0.f); }
          float* cb = (float*)(F.ws + SM_CBIAS);
          { const int i = F.wg * 8 + F.wave; if (i < 512) { const int kv = i >> 8, n = i & 255; float acc = 0.f;
              if (n < 128) { for (int k = F.tid & 63; k < 2048; k += 64) acc += F.in[16][kv * 2048 + k] * F.in[17][((size_t)kv * 2048 + k) * 128 + n]; acc = wave_sum(acc); }
              if ((F.tid & 63) == 0) cb[i] = acc; } }
          float* rn = (float*)(F.ws + SM_ROPEN);
          for (int i = F.wg * NTH + F.tid; i < 8192 * 8; i += GRID * NTH) { const int p = i >> 3, k = i & 7;
              const double ang = (double)p * exp(-13.122363377404328 * (double)k / 8.0); rn[2 * i] = (float)cos(ang); rn[2 * i + 1] = (float)sin(ang); } }
        tr_job(F, F.in[19], 6144, 1024, 6144, 6144, (bf16_t*)(F.ws + W_RTIN), 1024, 3, RTI8 ? F8_SW : 0.f);
        tr_job(F, F.in[20], 1024, 2048, 1024, 1024, (bf16_t*)(F.ws + W_RTOUT), 2048, 0, RTO8 ? F8_SWO : 0.f);
        __syncthreads();
    }
    SEAM(0);
#if PROBE == 11
    {
        tr_job(F, F.in[1], 3352, 1024, 3352, 3584, (bf16_t*)(F.ws + W_IN0), 1024, 0);
        tr_job(F, F.in[2], 1024, 1024, 1024, 1024, (bf16_t*)(F.ws + W_OUT0), 1024, 0);
        {
          const float* x = F.in[0]; bf16_t* xb = (bf16_t*)(F.ws + OFF_XB);
          for (size_t i0 = (size_t)F.wg * NTH + F.tid; i0 < (size_t)T * D / 8; i0 += (size_t)GRID * NTH * 4) {
              f32x4 a[4], b[4];
#pragma unroll
              for (int k = 0; k < 4; ++k) { const size_t i = i0 + (size_t)k * GRID * NTH; a[k] = *(const f32x4*)(x + i * 8); b[k] = *(const f32x4*)(x + i * 8 + 4); }
#pragma unroll
              for (int k = 0; k < 4; ++k) { const size_t i = i0 + (size_t)k * GRID * NTH; u32x4 o; o[0] = pack2(a[k][0], a[k][1]); o[1] = pack2(a[k][2], a[k][3]); o[2] = pack2(b[k][0], b[k][1]); o[3] = pack2(b[k][2], b[k][3]);
                  *(u32x4*)(xb + i * 8) = o; } } }
        {
          bf16_t* wl1 = (bf16_t*)(F.ws + W_L1); const float* mu = F.in[3];
          for (int i = F.wg * NTH + F.tid; i < 256 * 1024; i += GRID * NTH) { const int n = i >> 10, k = i & 1023, kk = k & 511;
              const int which = n < 64 ? 0 : (n < 128 ? 1 : 2); const int j = n - (which == 0 ? 0 : (which == 1 ? 64 : 128));
              const float* X1 = which == 0 ? F.in[5] : (which == 1 ? F.in[8] : F.in[10]); const int ldx = which == 2 ? 128 : 64;
              const float m = mu[(3 + which) * 512 + kk]; wl1[i] = f2bf((k < 512 ? (1.0f - m) : m) * X1[kk * ldx + j]); }
          bf16_t* wl2 = (bf16_t*)(F.ws + W_L2);
          for (int i = F.wg * NTH + F.tid; i < 1536 * 256; i += GRID * NTH) { const int n = i >> 8, k = i & 255; float v = 0.f;
              if (n < 512) { if (k < 64) v = F.in[6][k * 512 + n]; } else if (n < 1024) { if (k >= 64 && k < 128) v = F.in[9][(k - 64) * 512 + n - 512]; } else { if (k >= 128) v = F.in[11][(k - 128) * 512 + n - 1024]; }
              wl2[i] = f2bf(v); }
          bf16_t* pr = (bf16_t*)(F.ws + OFF_PR);
          for (int i = F.wg * NTH + F.tid; i < 8 * 2048; i += GRID * NTH) pr[(size_t)(i >> 11) * 8193 * 2048 + (i & 2047)] = 0; }
        tr_job(F, F.in[17], 128, 2048, 128, 256, (bf16_t*)(F.ws + W_C1), 2048, 0);
        tr_job(F, F.in[17] + 2048 * 128, 128, 2048, 128, 256, (bf16_t*)(F.ws + W_C1) + 256 * 2048, 2048, 0);
        {
          bf16_t* wc2 = (bf16_t*)(F.ws + W_C2);
          for (int i = F.wg * NTH + F.tid; i < 2 * 256 * 256; i += GRID * NTH) { const int kv = i >> 16, n = (i >> 8) & 255, k = i & 255;
              wc2[i] = f2bf((n < 64 && k < 128) ? F.in[18][(size_t)kv * 128 * 64 + k * 64 + n] : 0.f); }
          float* cb = (float*)(F.ws + SM_CBIAS);
          { const int i = F.wg * 8 + F.wave; if (i < 512) { const int kv = i >> 8, n = i & 255; float acc = 0.f;
              if (n < 128) { for (int k = F.tid & 63; k < 2048; k += 64) acc += F.in[16][kv * 2048 + k] * F.in[17][((size_t)kv * 2048 + k) * 128 + n]; acc = wave_sum(acc); }
              if ((F.tid & 63) == 0) cb[i] = acc; } }
          float* rn = (float*)(F.ws + SM_ROPEN);
          for (int i = F.wg * NTH + F.tid; i < 8192 * 8; i += GRID * NTH) { const int p = i >> 3, k = i & 7;
              const double ang = (double)p * exp(-13.122363377404328 * (double)k / 8.0); rn[2 * i] = (float)cos(ang); rn[2 * i + 1] = (float)sin(ang); } }
        tr_job(F, F.in[19], 6144, 1024, 6144, 6144, (bf16_t*)(F.ws + W_RTIN), 1024, 3, RTI8 ? F8_SW : 0.f);
        tr_job(F, F.in[20], 1024, 2048, 1024, 1024, (bf16_t*)(F.ws + W_RTOUT), 2048, 0, RTO8 ? F8_SWO : 0.f);
        __syncthreads();
        { float* rr = (float*)(F.ws + SM_ROPER);
          for (int i = F.wg * NTH + F.tid; i < 8192 * 64; i += GRID * NTH) { const int p = i >> 6, k = i & 63;
              const double ang = (double)p * exp(-9.210340371976184 * (double)k / 63.0); rr[2 * i] = (float)cos(ang); rr[2 * i + 1] = (float)sin(ang); } }
    }
    xcd_barrier(bar);
#endif
    if (IN(1)) {
        pg8::GemmK g{1024, 1024, 1024, 128, 1 << 30, 0};
        pg8::DenseSched S; S.init(F.ws + OFF_XB, 1024, F.ws + W_IN0, 1024, T, 3584, GRID, F.wg);
        bf16_t* PR = (bf16_t*)(F.ws + OFF_PR); bf16_t* PN = (bf16_t*)(F.ws + OFF_PN);
        auto f = [PR, PN](const pg8::Unit&, int row, int col, const float (&v)[8]) {
            if (col < 2048) store8(PR + ((size_t)row + (row >> 13) + 1) * 2048 + col, v);
            else if (col < 2560) { float o[8];
#pragma unroll
                for (int i = 0; i < 8; ++i) o[i] = v[i] * NS_C;
                store8(PN + (size_t)row * 1536 + (col - 2048), o); }
            else store8(PN + (size_t)row * 1536 + (col - 2048), v); };
        pg8::EpiRow8<decltype(f)> E{f};
        pg8::gemm_phase(F.lds, F.wave, g, S, E);
    }
    SEAM(1);
#if PROBE == 6
    {
        pg8::GemmK g{1024, 1024, 1024, 128, 1 << 30, 0};
        pg8::DenseSched S; S.init(F.ws + OFF_XB, 1024, F.ws + W_IN0, 1024, T, 3584, GRID, F.wg);
        bf16_t* PR = (bf16_t*)(F.ws + OFF_PR); bf16_t* PN = (bf16_t*)(F.ws + OFF_PN);
        auto f = [PR, PN](const pg8::Unit&, int row, int col, const float (&v)[8]) {
            if (col < 2048) store8(PR + ((size_t)row + (row >> 13) + 1) * 2048 + col, v);
            else if (col < 2560) { float o[8];
#pragma unroll
                for (int i = 0; i < 8; ++i) o[i] = v[i] * NS_C;
                store8(PN + (size_t)row * 1536 + (col - 2048), o); }
            else store8(PN + (size_t)row * 1536 + (col - 2048), v); };
        pg8::EpiRow8<decltype(f)> E{f};
        pg8::gemm_phase(F.lds, F.wave, g, S, E);
        xcd_barrier(bar);
    }
#endif
    if (IN(2)) {
        rwkv_e1_phase(F);
        nsa_rope_phase(F);
        pg8::GemmK g{2048, 1024, 1024, 128, 8, -5120};
        pg8::DenseSched S; S.init(F.ws + OFF_PR + 1536 * 2, 2048, F.ws + W_L1, 1024, T, 256, GRID, F.wg, 1);
        bf16_t* HID = (bf16_t*)(F.ws + OFF_O0) + 512;
        auto f = [HID](const pg8::Unit&, int row, int col, const float (&v)[8]) {
            float o[8];
#pragma unroll
            for (int i = 0; i < 8; ++i) o[i] = col < 64 ? tanhf_(v[i]) : (col < 128 ? v[i] : sigmoidf_(v[i]));
            store8(HID + (size_t)row * 1024 + col, o); };
        pg8::EpiRow8<decltype(f)> E{f};
        pg8::gemm_phase(F.lds, F.wave, g, S, E);
    }
    SEAM(2);
    if (IN(3) && F.wg >= 64) {
        pg8::GemmK g{1024, 256, 256, 128, 1 << 30, 0};
        pg8::DenseSched S; S.init(F.ws + OFF_O0 + 512 * 2, 1024, F.ws + W_L2, 256, T, 1536, GRID - 64, F.wg - 64);
        bf16_t* SW = st_w(F); bf16_t* SKK = st_kk(F); bf16_t* SB = st_b(F); bf16_t* SKP = st_kp(F); bf16_t* O0 = (bf16_t*)(F.ws + OFF_O0);
        const float* w0 = F.in[4]; const float* a0 = F.in[7]; const float* kkw = F.in[12]; const float* kaw = F.in[13]; const float* rn = (const float*)(F.ws + SM_RNORM);
        auto f = [=](const pg8::Unit&, int row, int col, const float (&v)[8]) {
            float o[8];
            if (col < 512) {
#pragma unroll
                for (int i = 0; i < 8; ++i) o[i] = __builtin_amdgcn_exp2f(-0.606531f * 1.44269504088896341f * sigmoidf_(w0[col + i] + v[i]));
                store8(SW + (size_t)row * 512 + col, o);
            } else if (col < 1024) {
                const int c = col - 512; float k[8], kk[8], bb[8];
                unpack8(*(const u32x4*)(SKP + (size_t)row * 512 + c), k);
                const float r = rn[(size_t)row * 8 + (c >> 6)];
#pragma unroll
                for (int i = 0; i < 8; ++i) { const float a = sigmoidf_(a0[c + i] + v[i]); kk[i] = k[i] * kkw[c + i] * r; bb[i] = kk[i] * a; o[i] = k[i] * (1.0f + (a - 1.0f) * kaw[c + i]); }
                store8(SKK + (size_t)row * 512 + c, kk); store8(SB + (size_t)row * 512 + c, bb); store8(SKP + (size_t)row * 512 + c, o);
            } else {
                store8(O0 + (size_t)row * 1024 + (col - 1024), v);
            } };
        pg8::EpiRow8<decltype(f)> E{f};
        pg8::gemm_phase(F.lds, F.wave, g, S, E);
    }
    if (IN(3)) {
        pg8::GemmK g{16 * 1536, 2048, 2048, 1536 * 2, 1 << 30, 0};
        pg8::CmpSched S{(const char*)(F.ws + OFF_PN + 512 * 2), (const char*)(F.ws + W_C1), (size_t)128, (size_t)256 * 16 * 1536 * 2, (size_t)256 * 2048 * 2, GRID, F.wg};
        bf16_t* HC = (bf16_t*)(F.ws + OFF_HC); const float* cb = (const float*)(F.ws + SM_CBIAS);
        auto f = [HC, cb](const pg8::Unit& u, int row, int col, const float (&v)[8]) {
            float o[8];
#pragma unroll
            for (int i = 0; i < 8; ++i) { const float x = v[i] + cb[(u.aux >> 1) * 256 + col + i]; o[i] = 0.5f * x * (1.0f + tanhf(0.7978845608028654f * (x + 0.044715f * x * x * x))); }
            store8(HC + ((size_t)u.aux * 4096 + row) * 256 + col, o); };
        pg8::EpiRow8<decltype(f)> E{f};
        pg8::gemm_phase(F.lds, F.wave, g, S, E);
        __threadfence(); __syncthreads();
    }
    if (IN(3)) {
        pg8::GemmK g{256, 256, 256, 128, 1 << 30, 0};
        pg8::CmpSched S{(const char*)(F.ws + OFF_HC), (const char*)(F.ws + W_C2), (size_t)4096 * 256 * 2, (size_t)256 * 256 * 2, (size_t)256 * 256 * 2, GRID, F.wg};
        bf16_t* KC = (bf16_t*)(F.ws + SM_KCMP); bf16_t* VC = (bf16_t*)(F.ws + SM_VCMPT);
        auto f = [KC, VC](const pg8::Unit& u, int row, int col, const float (&v)[8]) {
            if (col < 64) store8((u.aux < 2 ? KC : VC) + ((size_t)row * 2 + (u.aux & 1)) * 64 + col, v); };
        pg8::EpiRow8<decltype(f)> E{f};
        pg8::gemm_phase(F.lds, F.wave, g, S, E);
    }
    SEAM(3);
    if (IN(5)) { if (F.wg < SC_WGS) rwkv_scan(F); else nsa_phase(F); }
    SEAM(5);
#if PROBE == 1
    if (F.wg < SC_WGS) rwkv_scan(F, false);
    xcd_barrier(bar);
#elif PROBE == 2
    nsa_phase(F, 1);
    xcd_barrier(bar);
#elif PROBE >= 20 && PROBE < 30
    nsa_phase(F, 1, PROBE == 20 ? 0x01 : PROBE == 21 ? 0x03 : PROBE == 22 ? 0x07 : PROBE == 23 ? 0x27 : PROBE == 24 ? 0x2B : PROBE == 25 ? 0x0B : 0x2F);
    xcd_barrier(bar);
#endif
    if (IN(7)) {
        pg8::GemmK g{1024, 1024, 1024, 128, 1 << 30, 0};
        pg8::DenseSched S; S.init(F.ws + OFF_O0, 1024, F.ws + W_OUT0, 1024, T, 1024, GRID, F.wg);
        bf16_t* MX = (bf16_t*)(F.ws + OFF_MIX);
        auto f = [MX](const pg8::Unit&, int row, int col, const float (&v)[8]) { store8(MX + (size_t)row * 1024 + col, v); };
        pg8::EpiRow8<decltype(f)> E{f};
        pg8::gemm_phase(F.lds, F.wave, g, S, E);
    }
    SEAM(7);
    if (IN(10)) { ln1_router_phase(F, nullptr  , (const bf16_t*)(F.ws + OFF_MIX), (bf16_t*)(F.ws + OFF_XB), ln + 0 * 1024, ln + 1 * 1024, 0, MOE8_L0 ? F.ws + OFF_XB8 : nullptr); moe_weights(F, 0, MOE8_L0); }
    SEAM(10);
#if PROBE == 5
    ln1_router_phase(F, F.in[0], (const bf16_t*)(F.ws + OFF_MIX), (bf16_t*)(F.ws + OFF_XB), ln + 0 * 1024, ln + 1 * 1024, 0); moe_weights(F, 0);
    xcd_barrier(bar);
#endif
    if (IN(11)) moe_scatter_phase(F, nullptr, 0);
    SEAM(11);
#if PROBE == 7
    moe_scatter_phase(F, nullptr, 0);
    xcd_barrier(bar);
#endif
    if (IN(12)) {
        { const int kt_ = F.wave * 64 + lane_id(); if (kt_ < 17) tile_start[kt_] = ((const int*)(F.ws + CTL_TILES))[kt_]; }
        __syncthreads();
        if (MOE8_L0) {
            pg8::GemmK g{512, 512, 512, 128, 1 << 30, 0};
            pg8::MoeSched S{(const char*)(F.ws + OFF_XB8), (const char*)(F.ws + OFF_WMOE), (size_t)0, (size_t)256 * 1024, tile_start, 8, GRID, F.wg, (const int*)(F.ws + SM_ROWTOK)};
            pg8::EpiGU8 E{F.ws + OFF_H};
            pg8::gemm_phase<pg8::EpiGU8, pg8::MoeSched, true, true>(F.lds, F.wave, g, S, E);
        } else {
        pg8::GemmK g{1024, 1024, 1024, 128, 1 << 30, 0};
        pg8::MoeSched S{(const char*)(F.ws + OFF_XB), (const char*)(F.ws + OFF_WMOE), (size_t)0, (size_t)256 * 1024 * 2, tile_start, 8, GRID, F.wg, (const int*)(F.ws + SM_ROWTOK)};
        pg8::EpiGU E{(bf16_t*)(F.ws + OFF_H)};
        pg8::gemm_phase<pg8::EpiGU, pg8::MoeSched, true>(F.lds, F.wave, g, S, E);
        }
    }
    SEAM(12);
    if (IN(13)) {
        { const int kt_ = F.wave * 64 + lane_id(); if (kt_ < 17) tile_start[kt_] = ((const int*)(F.ws + CTL_TILES))[kt_]; }
        __syncthreads();
        bf16_t* Y = (bf16_t*)(F.ws + OFF_XS);
        if (MOE8_L0) {
            pg8::GemmK g{512, 512, 512, 128, 1 << 30, 0};
            pg8::MoeSched S{(const char*)(F.ws + OFF_H), (const char*)(F.ws + OFF_WMOE + (size_t)16 * 2048 * 1024), (size_t)256 * 1024, (size_t)256 * 1024, tile_start, 4, GRID, F.wg};
            auto f = [Y](const pg8::Unit&, int row, int col, const float (&v)[8]) { float o[8];
#pragma unroll
                for (int i = 0; i < 8; ++i) o[i] = v[i] * (1.0f / (F8_SH * F8_SD));
                store8(Y + (size_t)row * 1024 + col, o); };
            pg8::EpiRow8<decltype(f)> E{f};
            pg8::gemm_phase<decltype(E), pg8::MoeSched, false, true>(F.lds, F.wave, g, S, E);
        } else {
        pg8::GemmK g{1024, 1024, 1024, 128, 1 << 30, 0};
        pg8::MoeSched S{(const char*)(F.ws + OFF_H), (const char*)(F.ws + OFF_WMOE + (size_t)16 * 2048 * 1024 * 2), (size_t)256 * 1024 * 2, (size_t)256 * 1024 * 2, tile_start, 4, GRID, F.wg};
        auto f = [Y](const pg8::Unit&, int row, int col, const float (&v)[8]) { store8(Y + (size_t)row * 1024 + col, v); };
        pg8::EpiRow8<decltype(f)> E{f};
        pg8::gemm_phase(F.lds, F.wave, g, S, E);
        }
    }
    SEAM(13);
#if PROBE == 4
    {
        { const int kt_ = F.wave * 64 + lane_id(); if (kt_ < 17) tile_start[kt_] = ((const int*)(F.ws + CTL_TILES))[kt_]; }
        __syncthreads();
        pg8::GemmK g{1024, 1024, 1024, 128, 1 << 30, 0};
        pg8::MoeSched S{(const char*)(F.ws + OFF_XB), (const char*)(F.ws + OFF_WMOE), (size_t)0, (size_t)256 * 1024 * 2, tile_start, 8, GRID, F.wg, (const int*)(F.ws + SM_ROWTOK)};
        pg8::EpiGU E{(bf16_t*)(F.ws + OFF_H)};
        pg8::gemm_phase<pg8::EpiGU, pg8::MoeSched, true>(F.lds, F.wave, g, S, E);
        xcd_barrier(bar);
    }
#endif
    if (IN(14)) { ln2_phase(F, nullptr, ln + 2 * 1024, ln + 3 * 1024, (bf16_t*)(F.ws + OFF_XB), true, RTI8 ? F.ws + OFF_XB8B : nullptr); }
    SEAM(14);
#pragma unroll 1
    for (int k_ = 0; k_ < (PROBE == 12 ? 10 : 5); ++k_) { const int k = k_ % 5;
        if (IN(20)) {
#define PGB(j) ((bf16_t*)(F.ws + OFF_PG + (size_t)((j) & 1) * PG_BYTES))
#define KVB(j) ((bf16_t*)(F.ws + OFF_KV + (size_t)((j) & 1) * KV_BYTES))
            if (k >= 1) ret_r2_phase(F, KVB(k - 1));
            if (k <= 3) {
                pg8::GemmK g{RTI8 ? 512 : 1024, RTI8 ? 512 : 1024, RTI8 ? 512 : 1024, 128, 1 << 30, 0};
                pg8::DenseSched S; if (RTI8) S.init(F.ws + OFF_XB8B + (size_t)k * 16384 * 1024, 512, F.ws + W_RTIN, 512, 16384, 6144, GRID, F.wg); else S.init(F.ws + OFF_XB + (size_t)k * 16384 * 1024 * 2, 1024, F.ws + W_RTIN, 1024, 16384, 6144, GRID, F.wg);
                bf16_t* P = PGB(k);
                auto f = [P](const pg8::Unit&, int row, int col, const float (&v_)[8]) {
                    float v[8];
#pragma unroll
                    for (int i = 0; i < 8; ++i) v[i] = RTI8 ? v_[i] * (1.0f / (F8_SX * F8_SW)) : v_[i];
                    if (col < 2048) {
                        float o[8]; const float posf = (float)(row & 8191); const int m0 = (col & 127) >> 1;
#pragma unroll
                        for (int i = 0; i < 4; ++i) { const float rev = __builtin_amdgcn_fractf(posf * (__builtin_amdgcn_exp2f((float)(m0 + i) * (-13.287712379549449f / 63.0f)) * 0.15915494309189535f));
                            const float co = __builtin_amdgcn_cosf(rev), si = __builtin_amdgcn_sinf(rev); o[2 * i] = v[2 * i] * co - v[2 * i + 1] * si; o[2 * i + 1] = v[2 * i + 1] * co + v[2 * i] * si; }
                        store8(P + (size_t)row * PGLD + col, o);
                    } else if (PGV8) { u32x2 w8; w8[0] = pk_fp8x4(v[0] * F8_SX, v[1] * F8_SX, v[2] * F8_SX, v[3] * F8_SX); w8[1] = pk_fp8x4(v[4] * F8_SX, v[5] * F8_SX, v[6] * F8_SX, v[7] * F8_SX);
                        *(u32x2*)((unsigned char*)P + (size_t)row * 8192 + 4096 + (col - 2048)) = w8; }
                    else store8(P + (size_t)row * 6144 + col, v); };
                pg8::EpiRow8<decltype(f)> E{f};
                pg8::gemm_phase<decltype(E), pg8::DenseSched, false, RTI8>(F.lds, F.wave, g, S, E);
            }
            xcd_barrier(bar);
            if (k >= 1) ret_r3_phase(F, PGB(k - 1), KVB(k - 1), (bf16_t*)(F.ws + OFF_O1), k - 1, F.in[21]);
            if (k <= 3) { for (int u = F.wg; u < 1024; u += GRID) ret_r1_unit(F, PGB(k), KVB(k), u); }
            xcd_barrier(bar);
#undef PGB
#undef KVB
        }
    }
    if (IN(20)) {
        bf16_t* MX = (bf16_t*)(F.ws + OFF_MIX1);
        if (RTO8) {
            pg8::GemmK g{1024, 1024, 1024, 128, 1 << 30, 0};
            pg8::DenseSched S; S.init(F.ws + OFF_O1, 1024, F.ws + W_RTOUT, 1024, T, 1024, GRID, F.wg);
            auto f = [MX](const pg8::Unit&, int row, int col, const float (&v)[8]) { float o[8];
#pragma unroll
                for (int i = 0; i < 8; ++i) o[i] = v[i] * (1.0f / (F8_SO * F8_SWO));
                store8(MX + (size_t)row * 1024 + col, o); };
            pg8::EpiRow8<decltype(f)> E{f};
            pg8::gemm_phase<decltype(E), pg8::DenseSched, false, true>(F.lds, F.wave, g, S, E);
        } else {
        pg8::GemmK g{2048, 2048, 2048, 128, 1 << 30, 0};
        pg8::DenseSched S; S.init(F.ws + OFF_O1, 2048, F.ws + W_RTOUT, 2048, T, 1024, GRID, F.wg);
        auto f = [MX](const pg8::Unit&, int row, int col, const float (&v)[8]) { store8(MX + (size_t)row * 1024 + col, v); };
        pg8::EpiRow8<decltype(f)> E{f};
        pg8::gemm_phase(F.lds, F.wave, g, S, E);
        }
        xcd_barrier(bar);
    }
    if (IN(30)) { ln1_router_phase(F, nullptr, (const bf16_t*)(F.ws + OFF_MIX1), (bf16_t*)(F.ws + OFF_XB), ln + 4 * 1024, ln + 5 * 1024, 1, MOE8_L1 ? F.ws + OFF_XB8 : nullptr); moe_weights(F, 1, MOE8_L1); }
    SEAM(30);
    if (IN(31)) moe_scatter_phase(F, nullptr, 1);
    SEAM(31);
    if (IN(32)) {
        { const int kt_ = F.wave * 64 + lane_id(); if (kt_ < 17) tile_start[kt_] = ((const int*)(F.ws + CTL_TILES))[32 + kt_]; }
        __syncthreads();
        if (MOE8_L1) {
            pg8::GemmK g{512, 512, 512, 128, 1 << 30, 0};
            pg8::MoeSched S{(const char*)(F.ws + OFF_XB8), (const char*)(F.ws + OFF_WMOE), (size_t)0, (size_t)256 * 1024, tile_start, 8, GRID, F.wg, (const int*)(F.ws + SM_ROWTOK)};
            pg8::EpiGU8 E{F.ws + OFF_H};
            pg8::gemm_phase<pg8::EpiGU8, pg8::MoeSched, true, true>(F.lds, F.wave, g, S, E);
        } else {
        pg8::GemmK g{1024, 1024, 1024, 128, 1 << 30, 0};
        pg8::MoeSched S{(const char*)(F.ws + OFF_XB), (const char*)(F.ws + OFF_WMOE), (size_t)0, (size_t)256 * 1024 * 2, tile_start, 8, GRID, F.wg, (const int*)(F.ws + SM_ROWTOK)};
        pg8::EpiGU E{(bf16_t*)(F.ws + OFF_H)};
        pg8::gemm_phase<pg8::EpiGU, pg8::MoeSched, true>(F.lds, F.wave, g, S, E);
        }
    }
    SEAM(32);
    if (IN(33)) {
        { const int kt_ = F.wave * 64 + lane_id(); if (kt_ < 17) tile_start[kt_] = ((const int*)(F.ws + CTL_TILES))[32 + kt_]; }
        __syncthreads();
        bf16_t* Y = (bf16_t*)(F.ws + OFF_XS);
        if (MOE8_L1) {
            pg8::GemmK g{512, 512, 512, 128, 1 << 30, 0};
            pg8::MoeSched S{(const char*)(F.ws + OFF_H), (const char*)(F.ws + OFF_WMOE + (size_t)16 * 2048 * 1024), (size_t)256 * 1024, (size_t)256 * 1024, tile_start, 4, GRID, F.wg};
            auto f = [Y](const pg8::Unit&, int row, int col, const float (&v)[8]) { float o[8];
#pragma unroll
                for (int i = 0; i < 8; ++i) o[i] = v[i] * (1.0f / (F8_SH * F8_SD));
                store8(Y + (size_t)row * 1024 + col, o); };
            pg8::EpiRow8<decltype(f)> E{f};
            pg8::gemm_phase<decltype(E), pg8::MoeSched, false, true>(F.lds, F.wave, g, S, E);
        } else {
        pg8::GemmK g{1024, 1024, 1024, 128, 1 << 30, 0};
        pg8::MoeSched S{(const char*)(F.ws + OFF_H), (const char*)(F.ws + OFF_WMOE + (size_t)16 * 2048 * 1024 * 2), (size_t)256 * 1024 * 2, (size_t)256 * 1024 * 2, tile_start, 4, GRID, F.wg};
        auto f = [Y](const pg8::Unit&, int row, int col, const float (&v)[8]) { store8(Y + (size_t)row * 1024 + col, v); };
        pg8::EpiRow8<decltype(f)> E{f};
        pg8::gemm_phase(F.lds, F.wave, g, S, E);
        }
    }
    SEAM(33);
    if (IN(34)) ln2_phase(F, F.out, ln + 6 * 1024, ln + 7 * 1024, (bf16_t*)(F.ws + OFF_XB), true);
#undef IN
#undef SEAM
}

extern "C" void kernel_launch(void* const* d_in, const int* in_sizes, int n_in, void* d_out, int out_size, void* d_ws, size_t ws_size, hipStream_t stream) {
    static int ready = 0;
    if (ready == 0) {
        if (n_in != 28 || out_size != T * D || ws_size < WS_END) { fprintf(stderr, "kernel_launch: unexpected shapes / workspace (%d inputs, out %d, ws %zu)\n", n_in, out_size, ws_size); ready = -1; return; }
        if (hipFuncSetAttribute((const void*)fwd_kernel, hipFuncAttributeMaxDynamicSharedMemorySize, LDS_BYTES) != hipSuccess) { fprintf(stderr, "kernel_launch: hipFuncSetAttribute failed\n"); ready = -1; return; }
        int per_cu = 0;
        if (hipOccupancyMaxActiveBlocksPerMultiprocessor(&per_cu, (const void*)fwd_kernel, NTH, LDS_BYTES) != hipSuccess || per_cu < 1) { fprintf(stderr, "kernel_launch: occupancy query says %d\n", per_cu); }
        (void)hipGetLastError();
        ready = 1;
    }
    if (ready < 0) return;
    (void)hipMemsetAsync((char*)d_ws + OFF_CTL, 0, CTL_BYTES, stream);
    Args a{};
    for (int i = 0; i < 28; ++i) a.in[i] = (const float*)d_in[i];
    a.out = (float*)d_out; a.ws = (unsigned char*)d_ws; a.ph_lo = 0; a.ph_hi = 1000;
    hipLaunchKernelGGL(fwd_kernel, dim3(GRID), dim3(NTH), LDS_BYTES, stream, a);
}
```

```cpp
#include <hip/hip_runtime.h>
#include <stdint.h>
#include <stdio.h>

#ifndef PROBE
#define PROBE 0
#endif
#define DI __device__ __forceinline__
#define LAS __attribute__((address_space(3)))
typedef unsigned short bf16_t;
typedef short bf16x8 __attribute__((ext_vector_type(8)));
typedef float f32x4 __attribute__((ext_vector_type(4)));
typedef unsigned u32x4 __attribute__((ext_vector_type(4)));
typedef unsigned u32x2 __attribute__((ext_vector_type(2)));
typedef int i32x4 __attribute__((ext_vector_type(4)));
typedef float f32x2 __attribute__((ext_vector_type(2)));

constexpr int T = 65536, D = 1024, SEQ = 8192, NB = 8;
constexpr int NTH = 512, GRID = 256;
constexpr float ALPHA = 1.41421356237309515f;
constexpr float LN_EPS = 1e-5f;
constexpr size_t MiB = (size_t)1 << 20;

constexpr size_t OFF_CTL = 0;
constexpr size_t CTL_BYTES = 256 * 1024;
constexpr size_t CTL_BAR = 0;
constexpr size_t CTL_Q = 16 * 1024;
constexpr size_t CTL_BLKCNT = 32 * 1024;
constexpr size_t CTL_TILES = 96 * 1024;
constexpr size_t OFF_SMALL = 1 * MiB;
constexpr size_t SM_ROPEN = OFF_SMALL + 0;
constexpr size_t SM_ROPER = OFF_SMALL + 1 * MiB;
constexpr size_t SM_CBIAS = OFF_SMALL + 5 * MiB;
constexpr size_t SM_TOKE = OFF_SMALL + 6 * MiB;
constexpr size_t SM_TOKW = OFF_SMALL + 7 * MiB;
constexpr size_t SM_TOKP = OFF_SMALL + 8 * MiB;
constexpr size_t SM_RNORM = OFF_SMALL + 9 * MiB;
constexpr size_t SM_KCMP = OFF_SMALL + 11 * MiB;
constexpr size_t SM_VCMPT = OFF_SMALL + 12 * MiB;
constexpr size_t SM_ROWTOK = OFF_SMALL + 13 * MiB;
constexpr size_t OFF_WSM = 16 * MiB;
constexpr size_t W_IN0 = OFF_WSM;
constexpr size_t W_OUT0 = OFF_WSM + 7 * MiB;
constexpr size_t W_RTIN = OFF_WSM + 9 * MiB;
constexpr size_t W_RTOUT = OFF_WSM + 21 * MiB;
constexpr size_t W_L1 = OFF_WSM + 25 * MiB;
constexpr size_t W_L2 = OFF_WSM + 25 * MiB + 512 * 1024;
constexpr size_t W_C1 = OFF_WSM + 27 * MiB;
constexpr size_t W_C2 = OFF_WSM + 29 * MiB;
constexpr size_t OFF_XB = 48 * MiB;
constexpr size_t OFF_BIG = 176 * MiB;
constexpr size_t OFF_MIX = OFF_BIG;
constexpr size_t OFF_H = OFF_BIG;
constexpr size_t OFF_WMOE = 448 * MiB;
constexpr size_t OFF_XS = 544 * MiB;
constexpr size_t OFF_PR = OFF_BIG;
constexpr size_t OFF_ORAW = OFF_BIG;
constexpr size_t OFF_PN = 433 * MiB;
constexpr size_t OFF_O0 = 625 * MiB;
constexpr size_t OFF_HC = 753 * MiB;
constexpr size_t OFF_PG = OFF_BIG;
constexpr size_t PG_BYTES = 192 * MiB;
constexpr size_t OFF_O1 = 560 * MiB;
constexpr size_t OFF_KV = 816 * MiB;
constexpr size_t KV_BYTES = 64 * MiB;
constexpr size_t OFF_MIX1 = OFF_BIG;
constexpr size_t OFF_XB8 = 816 * MiB;
constexpr size_t OFF_STR = 768 * MiB;
constexpr size_t OFF_XB8B = 944 * MiB;
constexpr size_t WS_END = 1008 * MiB;
constexpr bool MOE8_L0 = true, MOE8_L1 = true;
constexpr bool PGV8 = true;
constexpr int PGLD = PGV8 ? 4096 : 6144;
constexpr bool RTI8 = true;
constexpr bool RTO8 = true;
constexpr float F8_SO = 8.f, F8_SWO = 512.f;
constexpr float F8_SX = 16.f, F8_SW = 256.f, F8_SH = 8.f, F8_SD = 512.f;
constexpr int MOE_ROWS_MAX = 135168;

DI float bf2f(bf16_t b) { return __uint_as_float(((unsigned)b) << 16); }
DI bf16_t f2bf(float f) { unsigned u = __float_as_uint(f); u += 0x7FFFu + ((u >> 16) & 1u); return (bf16_t)(u >> 16); }
typedef __bf16 bf16v2_t __attribute__((ext_vector_type(2)));
DI unsigned pack2(float lo, float hi) { const bf16v2_t r = __builtin_convertvector((f32x2){lo, hi}, bf16v2_t); return __builtin_bit_cast(unsigned, r); }
DI int lane_id() { int l; asm volatile("v_mbcnt_lo_u32_b32 %0, -1, 0\n\tv_mbcnt_hi_u32_b32 %0, -1, %0" : "=v"(l)); return l; }
DI float shx(float v, int m) { const int l = lane_id(); return __int_as_float(__builtin_amdgcn_ds_bpermute((l ^ m) << 2, __float_as_int(v))); }
DI float f8sat(float x) { return __builtin_amdgcn_fmed3f(x, -448.f, 448.f); }
DI unsigned pk_fp8x4(float a, float b, float c, float d) {
    int p = __builtin_amdgcn_cvt_pk_fp8_f32(f8sat(a), f8sat(b), 0, false); p = __builtin_amdgcn_cvt_pk_fp8_f32(f8sat(c), f8sat(d), p, true); return (unsigned)p; }
DI float wave_sum(float v) {
#pragma unroll
    for (int o = 32; o; o >>= 1) v += shx(v, o);
    return v;
}
DI int lds_add(LAS int* p, int v) { return __hip_atomic_fetch_add(p, v, __ATOMIC_RELAXED, __HIP_MEMORY_SCOPE_WORKGROUP); }
DI float rcpf_(float x) { return __builtin_amdgcn_rcpf(x); }
DI float sigmoidf_(float x) { return rcpf_(1.0f + __builtin_amdgcn_exp2f(-1.44269504088896341f * x)); }
DI float siluf_(float x) { return x * sigmoidf_(x); }
DI float tanhf_(float x) { return 1.0f - 2.0f * rcpf_(1.0f + __builtin_amdgcn_exp2f(2.88539008177792681f * x)); }

#define XB_TMO      128
#define XB_XCNT(j)  (256  + 64 * (j))
#define XB_XSUB(j)  (1280 + 64 * (j))
#define XB_XGEN(j)  (2304 + 64 * (j))
#define XB_TOP      3328
#define XB_TOPGEN   3392
#define XCD_BAR_WORDS 3456
#define XB_SPIN_CAP (1u << 24)

DI unsigned xb_ld(unsigned* p)              { return __hip_atomic_load(p, __ATOMIC_RELAXED, __HIP_MEMORY_SCOPE_AGENT); }
DI unsigned xb_add(unsigned* p, unsigned v) { return __hip_atomic_fetch_add(p, v, __ATOMIC_RELAXED, __HIP_MEMORY_SCOPE_AGENT); }
DI unsigned xb_xcc_id() { return (unsigned)__builtin_amdgcn_s_getreg((3 << 11) | 20) & 0xFu; }
#define XB_SPIN(cond, bar) do { unsigned _sp = 0; while (cond) { __builtin_amdgcn_s_sleep(1); \
    if ((++_sp & 255u) == 0u) { if (xb_ld(&(bar)[XB_TMO])) break; if (_sp > XB_SPIN_CAP) { atomicAdd(&(bar)[XB_TMO], 1u); break; } } } } while (0)

struct XcdBarrier { unsigned* bar; unsigned x; volatile LAS unsigned* st; };

DI XcdBarrier xcd_barrier_post(unsigned* bar, volatile LAS unsigned* st) {
    XcdBarrier b; b.bar = bar; b.x = xb_xcc_id(); b.st = st;
    if (threadIdx.x == 0) (void)xb_add(&bar[XB_XCNT(b.x)], 1u);
    return b;
}
DI void xcd_barrier_complete(unsigned* bar, unsigned x, unsigned& nloc, unsigned& nx) {
    const unsigned G = gridDim.x * gridDim.y * gridDim.z;
    unsigned sum, cnt, mine, sp = 0u;
    for (;;) {
        sum = 0u; cnt = 0u; mine = 0u;
#pragma unroll
        for (unsigned j = 0; j < 16; ++j) { const unsigned c = xb_ld(&bar[XB_XCNT(j)]); sum += c; cnt += (c > 0u) ? 1u : 0u; mine = (j == x) ? c : mine; }
        if (sum == G) break;
        __builtin_amdgcn_s_sleep(1);
        if ((++sp & 255u) == 0u) { if (xb_ld(&bar[XB_TMO])) break; if (sp > XB_SPIN_CAP) { atomicAdd(&bar[XB_TMO], 1u); break; } }
    }
    nloc = mine > 0u ? mine : 1u; nx = cnt > 0u ? cnt : 1u;
}
DI void xcd_barrier(const XcdBarrier& b) {
    asm volatile("s_waitcnt vmcnt(0)" ::: "memory");
    __syncthreads();
    if (threadIdx.x == 0) {
        unsigned* bar = b.bar;
        __builtin_amdgcn_s_waitcnt(0);
        unsigned nloc = b.st[0], nx = b.st[1];
        if (nloc == 0u) { xcd_barrier_complete(bar, b.x, nloc, nx); b.st[0] = nloc; b.st[1] = nx; }
        const unsigned old = xb_add(&bar[XB_XSUB(b.x)], 1u);
        const unsigned gen = old / nloc;
        if (old + 1u == (gen + 1u) * nloc) {
            __builtin_amdgcn_fence(__ATOMIC_RELEASE, "agent");
            asm volatile("s_waitcnt vmcnt(0)" ::: "memory");
            const unsigned og = xb_add(&bar[XB_TOP], 1u);
            const unsigned tg = og / nx;
            if (og + 1u == (tg + 1u) * nx) xb_add(&bar[XB_TOPGEN], 1u);
            else XB_SPIN(xb_ld(&bar[XB_TOPGEN]) == tg, bar);
            __builtin_amdgcn_fence(__ATOMIC_ACQUIRE, "agent");
            xb_add(&bar[XB_XGEN(b.x)], 1u);
            asm volatile("s_waitcnt vmcnt(0)" ::: "memory");
        } else {
            XB_SPIN(xb_ld(&bar[XB_XGEN(b.x)]) == gen, bar);
            __builtin_amdgcn_fence(__ATOMIC_ACQUIRE, "agent");
            asm volatile("s_waitcnt vmcnt(0)" ::: "memory");
        }
    }
    __syncthreads();
}

namespace pg8 {
constexpr int BM = 256, BK = 64, HALF = 128, HTB = HALF * BK * 2, STAGE_BYTES = 8 * HTB, NXCD = 8, WGM = 8;
DI int lds_byte(int r, int c) { const int st = (r >> 4) * 2 + (c >> 5), rr = r & 15, cc = c & 31, ob = rr * 64 + cc * 2; return st * 1024 + (ob ^ (((ob >> 9) & 1) << 5)); }
DI void stage_rc(int b, int& R, int& C) { const int st = b / 1024, sb = b % 1024, swz = sb ^ (((sb >> 9) & 1) << 5); R = (st >> 1) * 16 + swz / 64; C = (st & 1) * 32 + (swz % 64) / 2; }
DI int perm32(int rho) { const int n = rho >> 4, i = rho & 15; return 8 * (i >> 2) + 4 * n + (i & 3); }

struct Unit { const char* a; const char* b; int pm, pn, aux; const int* rows; };
struct GemmK { int lda, ldb, K, kstepA, ksplit, kjump; };

template <class Epi, class Sched, bool GATHER = false, bool F8 = false>
DI void gemm_phase(LAS unsigned char* lds, int wave_, const GemmK g, const Sched& S, const Epi& E) {
    int tid = wave_ * 64 + lane_id(); asm volatile("" : "+v"(tid));
    const int wid = __builtin_amdgcn_readfirstlane(tid >> 6), lane = tid & 63, wr = wid >> 2, wc = wid & 3, fr = lane & 15, fq = lane >> 4;
    const int nt = g.K / BK;
    unsigned voffA[2], voffB[2], cA2[2]; int rA[2]; unsigned vgc[2][2], vgn[2][2];
#pragma unroll
    for (int i = 0; i < 2; ++i) { int R, C; stage_rc(tid * 16 + i * 8192, R, C); const int Rb = Epi::PERM ? ((R & ~31) + perm32(R & 31)) : R;
        voffA[i] = (unsigned)(R * g.lda + C) * 2u; voffB[i] = (unsigned)(Rb * g.ldb + C) * 2u; rA[i] = R; cA2[i] = (unsigned)C * 2u; }
    const size_t kstepA = (size_t)g.kstepA, kstepB = (size_t)(BK * 2);
    const size_t hstepA = (size_t)HALF * g.lda * 2, hstepB = (size_t)HALF * g.ldb * 2;
    const unsigned ldsw = (unsigned)wid * 1024u;
    const int aoff = lds_byte(wr * 64 + fr, fq * 8), boff = lds_byte(wc * 32 + fr, fq * 8);
#define PG8_AK(base, kt) ((base) + (size_t)(kt) * kstepA + (((kt) >= g.ksplit) ? (long)g.kjump : 0l))
#define PG8_SA(b, h) (((b) * 2 + (h)) * HTB)
#define PG8_SB(b, h) ((4 + (b) * 2 + (h)) * HTB)
#define PG8_STAGE(bufoff, gbase, voff) do { _Pragma("unroll") for (int _i = 0; _i < 2; ++_i) \
        __builtin_amdgcn_global_load_lds((const unsigned*)((const char*)(gbase) + (voff)[_i]), (LAS unsigned*)(lds + (bufoff) + ldsw + _i * 8192), 16, 0, 0); } while (0)
#define PG8_STAGE_A(bufoff, kbase, h, nx) do { if (GATHER) { _Pragma("unroll") for (int _i = 0; _i < 2; ++_i) { const unsigned _vo = (nx) ? vgn[h][_i] : vgc[h][_i]; \
        __builtin_amdgcn_global_load_lds((const unsigned*)((const char*)(kbase) + _vo), (LAS unsigned*)(lds + (bufoff) + ldsw + _i * 8192), 16, 0, 0); } } \
        else PG8_STAGE(bufoff, (kbase) + (h) * hstepA, voffA); } while (0)
#define PG8_ROWS(dst, u) do { if (GATHER) { _Pragma("unroll") for (int _h = 0; _h < 2; ++_h) _Pragma("unroll") for (int _i = 0; _i < 2; ++_i) dst[_h][_i] = (unsigned)(u).rows[128 * _h + rA[_i]] * (unsigned)(g.lda * 2) + cA2[_i]; } } while (0)
#define PG8_LDA(dst, b, h) do { _Pragma("unroll") for (int m = 0; m < 4; ++m) _Pragma("unroll") for (int k = 0; k < 2; ++k) dst[m][k] = *(const LAS bf16x8*)(lds + PG8_SA(b, h) + aoff + m * 2048 + k * 1024); } while (0)
#define PG8_LDB(dst, b, h) do { _Pragma("unroll") for (int n = 0; n < 2; ++n) _Pragma("unroll") for (int k = 0; k < 2; ++k) dst[n][k] = *(const LAS bf16x8*)(lds + PG8_SB(b, h) + boff + n * 2048 + k * 1024); } while (0)
#define PG8_CAT(x, y) __builtin_shufflevector(__builtin_bit_cast(i32x4, x), __builtin_bit_cast(i32x4, y), 0, 1, 2, 3, 4, 5, 6, 7)
#define PG8_MMA(ai, bj, At, Bt) do { __builtin_amdgcn_s_setprio(1); \
        if (F8) { _Pragma("unroll") for (int m = 0; m < 4; ++m) _Pragma("unroll") for (int n = 0; n < 2; ++n) \
            asm volatile("v_mfma_f32_16x16x128_f8f6f4 %0, %1, %2, %0" : "+v"(acc[ai][bj][m][n]) : "v"(PG8_CAT(Bt[n][0], Bt[n][1])), "v"(PG8_CAT(At[m][0], At[m][1]))); }     \
        else { _Pragma("unroll") for (int m = 0; m < 4; ++m) _Pragma("unroll") for (int n = 0; n < 2; ++n) _Pragma("unroll") for (int k = 0; k < 2; ++k) \
            acc[ai][bj][m][n] = __builtin_amdgcn_mfma_f32_16x16x32_bf16(Bt[n][k], At[m][k], acc[ai][bj][m][n], 0, 0, 0); } \
        __builtin_amdgcn_s_setprio(0); } while (0)
#define PG8_WAIT_V(n) asm volatile("s_waitcnt vmcnt(" #n ")" ::: "memory")
#define PG8_WAIT_L(n) asm volatile("s_waitcnt lgkmcnt(" #n ")" ::: "memory")
#define PG8_BAR __builtin_amdgcn_s_barrier()
#define PG8_SCHED __builtin_amdgcn_sched_barrier(0)
    Unit cur, nxt; int ui = 0;
    if (!S.next(0, cur)) return;
    f32x4 acc[2][2][4][2];
#pragma unroll
    for (int a = 0; a < 2; ++a)
#pragma unroll
        for (int b = 0; b < 2; ++b)
#pragma unroll
            for (int m = 0; m < 4; ++m)
#pragma unroll
                for (int n = 0; n < 2; ++n) acc[a][b][m][n] = (f32x4){0.f, 0.f, 0.f, 0.f};
    bf16x8 At[4][2], B0[2][2], B1[2][2];
    const char* cA = cur.a; const char* cB = cur.b;
    PG8_ROWS(vgc, cur);
    PG8_STAGE(PG8_SB(0, 0), cB, voffB); PG8_STAGE_A(PG8_SA(0, 0), cA, 0, false); PG8_STAGE(PG8_SB(0, 1), cB + hstepB, voffB); PG8_STAGE_A(PG8_SA(0, 1), cA, 1, false);
    if (wr == 1) PG8_BAR;
    PG8_WAIT_V(4); PG8_BAR;
    PG8_STAGE(PG8_SB(1, 0), cB + kstepB, voffB); PG8_STAGE_A(PG8_SA(1, 0), PG8_AK(cA, 1), 0, false); PG8_STAGE(PG8_SB(1, 1), cB + hstepB + kstepB, voffB);
    PG8_WAIT_V(6); PG8_BAR;
    for (;;) {
        const bool has_next = S.next(ui + 1, nxt);
        const char* nA = has_next ? nxt.a : cA; const char* nB = has_next ? nxt.b : cB;
        if (GATHER) { if (has_next) PG8_ROWS(vgn, nxt); else { _Pragma("unroll") for (int _h = 0; _h < 2; ++_h) _Pragma("unroll") for (int _i = 0; _i < 2; ++_i) vgn[_h][_i] = vgc[_h][_i]; } }
#pragma unroll 1
        for (int t = 0; t < nt; t += 2) {
            const bool last = (t == nt - 2);
            const char* a1 = PG8_AK(cA, t + 1);
            const char* a2 = last ? nA : PG8_AK(cA, t + 2); const char* b2 = last ? nB : cB + (size_t)(t + 2) * kstepB;
            const char* a3 = last ? PG8_AK(nA, 1) : PG8_AK(cA, t + 3); const char* b3 = b2 + kstepB;
            PG8_LDB(B0, 0, 0); PG8_SCHED; PG8_LDA(At, 0, 0); PG8_STAGE_A(PG8_SA(1, 1), a1, 1, false);
            PG8_WAIT_L(8); PG8_BAR; PG8_WAIT_L(0); PG8_MMA(0, 0, At, B0); PG8_BAR; PG8_SCHED;
            PG8_LDB(B1, 0, 1); PG8_STAGE(PG8_SB(0, 0), b2, voffB);
            PG8_BAR; PG8_WAIT_L(0); PG8_MMA(0, 1, At, B1); PG8_BAR;
            PG8_LDA(At, 0, 1); PG8_STAGE_A(PG8_SA(0, 0), a2, 0, last);
            PG8_BAR; PG8_WAIT_L(0); PG8_MMA(1, 0, At, B0); PG8_BAR; PG8_SCHED;
            PG8_STAGE(PG8_SB(0, 1), b2 + hstepB, voffB);
            PG8_WAIT_V(6); PG8_BAR; PG8_MMA(1, 1, At, B1); PG8_BAR;
            PG8_LDB(B0, 1, 0); PG8_SCHED; PG8_LDA(At, 1, 0); PG8_STAGE_A(PG8_SA(0, 1), a2, 1, last);
            PG8_WAIT_L(8); PG8_BAR; PG8_WAIT_L(0); PG8_MMA(0, 0, At, B0); PG8_BAR; PG8_SCHED;
            PG8_LDB(B1, 1, 1); PG8_STAGE(PG8_SB(1, 0), b3, voffB);
            PG8_BAR; PG8_WAIT_L(0); PG8_MMA(0, 1, At, B1); PG8_BAR;
            PG8_LDA(At, 1, 1); PG8_STAGE_A(PG8_SA(1, 0), a3, 0, last);
            PG8_BAR; PG8_WAIT_L(0); PG8_MMA(1, 0, At, B0); PG8_BAR; PG8_SCHED;
            PG8_STAGE(PG8_SB(1, 1), b3 + hstepB, voffB);
            PG8_WAIT_V(6); PG8_BAR; PG8_MMA(1, 1, At, B1); PG8_BAR;
        }
        if (F8) {
#pragma unroll
            for (int a = 0; a < 2; ++a)
#pragma unroll
                for (int b = 0; b < 2; ++b) {
                    if (a == 0 && b == 0) asm volatile("s_nop 15\n\ts_nop 15" : "+v"(acc[a][b][0][0]), "+v"(acc[a][b][0][1]), "+v"(acc[a][b][1][0]), "+v"(acc[a][b][1][1]), "+v"(acc[a][b][2][0]), "+v"(acc[a][b][2][1]), "+v"(acc[a][b][3][0]), "+v"(acc[a][b][3][1]));
                    else asm volatile("" : "+v"(acc[a][b][0][0]), "+v"(acc[a][b][0][1]), "+v"(acc[a][b][1][0]), "+v"(acc[a][b][1][1]), "+v"(acc[a][b][2][0]), "+v"(acc[a][b][2][1]), "+v"(acc[a][b][3][0]), "+v"(acc[a][b][3][1])); } }
        E(acc, cur, wr, wc, fr, fq);
        if (!has_next) break;
#pragma unroll
        for (int a = 0; a < 2; ++a)
#pragma unroll
            for (int b = 0; b < 2; ++b)
#pragma unroll
                for (int m = 0; m < 4; ++m)
#pragma unroll
                    for (int n = 0; n < 2; ++n) acc[a][b][m][n] = (f32x4){0.f, 0.f, 0.f, 0.f};
        cur = nxt; cA = nA; cB = nB; ++ui;
        if (GATHER) { _Pragma("unroll") for (int _h = 0; _h < 2; ++_h) _Pragma("unroll") for (int _i = 0; _i < 2; ++_i) vgc[_h][_i] = vgn[_h][_i]; }
    }
    PG8_WAIT_V(0);
    if (wr == 0) PG8_BAR;
    PG8_BAR;
#undef PG8_AK
#undef PG8_SA
#undef PG8_SB
#undef PG8_STAGE
#undef PG8_STAGE_A
#undef PG8_ROWS
#undef PG8_LDA
#undef PG8_LDB
#undef PG8_MMA
#undef PG8_CAT
#undef PG8_WAIT_V
#undef PG8_WAIT_L
#undef PG8_BAR
#undef PG8_SCHED
}

struct DenseSched {
    const char* A; const char* B; size_t tstepA, tstepB; int nM, nN, nwg, G, c; int prp;
    DI void init(const void* A_, int lda, const void* B_, int ldb, int M, int N, int G_, int c_, int prp_ = 0) {
        A = (const char*)A_; B = (const char*)B_; tstepA = (size_t)BM * lda * 2; tstepB = (size_t)BM * ldb * 2; nM = M / BM; nN = N / BM; nwg = nM * nN; G = G_; c = c_; prp = prp_; }
    DI bool next(int i, Unit& u) const {
        const long L = (long)i * G + c; if (L >= nwg) return false;
        int wgid = (int)L; { const int q = nwg / NXCD, r = nwg % NXCD, xcd = wgid % NXCD, off = wgid / NXCD; wgid = (xcd < r ? xcd * (q + 1) : r * (q + 1) + (xcd - r) * q) + off; }
        const int nig = WGM * nN, gid = wgid / nig, fm = gid * WGM, gsz = (nM - fm) < WGM ? (nM - fm) : WGM;
        u.pm = fm + ((wgid % nig) % gsz); u.pn = (wgid % nig) / gsz; u.aux = 0;
        u.a = A + (size_t)u.pm * tstepA + (prp ? (size_t)((u.pm >> 5) + 1) * (tstepA / BM) : (size_t)0);
        u.b = B + (size_t)u.pn * tstepB; u.rows = nullptr;
        return true;
    }
};
struct MoeSched {
    const char* A; const char* B; size_t tstepA, tstepB; const LAS int* ts; int nN, G, c; const int* rowtab;
    DI bool next(int i, Unit& u) const {
        const long L0 = (long)i * G + c; const int nwg = ts[16] * nN; if (L0 >= nwg) return false;
        int L = (int)L0; { const int q = nwg / NXCD, r = nwg % NXCD, xcd = L % NXCD, off = L / NXCD; L = (xcd < r ? xcd * (q + 1) : r * (q + 1) + (xcd - r) * q) + off; }
        const int rt = L / nN, pn = L % nN;
        int e = 0;
#pragma unroll
        for (int j = 1; j < 16; ++j) e += (rt >= ts[j]) ? 1 : 0;
        u.pm = rt; u.pn = pn; u.aux = e;
        u.a = rowtab ? A : A + (size_t)rt * tstepA; u.b = B + (size_t)(e * nN + pn) * tstepB; u.rows = rowtab ? rowtab + rt * 256 : nullptr;
        return true;
    }
};

template <class F> struct EpiRow8 {
    static constexpr bool PERM = true;
    F f;
    DI void operator()(const f32x4 (&acc)[2][2][4][2], const Unit& u, int wr, int wc, int fr, int fq) const {
#pragma unroll
        for (int ai = 0; ai < 2; ++ai)
#pragma unroll
            for (int m = 0; m < 4; ++m) {
                const int row = u.pm * BM + ai * HALF + wr * 64 + m * 16 + fr;
#pragma unroll
                for (int bj = 0; bj < 2; ++bj) {
                    const int col = u.pn * BM + bj * HALF + wc * 32 + 8 * fq;
                    float v[8];
#pragma unroll
                    for (int j = 0; j < 4; ++j) { v[j] = acc[ai][bj][m][0][j]; v[4 + j] = acc[ai][bj][m][1][j]; }
                    f(u, row, col, v);
                }
            }
    }
};
struct EpiF32 {
    static constexpr bool PERM = false;
    float* C; int ldc;
    DI void operator()(const f32x4 (&acc)[2][2][4][2], const Unit& u, int wr, int wc, int fr, int fq) const {
        const int row0 = u.pm * BM + wr * 64 + fr, col0 = u.pn * BM + wc * 32 + 4 * fq;
#pragma unroll
        for (int ai = 0; ai < 2; ++ai)
#pragma unroll
            for (int m = 0; m < 4; ++m) { float* rowp = C + (size_t)(row0 + ai * HALF + m * 16) * ldc + col0;
#pragma unroll
                for (int bj = 0; bj < 2; ++bj)
#pragma unroll
                    for (int n = 0; n < 2; ++n) *(f32x4*)(rowp + bj * HALF + n * 16) = acc[ai][bj][m][n]; }
    }
};
struct EpiGU {
    static constexpr bool PERM = true;
    bf16_t* H;
    DI void operator()(const f32x4 (&acc)[2][2][4][2], const Unit& u, int wr, int wc, int fr, int fq) const {
#pragma unroll
        for (int ai = 0; ai < 2; ++ai)
#pragma unroll
            for (int m = 0; m < 4; ++m) {
                const int row = u.pm * BM + ai * HALF + wr * 64 + m * 16 + fr;
                const int col = u.pn * HALF + wc * 32 + 8 * fq;
                float h[8];
#pragma unroll
                for (int j = 0; j < 4; ++j) {
                    const float g0 = acc[ai][0][m][0][j], u0 = acc[ai][1][m][0][j], g1 = acc[ai][0][m][1][j], u1 = acc[ai][1][m][1][j];
                    h[j] = siluf_(g0) * u0; h[4 + j] = siluf_(g1) * u1;
                }
                u32x4 o; o[0] = pack2(h[0], h[1]); o[1] = pack2(h[2], h[3]); o[2] = pack2(h[4], h[5]); o[3] = pack2(h[6], h[7]);
                *(u32x4*)(H + (size_t)row * 1024 + col) = o;
            }
    }
};
struct EpiGU8 {
    static constexpr bool PERM = true;
    unsigned char* H;
    DI void operator()(const f32x4 (&acc)[2][2][4][2], const Unit& u, int wr, int wc, int fr, int fq) const {
        constexpr float SI = 1.0f / (F8_SX * F8_SW);
#pragma unroll
        for (int ai = 0; ai < 2; ++ai)
#pragma unroll
            for (int m = 0; m < 4; ++m) {
                const int row = u.pm * BM + ai * HALF + wr * 64 + m * 16 + fr;
                const int col = u.pn * HALF + wc * 32 + 8 * fq;
                float h[8];
#pragma unroll
                for (int j = 0; j < 4; ++j) {
                    const float g0 = acc[ai][0][m][0][j] * SI, u0 = acc[ai][1][m][0][j] * (SI * F8_SH), g1 = acc[ai][0][m][1][j] * SI, u1 = acc[ai][1][m][1][j] * (SI * F8_SH);
                    h[j] = siluf_(g0) * u0; h[4 + j] = siluf_(g1) * u1;
                }
                u32x2 o; o[0] = pk_fp8x4(h[0], h[1], h[2], h[3]); o[1] = pk_fp8x4(h[4], h[5], h[6], h[7]);
                *(u32x2*)(H + (size_t)row * 1024 + col) = o;
            }
    }
};
}

DI void unpack8(const u32x4 a, float (&o)[8]) {
#pragma unroll
    for (int i = 0; i < 4; ++i) { o[2 * i] = __uint_as_float(a[i] << 16); o[2 * i + 1] = __uint_as_float(a[i] & 0xffff0000u); }
}
DI u32x4 pack8(const float (&v)[8]) { u32x4 o; o[0] = pack2(v[0], v[1]); o[1] = pack2(v[2], v[3]); o[2] = pack2(v[4], v[5]); o[3] = pack2(v[6], v[7]); return o; }
DI void store8(bf16_t* p, const float (&v)[8]) {
    u32x4 o; o[0] = pack2(v[0], v[1]); o[1] = pack2(v[2], v[3]); o[2] = pack2(v[4], v[5]); o[3] = pack2(v[6], v[7]);
    *(u32x4*)p = o;
}

struct Args { const float* in[28]; float* out; unsigned char* ws; int ph_lo, ph_hi; };
struct Frame {
    LAS unsigned char* lds; int tid, lane, wave, wg;
    unsigned char* ws; float* out; const float* const* in;
};

constexpr int LDS_SCR = 1024;
constexpr int LDS_BYTES = 1024 + 155 * 1024;

struct TrTile { const float* src; int ldsrc, N; bf16_t* dst; int ldd, rowmode, k0, n0; float f8; };
DI void tr_load(const Frame& F, const TrTile& d, f32x4 (&v)[2]) {
#pragma unroll
    for (int i = 0; i < 2; ++i) { const int kk = (F.tid >> 4) + 32 * i, n4 = (F.tid & 15) * 4;
        v[i] = (d.n0 + n4 < d.N) ? *(const f32x4*)(d.src + (size_t)(d.k0 + kk) * d.ldsrc + d.n0 + n4) : (f32x4){0.f, 0.f, 0.f, 0.f}; }
}
template <class Desc> DI void tr_run(const Frame& F, int ntiles, Desc desc) {
    LAS float* tile = (LAS float*)F.lds;
    const int nq = ntiles >> 2;
    int id = F.wg; if (id >= nq) return;
    TrTile d[4]; f32x4 v[4][2];
#pragma unroll
    for (int s4 = 0; s4 < 4; ++s4) { d[s4] = desc(4 * id + s4); tr_load(F, d[s4], v[s4]); }
    for (;;) {
        __syncthreads();
#pragma unroll
        for (int s4 = 0; s4 < 4; ++s4)
#pragma unroll
            for (int i = 0; i < 2; ++i) { const int kk = (F.tid >> 4) + 32 * i, n4 = (F.tid & 15) * 4;
#pragma unroll
                for (int e = 0; e < 4; ++e) tile[s4 * (64 * 65) + kk * 65 + n4 + e] = v[s4][i][e]; }
        __syncthreads();
        TrTile cur[4];
#pragma unroll
        for (int s4 = 0; s4 < 4; ++s4) cur[s4] = d[s4];
        const int nid = id + GRID; const bool more = nid < nq;
        if (more) {
#pragma unroll
            for (int s4 = 0; s4 < 4; ++s4) { d[s4] = desc(4 * nid + s4); tr_load(F, d[s4], v[s4]); } }
#pragma unroll
        for (int s4 = 0; s4 < 4; ++s4) { const TrTile& c = cur[s4]; const int nn = F.tid >> 3, kc = (F.tid & 7) * 8; const int n = c.n0 + nn;
          const int r = c.rowmode == 0 ? n : (c.rowmode == 3 ? (n < 2048 ? ((n & ~127) + 2 * (n & 63) + ((n >> 6) & 1)) : n) : ((n >> 7) * 256 + (n & 127) + (c.rowmode == 2 ? 128 : 0)));
          float o[8];
#pragma unroll
          for (int e = 0; e < 8; ++e) o[e] = tile[s4 * (64 * 65) + (kc + e) * 65 + nn];
          if (c.f8 != 0.f) { u32x2 w; w[0] = pk_fp8x4(o[0] * c.f8, o[1] * c.f8, o[2] * c.f8, o[3] * c.f8); w[1] = pk_fp8x4(o[4] * c.f8, o[5] * c.f8, o[6] * c.f8, o[7] * c.f8);
              *(u32x2*)((unsigned char*)c.dst + (size_t)r * c.ldd + c.k0 + kc) = w; }
          else store8(c.dst + (size_t)r * c.ldd + c.k0 + kc, o); }
        if (!more) break;
        id = nid;
    }
    __syncthreads();
}
DI void tr_job(const Frame& F, const float* src, int ldsrc, int K, int N, int Npad, bf16_t* dst, int ldd, int rowmode, float f8 = 0.f) {
    const int tn = Npad / 64, n = (K / 64) * tn;
    tr_run(F, n, [=](int i) { return TrTile{src, ldsrc, N, dst, ldd, rowmode, (i / tn) * 64, (i % tn) * 64, f8}; });
}
DI void moe_weights(const Frame& F0, int layer, const bool f8 = false) {
    Frame F = F0; F.tid = F.wave * 64 + lane_id(); asm volatile("" : "+v"(F.tid)); F.lane = F.tid & 63;
    const size_t esz = f8 ? 1 : 2;
    unsigned char* wgu = F.ws + OFF_WMOE; unsigned char* wd = wgu + (size_t)16 * 2048 * 1024 * esz;
    const size_t lo_ = (size_t)layer * 16 * 1024 * 1024;
    const float* g = F.in[24] + lo_; const float* u = F.in[25] + lo_; const float* dn = F.in[26] + lo_;
    const float sgu = f8 ? F8_SW : 0.f, sdn = f8 ? F8_SD : 0.f;
    tr_run(F, 16 * 256, [=](int id) { const int e = id >> 8, tl = id & 255; return TrTile{g + (size_t)e * 1024 * 1024, 1024, 1024, (bf16_t*)(wgu + (size_t)e * 2048 * 1024 * esz), 1024, 1, (tl >> 4) * 64, (tl & 15) * 64, sgu}; });
    tr_run(F, 16 * 256, [=](int id) { const int e = id >> 8, tl = id & 255; return TrTile{u + (size_t)e * 1024 * 1024, 1024, 1024, (bf16_t*)(wgu + (size_t)e * 2048 * 1024 * esz), 1024, 2, (tl >> 4) * 64, (tl & 15) * 64, sgu}; });
    tr_run(F, 16 * 256, [=](int id) { const int e = id >> 8, tl = id & 255; return TrTile{dn + (size_t)e * 1024 * 1024, 1024, 1024, (bf16_t*)(wd + (size_t)e * 1024 * 1024 * esz), 1024, 0, (tl >> 4) * 64, (tl & 15) * 64, sdn}; });
}

DI void ln1_router_phase(const Frame& F0, const float* xin  , const bf16_t* mix, bf16_t* xb, const float* lng, const float* lnb, int layer, unsigned char* xb8 = nullptr  ) {
    Frame F = F0; F.tid = F.wave * 64 + lane_id(); asm volatile("" : "+v"(F.tid)); F.lane = F.tid & 63;
    LAS float* tile = (LAS float*)F.lds;
    LAS float* part = (LAS float*)(F.lds + 16 * 1028 * 4);
    LAS float* lgt = part + 8 * 256;
    LAS float* scr = lgt + 256;
    LAS int* hist = (LAS int*)(scr + 256);
    const float* rw = F.in[22]; const float* rb = F.in[23];
    const int lane = F.lane, w = F.wave, fr = lane & 15, fq = lane >> 4;
    if (F.tid < 16) hist[F.tid] = 0;
    float bfrag[32];
#pragma unroll
    for (int s = 0; s < 32; ++s) bfrag[s] = rw[(size_t)(128 * w + 4 * s + fq) * 16 + fr];
    f32x4 gv[4], bv[4];
#pragma unroll
    for (int j = 0; j < 4; ++j) { gv[j] = *(const f32x4*)(lng + j * 256 + lane * 4); bv[j] = *(const f32x4*)(lnb + j * 256 + lane * 4); }
    int* tok_e = (int*)(F.ws + SM_TOKE); float* tok_w = (float*)(F.ws + SM_TOKW);
    const int t0 = F.wg * 256;
    f32x4 xv[2][4]; u32x2 mv[2][4];
    auto issue_rows = [&](int grp) {
#pragma unroll
        for (int rr = 0; rr < 2; ++rr) { const size_t t = (size_t)t0 + grp * 16 + 2 * w + rr;
#pragma unroll
            for (int j = 0; j < 4; ++j) {
                if (xin) xv[rr][j] = *(const f32x4*)(xin + t * D + j * 256 + lane * 4);
                else { const u32x2 xr = *(const u32x2*)(xb + t * D + j * 256 + lane * 4); xv[rr][j] = (f32x4){__uint_as_float(xr[0] << 16), __uint_as_float(xr[0] & 0xffff0000u), __uint_as_float(xr[1] << 16), __uint_as_float(xr[1] & 0xffff0000u)}; }
                if (mix) mv[rr][j] = *(const u32x2*)(mix + t * D + j * 256 + lane * 4); } }
    };
    issue_rows(0);
    for (int grp = 0; grp < 16; ++grp) {
        __syncthreads();
#pragma unroll
        for (int rr = 0; rr < 2; ++rr) {
            const int i = 2 * w + rr; const size_t t = (size_t)t0 + grp * 16 + i;
            f32x4 y[4]; float s = 0.f;
#pragma unroll
            for (int j = 0; j < 4; ++j) { y[j] = xv[rr][j] * ALPHA;
                if (mix) { const u32x2 m2 = mv[rr][j]; y[j] += (f32x4){__uint_as_float(m2[0] << 16), __uint_as_float(m2[0] & 0xffff0000u), __uint_as_float(m2[1] << 16), __uint_as_float(m2[1] & 0xffff0000u)}; }
                s += y[j][0] + y[j][1] + y[j][2] + y[j][3]; }
            const float mean = wave_sum(s) * (1.0f / D); float q = 0.f;
#pragma unroll
            for (int j = 0; j < 4; ++j) { y[j] -= mean; q += y[j][0] * y[j][0] + y[j][1] * y[j][1] + y[j][2] * y[j][2] + y[j][3] * y[j][3]; }
            const float rstd = rsqrtf(wave_sum(q) * (1.0f / D) + LN_EPS);
#pragma unroll
            for (int j = 0; j < 4; ++j) { f32x4 o = y[j] * rstd * gv[j] + bv[j];
                { u32x2 ob; ob[0] = pack2(o[0], o[1]); ob[1] = pack2(o[2], o[3]); *(u32x2*)(xb + t * D + j * 256 + lane * 4) = ob; }
                if (xb8) *(unsigned*)(xb8 + t * D + j * 256 + lane * 4) = pk_fp8x4(o[0] * F8_SX, o[1] * F8_SX, o[2] * F8_SX, o[3] * F8_SX);
                *(LAS f32x4*)(tile + i * 1028 + j * 256 + lane * 4) = o; }
        }
        if (grp + 1 < 16) issue_rows(grp + 1);
        __syncthreads();
        f32x4 acc = (f32x4){0.f, 0.f, 0.f, 0.f};
#pragma unroll
        for (int s = 0; s < 32; ++s) { const float a = tile[fr * 1028 + 128 * w + 4 * s + fq]; acc = __builtin_amdgcn_mfma_f32_16x16x4f32(a, bfrag[s], acc, 0, 0, 0); }
#pragma unroll
        for (int r = 0; r < 4; ++r) part[w * 256 + (4 * fq + r) * 16 + fr] = acc[r];
        __syncthreads();
        if (F.tid < 256) { float s = 0.f;
#pragma unroll
            for (int ww = 0; ww < 8; ++ww) s += part[ww * 256 + F.tid];
            const float aff = sigmoidf_(s); lgt[F.tid] = aff; scr[F.tid] = aff + rb[F.tid & 15]; }
        __syncthreads();
        if (F.tid < 16) {
            const int i = F.tid; const LAS float* sc = scr + i * 16; const LAS float* af = lgt + i * 16;
            int bg = 0; float bs = -1e30f;
#pragma unroll
            for (int gr = 0; gr < 4; ++gr) { const float a = sc[4 * gr], b = sc[4 * gr + 1], c = sc[4 * gr + 2], d = sc[4 * gr + 3];
                const float x = fmaxf(a, b), yv = fminf(a, b), z = fmaxf(c, d), u = fminf(c, d);
                const float top2 = fmaxf(x, z) + fmaxf(fminf(x, z), fmaxf(yv, u));
                if (top2 > bs) { bs = top2; bg = gr; } }
            const float v0 = sc[4 * bg], v1 = sc[4 * bg + 1], v2 = sc[4 * bg + 2], v3 = sc[4 * bg + 3];
            int l0 = 0; float m0 = v0; if (v1 > m0) { m0 = v1; l0 = 1; } if (v2 > m0) { m0 = v2; l0 = 2; } if (v3 > m0) { m0 = v3; l0 = 3; }
            int l1 = -1; float m1 = -1e30f;
            if (l0 != 0 && v0 > m1) { m1 = v0; l1 = 0; } if (l0 != 1 && v1 > m1) { m1 = v1; l1 = 1; } if (l0 != 2 && v2 > m1) { m1 = v2; l1 = 2; } if (l0 != 3 && v3 > m1) { m1 = v3; l1 = 3; }
            const int e0 = 4 * bg + l0, e1 = 4 * bg + l1; const float a0 = af[e0], a1 = af[e1], inv = rcpf_(a0 + a1);
            const size_t t = (size_t)t0 + grp * 16 + i;
            tok_e[2 * t] = e0; tok_e[2 * t + 1] = e1; tok_w[2 * t] = a0 * inv; tok_w[2 * t + 1] = a1 * inv;
            lds_add(&hist[e0], 1); lds_add(&hist[e1], 1);
        }
    }
    __syncthreads();
    if (F.tid < 16) ((int*)(F.ws + CTL_BLKCNT))[(layer * 256 + F.wg) * 16 + F.tid] = hist[F.tid];
    __syncthreads();
}

DI void moe_scatter_phase(const Frame& F0, const float* xa, int layer) {
    Frame F = F0; F.tid = F.wave * 64 + lane_id(); asm volatile("" : "+v"(F.tid)); F.lane = F.tid & 63;
    LAS int* tot = (LAS int*)F.lds; LAS int* before = tot + 16; LAS int* base = tot + 32; LAS int* lcnt = tot + 48;
    const int* blk = (const int*)(F.ws + CTL_BLKCNT) + layer * 256 * 16;
    __syncthreads();
    if (F.tid < 16) { int tt = 0, bb = 0; for (int g = 0; g < 256; ++g) { const int c = blk[g * 16 + F.tid]; tt += c; bb += (g < F.wg) ? c : 0; } tot[F.tid] = tt; before[F.tid] = bb; lcnt[F.tid] = 0; }
    __syncthreads();
    if (F.tid == 0) { int ts = 0; int* gts = (int*)(F.ws + CTL_TILES) + layer * 32;
        for (int e = 0; e < 16; ++e) { base[e] = ts * 256 + before[e]; if (F.wg == 0) gts[e] = ts; ts += (tot[e] + 255) >> 8; }
        if (F.wg == 0) gts[16] = ts; }
    __syncthreads();
    const int* tok_e = (const int*)(F.ws + SM_TOKE); int* tok_p = (int*)(F.ws + SM_TOKP); int* rowtok = (int*)(F.ws + SM_ROWTOK);
    const int t0 = F.wg * 256;
    { const int i = F.tid; const int e = tok_e[2 * t0 + i]; const int pos = base[e] + lds_add(&lcnt[e], 1); tok_p[2 * t0 + i] = pos; rowtok[pos] = t0 + (i >> 1); }
    if (F.wg == 0) {
        for (int e = 0; e < 16; ++e) { const int rs = base[e] - before[e], lo = rs + tot[e], hi = rs + (((tot[e] + 255) >> 8) << 8);
            for (int i = lo + F.tid; i < hi; i += NTH) rowtok[i] = 0; }
    }
    __syncthreads();
}

DI void ln2_phase(const Frame& F0, float* xout  , const float* lng, const float* lnb, bf16_t* xb, bool use_ffn, unsigned char* xb8 = nullptr  ) {
    Frame F = F0; F.tid = F.wave * 64 + lane_id(); asm volatile("" : "+v"(F.tid)); F.lane = F.tid & 63;
    const int lane = F.lane; const bf16_t* Y = (const bf16_t*)(F.ws + OFF_XS);
    const int* tok_p = (const int*)(F.ws + SM_TOKP); const float* tok_w = (const float*)(F.ws + SM_TOKW);
    f32x4 gv[4], bv[4];
#pragma unroll
    for (int j = 0; j < 4; ++j) { gv[j] = *(const f32x4*)(lng + j * 256 + lane * 4); bv[j] = *(const f32x4*)(lnb + j * 256 + lane * 4); }
    for (int r = F.wave; r < 256; r += 16) {
        size_t t[2]; int p0[2], p1[2]; float w0[2], w1[2]; f32x4 xv[2][4]; u32x2 ya[2][4], yb[2][4];
#pragma unroll
        for (int k = 0; k < 2; ++k) { t[k] = (size_t)F.wg * 256 + r + 8 * k; p0[k] = tok_p[2 * t[k]]; p1[k] = tok_p[2 * t[k] + 1]; w0[k] = tok_w[2 * t[k]]; w1[k] = tok_w[2 * t[k] + 1]; }
#pragma unroll
        for (int k = 0; k < 2; ++k)
#pragma unroll
            for (int j = 0; j < 4; ++j) { const u32x2 xr = *(const u32x2*)(xb + t[k] * D + j * 256 + lane * 4); xv[k][j] = (f32x4){__uint_as_float(xr[0] << 16), __uint_as_float(xr[0] & 0xffff0000u), __uint_as_float(xr[1] << 16), __uint_as_float(xr[1] & 0xffff0000u)}; }
        if (use_ffn) {
#pragma unroll
            for (int k = 0; k < 2; ++k)
#pragma unroll
                for (int j = 0; j < 4; ++j) { ya[k][j] = *(const u32x2*)(Y + (size_t)p0[k] * D + j * 256 + lane * 4); yb[k][j] = *(const u32x2*)(Y + (size_t)p1[k] * D + j * 256 + lane * 4); }
        }
#pragma unroll
        for (int k = 0; k < 2; ++k) {
            f32x4 y[4]; float s = 0.f;
#pragma unroll
            for (int j = 0; j < 4; ++j) { y[j] = xv[k][j] * ALPHA;
                if (use_ffn) { const u32x2 a = ya[k][j], b = yb[k][j];
                    y[j][0] += w0[k] * __uint_as_float(a[0] << 16) + w1[k] * __uint_as_float(b[0] << 16);
                    y[j][1] += w0[k] * __uint_as_float(a[0] & 0xffff0000u) + w1[k] * __uint_as_float(b[0] & 0xffff0000u);
                    y[j][2] += w0[k] * __uint_as_float(a[1] << 16) + w1[k] * __uint_as_float(b[1] << 16);
                    y[j][3] += w0[k] * __uint_as_float(a[1] & 0xffff0000u) + w1[k] * __uint_as_float(b[1] & 0xffff0000u); }
                s += y[j][0] + y[j][1] + y[j][2] + y[j][3]; }
            const float mean = wave_sum(s) * (1.0f / D); float q = 0.f;
#pragma unroll
            for (int j = 0; j < 4; ++j) { y[j] -= mean; q += y[j][0] * y[j][0] + y[j][1] * y[j][1] + y[j][2] * y[j][2] + y[j][3] * y[j][3]; }
            const float rstd = rsqrtf(wave_sum(q) * (1.0f / D) + LN_EPS);
#pragma unroll
            for (int j = 0; j < 4; ++j) { f32x4 o = y[j] * rstd * gv[j] + bv[j];
                if (xout) *(f32x4*)(xout + t[k] * D + j * 256 + lane * 4) = o;
                else { u32x2 ob; ob[0] = pack2(o[0], o[1]); ob[1] = pack2(o[2], o[3]); *(u32x2*)(xb + t[k] * D + j * 256 + lane * 4) = ob;
                    if (xb8) *(unsigned*)(xb8 + t[k] * D + j * 256 + lane * 4) = pk_fp8x4(o[0] * F8_SX, o[1] * F8_SX, o[2] * F8_SX, o[3] * F8_SX); } }
        }
    }
}

typedef short s16x4 __attribute__((ext_vector_type(4)));
#define MFMA16(a, b, c) __builtin_amdgcn_mfma_f32_16x16x32_bf16((a), (b), (c), 0, 0, 0)
DI bf16x8 ld_row(const LAS bf16_t* p) { return *(const LAS bf16x8*)p; }
DI bf16x8 ld_tr2(const LAS bf16_t* pa, const LAS bf16_t* pb) {
    const s16x4 lo = __builtin_amdgcn_ds_read_tr16_b64_v4i16((LAS s16x4*)pa), hi = __builtin_amdgcn_ds_read_tr16_b64_v4i16((LAS s16x4*)pb);
    return __builtin_shufflevector(lo, hi, 0, 1, 2, 3, 4, 5, 6, 7);
}

constexpr int R_LDK = 136, R_LDV = 264;
template <int NCOLS> DI void ret_copy(const Frame& F, const bf16_t* src, size_t gld, LAS bf16_t* dst, int lld) {
    constexpr int cpr = NCOLS >> 3, n = 128 * cpr;
    u32x4 v[n / NTH];
#pragma unroll
    for (int i = 0; i < n / NTH; ++i) { const int id = F.tid + i * NTH, r = id / cpr, ch = id % cpr; v[i] = *(const u32x4*)(src + (size_t)r * gld + ch * 8); }
#pragma unroll
    for (int i = 0; i < n / NTH; ++i) { const int id = F.tid + i * NTH, r = id / cpr, ch = id % cpr; *(LAS u32x4*)(dst + r * lld + ch * 8) = v[i]; }
}
template <int NCOLS> DI void blk_fetch(const Frame& F, const bf16_t* src, int gld, u32x4 (&v)[128 * (NCOLS >> 3) / NTH]) {
    constexpr int cpr = NCOLS >> 3;
    int t_ = F.tid; asm volatile("" : "+v"(t_));
#pragma unroll
    for (int i = 0; i < 128 * cpr / NTH; ++i) { const int id = t_ + i * NTH, r = id / cpr, ch = id % cpr; v[i] = *(const u32x4*)((const char*)src + (unsigned)(r * gld + ch * 8) * 2u); }
}
template <int NCOLS> DI void blk_put(const Frame& F, const u32x4 (&v)[128 * (NCOLS >> 3) / NTH], LAS bf16_t* dst, int lld) {
    constexpr int cpr = NCOLS >> 3;
    int t_ = F.tid; asm volatile("" : "+v"(t_));
#pragma unroll
    for (int i = 0; i < 128 * cpr / NTH; ++i) { const int id = t_ + i * NTH, r = id / cpr, ch = id % cpr; *(LAS u32x4*)(dst + r * lld + ch * 8) = v[i]; }
}
template <int NCOLS> DI void blk_fetch8(const Frame& F, const unsigned char* src, int gld, u32x4 (&v)[128 * (NCOLS >> 4) / NTH]) {
    constexpr int cpr = NCOLS >> 4;
    int t_ = F.tid; asm volatile("" : "+v"(t_));
#pragma unroll
    for (int i = 0; i < 128 * cpr / NTH; ++i) { const int id = t_ + i * NTH, r = id / cpr, ch = id % cpr; v[i] = *(const u32x4*)(src + (unsigned)(r * gld + ch * 16)); }
}
DI u32x2 fp8x4_bf16(unsigned d) { const auto a = __builtin_amdgcn_cvt_pk_f32_fp8((int)d, false), b = __builtin_amdgcn_cvt_pk_f32_fp8((int)d, true); u32x2 o; o[0] = pack2(a[0], a[1]); o[1] = pack2(b[0], b[1]); return o; }
template <int NCOLS> DI void blk_put8(const Frame& F, const u32x4 (&v)[128 * (NCOLS >> 4) / NTH], LAS bf16_t* dst, int lld) {
    constexpr int cpr = NCOLS >> 4;
    int t_ = F.tid; asm volatile("" : "+v"(t_));
#pragma unroll
    for (int i = 0; i < 128 * cpr / NTH; ++i) { const int id = t_ + i * NTH, r = id / cpr, ch = id % cpr; u32x4 lo, hi;
        const u32x2 c0 = fp8x4_bf16(v[i][0]), c1 = fp8x4_bf16(v[i][1]), c2 = fp8x4_bf16(v[i][2]), c3 = fp8x4_bf16(v[i][3]);
        lo = (u32x4){c0[0], c0[1], c1[0], c1[1]}; hi = (u32x4){c2[0], c2[1], c3[0], c3[1]};
        *(LAS u32x4*)(dst + r * lld + ch * 16) = lo; *(LAS u32x4*)(dst + r * lld + ch * 16 + 8) = hi; }
}
DI void ret_r1_unit(const Frame& F0, const bf16_t* Pg, bf16_t* KV, int unit) {
    Frame F = F0; F.tid = F.wave * 64 + lane_id(); asm volatile("" : "+v"(F.tid)); F.lane = F.tid & 63;
    const int c = unit & 63, h = (unit >> 6) & 7, bl = unit >> 9;
    LAS bf16_t* Kd = (LAS bf16_t*)F.lds; LAS bf16_t* Vs = Kd + 128 * R_LDK;
    const size_t row0 = (size_t)bl * 8192 + c * 128;
    const float l2g = log2f(1.0f - exp2f(-5.0f - (float)h));
    __syncthreads();
    { u32x4 kv_[4]; blk_fetch<128>(F, Pg + row0 * PGLD + 1024 + h * 128, PGLD, kv_);
#pragma unroll
      for (int i = 0; i < 4; ++i) { const int r_ = (F.tid + i * NTH) >> 4; const float sc = 0.08838834764831845f * __builtin_amdgcn_exp2f((float)(127 - r_) * l2g); float t8[8]; unpack8(kv_[i], t8);
#pragma unroll
          for (int e = 0; e < 8; ++e) t8[e] *= sc;
          kv_[i] = pack8(t8); }
      blk_put<128>(F, kv_, Kd, R_LDK); }
    if (PGV8) { u32x4 vv_[4]; blk_fetch8<256>(F, (const unsigned char*)Pg + row0 * 8192 + 4096 + h * 256, 8192, vv_); blk_put8<256>(F, vv_, Vs, R_LDV); }
    else ret_copy<256>(F, Pg + row0 * 6144 + 2048 + h * 256, 6144, Vs, R_LDV);
    __syncthreads();
    int w = F.wave; asm volatile("" : "+s"(w));
    const int lane = F.lane, fq = lane >> 4, q = (lane & 15) >> 2, pp = lane & 3;
    f32x4 acc[16];
#pragma unroll
    for (int i = 0; i < 16; ++i) acc[i] = (f32x4){0.f, 0.f, 0.f, 0.f};
#pragma unroll
    for (int ks = 0; ks < 4; ++ks) {
        const int ra = 32 * ks + 8 * fq + q, rb = ra + 4;
        const bf16x8 X = ld_tr2(Kd + ra * R_LDK + 16 * w + 4 * pp, Kd + rb * R_LDK + 16 * w + 4 * pp);
#pragma unroll
        for (int vt = 0; vt < 16; ++vt) { const bf16x8 Y = ld_tr2(Vs + ra * R_LDV + 16 * vt + 4 * pp, Vs + rb * R_LDV + 16 * vt + 4 * pp); acc[vt] = MFMA16(Y, X, acc[vt]); }
    }
    bf16_t* o = KV + (size_t)unit * 32768 + (16 * w + (lane & 15)) * 256 + 4 * fq;
#pragma unroll
    for (int vt = 0; vt < 16; ++vt) { u32x2 ov; ov[0] = pack2(acc[vt][0], acc[vt][1]); ov[1] = pack2(acc[vt][2], acc[vt][3]); *(u32x2*)(o + 16 * vt) = ov; }
}
DI void ret_r2_phase(const Frame& F0, bf16_t* KV) {
    Frame F = F0; F.tid = F.wave * 64 + lane_id(); asm volatile("" : "+v"(F.tid)); F.lane = F.tid & 63;
    const int gt = F.wg * NTH + F.tid;
    if (gt >= 65536) return;
    const int pair = gt >> 12, e8 = gt & 4095, h = pair & 7;
    const float cd = exp2f(128.0f * log2f(1.0f - exp2f(-5.0f - (float)h)));
    float st[8];
#pragma unroll
    for (int i = 0; i < 8; ++i) st[i] = 0.f;
#pragma unroll 8
    for (int c = 0; c < 64; ++c) {
        bf16_t* p = KV + ((size_t)(pair * 64 + c)) * 32768 + (size_t)e8 * 8;
        float kv[8]; unpack8(*(const u32x4*)p, kv);
        *(u32x4*)p = pack8(st);
#pragma unroll
        for (int i = 0; i < 8; ++i) st[i] = st[i] * cd + kv[i];
    }
}
DI void ret_r3_phase(const Frame& F0, const bf16_t* Pg, const bf16_t* RS, bf16_t* O1, int gq, const float* gn) {
    Frame F = F0; F.tid = F.wave * 64 + lane_id(); asm volatile("" : "+v"(F.tid)); F.lane = F.tid & 63;
    LAS bf16_t* Qs = (LAS bf16_t*)F.lds; LAS bf16_t* Ks = Qs + 128 * R_LDK; LAS bf16_t* Vh = Ks + 128 * R_LDK; LAS bf16_t* Rh = Vh + 128 * R_LDK;
    int w = F.wave; asm volatile("" : "+s"(w));
    u32x4 RQ[4], RK[4];
    { const int u0 = F.wg; const size_t r0 = (size_t)(u0 >> 9) * 8192 + (u0 & 63) * 128; const int h0 = (u0 >> 6) & 7;
      blk_fetch<128>(F, Pg + r0 * PGLD + h0 * 128, PGLD, RQ); blk_fetch<128>(F, Pg + r0 * PGLD + 1024 + h0 * 128, PGLD, RK); }
#pragma unroll 1
    for (int unit = F.wg; unit < 1024; unit += GRID) {
        const int c = unit & 63, h = (unit >> 6) & 7, bl = unit >> 9;
        const size_t row0 = (size_t)bl * 8192 + c * 128;
        const float l2g = log2f(1.0f - exp2f(-5.0f - (float)h));
        const bf16_t* rsu = RS + (size_t)unit * 32768;
        int lane = F.lane; asm volatile("" : "+v"(lane));
        const int fr = lane & 15, fq = lane >> 4, q = fr >> 2, pp = lane & 3;
        __syncthreads();
        blk_put<128>(F, RQ, Qs, R_LDK); blk_put<128>(F, RK, Ks, R_LDK);
        static_assert(PGV8, "the chunk-output phase reads v and g as e4m3");
        u32x4 RV[2], RR[4];
        const unsigned char* Pg8 = (const unsigned char*)Pg + row0 * 8192 + 4096 + h * 256;
        blk_fetch8<128>(F, Pg8, 8192, RV);
        blk_fetch<128>(F, rsu, 256, RR);
        __syncthreads();
        f32x4 sacc[8];
#pragma unroll
        for (int jt = 0; jt < 8; ++jt) sacc[jt] = (f32x4){0.f, 0.f, 0.f, 0.f};
#pragma unroll
        for (int ks = 0; ks < 4; ++ks) {
            const bf16x8 Yq = ld_row(Qs + (16 * w + fr) * R_LDK + 32 * ks + 8 * fq);
#pragma unroll
            for (int jt = 0; jt < 8; ++jt) { const bf16x8 Xk = ld_row(Ks + (16 * jt + fr) * R_LDK + 32 * ks + 8 * fq); sacc[jt] = MFMA16(Xk, Yq, sacc[jt]); }
        }
        __syncthreads();
        { const int i = 16 * w + fr;
#pragma unroll
          for (int jt = 0; jt < 8; ++jt) { float pv[4];
#pragma unroll
              for (int r = 0; r < 4; ++r) { const int j = 16 * jt + 4 * fq + r; pv[r] = (i >= j) ? sacc[jt][r] * (0.08838834764831845f * __builtin_amdgcn_exp2f((float)(i - j) * l2g)) : 0.f; }
              u32x2 o; o[0] = pack2(pv[0], pv[1]); o[1] = pack2(pv[2], pv[3]);
              *(LAS u32x2*)(Ks + i * R_LDK + 16 * jt + 4 * fq) = o; } }
        f32x4 acc[16];
#pragma unroll
        for (int i = 0; i < 16; ++i) acc[i] = (f32x4){0.f, 0.f, 0.f, 0.f};
        const float qdec = exp2f((float)(16 * w + fr + 1) * l2g);
        u32x4 RG[4];
#pragma unroll
        for (int half = 0; half < 2; ++half) {
            if (half) __syncthreads();
            blk_put8<128>(F, RV, Vh, R_LDK);
            blk_put<128>(F, RR, Rh, R_LDK);
            if (half == 0) { blk_fetch8<128>(F, Pg8 + 128, 8192, RV);
                blk_fetch<128>(F, rsu + 128, 256, RR); }
            else blk_fetch8<256>(F, Pg8 + 2048, 8192, RG);
            __syncthreads();
#pragma unroll
            for (int ks = 0; ks < 4; ++ks) {
                const bf16x8 Yq = ld_row(Qs + (16 * w + fr) * R_LDK + 32 * ks + 8 * fq);
                const int ra = 32 * ks + 8 * fq + q, rb = ra + 4;
#pragma unroll
                for (int vt = 0; vt < 8; ++vt) { const bf16x8 Xr = ld_tr2(Rh + ra * R_LDK + 16 * vt + 4 * pp, Rh + rb * R_LDK + 16 * vt + 4 * pp); acc[half * 8 + vt] = MFMA16(Xr, Yq, acc[half * 8 + vt]); }
            }
#pragma unroll
            for (int vt = 0; vt < 8; ++vt) acc[half * 8 + vt] *= qdec;
#pragma unroll
            for (int ks = 0; ks < 4; ++ks) {
                const bf16x8 Yp = ld_row(Ks + (16 * w + fr) * R_LDK + 32 * ks + 8 * fq);
                const int ra = 32 * ks + 8 * fq + q, rb = ra + 4;
#pragma unroll
                for (int vt = 0; vt < 8; ++vt) { const bf16x8 Xv = ld_tr2(Vh + ra * R_LDK + 16 * vt + 4 * pp, Vh + rb * R_LDK + 16 * vt + 4 * pp); acc[half * 8 + vt] = MFMA16(Xv, Yp, acc[half * 8 + vt]); }
            }
        }
        __syncthreads();
        LAS bf16_t* Gs = Vh;
        LAS float* gnl = (LAS float*)(Qs);
        blk_put8<256>(F, RG, Gs, R_LDV);
        if (F.tid < 256) { gnl[F.tid] = gn[h * 256 + F.tid]; gnl[256 + F.tid] = gn[2048 + h * 256 + F.tid]; }
        { const int un = unit + GRID; if (un < 1024) { const size_t rn = (size_t)(un >> 9) * 8192 + (un & 63) * 128; const int hn = (un >> 6) & 7;
            blk_fetch<128>(F, Pg + rn * PGLD + hn * 128, PGLD, RQ); blk_fetch<128>(F, Pg + rn * PGLD + 1024 + hn * 128, PGLD, RK); } }
        float s = 0.f;
#pragma unroll
        for (int vt = 0; vt < 16; ++vt) s += acc[vt][0] + acc[vt][1] + acc[vt][2] + acc[vt][3];
        s += shx(s, 16); s += shx(s, 32);
        const float mean = s * (1.0f / 256.0f); float qq = 0.f;
#pragma unroll
        for (int vt = 0; vt < 16; ++vt)
#pragma unroll
            for (int r = 0; r < 4; ++r) { const float d = acc[vt][r] - mean; qq += d * d; }
        qq += shx(qq, 16); qq += shx(qq, 32);
        const float rstd = rsqrtf(qq * (1.0f / 256.0f) + (PGV8 ? 1e-5f * F8_SX * F8_SX : 1e-5f));
        __syncthreads();
        const size_t trow = row0 + 16 * w + fr;
        bf16_t* op = O1 + ((size_t)gq * 16384 + trow) * 2048 + h * 256;
#pragma unroll
        for (int vt = 0; vt < 16; ++vt) {
            const int v0 = 16 * vt + 4 * fq;
            if ((vt & 3) == 0) asm volatile("" ::: "memory");
            const u32x2 gr = *(const LAS u32x2*)(Gs + (16 * w + fr) * R_LDV + v0);
            const f32x4 gg = *(const LAS f32x4*)(gnl + v0), gb = *(const LAS f32x4*)(gnl + 256 + v0);
            float gv[4] = {__uint_as_float(gr[0] << 16), __uint_as_float(gr[0] & 0xffff0000u), __uint_as_float(gr[1] << 16), __uint_as_float(gr[1] & 0xffff0000u)};
            if (PGV8) {
#pragma unroll
                for (int r = 0; r < 4; ++r) gv[r] *= (1.0f / F8_SX); }
            float o[4];
#pragma unroll
            for (int r = 0; r < 4; ++r) { const float nv = (acc[vt][r] - mean) * rstd * gg[r] + gb[r]; o[r] = siluf_(gv[r]) * nv; }
            if (RTO8) *(unsigned*)((unsigned char*)O1 + ((size_t)gq * 16384 + trow) * 2048 + h * 256 + v0) = pk_fp8x4(o[0] * F8_SO, o[1] * F8_SO, o[2] * F8_SO, o[3] * F8_SO);
            else { u32x2 ov; ov[0] = pack2(o[0], o[1]); ov[1] = pack2(o[2], o[3]);
            *(u32x2*)(op + v0) = ov; }
        }
    }
}

DI bf16_t* st_w(const Frame& F) { return (bf16_t*)(F.ws + OFF_STR); }
DI bf16_t* st_kk(const Frame& F) { return (bf16_t*)(F.ws + OFF_STR) + (size_t)T * 512; }
DI bf16_t* st_b(const Frame& F) { return (bf16_t*)F.out; }
DI bf16_t* st_kp(const Frame& F) { return (bf16_t*)F.out + (size_t)T * 512; }
DI bf16_t* st_r(const Frame& F) { return (bf16_t*)F.out + (size_t)T * 1024; }
DI bf16_t* st_v(const Frame& F) { return (bf16_t*)F.out + (size_t)T * 1536; }

DI void rwkv_e1_phase(const Frame& F0) {
    Frame F = F0; F.tid = F.wave * 64 + lane_id(); asm volatile("" : "+v"(F.tid)); F.lane = F.tid & 63;
    const bf16_t* PR = (const bf16_t*)(F.ws + OFF_PR); const float* mu = F.in[3]; const float* kkw = F.in[12];
    const int c = F.lane * 8;
    float m0[8], m1[8], m2[8], kw[8];
#pragma unroll
    for (int i = 0; i < 8; ++i) { m0[i] = mu[c + i]; m1[i] = mu[512 + c + i]; m2[i] = mu[1024 + c + i]; kw[i] = kkw[c + i]; }
    float* rn = (float*)(F.ws + SM_RNORM);
    for (int r = F.wave; r < 256; r += 16) {
        u32x4 ld[2][6]; size_t t[2];
#pragma unroll
        for (int k = 0; k < 2; ++k) { t[k] = (size_t)F.wg * 256 + r + 8 * k; const size_t row = t[k] + (t[k] >> 13) + 1;
            const bf16_t* cur = PR + row * 2048 + c; const bf16_t* prv = cur - 2048;
            ld[k][0] = *(const u32x4*)cur; ld[k][1] = *(const u32x4*)prv; ld[k][2] = *(const u32x4*)(cur + 512); ld[k][3] = *(const u32x4*)(prv + 512); ld[k][4] = *(const u32x4*)(cur + 1024); ld[k][5] = *(const u32x4*)(prv + 1024); }
#pragma unroll
        for (int k = 0; k < 2; ++k) {
            float a[8], p[8], o[8];
            unpack8(ld[k][0], a); unpack8(ld[k][1], p);
#pragma unroll
            for (int i = 0; i < 8; ++i) o[i] = a[i] + (p[i] - a[i]) * m0[i];
            *(u32x4*)(st_r(F) + t[k] * 512 + c) = pack8(o);
            unpack8(ld[k][2], a); unpack8(ld[k][3], p);
            float ss = 0.f;
#pragma unroll
            for (int i = 0; i < 8; ++i) { o[i] = a[i] + (p[i] - a[i]) * m1[i]; const float q = o[i] * kw[i]; ss += q * q; }
            *(u32x4*)(st_kp(F) + t[k] * 512 + c) = pack8(o);
            ss += shx(ss, 1); ss += shx(ss, 2); ss += shx(ss, 4);
            if ((F.lane & 7) == 0) rn[t[k] * 8 + (F.lane >> 3)] = rcpf_(fmaxf(__builtin_amdgcn_sqrtf(ss), 1e-12f));
            unpack8(ld[k][4], a); unpack8(ld[k][5], p);
#pragma unroll
            for (int i = 0; i < 8; ++i) o[i] = a[i] + (p[i] - a[i]) * m2[i];
            *(u32x4*)(st_v(F) + t[k] * 512 + c) = pack8(o);
        }
    }
}

DI float dpp_f(float v, int ctrl_qp1, int) { return v; }
template <int CTRL> DI float dpp_mov(float v) { return __int_as_float(__builtin_amdgcn_update_dpp(0, __float_as_int(v), CTRL, 0xf, 0xf, true)); }
DI float row_sum16(float v) {
    v += dpp_mov<0xB1>(v);
    v += dpp_mov<0x4E>(v);
    v += dpp_mov<0x141>(v);
    v += dpp_mov<0x140>(v);
    return v;
}

DI float row_sum8(float v) {
    v += dpp_mov<0xB1>(v);
    v += dpp_mov<0x4E>(v);
    v += dpp_mov<0x141>(v);
    return v;
}
typedef _Float16 h2_t __attribute__((ext_vector_type(2)));
typedef _Float16 h8_t __attribute__((ext_vector_type(8)));
constexpr int SC_STEPS = 32;
constexpr int SC_BUF = SC_STEPS * (5 * 64 + 64) * 2;
constexpr int SC_WGS = 64;
constexpr int SC_OBS = 260;
struct ScOp { u32x4 a0, a1, a2, a3, a4; unsigned v0, v1; };
template <int U> DI void sc_ld(ScOp& o, unsigned pb, unsigned pv) {
    asm volatile("ds_read_b128 %0, %1 offset:%c2" : "=v"(o.a0) : "v"(pb), "i"(U * 640) : "memory");
    asm volatile("ds_read_b128 %0, %1 offset:%c2" : "=v"(o.a1) : "v"(pb), "i"(U * 640 + 128) : "memory");
    asm volatile("ds_read_b128 %0, %1 offset:%c2" : "=v"(o.a2) : "v"(pb), "i"(U * 640 + 256) : "memory");
    asm volatile("ds_read_b128 %0, %1 offset:%c2" : "=v"(o.a3) : "v"(pb), "i"(U * 640 + 384) : "memory");
    asm volatile("ds_read_b128 %0, %1 offset:%c2" : "=v"(o.a4) : "v"(pb), "i"(U * 640 + 512) : "memory");
    asm volatile("ds_read_u16 %0, %1 offset:%c2" : "=v"(o.v0) : "v"(pv), "i"(U * 128) : "memory");
    asm volatile("ds_read_u16 %0, %1 offset:%c2" : "=v"(o.v1) : "v"(pv), "i"(U * 128 + 2) : "memory");
}
DI void sc_wait(ScOp& o) { asm volatile("s_waitcnt lgkmcnt(0)" : "+v"(o.a0), "+v"(o.a1), "+v"(o.a2), "+v"(o.a3), "+v"(o.a4), "+v"(o.v0), "+v"(o.v1) :: "memory"); }
DI h2_t h2of(unsigned x) { return __builtin_bit_cast(h2_t, x); }
DI float dot2z(h2_t a, h2_t b) { float r; asm("v_dot2_f32_f16 %0, %1, %2, 0" : "=v"(r) : "v"(a), "v"(b)); return r; }
DI float sc_dot(const h2_t (&S)[4], const u32x4& x) {
    float o = dot2z(S[0], h2of(x[0])); o = __builtin_amdgcn_fdot2(S[1], h2of(x[1]), o, false); o = __builtin_amdgcn_fdot2(S[2], h2of(x[2]), o, false); return __builtin_amdgcn_fdot2(S[3], h2of(x[3]), o, false); }
DI unsigned sc_readout(const h2_t (&S)[2][4], const u32x4& rp) {
    const float o0 = sc_dot(S[0], rp), o1 = sc_dot(S[1], rp);
    return __builtin_bit_cast(unsigned, __builtin_amdgcn_cvt_pkrtz(o0, o1));
}
template <int U> DI void sc_step(h2_t (&S)[2][4], ScOp& cur, u32x4& rp, LAS unsigned* obw, unsigned pb, unsigned pv) {
    ScOp nxt; sc_ld<U + 1>(nxt, pb, pv);
    __builtin_amdgcn_sched_barrier(0);
    const float sa0 = sc_dot(S[0], cur.a1), sa1 = sc_dot(S[1], cur.a1);
    obw[U * SC_OBS] = sc_readout(S, rp);
    const _Float16 sh0 = (_Float16)(-row_sum8(sa0)), sh1 = (_Float16)(-row_sum8(sa1));
    const h2_t sav[2] = {(h2_t){sh0, sh0}, (h2_t){sh1, sh1}};
    const _Float16 vh0 = h2of(cur.v0)[0], vh1 = h2of(cur.v1)[0];
    const h2_t vv2[2] = {(h2_t){vh0, vh0}, (h2_t){vh1, vh1}};
#pragma unroll
    for (int rw = 0; rw < 2; ++rw)
#pragma unroll
        for (int i = 0; i < 4; ++i) S[rw][i] = S[rw][i] * h2of(cur.a0[i]) + (sav[rw] * h2of(cur.a2[i]) + vv2[rw] * h2of(cur.a3[i]));
    rp = cur.a4;
    __builtin_amdgcn_sched_barrier(0);
    sc_wait(nxt); cur = nxt;
}
DI void rwkv_scan(const Frame& F0, const bool do_post = true) {
    Frame F = F0; F.tid = F.wave * 64 + lane_id(); asm volatile("" : "+v"(F.tid)); F.lane = F.tid & 63;
    const int stream = F.wg, b = stream >> 3, h = stream & 7;
    const int rloc = 16 * F.wave + 2 * (F.lane >> 3), cg = F.lane & 7;
    const size_t tb = (size_t)b * SEQ;
    LAS unsigned* OBP = (LAS unsigned*)(F.lds + 2 * SC_BUF);
    const bf16_t* arrs[6] = {st_w(F), st_kk(F), st_b(F), st_kp(F), st_r(F), st_v(F)};
    u32x4 stage[3];
    const bool hiw = F.wave >= 4;
    const bf16_t* ab0 = hiw ? arrs[1] : arrs[0]; const bf16_t* ab1 = hiw ? arrs[3] : arrs[2]; const bf16_t* ab2 = hiw ? arrs[5] : arrs[4];
    const int lstep = (F.tid & 255) >> 3, lch = F.tid & 7;
    const size_t loff = (tb + (size_t)lstep) * 512 + h * 64 + lch * 8;
    auto issue = [&](int chunk) { const size_t o = loff + (size_t)chunk * SC_STEPS * 512;
        stage[0] = *(const u32x4*)(ab0 + o); stage[1] = *(const u32x4*)(ab1 + o); stage[2] = *(const u32x4*)(ab2 + o);
    };
    auto commit = [&](int buf) {
        LAS _Float16* L = (LAS _Float16*)(F.lds + buf * SC_BUF);
#pragma unroll
        for (int i = 0; i < 3; ++i) {
            float v[8]; unpack8(stage[i], v);
            h8_t hv;
#pragma unroll
            for (int e = 0; e < 8; ++e) hv[e] = (_Float16)v[e];
            LAS _Float16* d = (i == 2 && hiw) ? (L + SC_STEPS * 320 + lstep * 64 + lch * 8) : (L + lstep * 320 + (2 * i + (hiw ? 1 : 0)) * 64 + lch * 8);
            *(LAS h8_t*)d = hv; }
    };
    const int pstep = (F.tid - 256) >> 3, pc = h * 64 + 8 * (F.tid & 7);
    float lg[8], lb[8], rk[8];
    if (F.wave >= 4) {
#pragma unroll
        for (int i = 0; i < 8; ++i) { lg[i] = F.in[15][pc + i]; lb[i] = F.in[15][512 + pc + i]; rk[i] = F.in[14][pc + i]; } }
    bf16_t* O0 = (bf16_t*)(F.ws + OFF_O0);
    auto post = [&](int chunk) {
        const size_t t = tb + (size_t)chunk * SC_STEPS + pstep;
        const LAS unsigned* ob = OBP + ((chunk & 1) * (SC_STEPS + 1) + pstep + 1) * SC_OBS + 32 * (F.tid & 7);
        float o[8];
#pragma unroll
        for (int p = 0; p < 4; ++p) { float s0 = 0.f, s1 = 0.f;
#pragma unroll
            for (int hf = 0; hf < 2; ++hf) { const u32x4 q = *(const LAS u32x4*)(ob + p * 8 + hf * 4);
#pragma unroll
                for (int e = 0; e < 4; ++e) { const h2_t hv = h2of(q[e]); s0 += (float)hv[0]; s1 += (float)hv[1]; } }
            o[2 * p] = s0; o[2 * p + 1] = s1; }
        float rr[8], kp[8], vv[8], gg[8];
        unpack8(*(const u32x4*)(st_r(F) + t * 512 + pc), rr); unpack8(*(const u32x4*)(st_kp(F) + t * 512 + pc), kp); unpack8(*(const u32x4*)(st_v(F) + t * 512 + pc), vv);
        unpack8(*(const u32x4*)(O0 + t * 1024 + pc), gg);
        float s = 0.f, bs = 0.f;
#pragma unroll
        for (int i = 0; i < 8; ++i) { s += o[i]; bs += rr[i] * kp[i] * rk[i]; }
        s += shx(s, 1); s += shx(s, 2); s += shx(s, 4);
        bs += shx(bs, 1); bs += shx(bs, 2); bs += shx(bs, 4);
        const float mean = s * (1.0f / 64.0f); float q = 0.f;
#pragma unroll
        for (int i = 0; i < 8; ++i) { const float d = o[i] - mean; q += d * d; }
        q += shx(q, 1); q += shx(q, 2); q += shx(q, 4);
        const float rstd = rsqrtf(q * (1.0f / 64.0f) + 64e-5f);
        float res[8];
#pragma unroll
        for (int i = 0; i < 8; ++i) res[i] = ((o[i] - mean) * rstd * lg[i] + lb[i] + bs * vv[i]) * gg[i];
        *(u32x4*)(O0 + t * 1024 + pc) = pack8(res);
    };
    h2_t S[2][4];
#pragma unroll
    for (int i = 0; i < 4; ++i) { S[0][i] = (h2_t){(_Float16)0.f, (_Float16)0.f}; S[1][i] = S[0][i]; }
    __syncthreads();
    issue(0); commit(0);
    __syncthreads();
    constexpr int NCH = SEQ / SC_STEPS;
    for (int chunk = 0; chunk < NCH; ++chunk) {
        if (chunk + 1 < NCH) issue(chunk + 1);
        const LAS _Float16* L = (const LAS _Float16*)(F.lds + (chunk & 1) * SC_BUF);
        if (F.wave < 4) {
            LAS unsigned* obw = OBP + (chunk & 1) * (SC_STEPS + 1) * SC_OBS + F.tid;
            unsigned pb = (unsigned)(size_t)(F.lds + (chunk & 1) * SC_BUF) + 16 * cg, pv = (unsigned)(size_t)(F.lds + (chunk & 1) * SC_BUF) + SC_STEPS * 640 + 2 * rloc;
            ScOp cur; sc_ld<0>(cur, pb, pv); sc_wait(cur);
            u32x4 rp = cur.a4;
#pragma unroll 1
            for (int g8 = 0; g8 < SC_STEPS / 8; ++g8) {
                sc_step<0>(S, cur, rp, obw, pb, pv); sc_step<1>(S, cur, rp, obw, pb, pv); sc_step<2>(S, cur, rp, obw, pb, pv); sc_step<3>(S, cur, rp, obw, pb, pv);
                sc_step<4>(S, cur, rp, obw, pb, pv); sc_step<5>(S, cur, rp, obw, pb, pv); sc_step<6>(S, cur, rp, obw, pb, pv); sc_step<7>(S, cur, rp, obw, pb, pv);
                pb += 8 * 640; pv += 8 * 128; obw += 8 * SC_OBS;
            }
            obw[0] = sc_readout(S, rp);
        } else if (chunk > 0 && do_post) post(chunk - 1);
        if (chunk + 1 < NCH) commit((chunk + 1) & 1);
        __syncthreads();
    }
    if (F.wave >= 4 && do_post) post(NCH - 1);
}

DI void nsa_rope_phase(const Frame& F0) {
    Frame F = F0; F.tid = F.wave * 64 + lane_id(); asm volatile("" : "+v"(F.tid)); F.lane = F.tid & 63;
    bf16_t* PN = (bf16_t*)(F.ws + OFF_PN); const float* tab = (const float*)(F.ws + SM_ROPEN);
    const int hh = F.lane >> 2, j0 = (F.lane & 3) * 2;
    const int col = hh < 8 ? hh * 64 : 512 + ((hh - 8) >> 1) * 256 + ((hh - 8) & 1) * 64;
    if (hh >= 14) return;
    for (int r = F.wave; r < 256; r += 8) {
        const size_t t = (size_t)F.wg * 256 + r; const int pos = (int)(t & 8191);
        bf16_t* p = PN + t * 1536 + col + j0;
        const unsigned a = *(const unsigned*)p, bq = *(const unsigned*)(p + 8);
        const f32x4 cs = *(const f32x4*)(tab + ((size_t)pos * 8 + j0) * 2);
        const float x10 = __uint_as_float(a << 16), x11 = __uint_as_float(a & 0xffff0000u), x20 = __uint_as_float(bq << 16), x21 = __uint_as_float(bq & 0xffff0000u);
        *(unsigned*)p = pack2(x10 * cs[0] - x20 * cs[1], x11 * cs[2] - x21 * cs[3]);
        *(unsigned*)(p + 8) = pack2(x20 * cs[0] + x10 * cs[1], x21 * cs[2] + x11 * cs[3]);
    }
}
namespace pg8 {
struct CmpSched {
    const char* A; const char* B; size_t slotstepA, tstepA, bstride; int G, c;
    DI bool next(int i, Unit& u) const {
        const int L = i * G + c; if (L >= 64) return false;
        const int slot = L >> 4, pm = L & 15; u.pm = pm; u.pn = 0; u.aux = slot;
        u.a = A + (size_t)slot * slotstepA + (size_t)pm * tstepA; u.b = B + (size_t)(slot >> 1) * bstride; u.rows = nullptr; return true;
    }
};
}
constexpr int NS_STG = 16384, NS_NSTG = 4;
constexpr int NS_OFF_IMP = NS_NSTG * NS_STG, NS_OFF_SEL = NS_OFF_IMP + 128 * 128 * 4, NS_OFF_U = NS_OFF_SEL + 2048;
constexpr float NS_C = 0.125f * 1.44269504088896341f;
struct FState { f32x4 o[4][4]; float m[4], l[4]; };
struct TileSrc { const bf16_t* k; const bf16_t* v; size_t rstride; };
DI void ns_dma(const Frame& F, const TileSrc& S, int j, int stage) {
    int l_ = F.lane; asm volatile("" : "+v"(l_));
    const int row = 8 * F.wave + (l_ >> 3), c = (l_ & 7) ^ (l_ >> 3);
    const unsigned off = ((unsigned)(j * 64 + row) * (unsigned)S.rstride + c * 8) * 2u;
    LAS unsigned char* base = F.lds + stage * NS_STG + F.wave * 1024;
    __builtin_amdgcn_global_load_lds((const unsigned*)((const char*)S.k + off), (LAS unsigned*)base, 16, 0, 0);
    __builtin_amdgcn_global_load_lds((const unsigned*)((const char*)S.v + off), (LAS unsigned*)(base + 8192), 16, 0, 0);
}
DI void ns_wait(int after) {
    if (after >= 2) asm volatile("s_waitcnt vmcnt(4)" ::: "memory"); else if (after == 1) asm volatile("s_waitcnt vmcnt(2)" ::: "memory"); else asm volatile("s_waitcnt vmcnt(0)" ::: "memory");
    __builtin_amdgcn_s_barrier(); asm volatile("" ::: "memory");
}
DI float fexp2(float x) { return __builtin_amdgcn_exp2f(x); }
DI unsigned cvtpk(float lo, float hi) { return pack2(lo, hi); }
constexpr float NS_NINF = -__builtin_inff();
DI float vmax(float a, float b) { return __builtin_fmaxf(a, b); }
DI float vmax3(float a, float b, float c) { return __builtin_fmaxf(__builtin_fmaxf(a, b), c); }
DI float xquad_max(float v) {
    u32x2 r = __builtin_amdgcn_permlane16_swap(__float_as_uint(v), __float_as_uint(v), false, false);
    v = vmax(__uint_as_float(r[0]), __uint_as_float(r[1]));
    r = __builtin_amdgcn_permlane32_swap(__float_as_uint(v), __float_as_uint(v), false, false);
    return vmax(__uint_as_float(r[0]), __uint_as_float(r[1]));
}
template <int MM, bool PV, bool CMPHI = false, bool QL = false>
DI void ns_step(const LAS unsigned char* tb  , int kabs, const bf16x8 (&Qf)[4][2], FState& st, unsigned rtm, unsigned sb, int posl, int lod, int fr, int fq, int q, int pp, const LAS bf16_t* qb = nullptr) {
    const int lk = fr * 128 + ((fq ^ (fr & 7)) << 4);
    const int m_ = (4 * fq + q) & 7, vbl = (4 * fq + q) * 128 + ((((pp >> 1) ^ (m_ & 1))) << 4) + (pp & 1) * 8 + ((m_ >> 1) << 5);
    const LAS unsigned char* kp0 = tb + lk; const LAS unsigned char* kp1 = tb + (lk ^ 64); const LAS unsigned char* vp_ = tb + 8192 + vbl;
    asm volatile("" : "+v"(kp0), "+v"(kp1), "+v"(vp_));
    f32x4 s[2][4];
    bf16x8 X[2][2];
#pragma unroll
    for (int kt = 0; kt < 2; ++kt) { X[kt][0] = *(const LAS bf16x8*)(kp0 + kt * 2048); X[kt][1] = *(const LAS bf16x8*)(kp1 + kt * 2048); }
#pragma unroll
    for (int rt = 0; rt < 4; ++rt) if ((rtm >> rt) & 1u) {
        const bf16x8 q0 = QL ? ld_row(qb + (rt * 2 + 0) * 512) : Qf[rt][0], q1 = QL ? ld_row(qb + (rt * 2 + 1) * 512) : Qf[rt][1];
#pragma unroll
        for (int kt = 0; kt < 2; ++kt) { s[kt][rt] = MFMA16(X[kt][0], q0, ((f32x4){0.f, 0.f, 0.f, 0.f})); s[kt][rt] = MFMA16(X[kt][1], q1, s[kt][rt]); }
    }
    bf16x8 Y[4];
#pragma unroll
    for (int rt = 0; rt < 4; ++rt) {
        if ((rtm >> rt) & 1u) {
            if (MM) {
#pragma unroll
                for (int kt = 0; kt < 2; ++kt)
#pragma unroll
                    for (int r = 0; r < 4; ++r) { const int key = kabs + 16 * kt + 4 * fq + r; const int hi_ = CMPHI ? ((posl + 4 * rt - 31) >> 4) : (posl + 4 * rt);
                        const bool ok = MM == 1 ? (key <= hi_) : (key <= hi_ && key > hi_ - lod);
                        s[kt][rt][r] = ok ? s[kt][rt][r] : NS_NINF; }
            }
            const float rowneg = ((sb >> rt) & 1u) ? 0.f : NS_NINF;
            float mx = vmax3(s[0][rt][0], s[0][rt][1], s[0][rt][2]); mx = vmax3(mx, s[0][rt][3], s[1][rt][0]); mx = vmax3(mx, s[1][rt][1], s[1][rt][2]); mx = vmax(mx, s[1][rt][3]);
            mx = vmax(mx + rowneg, st.m[rt]);
            mx = xquad_max(mx);
            const float alpha = fexp2(st.m[rt] - mx); st.m[rt] = mx;
            const float c = rowneg - mx; const f32x2 c2 = (f32x2){c, c};
            f32x2 p[4];
#pragma unroll
            for (int kt = 0; kt < 2; ++kt) { const f32x2 a = (f32x2){s[kt][rt][0], s[kt][rt][1]} + c2, b = (f32x2){s[kt][rt][2], s[kt][rt][3]} + c2;
                p[2 * kt] = (f32x2){fexp2(a[0]), fexp2(a[1])}; p[2 * kt + 1] = (f32x2){fexp2(b[0]), fexp2(b[1])}; }
            const f32x2 ps2 = (p[0] + p[1]) + (p[2] + p[3]);
            st.l[rt] = st.l[rt] * alpha + (ps2[0] + ps2[1]);
            if (PV) {
                if (__ballot(alpha != 1.0f) != 0ull) {
#pragma unroll
                    for (int dt = 0; dt < 4; ++dt) st.o[dt][rt] *= alpha; }
                u32x4 w; w[0] = cvtpk(p[0][0], p[0][1]); w[1] = cvtpk(p[1][0], p[1][1]); w[2] = cvtpk(p[2][0], p[2][1]); w[3] = cvtpk(p[3][0], p[3][1]);
                Y[rt] = __builtin_bit_cast(bf16x8, w);
            }
        } else if (PV) {
            Y[rt] = (bf16x8){0, 0, 0, 0, 0, 0, 0, 0};
        }
    }
    if (PV) {
        const unsigned a0 = (unsigned)(size_t)vp_, a1 = a0 ^ 32u, a2 = a0 ^ 64u, a3 = a0 ^ 96u;
        s16x4 t0, t1, t2, t3, t4, t5, t6, t7;
        asm volatile("ds_read_b64_tr_b16 %0, %8\n\tds_read_b64_tr_b16 %1, %8 offset:2048\n\tds_read_b64_tr_b16 %2, %9\n\tds_read_b64_tr_b16 %3, %9 offset:2048\n\t"
                     "ds_read_b64_tr_b16 %4, %10\n\tds_read_b64_tr_b16 %5, %10 offset:2048\n\tds_read_b64_tr_b16 %6, %11\n\tds_read_b64_tr_b16 %7, %11 offset:2048\n\ts_waitcnt lgkmcnt(0)"
                     : "=&v"(t0), "=&v"(t1), "=&v"(t2), "=&v"(t3), "=&v"(t4), "=&v"(t5), "=&v"(t6), "=&v"(t7) : "v"(a0), "v"(a1), "v"(a2), "v"(a3) : "memory");
        const bf16x8 Xv[4] = {__builtin_shufflevector(t0, t1, 0, 1, 2, 3, 4, 5, 6, 7), __builtin_shufflevector(t2, t3, 0, 1, 2, 3, 4, 5, 6, 7), __builtin_shufflevector(t4, t5, 0, 1, 2, 3, 4, 5, 6, 7), __builtin_shufflevector(t6, t7, 0, 1, 2, 3, 4, 5, 6, 7)};
#pragma unroll
        for (int dt = 0; dt < 4; ++dt)
#pragma unroll
            for (int rt = 0; rt < 4; ++rt) st.o[dt][rt] = MFMA16(Xv[dt], Y[rt], st.o[dt][rt]);
    }
}
DI void ns_reset(FState& st) {
#pragma unroll
    for (int rt = 0; rt < 4; ++rt) { st.m[rt] = -1e30f; st.l[rt] = 0.f;
#pragma unroll
        for (int dt = 0; dt < 4; ++dt) st.o[dt][rt] = (f32x4){0.f, 0.f, 0.f, 0.f}; }
}


DI void ns_vtr8(const LAS unsigned char* vp_, bf16x8 (&Xv)[4]) {
    const unsigned a0 = (unsigned)(size_t)vp_, a1 = a0 ^ 32u, a2 = a0 ^ 64u, a3 = a0 ^ 96u;
    s16x4 t0, t1, t2, t3, t4, t5, t6, t7;
    asm volatile("ds_read_b64_tr_b16 %0, %8\n\tds_read_b64_tr_b16 %1, %8 offset:2048\n\tds_read_b64_tr_b16 %2, %9\n\tds_read_b64_tr_b16 %3, %9 offset:2048\n\t"
                 "ds_read_b64_tr_b16 %4, %10\n\tds_read_b64_tr_b16 %5, %10 offset:2048\n\tds_read_b64_tr_b16 %6, %11\n\tds_read_b64_tr_b16 %7, %11 offset:2048\n\ts_waitcnt lgkmcnt(0)"
                 : "=&v"(t0), "=&v"(t1), "=&v"(t2), "=&v"(t3), "=&v"(t4), "=&v"(t5), "=&v"(t6), "=&v"(t7) : "v"(a0), "v"(a1), "v"(a2), "v"(a3) : "memory");
    Xv[0] = __builtin_shufflevector(t0, t1, 0, 1, 2, 3, 4, 5, 6, 7); Xv[1] = __builtin_shufflevector(t2, t3, 0, 1, 2, 3, 4, 5, 6, 7);
    Xv[2] = __builtin_shufflevector(t4, t5, 0, 1, 2, 3, 4, 5, 6, 7); Xv[3] = __builtin_shufflevector(t6, t7, 0, 1, 2, 3, 4, 5, 6, 7);
}

namespace nsb {
typedef float f32x16 __attribute__((ext_vector_type(16)));
constexpr int NSLOT = 3, SLOTB = 8192, LDS_K = 0, LDS_V = NSLOT * SLOTB, LDS_WS = 2 * NSLOT * SLOTB, LDS_OST = LDS_WS + 8 * 64 * 4, LDS_BYTES = LDS_OST + 8 * 4096;
constexpr int PITCH = 1536;
DI int crow(int r, int hi) { return (r & 3) + 8 * (r >> 2) + 4 * hi; }
#define NSB_SBAR() __builtin_amdgcn_sched_barrier(0)
DI void glds16(const void* sbase_, unsigned voff, unsigned lds_dst) { unsigned keep;
    const unsigned long long a_ = (unsigned long long)sbase_;
    const unsigned long long sbase = ((unsigned long long)(unsigned)__builtin_amdgcn_readfirstlane((int)(a_ >> 32)) << 32) | (unsigned)__builtin_amdgcn_readfirstlane((int)a_);
    asm volatile("s_mov_b32 %0, m0\n\ts_mov_b32 m0, %3\n\ts_nop 0\n\tglobal_load_lds_dwordx4 %1, %2\n\ts_mov_b32 m0, %0" : "=&s"(keep) : "v"(voff), "s"(sbase), "s"(lds_dst) : "memory"); }
DI float max3f(float a, float b, float c) { float r; asm("v_max3_f32 %0, %1, %2, %3" : "=v"(r) : "v"(a), "v"(b), "v"(c)); return r; }
DI float max2f(float a, float b) { float r; asm("v_max_f32_e32 %0, %1, %2" : "=v"(r) : "v"(a), "v"(b)); return r; }
DI float fadd_s(float a, float b) { float r; asm("v_add_f32_e32 %0, %1, %2" : "=v"(r) : "v"(a), "v"(b)); return r; }
DI float fsub_s(float a, float b) { float r; asm("v_sub_f32_e32 %0, %1, %2" : "=v"(r) : "v"(a), "v"(b)); return r; }
#define NSB_WAIT_BAR(N) asm volatile("s_waitcnt vmcnt(" #N ") lgkmcnt(0)\n\ts_barrier" ::: "memory")
typedef LAS const char* lds_cptr;
DI void qkt(f32x16& p0, f32x16& p1, lds_cptr Kslot, const bf16x8* qr, const f32x16& negm, int r32, int hi) {
    lds_cptr kb = Kslot + hi * 1024 + r32 * 16;
#pragma unroll
    for (int d0 = 0; d0 < 4; ++d0) {
        const bf16x8 b0 = *(const LAS bf16x8*)(kb + d0 * 2048), b1 = *(const LAS bf16x8*)(kb + d0 * 2048 + 512);
        if (d0 == 0) { p0 = __builtin_amdgcn_mfma_f32_32x32x16_bf16(b0, qr[0], negm, 0, 0, 0); p1 = __builtin_amdgcn_mfma_f32_32x32x16_bf16(b1, qr[0], negm, 0, 0, 0); }
        else { p0 = __builtin_amdgcn_mfma_f32_32x32x16_bf16(b0, qr[d0], p0, 0, 0, 0); p1 = __builtin_amdgcn_mfma_f32_32x32x16_bf16(b1, qr[d0], p1, 0, 0, 0); } }
}
DI void kload8(bf16x8* kf, lds_cptr kp) {
    kf[0] = *(const LAS bf16x8*)(kp);        kf[1] = *(const LAS bf16x8*)(kp + 512);
    kf[2] = *(const LAS bf16x8*)(kp + 2048); kf[3] = *(const LAS bf16x8*)(kp + 2560);
    kf[4] = *(const LAS bf16x8*)(kp + 4096); kf[5] = *(const LAS bf16x8*)(kp + 4608);
    kf[6] = *(const LAS bf16x8*)(kp + 6144); kf[7] = *(const LAS bf16x8*)(kp + 6656);
}
DI void kload2(bf16x8* kf, lds_cptr kp, int j) { kf[2 * j] = *(const LAS bf16x8*)(kp + j * 2048); kf[2 * j + 1] = *(const LAS bf16x8*)(kp + j * 2048 + 512); }
DI s16x4 vtr(lds_cptr p) { return __builtin_amdgcn_ds_read_tr16_b64_v4i16((LAS s16x4*)p); }
DI float rowmax(const f32x16& p0, const f32x16& p1) {
    float a = max3f(p0[0], p0[1], p1[0]), b = max3f(p0[2], p0[3], p1[1]); a = max3f(a, p1[2], p1[3]);
#pragma unroll
    for (int r = 4; r < 16; r += 4) { a = max3f(a, p0[r], p0[r + 1]); b = max3f(b, p0[r + 2], p0[r + 3]); a = max3f(a, p1[r], p1[r + 1]); b = max3f(b, p1[r + 2], p1[r + 3]); }
    const float m = max2f(a, b);
    auto rr = __builtin_amdgcn_permlane32_swap(__float_as_uint(m), __float_as_uint(m), false, false);
    return max2f(__uint_as_float(rr[0]), __uint_as_float(rr[1]));
}
DI void pv(f32x16* o, int vb, bf16x8 pa0, bf16x8 pa1, bf16x8 pa2, bf16x8 pa3) {
#pragma unroll
    for (int d0 = 0; d0 < 2; ++d0) { s16x4 lo[4], hi[4];
#pragma unroll
        for (int ks = 0; ks < 4; ++ks) {
            asm volatile("ds_read_b64_tr_b16 %0,%1 offset:%c2" : "=&v"(lo[ks]) : "v"(vb), "i"(d0 * 4096 + ks * 1024) : "memory");
            asm volatile("ds_read_b64_tr_b16 %0,%1 offset:%c2" : "=&v"(hi[ks]) : "v"(vb), "i"(d0 * 4096 + ks * 1024 + 512) : "memory"); }
        asm volatile("s_waitcnt lgkmcnt(0)" ::: "memory"); NSB_SBAR();
#define NSB_PK(k) (bf16x8){lo[k][0], lo[k][1], lo[k][2], lo[k][3], hi[k][0], hi[k][1], hi[k][2], hi[k][3]}
        o[d0] = __builtin_amdgcn_mfma_f32_32x32x16_bf16(pa0, NSB_PK(0), o[d0], 0, 0, 0);
        o[d0] = __builtin_amdgcn_mfma_f32_32x32x16_bf16(pa1, NSB_PK(1), o[d0], 0, 0, 0);
        o[d0] = __builtin_amdgcn_mfma_f32_32x32x16_bf16(pa2, NSB_PK(2), o[d0], 0, 0, 0);
        o[d0] = __builtin_amdgcn_mfma_f32_32x32x16_bf16(pa3, NSB_PK(3), o[d0], 0, 0, 0);
#undef NSB_PK
    }
}
DI void tmask(f32x16& p0, f32x16& p1, int mode, int tl, int hi) {
    const float NEG = -__builtin_inff();
#pragma unroll
    for (int r = 0; r < 16; ++r) { const int k0 = crow(r, hi), k1 = k0 + 32;
        const bool m0 = mode == 3 || (mode == 1 ? k0 > tl : (mode == 2 && k0 <= tl)), m1 = mode == 3 || (mode == 1 ? k1 > tl : (mode == 2 && k1 <= tl));
        if (m0) p0[r] = NEG; if (m1) p1[r] = NEG; }
}
template <int THRL, int BR>
DI void unit(const Frame& F, int b, int g, int tok0, const bf16_t* PN, bf16_t* O0, LAS char* shm, const LAS unsigned* selm_tok0, const bool do_store = true) {
    const int lane = F.lane, r32 = lane & 31, hi = lane >> 5, wid = F.wave;
    const long rowbase = (long)b * SEQ; const int jq = tok0 >> 6;
    const int tl = 8 * wid + (r32 >> 2);
    const bf16_t* Qw = PN + (rowbase + tok0 + tl) * PITCH + (g * 4 + (r32 & 3)) * 64;
    const bf16_t* Kh = PN + rowbase * PITCH + 512 + (BR == 1 ? 2 : 4) * 128 + g * 64; const bf16_t* Vh = PN + rowbase * PITCH + 512 + (BR == 1 ? 3 : 5) * 128 + g * 64;
    const unsigned lds0 = (unsigned)(size_t)shm;
    LAS float* wsf = (LAS float*)(shm + LDS_WS) + wid * 64;
    const int NTreal = BR == 1 ? jq + 1 : (jq + 1 < 9 ? jq + 1 : 9);
    int NT = (NTreal + 1) & ~1; if (NT < 4) NT = 4;
#define NSB_TILE(t) (((t) < NTreal) ? (jq - (t)) : 0)
    const bf16_t* ksrc = Kh + wid * 8; const unsigned koff = (unsigned)lane * (PITCH * 2);
    const bf16_t* vsrc = Vh + (long)(16 * (wid & 3)) * PITCH + (wid >> 2) * 32; const unsigned voff = (unsigned)(lane >> 2) * (PITCH * 2) + (lane & 3) * 16;
    const unsigned kdst = lds0 + LDS_K + wid * 1024, vdst = lds0 + LDS_V + wid * 1024;
#define NSB_DMA_K(t, slot) glds16(ksrc + (long)NSB_TILE(t) * 64 * PITCH, koff, (unsigned)__builtin_amdgcn_readfirstlane(kdst + (slot)))
#define NSB_DMA_V(t, slot) glds16(vsrc + (long)NSB_TILE(t) * 64 * PITCH, voff, (unsigned)__builtin_amdgcn_readfirstlane(vdst + (slot)))
    const int vb0 = (int)(lds0 + LDS_V) + ((lane >> 4) & 1) * 32 + (lane & 3) * 8 + (4 * hi + ((lane & 15) >> 2)) * 64;
    const lds_cptr shm3 = (lds_cptr)shm; const lds_cptr Kbase = shm3 + LDS_K; bf16x8 kf[8];
    const lds_cptr kp0 = shm3 + LDS_K + hi * 1024 + r32 * 16; const lds_cptr vp0 = shm3 + LDS_V + ((lane >> 4) & 1) * 32 + (lane & 3) * 8 + (4 * hi + ((lane & 15) >> 2)) * 64;
    NSB_DMA_K(0, 0); NSB_DMA_V(0, 0); NSB_DMA_K(1, SLOTB);
    bf16x8 qr[4];
#pragma unroll
    for (int d0 = 0; d0 < 4; ++d0) qr[d0] = *(const bf16x8*)(Qw + d0 * 16 + hi * 8);
    unsigned selw[4] = {0xFFFFFFFFu, 0xFFFFFFFFu, 0xFFFFFFFFu, 0xFFFFFFFFu};
    if (BR == 1) {
#pragma unroll
        for (int i = 0; i < 4; ++i) selw[i] = selm_tok0[tl * 4 + i]; }
    float mhat = 0.f, l_reg = 0.f; f32x16 o[2]; o[0] = f32x16{}; o[1] = f32x16{}; f32x16 negm = f32x16{}; asm volatile("" : "+v"(negm));
#define NSB_CMASK(P0, P1, t) do { const int t_ = (t); if (t_ == 0) tmask(P0, P1, 1, tl, hi); else if (t_ >= NTreal) tmask(P0, P1, 3, tl, hi); else if (BR == 2 && t_ == 8) tmask(P0, P1, 2, tl, hi); } while (0)
#define NSB_NEGM(t) do { if (BR == 1) { const int j_ = NSB_TILE(t); const unsigned wq_ = (j_ >> 5) == 0 ? selw[0] : ((j_ >> 5) == 1 ? selw[1] : ((j_ >> 5) == 2 ? selw[2] : selw[3])); const float nm_ = ((wq_ >> (j_ & 31)) & 1u) ? -mhat : -__builtin_inff(); \
        _Pragma("unroll") for (int r = 0; r < 16; ++r) negm[r] = nm_; asm volatile("" : "+v"(negm)); } } while (0)
    bool resc = false;
#define NSB_START(P0, P1) do { const float rm = rowmax(P0, P1); resc = false; \
    { const float dl = rm; mhat = fadd_s(mhat, dl); \
      _Pragma("unroll") for (int r = 0; r < 16; ++r) { P0[r] = fsub_s(P0[r], dl); P1[r] = fsub_s(P1[r], dl); } \
      if (BR != 1) { _Pragma("unroll") for (int r = 0; r < 16; ++r) negm[r] = -mhat; asm volatile("" : "+v"(negm)); } } \
    _Pragma("unroll") for (int r = 0; r < 16; ++r) P0[r] = __builtin_amdgcn_exp2f(P0[r]); } while (0)
#define NSB_RESC() do { if (resc) { asm volatile("s_waitcnt lgkmcnt(0)" ::: "memory"); \
      _Pragma("unroll") for (int d_ = 0; d_ < 2; ++d_) _Pragma("unroll") for (int r = 0; r < 16; ++r) o[d_][r] *= wsf[crow(r, hi)]; } } while (0)
    f32x16 pA0, pA1, pB0, pB1;
    int sl_prev = 0, sl_cur = 0, sl_next = SLOTB;
#define NSB_ROT() do { sl_prev = sl_cur; sl_cur = sl_next; sl_next = (sl_next == (NSLOT - 1) * SLOTB) ? 0 : sl_next + SLOTB; } while (0)
    NSB_DMA_K(2, 2 * SLOTB);
    NSB_WAIT_BAR(3);
    qkt(pA0, pA1, Kbase, qr, negm, r32, hi); asm volatile("s_nop 15\n\ts_nop 7" : "+v"(pA0), "+v"(pA1)); NSB_CMASK(pA0, pA1, 0);
    NSB_START(pA0, pA1);
#pragma unroll
    for (int r = 0; r < 16; ++r) pA1[r] = __builtin_amdgcn_exp2f(pA1[r]);
    NSB_WAIT_BAR(0);
    NSB_DMA_K(3, 0); NSB_DMA_V(1, SLOTB);
    NSB_ROT();
    kload8(kf, kp0 + sl_cur);
    NSB_WAIT_BAR(2);
    s16x4 vlo[8], vhi[8]; u32x4 pw0, pw1, pw2, pw3;
#define NSB_PKW(P, B) pack2(P[B], P[B + 1])
#define NSB_PAF(k) __builtin_bit_cast(bf16x8, pw##k)
#define NSB_VFR(i) (bf16x8){vlo[i][0], vlo[i][1], vlo[i][2], vlo[i][3], vhi[i][0], vhi[i][1], vhi[i][2], vhi[i][3]}
#define NSB_PIN(x) asm volatile("" : "+v"(x))
#define NSB_MX3(a, b, c) __builtin_fmaxf(__builtin_fmaxf((a), (b)), (c))
#define NSB_GAPA(MF, A0, A1, A2, A3, W0, W1, PW) do { MF; sacc += A0; sacc += A1; sacc += A2; sacc += A3; NSB_PIN(sacc); W0; W1; NSB_PIN(PW); NSB_SBAR(); } while (0)
#define NSB_EX(v) __builtin_amdgcn_exp2f(v)
#define NSB_GAPB(MF, X, B) do { MF; X[B] = NSB_EX(X[B]); X[B + 1] = NSB_EX(X[B + 1]); X[B + 2] = NSB_EX(X[B + 2]); X[B + 3] = NSB_EX(X[B + 3]); NSB_PIN(X); NSB_SBAR(); } while (0)
#define NSB_VRD(i) do { vlo[i] = vtr(vp_ + (((i) >> 2) * 4096 + ((i) & 3) * 1024)); vhi[i] = vtr(vp_ + (((i) >> 2) * 4096 + ((i) & 3) * 1024 + 512)); } while (0)
#define NSB_KRD(G, j) do { if (G) { kload2(kf, kp0 + sl_next, j); NSB_SBAR(); } } while (0)
#define NSB_STEP(C0, C1, P0, P1, t, GK, GV, GL) do { NSB_SBAR(); \
    const lds_cptr vp_ = vp0 + sl_prev; NSB_NEGM(t); \
    NSB_VRD(0); NSB_SBAR(); float sacc = (P0[0] + P0[1]); \
    NSB_GAPA(C0 = __builtin_amdgcn_mfma_f32_32x32x16_bf16(kf[0], qr[0], negm, 0, 0, 0), P0[2], P0[3], P0[4], P0[5],     pw0[0] = NSB_PKW(P0, 0), pw0[1] = NSB_PKW(P0, 2), pw0); \
    NSB_VRD(4); NSB_SBAR(); NSB_GAPA(C1 = __builtin_amdgcn_mfma_f32_32x32x16_bf16(kf[1], qr[0], negm, 0, 0, 0), P0[6], P0[7], P0[8], P0[9],     pw0[2] = NSB_PKW(P0, 4), pw0[3] = NSB_PKW(P0, 6), pw0); \
    NSB_VRD(1); NSB_SBAR(); NSB_GAPA(C0 = __builtin_amdgcn_mfma_f32_32x32x16_bf16(kf[2], qr[1], C0, 0, 0, 0),   P0[10], P0[11], P0[12], P0[13], pw1[0] = NSB_PKW(P0, 8), pw1[1] = NSB_PKW(P0, 10), pw1); \
    NSB_VRD(5); NSB_SBAR(); NSB_GAPA(C1 = __builtin_amdgcn_mfma_f32_32x32x16_bf16(kf[3], qr[1], C1, 0, 0, 0),   P0[14], P0[15], P1[0], P1[1],   pw1[2] = NSB_PKW(P0, 12), pw1[3] = NSB_PKW(P0, 14), pw1); \
    NSB_VRD(2); NSB_SBAR(); NSB_GAPA(C0 = __builtin_amdgcn_mfma_f32_32x32x16_bf16(kf[4], qr[2], C0, 0, 0, 0),   P1[2], P1[3], P1[4], P1[5],     pw2[0] = NSB_PKW(P1, 0), pw2[1] = NSB_PKW(P1, 2), pw2); \
    NSB_VRD(6); NSB_SBAR(); NSB_GAPA(C1 = __builtin_amdgcn_mfma_f32_32x32x16_bf16(kf[5], qr[2], C1, 0, 0, 0),   P1[6], P1[7], P1[8], P1[9],     pw2[2] = NSB_PKW(P1, 4), pw2[3] = NSB_PKW(P1, 6), pw2); \
    NSB_VRD(3); NSB_SBAR(); NSB_GAPA(C0 = __builtin_amdgcn_mfma_f32_32x32x16_bf16(kf[6], qr[3], C0, 0, 0, 0),   P1[10], P1[11], P1[12], P1[13], pw3[0] = NSB_PKW(P1, 8), pw3[1] = NSB_PKW(P1, 10), pw3); \
    NSB_VRD(7); NSB_SBAR(); NSB_GAPA(C1 = __builtin_amdgcn_mfma_f32_32x32x16_bf16(kf[7], qr[3], C1, 0, 0, 0),   P1[14], P1[15], 0.f, 0.f,       pw3[2] = NSB_PKW(P1, 12), pw3[3] = NSB_PKW(P1, 14), pw3); \
    l_reg += sacc; \
    if (GK) { NSB_DMA_K((t) + 3, sl_cur); } if (GV) { NSB_DMA_V((t) + 1, sl_next); } \
    NSB_CMASK2(C0, C1, t); \
    { float a = NSB_MX3(C0[0], C0[1], C1[0]), b_ = NSB_MX3(C0[2], C0[3], C1[1]); a = NSB_MX3(a, C1[2], C1[3]); \
      _Pragma("unroll") for (int r = 4; r < 16; r += 4) { a = NSB_MX3(a, C0[r], C0[r + 1]); b_ = NSB_MX3(b_, C0[r + 2], C0[r + 3]); a = NSB_MX3(a, C1[r], C1[r + 1]); b_ = NSB_MX3(b_, C1[r + 2], C1[r + 3]); } \
      float rm = __builtin_fmaxf(a, b_); { auto rr = __builtin_amdgcn_permlane32_swap(__float_as_uint(rm), __float_as_uint(rm), false, false); rm = __builtin_fmaxf(__uint_as_float(rr[0]), __uint_as_float(rr[1])); } \
      resc = false; \
      if (__builtin_expect(__any(rm > (float)THRL), 0)) { const float dl = __builtin_fmaxf(rm, 0.f); mhat += dl; \
        _Pragma("unroll") for (int r = 0; r < 16; ++r) { C0[r] -= dl; C1[r] -= dl; } \
        if (BR != 1) { _Pragma("unroll") for (int r = 0; r < 16; ++r) negm[r] = -mhat; asm volatile("" : "+v"(negm)); } \
        const float f = __builtin_amdgcn_exp2f(-dl); l_reg *= f; if (hi == 0) wsf[r32] = f; resc = true; } } \
    NSB_SBAR(); \
    NSB_GAPB(o[0] = __builtin_amdgcn_mfma_f32_32x32x16_bf16(NSB_PAF(0), NSB_VFR(0), o[0], 0, 0, 0), C0, 0); \
    NSB_GAPB(o[1] = __builtin_amdgcn_mfma_f32_32x32x16_bf16(NSB_PAF(0), NSB_VFR(4), o[1], 0, 0, 0), C0, 4); \
    NSB_KRD(GL, 0); NSB_GAPB(o[0] = __builtin_amdgcn_mfma_f32_32x32x16_bf16(NSB_PAF(1), NSB_VFR(1), o[0], 0, 0, 0), C0, 8); \
    NSB_KRD(GL, 1); NSB_GAPB(o[1] = __builtin_amdgcn_mfma_f32_32x32x16_bf16(NSB_PAF(1), NSB_VFR(5), o[1], 0, 0, 0), C0, 12); \
    NSB_KRD(GL, 2); NSB_GAPB(o[0] = __builtin_amdgcn_mfma_f32_32x32x16_bf16(NSB_PAF(2), NSB_VFR(2), o[0], 0, 0, 0), C1, 0); \
    NSB_KRD(GL, 3); NSB_GAPB(o[1] = __builtin_amdgcn_mfma_f32_32x32x16_bf16(NSB_PAF(2), NSB_VFR(6), o[1], 0, 0, 0), C1, 4); \
    NSB_GAPB(o[0] = __builtin_amdgcn_mfma_f32_32x32x16_bf16(NSB_PAF(3), NSB_VFR(3), o[0], 0, 0, 0), C1, 8); \
    NSB_GAPB(o[1] = __builtin_amdgcn_mfma_f32_32x32x16_bf16(NSB_PAF(3), NSB_VFR(7), o[1], 0, 0, 0), C1, 12); \
    } while (0)
    int t = 1;
#define NSB_CMASK2(P0, P1, t) do {} while (0)
    for (; t + 5 < NT; t += 2) {
        NSB_STEP(pB0, pB1, pA0, pA1, t, true, true, true);     NSB_WAIT_BAR(2); NSB_RESC(); NSB_ROT();
        NSB_STEP(pA0, pA1, pB0, pB1, t + 1, true, true, true); NSB_WAIT_BAR(2); NSB_RESC(); NSB_ROT();
    }
#undef NSB_CMASK2
#define NSB_CMASK2(P0, P1, t) NSB_CMASK(P0, P1, t)
#define NSB_ENDW(tt) do { if ((tt) + 3 < NT) { NSB_WAIT_BAR(2); } else if ((tt) + 2 < NT) { NSB_WAIT_BAR(1); } else { NSB_WAIT_BAR(0); } } while (0)
    for (; t + 1 < NT; t += 2) {
        NSB_STEP(pB0, pB1, pA0, pA1, t, (t + 3 < NT), (t + 1 < NT), (t + 1 < NT));         NSB_ENDW(t);     NSB_RESC(); NSB_ROT();
        NSB_STEP(pA0, pA1, pB0, pB1, t + 1, (t + 4 < NT), (t + 2 < NT), (t + 2 < NT));     NSB_ENDW(t + 1); NSB_RESC(); NSB_ROT();
    }
    NSB_STEP(pB0, pB1, pA0, pA1, NT - 1, false, false, false); NSB_RESC();
    { float sacc = pB0[0] + pB0[1];
#pragma unroll
      for (int r = 2; r < 16; ++r) sacc += pB0[r];
#pragma unroll
      for (int r = 0; r < 16; ++r) sacc += pB1[r];
      l_reg += sacc;
      pw0 = (u32x4){NSB_PKW(pB0, 0), NSB_PKW(pB0, 2), NSB_PKW(pB0, 4), NSB_PKW(pB0, 6)}; pw1 = (u32x4){NSB_PKW(pB0, 8), NSB_PKW(pB0, 10), NSB_PKW(pB0, 12), NSB_PKW(pB0, 14)};
      pw2 = (u32x4){NSB_PKW(pB1, 0), NSB_PKW(pB1, 2), NSB_PKW(pB1, 4), NSB_PKW(pB1, 6)}; pw3 = (u32x4){NSB_PKW(pB1, 8), NSB_PKW(pB1, 10), NSB_PKW(pB1, 12), NSB_PKW(pB1, 14)};
      NSB_SBAR(); pv(o, vb0 + sl_cur, NSB_PAF(0), NSB_PAF(1), NSB_PAF(2), NSB_PAF(3)); }
    { auto rr = __builtin_amdgcn_permlane32_swap(__float_as_uint(l_reg), __float_as_uint(l_reg), false, false); l_reg = __uint_as_float(rr[0]) + __uint_as_float(rr[1]); }
    const int lane2 = lane_id(), r32b = lane2 & 31, hib = lane2 >> 5;
    if (hib == 0) { const float gt = sigmoidf_(bf2f(PN[(rowbase + tok0 + 8 * wid + (r32b >> 2)) * PITCH + 1280 + BR * 8 + g * 4 + (r32b & 3)])); wsf[32 + r32b] = l_reg > 0.f ? gt * rcpf_(l_reg) : 0.f; }
    asm volatile("s_waitcnt lgkmcnt(0)" ::: "memory");
    float rli[16];
#pragma unroll
    for (int r = 0; r < 16; ++r) rli[r] = wsf[32 + crow(r, hib)];
    { LAS bf16_t* stg = (LAS bf16_t*)(shm + LDS_OST) + wid * 2048;
#pragma unroll
      for (int r = 0; r < 16; ++r) { const int orow = crow(r, hib);
#pragma unroll
          for (int d0 = 0; d0 < 2; ++d0) stg[orow * 64 + d0 * 32 + r32b] = f2bf(o[d0][r] * rli[r]); }
      asm volatile("s_waitcnt lgkmcnt(0)" ::: "memory");
#pragma unroll
      for (int i = 0; i < 4; ++i) { const int row = i * 8 + (lane2 >> 3), ch = lane2 & 7; const u32x4 v = *(const LAS u32x4*)(stg + row * 64 + ch * 8);
          bf16_t* op = O0 + (rowbase + tok0 + 8 * wid + (row >> 2)) * 1024 + 512 + (g * 4 + (row & 3)) * 64 + ch * 8;
          if (do_store) { float a8[8], b8[8]; unpack8(*(const u32x4*)op, a8); unpack8(v, b8);
#pragma unroll
              for (int e = 0; e < 8; ++e) a8[e] += b8[e];
              *(u32x4*)op = pack8(a8); }
          else asm volatile("" :: "v"(v)); } }
    asm volatile("s_waitcnt vmcnt(0) lgkmcnt(0)\n\ts_barrier" ::: "memory");
#undef NSB_TILE
#undef NSB_DMA_K
#undef NSB_DMA_V
#undef NSB_CMASK
#undef NSB_CMASK2
#undef NSB_NEGM
#undef NSB_START
#undef NSB_RESC
#undef NSB_ROT
#undef NSB_PKW
#undef NSB_PAF
#undef NSB_VFR
#undef NSB_PIN
#undef NSB_MX3
#undef NSB_GAPA
#undef NSB_GAPB
#undef NSB_EX
#undef NSB_VRD
#undef NSB_KRD
#undef NSB_STEP
#undef NSB_ENDW
}
#undef NSB_SBAR
#undef NSB_WAIT_BAR
}

DI void nsa_unit(const Frame& F0, int unit, const int mode = 0x3F) {
    Frame F = F0; F.tid = F.wave * 64 + lane_id(); asm volatile("" : "+v"(F.tid)); F.lane = F.tid & 63;
    const int qt = 63 - (unit >> 4), b = (unit >> 1) & 7, g = unit & 1;
    const int t0 = qt * 128, tw = t0 + 16 * F.wave;
    const size_t tokb = (size_t)b * SEQ;
    const int lane = F.lane, fr = lane & 15, fq = lane >> 4, q = fr >> 2, pp = lane & 3;
    const bf16_t* PN = (const bf16_t*)(F.ws + OFF_PN);
    LAS float* imp = (LAS float*)(F.lds + NS_OFF_IMP); LAS unsigned* selm = (LAS unsigned*)(F.lds + NS_OFF_SEL);
    const int hd = fr & 3, posl = tw + (fr >> 2);
    bf16x8 Qf[4][2];
#pragma unroll
    for (int rt = 0; rt < 4; ++rt)
#pragma unroll
        for (int ks = 0; ks < 2; ++ks) { float v[8]; unpack8(*(const u32x4*)(PN + (tokb + posl + 4 * rt) * 1536 + (g * 4 + hd) * 64 + 32 * ks + 8 * fq), v);
            u32x4 w; w[0] = cvtpk(v[0], v[1]); w[1] = cvtpk(v[2], v[3]); w[2] = cvtpk(v[4], v[5]); w[3] = cvtpk(v[6], v[7]);
            Qf[rt][ks] = __builtin_bit_cast(bf16x8, w); }
    __syncthreads();
    for (int i = F.tid; i < 128 * 128; i += NTH) imp[i] = 0.f;
    FState st;
    bf16_t* O0 = (bf16_t*)(F.ws + OFF_O0);
    if (mode & 1) {
        TileSrc S{(const bf16_t*)(F.ws + SM_KCMP) + ((size_t)b * 512 * 2 + g) * 64, (const bf16_t*)(F.ws + SM_VCMPT) + ((size_t)b * 512 * 2 + g) * 64, 128};
        int nmax = (t0 + 96) >> 4; if (nmax > 510) nmax = 510;
        const int ntl = (nmax >> 6) + 1;
        const int nfull = (tw - 31) >> 4;
        ns_reset(st);
        asm volatile("s_waitcnt vmcnt(0)" ::: "memory"); __syncthreads();
        for (int p_ = 0; p_ < 3 && p_ < ntl; ++p_) ns_dma(F, S, p_, p_);
#pragma unroll 1
        for (int j = 0; j < ntl; ++j) {
            ns_wait(ntl - 1 - j);
            if (j + 3 < ntl) ns_dma(F, S, j + 3, (j + 3) & 3);
            const LAS unsigned char* tb0 = F.lds + (j & 3) * NS_STG;
#pragma unroll 1
            for (int koff = 0; koff < 64; koff += 32) {
                const int nb = j * 64 + koff;
                if (16 * nb + 31 > tw + 15) continue;
                if (nb + 31 <= nfull) ns_step<0, false, true>(tb0 + koff * 128, nb, Qf, st, 0xFu, 0xFu, posl, 0, fr, fq, q, pp);
                else ns_step<1, false, true>(tb0 + koff * 128, nb, Qf, st, 0xFu, 0xFu, posl, 0, fr, fq, q, pp);
            }
        }
        float il[4];
#pragma unroll
        for (int rt = 0; rt < 4; ++rt) { float l = st.l[rt]; l += shx(l, 16); l += shx(l, 32); il[rt] = l > 0.f ? rcpf_(l) : 0.f; }
        __syncthreads();
        float carry[4] = {0.f, 0.f, 0.f, 0.f}; const int bpa = ((lane + 48) & 63) << 2;
        for (int p_ = 0; p_ < 3 && p_ < ntl; ++p_) ns_dma(F, S, p_, p_);
#pragma unroll 1
        for (int j = 0; j < ntl; ++j) {
            ns_wait(ntl - 1 - j);
            if (j + 3 < ntl) ns_dma(F, S, j + 3, (j + 3) & 3);
            const LAS unsigned char* tb0 = F.lds + (j & 3) * NS_STG;
#pragma unroll 1
            for (int koff = 0; koff < 64; koff += 32) {
                const int nb = j * 64 + koff;
                if (16 * nb + 31 > tw + 15) continue;
                const LAS unsigned char* tb = tb0 + koff * 128;
                const int lk = fr * 128 + ((fq ^ (fr & 7)) << 4);
                const int m_ = (4 * fq + q) & 7, vbl = (4 * fq + q) * 128 + ((((pp >> 1) ^ (m_ & 1))) << 4) + (pp & 1) * 8 + ((m_ >> 1) << 5);
                const LAS unsigned char* kp0 = tb + lk; const LAS unsigned char* kp1 = tb + (lk ^ 64); const LAS unsigned char* vp_ = tb + 8192 + vbl;
                asm volatile("" : "+v"(kp0), "+v"(kp1), "+v"(vp_));
                f32x4 s[2][4];
#pragma unroll
                for (int rt = 0; rt < 4; ++rt) { s[0][rt] = (f32x4){0.f, 0.f, 0.f, 0.f}; s[1][rt] = s[0][rt]; }
#pragma unroll
                for (int ks = 0; ks < 2; ++ks)
#pragma unroll
                    for (int kt = 0; kt < 2; ++kt) { const bf16x8 X = *(const LAS bf16x8*)((ks ? kp1 : kp0) + kt * 2048);
#pragma unroll
                        for (int rt = 0; rt < 4; ++rt) s[kt][rt] = MFMA16(X, Qf[rt][ks], s[kt][rt]); }
                bf16x8 Y[4];
#pragma unroll
                for (int rt = 0; rt < 4; ++rt) {
#pragma unroll
                    for (int kt = 0; kt < 2; ++kt) {
#pragma unroll
                        for (int r = 0; r < 4; ++r) { const int n = nb + 16 * kt + 4 * fq + r; s[kt][rt][r] = (n <= ((posl + 4 * rt - 31) >> 4)) ? fexp2(s[kt][rt][r] - st.m[rt]) * il[rt] : 0.f; }
                        float a = s[kt][rt][0] + s[kt][rt][1] + s[kt][rt][2] + 0.5f * s[kt][rt][3], bb = 0.5f * s[kt][rt][3];
                        a += dpp_mov<0xB1>(a); a += dpp_mov<0x4E>(a); bb += dpp_mov<0xB1>(bb); bb += dpp_mov<0x4E>(bb);
                        const float pull = __int_as_float(__builtin_amdgcn_ds_bpermute(bpa, __float_as_int(bb)));
                        const float val = a + (fq > 0 ? pull : carry[rt]); carry[rt] = pull;
                        if (hd == 0) { const int jj = (nb >> 2) + 4 * kt + fq; const int tl = 16 * F.wave + 4 * rt + (fr >> 2);
                            asm volatile("ds_write_b32 %0, %1" :: "v"((unsigned)(size_t)imp + (unsigned)(tl * 128 + jj) * 4u), "v"(val) : "memory"); }
                    }
                    u32x4 w; w[0] = cvtpk(s[0][rt][0], s[0][rt][1]); w[1] = cvtpk(s[0][rt][2], s[0][rt][3]); w[2] = cvtpk(s[1][rt][0], s[1][rt][1]); w[3] = cvtpk(s[1][rt][2], s[1][rt][3]);
                    Y[rt] = __builtin_bit_cast(bf16x8, w);
                }
                bf16x8 Xv[4]; ns_vtr8(vp_, Xv);
#pragma unroll
                for (int dt = 0; dt < 4; ++dt)
#pragma unroll
                    for (int rt = 0; rt < 4; ++rt) st.o[dt][rt] = MFMA16(Xv[dt], Y[rt], st.o[dt][rt]);
            }
        }
        int pl_ = posl; asm volatile("" : "+v"(pl_));
#pragma unroll
        for (int rt = 0; rt < 4; ++rt) { const float gt = sigmoidf_(bf2f(PN[(tokb + pl_ + 4 * rt) * 1536 + 1280 + 0 * 8 + g * 4 + hd]));
#pragma unroll
            for (int dt = 0; dt < 4; ++dt) { const f32x4 v = st.o[dt][rt] * gt; u32x2 o; o[0] = cvtpk(v[0], v[1]); o[1] = cvtpk(v[2], v[3]);
                if (mode & 16) *(u32x2*)(O0 + (tokb + pl_ + 4 * rt) * 1024 + 512 + (g * 4 + hd) * 64 + 16 * dt + 4 * fq) = o; } }
    }
    __syncthreads();
    {
        const int cur = tw >> 6; const int j0 = lane, j1 = lane + 64;
        const bool c0 = j0 >= 1 && j0 <= cur - 2, c1 = j1 <= cur - 2;
#pragma unroll 1
        for (int tl0 = 0; tl0 < ((mode & 2) ? 16 : 0); tl0 += 4) {
            bool s0[4], s1[4];
            if (cur < 16) {
#pragma unroll
                for (int i = 0; i < 4; ++i) { s0[i] = j0 <= cur; s1[i] = false; }
            } else {
                unsigned v0[4], v1[4], thr[4]; bool ex[4];
#pragma unroll
                for (int i = 0; i < 4; ++i) { const int tg = 16 * F.wave + tl0 + i;
                    v0[i] = c0 ? __float_as_uint(imp[tg * 128 + j0]) : 0u; v1[i] = c1 ? __float_as_uint(imp[tg * 128 + j1]) : 0u;
                    thr[i] = 0u; ex[i] = false; }
#pragma unroll 1
                for (int bit = 30; bit >= 0; --bit) {
#pragma unroll
                    for (int i = 0; i < 4; ++i) {
                        const unsigned cand = thr[i] | (1u << bit);
                        const int cnt = __popcll(__ballot(v0[i] >= cand)) + __popcll(__ballot(v1[i] >= cand));
                        thr[i] = (!ex[i] && cnt >= 13) ? cand : thr[i]; ex[i] = ex[i] || cnt == 13;
                    }
                    if (ex[0] && ex[1] && ex[2] && ex[3]) break;
                }
#pragma unroll
                for (int i = 0; i < 4; ++i) {
                    if (ex[i]) { s0[i] = c0 && v0[i] >= thr[i]; s1[i] = c1 && v1[i] >= thr[i]; }
                    else {
                        const unsigned long long g0 = __ballot(c0 && v0[i] > thr[i]), g1 = __ballot(c1 && v1[i] > thr[i]), e0 = __ballot(c0 && v0[i] == thr[i]), e1 = __ballot(c1 && v1[i] == thr[i]);
                        const int need = 13 - __popcll(g0) - __popcll(g1);
                        const unsigned long long lt = (1ull << lane) - 1ull;
                        s0[i] = c0 && (v0[i] > thr[i] || (v0[i] == thr[i] && __popcll(e0 & lt) < need));
                        s1[i] = c1 && (v1[i] > thr[i] || (v1[i] == thr[i] && __popcll(e0) + __popcll(e1 & lt) < need));
                    }
                    s0[i] = s0[i] || j0 == 0 || j0 == cur - 1 || j0 == cur; s1[i] = s1[i] || j1 == cur - 1 || j1 == cur;
                }
            }
#pragma unroll
            for (int i = 0; i < 4; ++i) { const int tg = 16 * F.wave + tl0 + i;
                const unsigned long long m0 = __ballot(s0[i]), m1 = __ballot(s1[i]);
                if (lane == 0) { selm[tg * 4 + 0] = (unsigned)m0; selm[tg * 4 + 1] = (unsigned)(m0 >> 32); selm[tg * 4 + 2] = (unsigned)m1; selm[tg * 4 + 3] = (unsigned)(m1 >> 32); } }
        }
    }
    __syncthreads();
    if (mode & 4) {
#pragma unroll 1
        for (int half = 0; half < 2; ++half) {
            nsb::unit<8, 1>(F, b, g, t0 + 64 * half, PN, O0, (LAS char*)F.lds, selm + 64 * half * 4, (mode & 16) != 0);
            if (mode & 8) nsb::unit<8, 2>(F, b, g, t0 + 64 * half, PN, O0, (LAS char*)F.lds, selm, (mode & 16) != 0);
        }
    }
}
DI void nsa_phase(const Frame& F0, int qi = 0, const int mode = 0x3F) {
    Frame F = F0; F.tid = F.wave * 64 + lane_id(); F.lane = F.tid & 63;
    LAS int* uw = (LAS int*)(F.lds + NS_OFF_U);
    unsigned* qh = (unsigned*)(F.ws + CTL_Q) + 64 * qi;
    for (;;) {
        __syncthreads();
        if (F.tid == 0) *uw = (int)__hip_atomic_fetch_add(qh, 1u, __ATOMIC_RELAXED, __HIP_MEMORY_SCOPE_AGENT);
        __syncthreads();
        const int u = *uw;
        if (u >= 1024) break;
        nsa_unit(F, u, mode);
    }
}

__global__ void __launch_bounds__(NTH, 2) fwd_kernel(Args args) {
    extern __shared__ __attribute__((aligned(16))) unsigned char lds_raw[];
    Frame F;
    F.lds = (LAS unsigned char*)lds_raw + LDS_SCR; F.tid = threadIdx.x; F.lane = F.tid & 63; F.wave = __builtin_amdgcn_readfirstlane(F.tid >> 6); F.wg = blockIdx.x;
    F.ws = args.ws; F.out = args.out; F.in = args.in;
    volatile LAS unsigned* misc = (volatile LAS unsigned*)((LAS unsigned char*)lds_raw);
    if (F.tid < 64) misc[F.tid] = 0u;
    __syncthreads();
    XcdBarrier bar = xcd_barrier_post((unsigned*)(F.ws + CTL_BAR), misc);
    LAS int* tile_start = (LAS int*)((LAS unsigned char*)lds_raw + 256);
    const int lo = args.ph_lo, hi = args.ph_hi;
#define IN(k) (lo <= (k) && (k) < hi)
#define SEAM(k) do { if (IN(k) && IN((k) + 1)) xcd_barrier(bar); } while (0)
    const float* ln = F.in[27];

    if (IN(0)) {
        tr_job(F, F.in[1], 3352, 1024, 3352, 3584, (bf16_t*)(F.ws + W_IN0), 1024, 0);
        tr_job(F, F.in[2], 1024, 1024, 1024, 1024, (bf16_t*)(F.ws + W_OUT0), 1024, 0);
        {
          const float* x = F.in[0]; bf16_t* xb = (bf16_t*)(F.ws + OFF_XB);
          for (size_t i0 = (size_t)F.wg * NTH + F.tid; i0 < (size_t)T * D / 8; i0 += (size_t)GRID * NTH * 4) {
              f32x4 a[4], b[4];
#pragma unroll
              for (int k = 0; k < 4; ++k) { const size_t i = i0 + (size_t)k * GRID * NTH; a[k] = *(const f32x4*)(x + i * 8); b[k] = *(const f32x4*)(x + i * 8 + 4); }
#pragma unroll
              for (int k = 0; k < 4; ++k) { const size_t i = i0 + (size_t)k * GRID * NTH; u32x4 o; o[0] = pack2(a[k][0], a[k][1]); o[1] = pack2(a[k][2], a[k][3]); o[2] = pack2(b[k][0], b[k][1]); o[3] = pack2(b[k][2], b[k][3]);
                  *(u32x4*)(xb + i * 8) = o; } } }
        {
          bf16_t* wl1 = (bf16_t*)(F.ws + W_L1); const float* mu = F.in[3];
          for (int i = F.wg * NTH + F.tid; i < 256 * 1024; i += GRID * NTH) { const int n = i >> 10, k = i & 1023, kk = k & 511;
              const int which = n < 64 ? 0 : (n < 128 ? 1 : 2); const int j = n - (which == 0 ? 0 : (which == 1 ? 64 : 128));
              const float* X1 = which == 0 ? F.in[5] : (which == 1 ? F.in[8] : F.in[10]); const int ldx = which == 2 ? 128 : 64;
              const float m = mu[(3 + which) * 512 + kk]; wl1[i] = f2bf((k < 512 ? (1.0f - m) : m) * X1[kk * ldx + j]); }
          bf16_t* wl2 = (bf16_t*)(F.ws + W_L2);
          for (int i = F.wg * NTH + F.tid; i < 1536 * 256; i += GRID * NTH) { const int n = i >> 8, k = i & 255; float v = 0.f;
              if (n < 512) { if (k < 64) v = F.in[6][k * 512 + n]; } else if (n < 1024) { if (k >= 64 && k < 128) v = F.in[9][(k - 64) * 512 + n - 512]; } else { if (k >= 128) v = F.in[11][(k - 128) * 512 + n - 1024]; }
              wl2[i] = f2bf(v); }
          bf16_t* pr = (bf16_t*)(F.ws + OFF_PR);
          for (int i = F.wg * NTH + F.tid; i < 8 * 2048; i += GRID * NTH) pr[(size_t)(i >> 11) * 8193 * 2048 + (i & 2047)] = 0; }
        tr_job(F, F.in[17], 128, 2048, 128, 256, (bf16_t*)(F.ws + W_C1), 2048, 0);
        tr_job(F, F.in[17] + 2048 * 128, 128, 2048, 128, 256, (bf16_t*)(F.ws + W_C1) + 256 * 2048, 2048, 0);
        {
          bf16_t* wc2 = (bf16_t*)(F.ws + W_C2);
          for (int i = F.wg * NTH + F.tid; i < 2 * 256 * 256; i += GRID * NTH) { const int kv = i >> 16, n = (i >> 8) & 255, k = i & 255;
              wc2[i] = f2bf((n < 64 && k < 128) ? F.in[18][(size_t)kv * 128 * 64 + k * 64 + n] : 0.f); }
          float* cb = (float*)(F.ws + SM_CBIAS);
          { const int i = F.wg * 8 + F.wave; if (i < 512) { const int kv = i >> 8, n = i & 255; float acc = 0.f;
              if (n < 128) { for (int k = F.tid & 63; k < 2048; k += 64) acc += F.in[16][kv * 2048 + k] * F.in[17][((size_t)kv * 2048 + k) * 128 + n]; acc = wave_sum(acc); }
              if ((F.tid & 63) == 0) cb[i] = acc; } }
          float* rn = (float*)(F.ws + SM_ROPEN);
          for (int i = F.wg * NTH + F.tid; i < 8192 * 8; i += GRID * NTH) { const int p = i >> 3, k = i & 7;
              const double ang = (double)p * exp(-13.122363377404328 * (double)k / 8.0); rn[2 * i] = (float)cos(ang); rn[2 * i + 1] = (float)sin(ang); } }
        tr_job(F, F.in[19], 6144, 1024, 6144, 6144, (bf16_t*)(F.ws + W_RTIN), 1024, 3, RTI8 ? F8_SW : 0.f);
        tr_job(F, F.in[20], 1024, 2048, 1024, 1024, (bf16_t*)(F.ws + W_RTOUT), 2048, 0, RTO8 ? F8_SWO : 0.f);
        __syncthreads();
    }
    SEAM(0);
#if PROBE == 11
    {
        tr_job(F, F.in[1], 3352, 1024, 3352, 3584, (bf16_t*)(F.ws + W_IN0), 1024, 0);
        tr_job(F, F.in[2], 1024, 1024, 1024, 1024, (bf16_t*)(F.ws + W_OUT0), 1024, 0);
        {
          const float* x = F.in[0]; bf16_t* xb = (bf16_t*)(F.ws + OFF_XB);
          for (size_t i0 = (size_t)F.wg * NTH + F.tid; i0 < (size_t)T * D / 8; i0 += (size_t)GRID * NTH * 4) {
              f32x4 a[4], b[4];
#pragma unroll
              for (int k = 0; k < 4; ++k) { const size_t i = i0 + (size_t)k * GRID * NTH; a[k] = *(const f32x4*)(x + i * 8); b[k] = *(const f32x4*)(x + i * 8 + 4); }
#pragma unroll
              for (int k = 0; k < 4; ++k) { const size_t i = i0 + (size_t)k * GRID * NTH; u32x4 o; o[0] = pack2(a[k][0], a[k][1]); o[1] = pack2(a[k][2], a[k][3]); o[2] = pack2(b[k][0], b[k][1]); o[3] = pack2(b[k][2], b[k][3]);
                  *(u32x4*)(xb + i * 8) = o; } } }
        {
          bf16_t* wl1 = (bf16_t*)(F.ws + W_L1); const float* mu = F.in[3];
          for (int i = F.wg * NTH + F.tid; i < 256 * 1024; i += GRID * NTH) { const int n = i >> 10, k = i & 1023, kk = k & 511;
              const int which = n < 64 ? 0 : (n < 128 ? 1 : 2); const int j = n - (which == 0 ? 0 : (which == 1 ? 64 : 128));
              const float* X1 = which == 0 ? F.in[5] : (which == 1 ? F.in[8] : F.in[10]); const int ldx = which == 2 ? 128 : 64;
              const float m = mu[(3 + which) * 512 + kk]; wl1[i] = f2bf((k < 512 ? (1.0f - m) : m) * X1[kk * ldx + j]); }
          bf16_t* wl2 = (bf16_t*)(F.ws + W_L2);
          for (int i = F.wg * NTH + F.tid; i < 1536 * 256; i += GRID * NTH) { const int n = i >> 8, k = i & 255; float v = 0.f;
              if (n < 512) { if (k < 64) v = F.in[6][k * 512 + n]; } else if (n < 1024) { if (k >= 64 && k < 128) v = F.in[9][(k - 64) * 512 + n - 512]; } else { if (k >= 128) v = F.in[11][(k - 128) * 512 + n - 1024]; }
              wl2[i] = f2bf(v); }
          bf16_t* pr = (bf16_t*)(F.ws + OFF_PR);
          for (int i = F.wg * NTH + F.tid; i < 8 * 2048; i += GRID * NTH) pr[(size_t)(i >> 11) * 8193 * 2048 + (i & 2047)] = 0; }
        tr_job(F, F.in[17], 128, 2048, 128, 256, (bf16_t*)(F.ws + W_C1), 2048, 0);
        tr_job(F, F.in[17] + 2048 * 128, 128, 2048, 128, 256, (bf16_t*)(F.ws + W_C1) + 256 * 2048, 2048, 0);
        {
          bf16_t* wc2 = (bf16_t*)(F.ws + W_C2);
          for (int i = F.wg * NTH + F.tid; i < 2 * 256 * 256; i += GRID * NTH) { const int kv = i >> 16, n = (i >> 8) & 255, k = i & 255;
              wc2[i] = f2bf((n < 64 && k < 128) ? F.in[18][(size_t)kv * 128 * 64 + k * 64 + n] : 0.f); }
          float* cb = (float*)(F.ws + SM_CBIAS);
          { const int i = F.wg * 8 + F.wave; if (i < 512) { const int kv = i >> 8, n = i & 255; float acc = 0.f;
              if (n < 128) { for (int k = F.tid & 63; k < 2048; k += 64) acc += F.in[16][kv * 2048 + k] * F.in[17][((size_t)kv * 2048 + k) * 128 + n]; acc = wave_sum(acc); }
              if ((F.tid & 63) == 0) cb[i] = acc; } }
          float* rn = (float*)(F.ws + SM_ROPEN);
          for (int i = F.wg * NTH + F.tid; i < 8192 * 8; i += GRID * NTH) { const int p = i >> 3, k = i & 7;
              const double ang = (double)p * exp(-13.122363377404328 * (double)k / 8.0); rn[2 * i] = (float)cos(ang); rn[2 * i + 1] = (float)sin(ang); } }
        tr_job(F, F.in[19], 6144, 1024, 6144, 6144, (bf16_t*)(F.ws + W_RTIN), 1024, 3, RTI8 ? F8_SW : 0.f);
        tr_job(F, F.in[20], 1024, 2048, 1024, 1024, (bf16_t*)(F.ws + W_RTOUT), 2048, 0, RTO8 ? F8_SWO : 0.f);
        __syncthreads();
        { float* rr = (float*)(F.ws + SM_ROPER);
          for (int i = F.wg * NTH + F.tid; i < 8192 * 64; i += GRID * NTH) { const int p = i >> 6, k = i & 63;
              const double ang = (double)p * exp(-9.210340371976184 * (double)k / 63.0); rr[2 * i] = (float)cos(ang); rr[2 * i + 1] = (float)sin(ang); } }
    }
    xcd_barrier(bar);
#endif
    if (IN(1)) {
        pg8::GemmK g{1024, 1024, 1024, 128, 1 << 30, 0};
        pg8::DenseSched S; S.init(F.ws + OFF_XB, 1024, F.ws + W_IN0, 1024, T, 3584, GRID, F.wg);
        bf16_t* PR = (bf16_t*)(F.ws + OFF_PR); bf16_t* PN = (bf16_t*)(F.ws + OFF_PN);
        auto f = [PR, PN](const pg8::Unit&, int row, int col, const float (&v)[8]) {
            if (col < 2048) store8(PR + ((size_t)row + (row >> 13) + 1) * 2048 + col, v);
            else if (col < 2560) { float o[8];
#pragma unroll
                for (int i = 0; i < 8; ++i) o[i] = v[i] * NS_C;
                store8(PN + (size_t)row * 1536 + (col - 2048), o); }
            else store8(PN + (size_t)row * 1536 + (col - 2048), v); };
        pg8::EpiRow8<decltype(f)> E{f};
        pg8::gemm_phase(F.lds, F.wave, g, S, E);
    }
    SEAM(1);
#if PROBE == 6
    {
        pg8::GemmK g{1024, 1024, 1024, 128, 1 << 30, 0};
        pg8::DenseSched S; S.init(F.ws + OFF_XB, 1024, F.ws + W_IN0, 1024, T, 3584, GRID, F.wg);
        bf16_t* PR = (bf16_t*)(F.ws + OFF_PR); bf16_t* PN = (bf16_t*)(F.ws + OFF_PN);
        auto f = [PR, PN](const pg8::Unit&, int row, int col, const float (&v)[8]) {
            if (col < 2048) store8(PR + ((size_t)row + (row >> 13) + 1) * 2048 + col, v);
            else if (col < 2560) { float o[8];
#pragma unroll
                for (int i = 0; i < 8; ++i) o[i] = v[i] * NS_C;
                store8(PN + (size_t)row * 1536 + (col - 2048), o); }
            else store8(PN + (size_t)row * 1536 + (col - 2048), v); };
        pg8::EpiRow8<decltype(f)> E{f};
        pg8::gemm_phase(F.lds, F.wave, g, S, E);
        xcd_barrier(bar);
    }
#endif
    if (IN(2)) {
        rwkv_e1_phase(F);
        nsa_rope_phase(F);
        pg8::GemmK g{2048, 1024, 1024, 128, 8, -5120};
        pg8::DenseSched S; S.init(F.ws + OFF_PR + 1536 * 2, 2048, F.ws + W_L1, 1024, T, 256, GRID, F.wg, 1);
        bf16_t* HID = (bf16_t*)(F.ws + OFF_O0) + 512;
        auto f = [HID](const pg8::Unit&, int row, int col, const float (&v)[8]) {
            float o[8];
#pragma unroll
            for (int i = 0; i < 8; ++i) o[i] = col < 64 ? tanhf_(v[i]) : (col < 128 ? v[i] : sigmoidf_(v[i]));
            store8(HID + (size_t)row * 1024 + col, o); };
        pg8::EpiRow8<decltype(f)> E{f};
        pg8::gemm_phase(F.lds, F.wave, g, S, E);
    }
    SEAM(2);
    if (IN(3) && F.wg >= 64) {
        pg8::GemmK g{1024, 256, 256, 128, 1 << 30, 0};
        pg8::DenseSched S; S.init(F.ws + OFF_O0 + 512 * 2, 1024, F.ws + W_L2, 256, T, 1536, GRID - 64, F.wg - 64);
        bf16_t* SW = st_w(F); bf16_t* SKK = st_kk(F); bf16_t* SB = st_b(F); bf16_t* SKP = st_kp(F); bf16_t* O0 = (bf16_t*)(F.ws + OFF_O0);
        const float* w0 = F.in[4]; const float* a0 = F.in[7]; const float* kkw = F.in[12]; const float* kaw = F.in[13]; const float* rn = (const float*)(F.ws + SM_RNORM);
        auto f = [=](const pg8::Unit&, int row, int col, const float (&v)[8]) {
            float o[8];
            if (col < 512) {
#pragma unroll
                for (int i = 0; i < 8; ++i) o[i] = __builtin_amdgcn_exp2f(-0.606531f * 1.44269504088896341f * sigmoidf_(w0[col + i] + v[i]));
                store8(SW + (size_t)row * 512 + col, o);
            } else if (col < 1024) {
                const int c = col - 512; float k[8], kk[8], bb[8];
                unpack8(*(const u32x4*)(SKP + (size_t)row * 512 + c), k);
                const float r = rn[(size_t)row * 8 + (c >> 6)];
#pragma unroll
                for (int i = 0; i < 8; ++i) { const float a = sigmoidf_(a0[c + i] + v[i]); kk[i] = k[i] * kkw[c + i] * r; bb[i] = kk[i] * a; o[i] = k[i] * (1.0f + (a - 1.0f) * kaw[c + i]); }
                store8(SKK + (size_t)row * 512 + c, kk); store8(SB + (size_t)row * 512 + c, bb); store8(SKP + (size_t)row * 512 + c, o);
            } else {
                store8(O0 + (size_t)row * 1024 + (col - 1024), v);
            } };
        pg8::EpiRow8<decltype(f)> E{f};
        pg8::gemm_phase(F.lds, F.wave, g, S, E);
    }
    if (IN(3)) {
        pg8::GemmK g{16 * 1536, 2048, 2048, 1536 * 2, 1 << 30, 0};
        pg8::CmpSched S{(const char*)(F.ws + OFF_PN + 512 * 2), (const char*)(F.ws + W_C1), (size_t)128, (size_t)256 * 16 * 1536 * 2, (size_t)256 * 2048 * 2, GRID, F.wg};
        bf16_t* HC = (bf16_t*)(F.ws + OFF_HC); const float* cb = (const float*)(F.ws + SM_CBIAS);
        auto f = [HC, cb](const pg8::Unit& u, int row, int col, const float (&v)[8]) {
            float o[8];
#pragma unroll
            for (int i = 0; i < 8; ++i) { const float x = v[i] + cb[(u.aux >> 1) * 256 + col + i]; o[i] = 0.5f * x * (1.0f + tanhf(0.7978845608028654f * (x + 0.044715f * x * x * x))); }
            store8(HC + ((size_t)u.aux * 4096 + row) * 256 + col, o); };
        pg8::EpiRow8<decltype(f)> E{f};
        pg8::gemm_phase(F.lds, F.wave, g, S, E);
        __threadfence(); __syncthreads();
    }
    if (IN(3)) {
        pg8::GemmK g{256, 256, 256, 128, 1 << 30, 0};
        pg8::CmpSched S{(const char*)(F.ws + OFF_HC), (const char*)(F.ws + W_C2), (size_t)4096 * 256 * 2, (size_t)256 * 256 * 2, (size_t)256 * 256 * 2, GRID, F.wg};
        bf16_t* KC = (bf16_t*)(F.ws + SM_KCMP); bf16_t* VC = (bf16_t*)(F.ws + SM_VCMPT);
        auto f = [KC, VC](const pg8::Unit& u, int row, int col, const float (&v)[8]) {
            if (col < 64) store8((u.aux < 2 ? KC : VC) + ((size_t)row * 2 + (u.aux & 1)) * 64 + col, v); };
        pg8::EpiRow8<decltype(f)> E{f};
        pg8::gemm_phase(F.lds, F.wave, g, S, E);
    }
    SEAM(3);
    if (IN(5)) { if (F.wg < SC_WGS) rwkv_scan(F); else nsa_phase(F); }
    SEAM(5);
#if PROBE == 1
    if (F.wg < SC_WGS) rwkv_scan(F, false);
    xcd_barrier(bar);
#elif PROBE == 2
    nsa_phase(F, 1);
    xcd_barrier(bar);
#elif PROBE >= 20 && PROBE < 30
    nsa_phase(F, 1, PROBE == 20 ? 0x01 : PROBE == 21 ? 0x03 : PROBE == 22 ? 0x07 : PROBE == 23 ? 0x27 : PROBE == 24 ? 0x2B : PROBE == 25 ? 0x0B : 0x2F);
    xcd_barrier(bar);
#endif
    if (IN(7)) {
        pg8::GemmK g{1024, 1024, 1024, 128, 1 << 30, 0};
        pg8::DenseSched S; S.init(F.ws + OFF_O0, 1024, F.ws + W_OUT0, 1024, T, 1024, GRID, F.wg);
        bf16_t* MX = (bf16_t*)(F.ws + OFF_MIX);
        auto f = [MX](const pg8::Unit&, int row, int col, const float (&v)[8]) { store8(MX + (size_t)row * 1024 + col, v); };
        pg8::EpiRow8<decltype(f)> E{f};
        pg8::gemm_phase(F.lds, F.wave, g, S, E);
    }
    SEAM(7);
    if (IN(10)) { ln1_router_phase(F, nullptr  , (const bf16_t*)(F.ws + OFF_MIX), (bf16_t*)(F.ws + OFF_XB), ln + 0 * 1024, ln + 1 * 1024, 0, MOE8_L0 ? F.ws + OFF_XB8 : nullptr); moe_weights(F, 0, MOE8_L0); }
    SEAM(10);
#if PROBE == 5
    ln1_router_phase(F, F.in[0], (const bf16_t*)(F.ws + OFF_MIX), (bf16_t*)(F.ws + OFF_XB), ln + 0 * 1024, ln + 1 * 1024, 0); moe_weights(F, 0);
    xcd_barrier(bar);
#endif
    if (IN(11)) moe_scatter_phase(F, nullptr, 0);
    SEAM(11);
#if PROBE == 7
    moe_scatter_phase(F, nullptr, 0);
    xcd_barrier(bar);
#endif
    if (IN(12)) {
        { const int kt_ = F.wave * 64 + lane_id(); if (kt_ < 17) tile_start[kt_] = ((const int*)(F.ws + CTL_TILES))[kt_]; }
        __syncthreads();
        if (MOE8_L0) {
            pg8::GemmK g{512, 512, 512, 128, 1 << 30, 0};
            pg8::MoeSched S{(const char*)(F.ws + OFF_XB8), (const char*)(F.ws + OFF_WMOE), (size_t)0, (size_t)256 * 1024, tile_start, 8, GRID, F.wg, (const int*)(F.ws + SM_ROWTOK)};
            pg8::EpiGU8 E{F.ws + OFF_H};
            pg8::gemm_phase<pg8::EpiGU8, pg8::MoeSched, true, true>(F.lds, F.wave, g, S, E);
        } else {
        pg8::GemmK g{1024, 1024, 1024, 128, 1 << 30, 0};
        pg8::MoeSched S{(const char*)(F.ws + OFF_XB), (const char*)(F.ws + OFF_WMOE), (size_t)0, (size_t)256 * 1024 * 2, tile_start, 8, GRID, F.wg, (const int*)(F.ws + SM_ROWTOK)};
        pg8::EpiGU E{(bf16_t*)(F.ws + OFF_H)};
        pg8::gemm_phase<pg8::EpiGU, pg8::MoeSched, true>(F.lds, F.wave, g, S, E);
        }
    }
    SEAM(12);
    if (IN(13)) {
        { const int kt_ = F.wave * 64 + lane_id(); if (kt_ < 17) tile_start[kt_] = ((const int*)(F.ws + CTL_TILES))[kt_]; }
        __syncthreads();
        bf16_t* Y = (bf16_t*)(F.ws + OFF_XS);
        if (MOE8_L0) {
            pg8::GemmK g{512, 512, 512, 128, 1 << 30, 0};
            pg8::MoeSched S{(const char*)(F.ws + OFF_H), (const char*)(F.ws + OFF_WMOE + (size_t)16 * 2048 * 1024), (size_t)256 * 1024, (size_t)256 * 1024, tile_start, 4, GRID, F.wg};
            auto f = [Y](const pg8::Unit&, int row, int col, const float (&v)[8]) { float o[8];
#pragma unroll
                for (int i = 0; i < 8; ++i) o[i] = v[i] * (1.0f / (F8_SH * F8_SD));
                store8(Y + (size_t)row * 1024 + col, o); };
            pg8::EpiRow8<decltype(f)> E{f};
            pg8::gemm_phase<decltype(E), pg8::MoeSched, false, true>(F.lds, F.wave, g, S, E);
        } else {
        pg8::GemmK g{1024, 1024, 1024, 128, 1 << 30, 0};
        pg8::MoeSched S{(const char*)(F.ws + OFF_H), (const char*)(F.ws + OFF_WMOE + (size_t)16 * 2048 * 1024 * 2), (size_t)256 * 1024 * 2, (size_t)256 * 1024 * 2, tile_start, 4, GRID, F.wg};
        auto f = [Y](const pg8::Unit&, int row, int col, const float (&v)[8]) { store8(Y + (size_t)row * 1024 + col, v); };
        pg8::EpiRow8<decltype(f)> E{f};
        pg8::gemm_phase(F.lds, F.wave, g, S, E);
        }
    }
    SEAM(13);
#if PROBE == 4
    {
        { const int kt_ = F.wave * 64 + lane_id(); if (kt_ < 17) tile_start[kt_] = ((const int*)(F.ws + CTL_TILES))[kt_]; }
        __syncthreads();
        pg8::GemmK g{1024, 1024, 1024, 128, 1 << 30, 0};
        pg8::MoeSched S{(const char*)(F.ws + OFF_XB), (const char*)(F.ws + OFF_WMOE), (size_t)0, (size_t)256 * 1024 * 2, tile_start, 8, GRID, F.wg, (const int*)(F.ws + SM_ROWTOK)};
        pg8::EpiGU E{(bf16_t*)(F.ws + OFF_H)};
        pg8::gemm_phase<pg8::EpiGU, pg8::MoeSched, true>(F.lds, F.wave, g, S, E);
        xcd_barrier(bar);
    }
#endif
    if (IN(14)) { ln2_phase(F, nullptr, ln + 2 * 1024, ln + 3 * 1024, (bf16_t*)(F.ws + OFF_XB), true, RTI8 ? F.ws + OFF_XB8B : nullptr); }
    SEAM(14);
#pragma unroll 1
    for (int k_ = 0; k_ < (PROBE == 12 ? 10 : 5); ++k_) { const int k = k_ % 5;
        if (IN(20)) {
#define PGB(j) ((bf16_t*)(F.ws + OFF_PG + (size_t)((j) & 1) * PG_BYTES))
#define KVB(j) ((bf16_t*)(F.ws + OFF_KV + (size_t)((j) & 1) * KV_BYTES))
            if (k >= 1) ret_r2_phase(F, KVB(k - 1));
            if (k <= 3) {
                pg8::GemmK g{RTI8 ? 512 : 1024, RTI8 ? 512 : 1024, RTI8 ? 512 : 1024, 128, 1 << 30, 0};
                pg8::DenseSched S; if (RTI8) S.init(F.ws + OFF_XB8B + (size_t)k * 16384 * 1024, 512, F.ws + W_RTIN, 512, 16384, 6144, GRID, F.wg); else S.init(F.ws + OFF_XB + (size_t)k * 16384 * 1024 * 2, 1024, F.ws + W_RTIN, 1024, 16384, 6144, GRID, F.wg);
                bf16_t* P = PGB(k);
                auto f = [P](const pg8::Unit&, int row, int col, const float (&v_)[8]) {
                    float v[8];
#pragma unroll
                    for (int i = 0; i < 8; ++i) v[i] = RTI8 ? v_[i] * (1.0f / (F8_SX * F8_SW)) : v_[i];
                    if (col < 2048) {
                        float o[8]; const float posf = (float)(row & 8191); const int m0 = (col & 127) >> 1;
#pragma unroll
                        for (int i = 0; i < 4; ++i) { const float rev = __builtin_amdgcn_fractf(posf * (__builtin_amdgcn_exp2f((float)(m0 + i) * (-13.287712379549449f / 63.0f)) * 0.15915494309189535f));
                            const float co = __builtin_amdgcn_cosf(rev), si = __builtin_amdgcn_sinf(rev); o[2 * i] = v[2 * i] * co - v[2 * i + 1] * si; o[2 * i + 1] = v[2 * i + 1] * co + v[2 * i] * si; }
                        store8(P + (size_t)row * PGLD + col, o);
                    } else if (PGV8) { u32x2 w8; w8[0] = pk_fp8x4(v[0] * F8_SX, v[1] * F8_SX, v[2] * F8_SX, v[3] * F8_SX); w8[1] = pk_fp8x4(v[4] * F8_SX, v[5] * F8_SX, v[6] * F8_SX, v[7] * F8_SX);
                        *(u32x2*)((unsigned char*)P + (size_t)row * 8192 + 4096 + (col - 2048)) = w8; }
                    else store8(P + (size_t)row * 6144 + col, v); };
                pg8::EpiRow8<decltype(f)> E{f};
                pg8::gemm_phase<decltype(E), pg8::DenseSched, false, RTI8>(F.lds, F.wave, g, S, E);
            }
            xcd_barrier(bar);
            if (k >= 1) ret_r3_phase(F, PGB(k - 1), KVB(k - 1), (bf16_t*)(F.ws + OFF_O1), k - 1, F.in[21]);
            if (k <= 3) { for (int u = F.wg; u < 1024; u += GRID) ret_r1_unit(F, PGB(k), KVB(k), u); }
            xcd_barrier(bar);
#undef PGB
#undef KVB
        }
    }
    if (IN(20)) {
        bf16_t* MX = (bf16_t*)(F.ws + OFF_MIX1);
        if (RTO8) {
            pg8::GemmK g{1024, 1024, 1024, 128, 1 << 30, 0};
            pg8::DenseSched S; S.init(F.ws + OFF_O1, 1024, F.ws + W_RTOUT, 1024, T, 1024, GRID, F.wg);
            auto f = [MX](const pg8::Unit&, int row, int col, const float (&v)[8]) { float o[8];
#pragma unroll
                for (int i = 0; i < 8; ++i) o[i] = v[i] * (1.0f / (F8_SO * F8_SWO));
                store8(MX + (size_t)row * 1024 + col, o); };
            pg8::EpiRow8<decltype(f)> E{f};
            pg8::gemm_phase<decltype(E), pg8::DenseSched, false, true>(F.lds, F.wave, g, S, E);
        } else {
        pg8::GemmK g{2048, 2048, 2048, 128, 1 << 30, 0};
        pg8::DenseSched S; S.init(F.ws + OFF_O1, 2048, F.ws + W_RTOUT, 2048, T, 1024, GRID, F.wg);
        auto f = [MX](const pg8::Unit&, int row, int col, const float (&v)[8]) { store8(MX + (size_t)row * 1024 + col, v); };
        pg8::EpiRow8<decltype(f)> E{f};
        pg8::gemm_phase(F.lds, F.wave, g, S, E);
        }
        xcd_barrier(bar);
    }
    if (IN(30)) { ln1_router_phase(F, nullptr, (const bf16_t*)(F.ws + OFF_MIX1), (bf16_t*)(F.ws + OFF_XB), ln + 4 * 1024, ln + 5 * 1024, 1, MOE8_L1 ? F.ws + OFF_XB8 : nullptr); moe_weights(F, 1, MOE8_L1); }
    SEAM(30);
    if (IN(31)) moe_scatter_phase(F, nullptr, 1);
    SEAM(31);
    if (IN(32)) {
        { const int kt_ = F.wave * 64 + lane_id(); if (kt_ < 17) tile_start[kt_] = ((const int*)(F.ws + CTL_TILES))[32 + kt_]; }
        __syncthreads();
        if (MOE8_L1) {
            pg8::GemmK g{512, 512, 512, 128, 1 << 30, 0};
            pg8::MoeSched S{(const char*)(F.ws + OFF_XB8), (const char*)(F.ws + OFF_WMOE), (size_t)0, (size_t)256 * 1024, tile_start, 8, GRID, F.wg, (const int*)(F.ws + SM_ROWTOK)};
            pg8::EpiGU8 E{F.ws + OFF_H};
            pg8::gemm_phase<pg8::EpiGU8, pg8::MoeSched, true, true>(F.lds, F.wave, g, S, E);
        } else {
        pg8::GemmK g{1024, 1024, 1024, 128, 1 << 30, 0};
        pg8::MoeSched S{(const char*)(F.ws + OFF_XB), (const char*)(F.ws + OFF_WMOE), (size_t)0, (size_t)256 * 1024 * 2, tile_start, 8, GRID, F.wg, (const int*)(F.ws + SM_ROWTOK)};
        pg8::EpiGU E{(bf16_t*)(F.ws + OFF_H)};
        pg8::gemm_phase<pg8::EpiGU, pg8::MoeSched, true>(F.lds, F.wave, g, S, E);
        }
    }
    SEAM(32);
    if (IN(33)) {
        { const int kt_ = F.wave * 64 + lane_id(); if (kt_ < 17) tile_start[kt_] = ((const int*)(F.ws + CTL_TILES))[32 + kt_]; }
        __syncthreads();
        bf16_t* Y = (bf16_t*)(F.ws + OFF_XS);
        if (MOE8_L1) {
            pg8::GemmK g{512, 512, 512, 128, 1 << 30, 0};
            pg8::MoeSched S{(const char*)(F.ws + OFF_H), (const char*)(F.ws + OFF_WMOE + (size_t)16 * 2048 * 1024), (size_t)256 * 1024, (size_t)256 * 1024, tile_start, 4, GRID, F.wg};
            auto f = [Y](const pg8::Unit&, int row, int col, const float (&v)[8]) { float o[8];
#pragma unroll
                for (int i = 0; i < 8; ++i) o[i] = v[i] * (1.0f / (F8_SH * F8_SD));
                store8(Y + (size_t)row * 1024 + col, o); };
            pg8::EpiRow8<decltype(f)> E{f};
            pg8::gemm_phase<decltype(E), pg8::MoeSched, false, true>(F.lds, F.wave, g, S, E);
        } else {
        pg8::GemmK g{1024, 1024, 1024, 128, 1 << 30, 0};
        pg8::MoeSched S{(const char*)(F.ws + OFF_H), (const char*)(F.ws + OFF_WMOE + (size_t)16 * 2048 * 1024 * 2), (size_t)256 * 1024 * 2, (size_t)256 * 1024 * 2, tile_start, 4, GRID, F.wg};
        auto f = [Y](const pg8::Unit&, int row, int col, const float (&v)[8]) { store8(Y + (size_t)row * 1024 + col, v); };
        pg8::EpiRow8<decltype(f)> E{f};
        pg8::gemm_phase(F.lds, F.wave, g, S, E);
        }
    }
    SEAM(33);
    if (IN(34)) ln2_phase(F, F.out, ln + 6 * 1024, ln + 7 * 1024, (bf16_t*)(F.ws + OFF_XB), true);
#undef IN
#undef SEAM
}

extern "C" void kernel_launch(void* const* d_in, const int* in_sizes, int n_in, void* d_out, int out_size, void* d_ws, size_t ws_size, hipStream_t stream) {
    static int ready = 0;
    if (ready == 0) {
        if (n_in != 28 || out_size != T * D || ws_size < WS_END) { fprintf(stderr, "kernel_launch: unexpected shapes / workspace (%d inputs, out %d, ws %zu)\n", n_in, out_size, ws_size); ready = -1; return; }
        if (hipFuncSetAttribute((const void*)fwd_kernel, hipFuncAttributeMaxDynamicSharedMemorySize, LDS_BYTES) != hipSuccess) { fprintf(stderr, "kernel_launch: hipFuncSetAttribute failed\n"); ready = -1; return; }
        int per_cu = 0;
        if (hipOccupancyMaxActiveBlocksPerMultiprocessor(&per_cu, (const void*)fwd_kernel, NTH, LDS_BYTES) != hipSuccess || per_cu < 1) { fprintf(stderr, "kernel_launch: occupancy query says %d\n", per_cu); }
        (void)hipGetLastError();
        ready = 1;
    }
    if (ready < 0) return;
    (void)hipMemsetAsync((char*)d_ws + OFF_CTL, 0, CTL_BYTES, stream);
    Args a{};
    for (int i = 0; i < 28; ++i) a.in[i] = (const float*)d_in[i];
    a.out = (float*)d_out; a.ws = (unsigned char*)d_ws; a.ph_lo = 0; a.ph_hi = 1000;
    hipLaunchKernelGGL(fwd_kernel, dim3(GRID), dim3(NTH), LDS_BYTES, stream, a);
}
```

```cpp
#include <hip/hip_runtime.h>
#include <stdint.h>
#include <stdio.h>

#ifndef PROBE
#define PROBE 0
#endif
#define DI __device__ __forceinline__
#define LAS __attribute__((address_space(3)))
typedef unsigned short bf16_t;
typedef short bf16x8 __attribute__((ext_vector_type(8)));
typedef float f32x4 __attribute__((ext_vector_type(4)));
typedef unsigned u32x4 __attribute__((ext_vector_type(4)));
typedef unsigned u32x2 __attribute__((ext_vector_type(2)));
typedef int i32x4 __attribute__((ext_vector_type(4)));
typedef float f32x2 __attribute__((ext_vector_type(2)));

constexpr int T = 65536, D = 1024, SEQ = 8192, NB = 8;
constexpr int NTH = 512, GRID = 256;
constexpr float ALPHA = 1.41421356237309515f;
constexpr float LN_EPS = 1e-5f;
constexpr size_t MiB = (size_t)1 << 20;

constexpr size_t OFF_CTL = 0;
constexpr size_t CTL_BYTES = 256 * 1024;
constexpr size_t CTL_BAR = 0;
constexpr size_t CTL_Q = 16 * 1024;
constexpr size_t CTL_BLKCNT = 32 * 1024;
constexpr size_t CTL_TILES = 96 * 1024;
constexpr size_t OFF_SMALL = 1 * MiB;
constexpr size_t SM_ROPEN = OFF_SMALL + 0;
constexpr size_t SM_ROPER = OFF_SMALL + 1 * MiB;
constexpr size_t SM_CBIAS = OFF_SMALL + 5 * MiB;
constexpr size_t SM_TOKE = OFF_SMALL + 6 * MiB;
constexpr size_t SM_TOKW = OFF_SMALL + 7 * MiB;
constexpr size_t SM_TOKP = OFF_SMALL + 8 * MiB;
constexpr size_t SM_RNORM = OFF_SMALL + 9 * MiB;
constexpr size_t SM_KCMP = OFF_SMALL + 11 * MiB;
constexpr size_t SM_VCMPT = OFF_SMALL + 12 * MiB;
constexpr size_t SM_ROWTOK = OFF_SMALL + 13 * MiB;
constexpr size_t OFF_WSM = 16 * MiB;
constexpr size_t W_IN0 = OFF_WSM;
constexpr size_t W_OUT0 = OFF_WSM + 7 * MiB;
constexpr size_t W_RTIN = OFF_WSM + 9 * MiB;
constexpr size_t W_RTOUT = OFF_WSM + 21 * MiB;
constexpr size_t W_L1 = OFF_WSM + 25 * MiB;
constexpr size_t W_L2 = OFF_WSM + 25 * MiB + 512 * 1024;
constexpr size_t W_C1 = OFF_WSM + 27 * MiB;
constexpr size_t W_C2 = OFF_WSM + 29 * MiB;
constexpr size_t OFF_XB = 48 * MiB;
constexpr size_t OFF_BIG = 176 * MiB;
constexpr size_t OFF_MIX = OFF_BIG;
constexpr size_t OFF_H = OFF_BIG;
constexpr size_t OFF_WMOE = 448 * MiB;
constexpr size_t OFF_XS = 544 * MiB;
constexpr size_t OFF_PR = OFF_BIG;
constexpr size_t OFF_ORAW = OFF_BIG;
constexpr size_t OFF_PN = 433 * MiB;
constexpr size_t OFF_O0 = 625 * MiB;
constexpr size_t OFF_HC = 753 * MiB;
constexpr size_t OFF_PG = OFF_BIG;
constexpr size_t PG_BYTES = 192 * MiB;
constexpr size_t OFF_O1 = 560 * MiB;
constexpr size_t OFF_KV = 816 * MiB;
constexpr size_t KV_BYTES = 64 * MiB;
constexpr size_t OFF_MIX1 = OFF_BIG;
constexpr size_t OFF_XB8 = 816 * MiB;
constexpr size_t OFF_STR = 768 * MiB;
constexpr size_t OFF_XB8B = 944 * MiB;
constexpr size_t WS_END = 1008 * MiB;
constexpr bool MOE8_L0 = true, MOE8_L1 = true;
constexpr bool PGV8 = true;
constexpr int PGLD = PGV8 ? 4096 : 6144;
constexpr bool RTI8 = true;
constexpr bool RTO8 = true;
constexpr float F8_SO = 8.f, F8_SWO = 512.f;
constexpr float F8_SX = 16.f, F8_SW = 256.f, F8_SH = 8.f, F8_SD = 512.f;
constexpr int MOE_ROWS_MAX = 135168;

DI float bf2f(bf16_t b) { return __uint_as_float(((unsigned)b) << 16); }
DI bf16_t f2bf(float f) { unsigned u = __float_as_uint(f); u += 0x7FFFu + ((u >> 16) & 1u); return (bf16_t)(u >> 16); }
typedef __bf16 bf16v2_t __attribute__((ext_vector_type(2)));
DI unsigned pack2(float lo, float hi) { const bf16v2_t r = __builtin_convertvector((f32x2){lo, hi}, bf16v2_t); return __builtin_bit_cast(unsigned, r); }
DI int lane_id() { int l; asm volatile("v_mbcnt_lo_u32_b32 %0, -1, 0\n\tv_mbcnt_hi_u32_b32 %0, -1, %0" : "=v"(l)); return l; }
DI float shx(float v, int m) { const int l = lane_id(); return __int_as_float(__builtin_amdgcn_ds_bpermute((l ^ m) << 2, __float_as_int(v))); }
DI float f8sat(float x) { return __builtin_amdgcn_fmed3f(x, -448.f, 448.f); }
DI unsigned pk_fp8x4(float a, float b, float c, float d) {
    int p = __builtin_amdgcn_cvt_pk_fp8_f32(f8sat(a), f8sat(b), 0, false); p = __builtin_amdgcn_cvt_pk_fp8_f32(f8sat(c), f8sat(d), p, true); return (unsigned)p; }
DI float wave_sum(float v) {
#pragma unroll
    for (int o = 32; o; o >>= 1) v += shx(v, o);
    return v;
}
DI int lds_add(LAS int* p, int v) { return __hip_atomic_fetch_add(p, v, __ATOMIC_RELAXED, __HIP_MEMORY_SCOPE_WORKGROUP); }
DI float rcpf_(float x) { return __builtin_amdgcn_rcpf(x); }
DI float sigmoidf_(float x) { return rcpf_(1.0f + __builtin_amdgcn_exp2f(-1.44269504088896341f * x)); }
DI float siluf_(float x) { return x * sigmoidf_(x); }
DI float tanhf_(float x) { return 1.0f - 2.0f * rcpf_(1.0f + __builtin_amdgcn_exp2f(2.88539008177792681f * x)); }

#define XB_TMO      128
#define XB_XCNT(j)  (256  + 64 * (j))
#define XB_XSUB(j)  (1280 + 64 * (j))
#define XB_XGEN(j)  (2304 + 64 * (j))
#define XB_TOP      3328
#define XB_TOPGEN   3392
#define XCD_BAR_WORDS 3456
#define XB_SPIN_CAP (1u << 24)

DI unsigned xb_ld(unsigned* p)              { return __hip_atomic_load(p, __ATOMIC_RELAXED, __HIP_MEMORY_SCOPE_AGENT); }
DI unsigned xb_add(unsigned* p, unsigned v) { return __hip_atomic_fetch_add(p, v, __ATOMIC_RELAXED, __HIP_MEMORY_SCOPE_AGENT); }
DI unsigned xb_xcc_id() { return (unsigned)__builtin_amdgcn_s_getreg((3 << 11) | 20) & 0xFu; }
#define XB_SPIN(cond, bar) do { unsigned _sp = 0; while (cond) { __builtin_amdgcn_s_sleep(1); \
    if ((++_sp & 255u) == 0u) { if (xb_ld(&(bar)[XB_TMO])) break; if (_sp > XB_SPIN_CAP) { atomicAdd(&(bar)[XB_TMO], 1u); break; } } } } while (0)

struct XcdBarrier { unsigned* bar; unsigned x; volatile LAS unsigned* st; };

DI XcdBarrier xcd_barrier_post(unsigned* bar, volatile LAS unsigned* st) {
    XcdBarrier b; b.bar = bar; b.x = xb_xcc_id(); b.st = st;
    if (threadIdx.x == 0) (void)xb_add(&bar[XB_XCNT(b.x)], 1u);
    return b;
}
DI void xcd_barrier_complete(unsigned* bar, unsigned x, unsigned& nloc, unsigned& nx) {
    const unsigned G = gridDim.x * gridDim.y * gridDim.z;
    unsigned sum, cnt, mine, sp = 0u;
    for (;;) {
        sum = 0u; cnt = 0u; mine = 0u;
#pragma unroll
        for (unsigned j = 0; j < 16; ++j) { const unsigned c = xb_ld(&bar[XB_XCNT(j)]); sum += c; cnt += (c > 0u) ? 1u : 0u; mine = (j == x) ? c : mine; }
        if (sum == G) break;
        __builtin_amdgcn_s_sleep(1);
        if ((++sp & 255u) == 0u) { if (xb_ld(&bar[XB_TMO])) break; if (sp > XB_SPIN_CAP) { atomicAdd(&bar[XB_TMO], 1u); break; } }
    }
    nloc = mine > 0u ? mine : 1u; nx = cnt > 0u ? cnt : 1u;
}
DI void xcd_barrier(const XcdBarrier& b) {
    asm volatile("s_waitcnt vmcnt(0)" ::: "memory");
    __syncthreads();
    if (threadIdx.x == 0) {
        unsigned* bar = b.bar;
        __builtin_amdgcn_s_waitcnt(0);
        unsigned nloc = b.st[0], nx = b.st[1];
        if (nloc == 0u) { xcd_barrier_complete(bar, b.x, nloc, nx); b.st[0] = nloc; b.st[1] = nx; }
        const unsigned old = xb_add(&bar[XB_XSUB(b.x)], 1u);
        const unsigned gen = old / nloc;
        if (old + 1u == (gen + 1u) * nloc) {
            __builtin_amdgcn_fence(__ATOMIC_RELEASE, "agent");
            asm volatile("s_waitcnt vmcnt(0)" ::: "memory");
            const unsigned og = xb_add(&bar[XB_TOP], 1u);
            const unsigned tg = og / nx;
            if (og + 1u == (tg + 1u) * nx) xb_add(&bar[XB_TOPGEN], 1u);
            else XB_SPIN(xb_ld(&bar[XB_TOPGEN]) == tg, bar);
            __builtin_amdgcn_fence(__ATOMIC_ACQUIRE, "agent");
            xb_add(&bar[XB_XGEN(b.x)], 1u);
            asm volatile("s_waitcnt vmcnt(0)" ::: "memory");
        } else {
            XB_SPIN(xb_ld(&bar[XB_XGEN(b.x)]) == gen, bar);
            __builtin_amdgcn_fence(__ATOMIC_ACQUIRE, "agent");
            asm volatile("s_waitcnt vmcnt(0)" ::: "memory");
        }
    }
    __syncthreads();
}

namespace pg8 {
constexpr int BM = 256, BK = 64, HALF = 128, HTB = HALF * BK * 2, STAGE_BYTES = 8 * HTB, NXCD = 8, WGM = 8;
DI int lds_byte(int r, int c) { const int st = (r >> 4) * 2 + (c >> 5), rr = r & 15, cc = c & 31, ob = rr * 64 + cc * 2; return st * 1024 + (ob ^ (((ob >> 9) & 1) << 5)); }
DI void stage_rc(int b, int& R, int& C) { const int st = b / 1024, sb = b % 1024, swz = sb ^ (((sb >> 9) & 1) << 5); R = (st >> 1) * 16 + swz / 64; C = (st & 1) * 32 + (swz % 64) / 2; }
DI int perm32(int rho) { const int n = rho >> 4, i = rho & 15; return 8 * (i >> 2) + 4 * n + (i & 3); }

struct Unit { const char* a; const char* b; int pm, pn, aux; const int* rows; };
struct GemmK { int lda, ldb, K, kstepA, ksplit, kjump; };

template <class Epi, class Sched, bool GATHER = false, bool F8 = false>
DI void gemm_phase(LAS unsigned char* lds, int wave_, const GemmK g, const Sched& S, const Epi& E) {
    int tid = wave_ * 64 + lane_id(); asm volatile("" : "+v"(tid));
    const int wid = __builtin_amdgcn_readfirstlane(tid >> 6), lane = tid & 63, wr = wid >> 2, wc = wid & 3, fr = lane & 15, fq = lane >> 4;
    const int nt = g.K / BK;
    unsigned voffA[2], voffB[2], cA2[2]; int rA[2]; unsigned vgc[2][2], vgn[2][2];
#pragma unroll
    for (int i = 0; i < 2; ++i) { int R, C; stage_rc(tid * 16 + i * 8192, R, C); const int Rb = Epi::PERM ? ((R & ~31) + perm32(R & 31)) : R;
        voffA[i] = (unsigned)(R * g.lda + C) * 2u; voffB[i] = (unsigned)(Rb * g.ldb + C) * 2u; rA[i] = R; cA2[i] = (unsigned)C * 2u; }
    const size_t kstepA = (size_t)g.kstepA, kstepB = (size_t)(BK * 2);
    const size_t hstepA = (size_t)HALF * g.lda * 2, hstepB = (size_t)HALF * g.ldb * 2;
    const unsigned ldsw = (unsigned)wid * 1024u;
    const int aoff = lds_byte(wr * 64 + fr, fq * 8), boff = lds_byte(wc * 32 + fr, fq * 8);
#define PG8_AK(base, kt) ((base) + (size_t)(kt) * kstepA + (((kt) >= g.ksplit) ? (long)g.kjump : 0l))
#define PG8_SA(b, h) (((b) * 2 + (h)) * HTB)
#define PG8_SB(b, h) ((4 + (b) * 2 + (h)) * HTB)
#define PG8_STAGE(bufoff, gbase, voff) do { _Pragma("unroll") for (int _i = 0; _i < 2; ++_i) \
        __builtin_amdgcn_global_load_lds((const unsigned*)((const char*)(gbase) + (voff)[_i]), (LAS unsigned*)(lds + (bufoff) + ldsw + _i * 8192), 16, 0, 0); } while (0)
#define PG8_STAGE_A(bufoff, kbase, h, nx) do { if (GATHER) { _Pragma("unroll") for (int _i = 0; _i < 2; ++_i) { const unsigned _vo = (nx) ? vgn[h][_i] : vgc[h][_i]; \
        __builtin_amdgcn_global_load_lds((const unsigned*)((const char*)(kbase) + _vo), (LAS unsigned*)(lds + (bufoff) + ldsw + _i * 8192), 16, 0, 0); } } \
        else PG8_STAGE(bufoff, (kbase) + (h) * hstepA, voffA); } while (0)
#define PG8_ROWS(dst, u) do { if (GATHER) { _Pragma("unroll") for (int _h = 0; _h < 2; ++_h) _Pragma("unroll") for (int _i = 0; _i < 2; ++_i) dst[_h][_i] = (unsigned)(u).rows[128 * _h + rA[_i]] * (unsigned)(g.lda * 2) + cA2[_i]; } } while (0)
#define PG8_LDA(dst, b, h) do { _Pragma("unroll") for (int m = 0; m < 4; ++m) _Pragma("unroll") for (int k = 0; k < 2; ++k) dst[m][k] = *(const LAS bf16x8*)(lds + PG8_SA(b, h) + aoff + m * 2048 + k * 1024); } while (0)
#define PG8_LDB(dst, b, h) do { _Pragma("unroll") for (int n = 0; n < 2; ++n) _Pragma("unroll") for (int k = 0; k < 2; ++k) dst[n][k] = *(const LAS bf16x8*)(lds + PG8_SB(b, h) + boff + n * 2048 + k * 1024); } while (0)
#define PG8_CAT(x, y) __builtin_shufflevector(__builtin_bit_cast(i32x4, x), __builtin_bit_cast(i32x4, y), 0, 1, 2, 3, 4, 5, 6, 7)
#define PG8_MMA(ai, bj, At, Bt) do { __builtin_amdgcn_s_setprio(1); \
        if (F8) { _Pragma("unroll") for (int m = 0; m < 4; ++m) _Pragma("unroll") for (int n = 0; n < 2; ++n) \
            asm volatile("v_mfma_f32_16x16x128_f8f6f4 %0, %1, %2, %0" : "+v"(acc[ai][bj][m][n]) : "v"(PG8_CAT(Bt[n][0], Bt[n][1])), "v"(PG8_CAT(At[m][0], At[m][1]))); }     \
        else { _Pragma("unroll") for (int m = 0; m < 4; ++m) _Pragma("unroll") for (int n = 0; n < 2; ++n) _Pragma("unroll") for (int k = 0; k < 2; ++k) \
            acc[ai][bj][m][n] = __builtin_amdgcn_mfma_f32_16x16x32_bf16(Bt[n][k], At[m][k], acc[ai][bj][m][n], 0, 0, 0); } \
        __builtin_amdgcn_s_setprio(0); } while (0)
#define PG8_WAIT_V(n) asm volatile("s_waitcnt vmcnt(" #n ")" ::: "memory")
#define PG8_WAIT_L(n) asm volatile("s_waitcnt lgkmcnt(" #n ")" ::: "memory")
#define PG8_BAR __builtin_amdgcn_s_barrier()
#define PG8_SCHED __builtin_amdgcn_sched_barrier(0)
    Unit cur, nxt; int ui = 0;
    if (!S.next(0, cur)) return;
    f32x4 acc[2][2][4][2];
#pragma unroll
    for (int a = 0; a < 2; ++a)
#pragma unroll
        for (int b = 0; b < 2; ++b)
#pragma unroll
            for (int m = 0; m < 4; ++m)
#pragma unroll
                for (int n = 0; n < 2; ++n) acc[a][b][m][n] = (f32x4){0.f, 0.f, 0.f, 0.f};
    bf16x8 At[4][2], B0[2][2], B1[2][2];
    const char* cA = cur.a; const char* cB = cur.b;
    PG8_ROWS(vgc, cur);
    PG8_STAGE(PG8_SB(0, 0), cB, voffB); PG8_STAGE_A(PG8_SA(0, 0), cA, 0, false); PG8_STAGE(PG8_SB(0, 1), cB + hstepB, voffB); PG8_STAGE_A(PG8_SA(0, 1), cA, 1, false);
    if (wr == 1) PG8_BAR;
    PG8_WAIT_V(4); PG8_BAR;
    PG8_STAGE(PG8_SB(1, 0), cB + kstepB, voffB); PG8_STAGE_A(PG8_SA(1, 0), PG8_AK(cA, 1), 0, false); PG8_STAGE(PG8_SB(1, 1), cB + hstepB + kstepB, voffB);
    PG8_WAIT_V(6); PG8_BAR;
    for (;;) {
        const bool has_next = S.next(ui + 1, nxt);
        const char* nA = has_next ? nxt.a : cA; const char* nB = has_next ? nxt.b : cB;
        if (GATHER) { if (has_next) PG8_ROWS(vgn, nxt); else { _Pragma("unroll") for (int _h = 0; _h < 2; ++_h) _Pragma("unroll") for (int _i = 0; _i < 2; ++_i) vgn[_h][_i] = vgc[_h][_i]; } }
#pragma unroll 1
        for (int t = 0; t < nt; t += 2) {
            const bool last = (t == nt - 2);
            const char* a1 = PG8_AK(cA, t + 1);
            const char* a2 = last ? nA : PG8_AK(cA, t + 2); const char* b2 = last ? nB : cB + (size_t)(t + 2) * kstepB;
            const char* a3 = last ? PG8_AK(nA, 1) : PG8_AK(cA, t + 3); const char* b3 = b2 + kstepB;
            PG8_LDB(B0, 0, 0); PG8_SCHED; PG8_LDA(At, 0, 0); PG8_STAGE_A(PG8_SA(1, 1), a1, 1, false);
            PG8_WAIT_L(8); PG8_BAR; PG8_WAIT_L(0); PG8_MMA(0, 0, At, B0); PG8_BAR; PG8_SCHED;
            PG8_LDB(B1, 0, 1); PG8_STAGE(PG8_SB(0, 0), b2, voffB);
            PG8_BAR; PG8_WAIT_L(0); PG8_MMA(0, 1, At, B1); PG8_BAR;
            PG8_LDA(At, 0, 1); PG8_STAGE_A(PG8_SA(0, 0), a2, 0, last);
            PG8_BAR; PG8_WAIT_L(0); PG8_MMA(1, 0, At, B0); PG8_BAR; PG8_SCHED;
            PG8_STAGE(PG8_SB(0, 1), b2 + hstepB, voffB);
            PG8_WAIT_V(6); PG8_BAR; PG8_MMA(1, 1, At, B1); PG8_BAR;
            PG8_LDB(B0, 1, 0); PG8_SCHED; PG8_LDA(At, 1, 0); PG8_STAGE_A(PG8_SA(0, 1), a2, 1, last);
            PG8_WAIT_L(8); PG8_BAR; PG8_WAIT_L(0); PG8_MMA(0, 0, At, B0); PG8_BAR; PG8_SCHED;
            PG8_LDB(B1, 1, 1); PG8_STAGE(PG8_SB(1, 0), b3, voffB);
            PG8_BAR; PG8_WAIT_L(0); PG8_MMA(0, 1, At, B1); PG8_BAR;
            PG8_LDA(At, 1, 1); PG8_STAGE_A(PG8_SA(1, 0), a3, 0, last);
            PG8_BAR; PG8_WAIT_L(0); PG8_MMA(1, 0, At, B0); PG8_BAR; PG8_SCHED;
            PG8_STAGE(PG8_SB(1, 1), b3 + hstepB, voffB);
            PG8_WAIT_V(6); PG8_BAR; PG8_MMA(1, 1, At, B1); PG8_BAR;
        }
        if (F8) {
#pragma unroll
            for (int a = 0; a < 2; ++a)
#pragma unroll
                for (int b = 0; b < 2; ++b) {
                    if (a == 0 && b == 0) asm volatile("s_nop 15\n\ts_nop 15" : "+v"(acc[a][b][0][0]), "+v"(acc[a][b][0][1]), "+v"(acc[a][b][1][0]), "+v"(acc[a][b][1][1]), "+v"(acc[a][b][2][0]), "+v"(acc[a][b][2][1]), "+v"(acc[a][b][3][0]), "+v"(acc[a][b][3][1]));
                    else asm volatile("" : "+v"(acc[a][b][0][0]), "+v"(acc[a][b][0][1]), "+v"(acc[a][b][1][0]), "+v"(acc[a][b][1][1]), "+v"(acc[a][b][2][0]), "+v"(acc[a][b][2][1]), "+v"(acc[a][b][3][0]), "+v"(acc[a][b][3][1])); } }
        E(acc, cur, wr, wc, fr, fq);
        if (!has_next) break;
#pragma unroll
        for (int a = 0; a < 2; ++a)
#pragma unroll
            for (int b = 0; b < 2; ++b)
#pragma unroll
                for (int m = 0; m < 4; ++m)
#pragma unroll
                    for (int n = 0; n < 2; ++n) acc[a][b][m][n] = (f32x4){0.f, 0.f, 0.f, 0.f};
        cur = nxt; cA = nA; cB = nB; ++ui;
        if (GATHER) { _Pragma("unroll") for (int _h = 0; _h < 2; ++_h) _Pragma("unroll") for (int _i = 0; _i < 2; ++_i) vgc[_h][_i] = vgn[_h][_i]; }
    }
    PG8_WAIT_V(0);
    if (wr == 0) PG8_BAR;
    PG8_BAR;
#undef PG8_AK
#undef PG8_SA
#undef PG8_SB
#undef PG8_STAGE
#undef PG8_STAGE_A
#undef PG8_ROWS
#undef PG8_LDA
#undef PG8_LDB
#undef PG8_MMA
#undef PG8_CAT
#undef PG8_WAIT_V
#undef PG8_WAIT_L
#undef PG8_BAR
#undef PG8_SCHED
}

struct DenseSched {
    const char* A; const char* B; size_t tstepA, tstepB; int nM, nN, nwg, G, c; int prp;
    DI void init(const void* A_, int lda, const void* B_, int ldb, int M, int N, int G_, int c_, int prp_ = 0) {
        A = (const char*)A_; B = (const char*)B_; tstepA = (size_t)BM * lda * 2; tstepB = (size_t)BM * ldb * 2; nM = M / BM; nN = N / BM; nwg = nM * nN; G = G_; c = c_; prp = prp_; }
    DI bool next(int i, Unit& u) const {
        const long L = (long)i * G + c; if (L >= nwg) return false;
        int wgid = (int)L; { const int q = nwg / NXCD, r = nwg % NXCD, xcd = wgid % NXCD, off = wgid / NXCD; wgid = (xcd < r ? xcd * (q + 1) : r * (q + 1) + (xcd - r) * q) + off; }
        const int nig = WGM * nN, gid = wgid / nig, fm = gid * WGM, gsz = (nM - fm) < WGM ? (nM - fm) : WGM;
        u.pm = fm + ((wgid % nig) % gsz); u.pn = (wgid % nig) / gsz; u.aux = 0;
        u.a = A + (size_t)u.pm * tstepA + (prp ? (size_t)((u.pm >> 5) + 1) * (tstepA / BM) : (size_t)0);
        u.b = B + (size_t)u.pn * tstepB; u.rows = nullptr;
        return true;
    }
};
struct MoeSched {
    const char* A; const char* B; size_t tstepA, tstepB; const LAS int* ts; int nN, G, c; const int* rowtab;
    DI bool next(int i, Unit& u) const {
        const long L0 = (long)i * G + c; const int nwg = ts[16] * nN; if (L0 >= nwg) return false;
        int L = (int)L0; { const int q = nwg / NXCD, r = nwg % NXCD, xcd = L % NXCD, off = L / NXCD; L = (xcd < r ? xcd * (q + 1) : r * (q + 1) + (xcd - r) * q) + off; }
        const int rt = L / nN, pn = L % nN;
        int e = 0;
#pragma unroll
        for (int j = 1; j < 16; ++j) e += (rt >= ts[j]) ? 1 : 0;
        u.pm = rt; u.pn = pn; u.aux = e;
        u.a = rowtab ? A : A + (size_t)rt * tstepA; u.b = B + (size_t)(e * nN + pn) * tstepB; u.rows = rowtab ? rowtab + rt * 256 : nullptr;
        return true;
    }
};

template <class F> struct EpiRow8 {
    static constexpr bool PERM = true;
    F f;
    DI void operator()(const f32x4 (&acc)[2][2][4][2], const Unit& u, int wr, int wc, int fr, int fq) const {
#pragma unroll
        for (int ai = 0; ai < 2; ++ai)
#pragma unroll
            for (int m = 0; m < 4; ++m) {
                const int row = u.pm * BM + ai * HALF + wr * 64 + m * 16 + fr;
#pragma unroll
                for (int bj = 0; bj < 2; ++bj) {
                    const int col = u.pn * BM + bj * HALF + wc * 32 + 8 * fq;
                    float v[8];
#pragma unroll
                    for (int j = 0; j < 4; ++j) { v[j] = acc[ai][bj][m][0][j]; v[4 + j] = acc[ai][bj][m][1][j]; }
                    f(u, row, col, v);
                }
            }
    }
};
struct EpiF32 {
    static constexpr bool PERM = false;
    float* C; int ldc;
    DI void operator()(const f32x4 (&acc)[2][2][4][2], const Unit& u, int wr, int wc, int fr, int fq) const {
        const int row0 = u.pm * BM + wr * 64 + fr, col0 = u.pn * BM + wc * 32 + 4 * fq;
#pragma unroll
        for (int ai = 0; ai < 2; ++ai)
#pragma unroll
            for (int m = 0; m < 4; ++m) { float* rowp = C + (size_t)(row0 + ai * HALF + m * 16) * ldc + col0;
#pragma unroll
                for (int bj = 0; bj < 2; ++bj)
#pragma unroll
                    for (int n = 0; n < 2; ++n) *(f32x4*)(rowp + bj * HALF + n * 16) = acc[ai][bj][m][n]; }
    }
};
struct EpiGU {
    static constexpr bool PERM = true;
    bf16_t* H;
    DI void operator()(const f32x4 (&acc)[2][2][4][2], const Unit& u, int wr, int wc, int fr, int fq) const {
#pragma unroll
        for (int ai = 0; ai < 2; ++ai)
#pragma unroll
            for (int m = 0; m < 4; ++m) {
                const int row = u.pm * BM + ai * HALF + wr * 64 + m * 16 + fr;
                const int col = u.pn * HALF + wc * 32 + 8 * fq;
                float h[8];
#pragma unroll
                for (int j = 0; j < 4; ++j) {
                    const float g0 = acc[ai][0][m][0][j], u0 = acc[ai][1][m][0][j], g1 = acc[ai][0][m][1][j], u1 = acc[ai][1][m][1][j];
                    h[j] = siluf_(g0) * u0; h[4 + j] = siluf_(g1) * u1;
                }
                u32x4 o; o[0] = pack2(h[0], h[1]); o[1] = pack2(h[2], h[3]); o[2] = pack2(h[4], h[5]); o[3] = pack2(h[6], h[7]);
                *(u32x4*)(H + (size_t)row * 1024 + col) = o;
            }
    }
};
struct EpiGU8 {
    static constexpr bool PERM = true;
    unsigned char* H;
    DI void operator()(const f32x4 (&acc)[2][2][4][2], const Unit& u, int wr, int wc, int fr, int fq) const {
        constexpr float SI = 1.0f / (F8_SX * F8_SW);
#pragma unroll
        for (int ai = 0; ai < 2; ++ai)
#pragma unroll
            for (int m = 0; m < 4; ++m) {
                const int row = u.pm * BM + ai * HALF + wr * 64 + m * 16 + fr;
                const int col = u.pn * HALF + wc * 32 + 8 * fq;
                float h[8];
#pragma unroll
                for (int j = 0; j < 4; ++j) {
                    const float g0 = acc[ai][0][m][0][j] * SI, u0 = acc[ai][1][m][0][j] * (SI * F8_SH), g1 = acc[ai][0][m][1][j] * SI, u1 = acc[ai][1][m][1][j] * (SI * F8_SH);
                    h[j] = siluf_(g0) * u0; h[4 + j] = siluf_(g1) * u1;
                }
                u32x2 o; o[0] = pk_fp8x4(h[0], h[1], h[2], h[3]); o[1] = pk_fp8x4(h[4], h[5], h[6], h[7]);
                *(u32x2*)(H + (size_t)row * 1024 + col) = o;
            }
    }
};
}

DI void unpack8(const u32x4 a, float (&o)[8]) {
#pragma unroll
    for (int i = 0; i < 4; ++i) { o[2 * i] = __uint_as_float(a[i] << 16); o[2 * i + 1] = __uint_as_float(a[i] & 0xffff0000u); }
}
DI u32x4 pack8(const float (&v)[8]) { u32x4 o; o[0] = pack2(v[0], v[1]); o[1] = pack2(v[2], v[3]); o[2] = pack2(v[4], v[5]); o[3] = pack2(v[6], v[7]); return o; }
DI void store8(bf16_t* p, const float (&v)[8]) {
    u32x4 o; o[0] = pack2(v[0], v[1]); o[1] = pack2(v[2], v[3]); o[2] = pack2(v[4], v[5]); o[3] = pack2(v[6], v[7]);
    *(u32x4*)p = o;
}

struct Args { const float* in[28]; float* out; unsigned char* ws; int ph_lo, ph_hi; };
struct Frame {
    LAS unsigned char* lds; int tid, lane, wave, wg;
    unsigned char* ws; float* out; const float* const* in;
};

constexpr int LDS_SCR = 1024;
constexpr int LDS_BYTES = 1024 + 155 * 1024;

struct TrTile { const float* src; int ldsrc, N; bf16_t* dst; int ldd, rowmode, k0, n0; float f8; };
DI void tr_load(const Frame& F, const TrTile& d, f32x4 (&v)[2]) {
#pragma unroll
    for (int i = 0; i < 2; ++i) { const int kk = (F.tid >> 4) + 32 * i, n4 = (F.tid & 15) * 4;
        v[i] = (d.n0 + n4 < d.N) ? *(const f32x4*)(d.src + (size_t)(d.k0 + kk) * d.ldsrc + d.n0 + n4) : (f32x4){0.f, 0.f, 0.f, 0.f}; }
}
template <class Desc> DI void tr_run(const Frame& F, int ntiles, Desc desc) {
    LAS float* tile = (LAS float*)F.lds;
    const int nq = ntiles >> 2;
    int id = F.wg; if (id >= nq) return;
    TrTile d[4]; f32x4 v[4][2];
#pragma unroll
    for (int s4 = 0; s4 < 4; ++s4) { d[s4] = desc(4 * id + s4); tr_load(F, d[s4], v[s4]); }
    for (;;) {
        __syncthreads();
#pragma unroll
        for (int s4 = 0; s4 < 4; ++s4)
#pragma unroll
            for (int i = 0; i < 2; ++i) { const int kk = (F.tid >> 4) + 32 * i, n4 = (F.tid & 15) * 4;
#pragma unroll
                for (int e = 0; e < 4; ++e) tile[s4 * (64 * 65) + kk * 65 + n4 + e] = v[s4][i][e]; }
        __syncthreads();
        TrTile cur[4];
#pragma unroll
        for (int s4 = 0; s4 < 4; ++s4) cur[s4] = d[s4];
        const int nid = id + GRID; const bool more = nid < nq;
        if (more) {
#pragma unroll
            for (int s4 = 0; s4 < 4; ++s4) { d[s4] = desc(4 * nid + s4); tr_load(F, d[s4], v[s4]); } }
#pragma unroll
        for (int s4 = 0; s4 < 4; ++s4) { const TrTile& c = cur[s4]; const int nn = F.tid >> 3, kc = (F.tid & 7) * 8; const int n = c.n0 + nn;
          const int r = c.rowmode == 0 ? n : (c.rowmode == 3 ? (n < 2048 ? ((n & ~127) + 2 * (n & 63) + ((n >> 6) & 1)) : n) : ((n >> 7) * 256 + (n & 127) + (c.rowmode == 2 ? 128 : 0)));
          float o[8];
#pragma unroll
          for (int e = 0; e < 8; ++e) o[e] = tile[s4 * (64 * 65) + (kc + e) * 65 + nn];
          if (c.f8 != 0.f) { u32x2 w; w[0] = pk_fp8x4(o[0] * c.f8, o[1] * c.f8, o[2] * c.f8, o[3] * c.f8); w[1] = pk_fp8x4(o[4] * c.f8, o[5] * c.f8, o[6] * c.f8, o[7] * c.f8);
              *(u32x2*)((unsigned char*)c.dst + (size_t)r * c.ldd + c.k0 + kc) = w; }
          else store8(c.dst + (size_t)r * c.ldd + c.k0 + kc, o); }
        if (!more) break;
        id = nid;
    }
    __syncthreads();
}
DI void tr_job(const Frame& F, const float* src, int ldsrc, int K, int N, int Npad, bf16_t* dst, int ldd, int rowmode, float f8 = 0.f) {
    const int tn = Npad / 64, n = (K / 64) * tn;
    tr_run(F, n, [=](int i) { return TrTile{src, ldsrc, N, dst, ldd, rowmode, (i / tn) * 64, (i % tn) * 64, f8}; });
}
DI void moe_weights(const Frame& F0, int layer, const bool f8 = false) {
    Frame F = F0; F.tid = F.wave * 64 + lane_id(); asm volatile("" : "+v"(F.tid)); F.lane = F.tid & 63;
    const size_t esz = f8 ? 1 : 2;
    unsigned char* wgu = F.ws + OFF_WMOE; unsigned char* wd = wgu + (size_t)16 * 2048 * 1024 * esz;
    const size_t lo_ = (size_t)layer * 16 * 1024 * 1024;
    const float* g = F.in[24] + lo_; const float* u = F.in[25] + lo_; const float* dn = F.in[26] + lo_;
    const float sgu = f8 ? F8_SW : 0.f, sdn = f8 ? F8_SD : 0.f;
    tr_run(F, 16 * 256, [=](int id) { const int e = id >> 8, tl = id & 255; return TrTile{g + (size_t)e * 1024 * 1024, 1024, 1024, (bf16_t*)(wgu + (size_t)e * 2048 * 1024 * esz), 1024, 1, (tl >> 4) * 64, (tl & 15) * 64, sgu}; });
    tr_run(F, 16 * 256, [=](int id) { const int e = id >> 8, tl = id & 255; return TrTile{u + (size_t)e * 1024 * 1024, 1024, 1024, (bf16_t*)(wgu + (size_t)e * 2048 * 1024 * esz), 1024, 2, (tl >> 4) * 64, (tl & 15) * 64, sgu}; });
    tr_run(F, 16 * 256, [=](int id) { const int e = id >> 8, tl = id & 255; return TrTile{dn + (size_t)e * 1024 * 1024, 1024, 1024, (bf16_t*)(wd + (size_t)e * 1024 * 1024 * esz), 1024, 0, (tl >> 4) * 64, (tl & 15) * 64, sdn}; });
}

DI void ln1_router_phase(const Frame& F0, const float* xin  , const bf16_t* mix, bf16_t* xb, const float* lng, const float* lnb, int layer, unsigned char* xb8 = nullptr  ) {
    Frame F = F0; F.tid = F.wave * 64 + lane_id(); asm volatile("" : "+v"(F.tid)); F.lane = F.tid & 63;
    LAS float* tile = (LAS float*)F.lds;
    LAS float* part = (LAS float*)(F.lds + 16 * 1028 * 4);
    LAS float* lgt = part + 8 * 256;
    LAS float* scr = lgt + 256;
    LAS int* hist = (LAS int*)(scr + 256);
    const float* rw = F.in[22]; const float* rb = F.in[23];
    const int lane = F.lane, w = F.wave, fr = lane & 15, fq = lane >> 4;
    if (F.tid < 16) hist[F.tid] = 0;
    float bfrag[32];
#pragma unroll
    for (int s = 0; s < 32; ++s) bfrag[s] = rw[(size_t)(128 * w + 4 * s + fq) * 16 + fr];
    f32x4 gv[4], bv[4];
#pragma unroll
    for (int j = 0; j < 4; ++j) { gv[j] = *(const f32x4*)(lng + j * 256 + lane * 4); bv[j] = *(const f32x4*)(lnb + j * 256 + lane * 4); }
    int* tok_e = (int*)(F.ws + SM_TOKE); float* tok_w = (float*)(F.ws + SM_TOKW);
    const int t0 = F.wg * 256;
    f32x4 xv[2][4]; u32x2 mv[2][4];
    auto issue_rows = [&](int grp) {
#pragma unroll
        for (int rr = 0; rr < 2; ++rr) { const size_t t = (size_t)t0 + grp * 16 + 2 * w + rr;
#pragma unroll
            for (int j = 0; j < 4; ++j) {
                if (xin) xv[rr][j] = *(const f32x4*)(xin + t * D + j * 256 + lane * 4);
                else { const u32x2 xr = *(const u32x2*)(xb + t * D + j * 256 + lane * 4); xv[rr][j] = (f32x4){__uint_as_float(xr[0] << 16), __uint_as_float(xr[0] & 0xffff0000u), __uint_as_float(xr[1] << 16), __uint_as_float(xr[1] & 0xffff0000u)}; }
                if (mix) mv[rr][j] = *(const u32x2*)(mix + t * D + j * 256 + lane * 4); } }
    };
    issue_rows(0);
    for (int grp = 0; grp < 16; ++grp) {
        __syncthreads();
#pragma unroll
        for (int rr = 0; rr < 2; ++rr) {
            const int i = 2 * w + rr; const size_t t = (size_t)t0 + grp * 16 + i;
            f32x4 y[4]; float s = 0.f;
#pragma unroll
            for (int j = 0; j < 4; ++j) { y[j] = xv[rr][j] * ALPHA;
                if (mix) { const u32x2 m2 = mv[rr][j]; y[j] += (f32x4){__uint_as_float(m2[0] << 16), __uint_as_float(m2[0] & 0xffff0000u), __uint_as_float(m2[1] << 16), __uint_as_float(m2[1] & 0xffff0000u)}; }
                s += y[j][0] + y[j][1] + y[j][2] + y[j][3]; }
            const float mean = wave_sum(s) * (1.0f / D); float q = 0.f;
#pragma unroll
            for (int j = 0; j < 4; ++j) { y[j] -= mean; q += y[j][0] * y[j][0] + y[j][1] * y[j][1] + y[j][2] * y[j][2] + y[j][3] * y[j][3]; }
            const float rstd = rsqrtf(wave_sum(q) * (1.0f / D) + LN_EPS);
#pragma unroll
            for (int j = 0; j < 4; ++j) { f32x4 o = y[j] * rstd * gv[j] + bv[j];
                { u32x2 ob; ob[0] = pack2(o[0], o[1]); ob[1] = pack2(o[2], o[3]); *(u32x2*)(xb + t * D + j * 256 + lane * 4) = ob; }
                if (xb8) *(unsigned*)(xb8 + t * D + j * 256 + lane * 4) = pk_fp8x4(o[0] * F8_SX, o[1] * F8_SX, o[2] * F8_SX, o[3] * F8_SX);
                *(LAS f32x4*)(tile + i * 1028 + j * 256 + lane * 4) = o; }
        }
        if (grp + 1 < 16) issue_rows(grp + 1);
        __syncthreads();
        f32x4 acc = (f32x4){0.f, 0.f, 0.f, 0.f};
#pragma unroll
        for (int s = 0; s < 32; ++s) { const float a = tile[fr * 1028 + 128 * w + 4 * s + fq]; acc = __builtin_amdgcn_mfma_f32_16x16x4f32(a, bfrag[s], acc, 0, 0, 0); }
#pragma unroll
        for (int r = 0; r < 4; ++r) part[w * 256 + (4 * fq + r) * 16 + fr] = acc[r];
        __syncthreads();
        if (F.tid < 256) { float s = 0.f;
#pragma unroll
            for (int ww = 0; ww < 8; ++ww) s += part[ww * 256 + F.tid];
            const float aff = sigmoidf_(s); lgt[F.tid] = aff; scr[F.tid] = aff + rb[F.tid & 15]; }
        __syncthreads();
        if (F.tid < 16) {
            const int i = F.tid; const LAS float* sc = scr + i * 16; const LAS float* af = lgt + i * 16;
            int bg = 0; float bs = -1e30f;
#pragma unroll
            for (int gr = 0; gr < 4; ++gr) { const float a = sc[4 * gr], b = sc[4 * gr + 1], c = sc[4 * gr + 2], d = sc[4 * gr + 3];
                const float x = fmaxf(a, b), yv = fminf(a, b), z = fmaxf(c, d), u = fminf(c, d);
                const float top2 = fmaxf(x, z) + fmaxf(fminf(x, z), fmaxf(yv, u));
                if (top2 > bs) { bs = top2; bg = gr; } }
            const float v0 = sc[4 * bg], v1 = sc[4 * bg + 1], v2 = sc[4 * bg + 2], v3 = sc[4 * bg + 3];
            int l0 = 0; float m0 = v0; if (v1 > m0) { m0 = v1; l0 = 1; } if (v2 > m0) { m0 = v2; l0 = 2; } if (v3 > m0) { m0 = v3; l0 = 3; }
            int l1 = -1; float m1 = -1e30f;
            if (l0 != 0 && v0 > m1) { m1 = v0; l1 = 0; } if (l0 != 1 && v1 > m1) { m1 = v1; l1 = 1; } if (l0 != 2 && v2 > m1) { m1 = v2; l1 = 2; } if (l0 != 3 && v3 > m1) { m1 = v3; l1 = 3; }
            const int e0 = 4 * bg + l0, e1 = 4 * bg + l1; const float a0 = af[e0], a1 = af[e1], inv = rcpf_(a0 + a1);
            const size_t t = (size_t)t0 + grp * 16 + i;
            tok_e[2 * t] = e0; tok_e[2 * t + 1] = e1; tok_w[2 * t] = a0 * inv; tok_w[2 * t + 1] = a1 * inv;
            lds_add(&hist[e0], 1); lds_add(&hist[e1], 1);
        }
    }
    __syncthreads();
    if (F.tid < 16) ((int*)(F.ws + CTL_BLKCNT))[(layer * 256 + F.wg) * 16 + F.tid] = hist[F.tid];
    __syncthreads();
}

DI void moe_scatter_phase(const Frame& F0, const float* xa, int layer) {
    Frame F = F0; F.tid = F.wave * 64 + lane_id(); asm volatile("" : "+v"(F.tid)); F.lane = F.tid & 63;
    LAS int* tot = (LAS int*)F.lds; LAS int* before = tot + 16; LAS int* base = tot + 32; LAS int* lcnt = tot + 48;
    const int* blk = (const int*)(F.ws + CTL_BLKCNT) + layer * 256 * 16;
    __syncthreads();
    if (F.tid < 16) { int tt = 0, bb = 0; for (int g = 0; g < 256; ++g) { const int c = blk[g * 16 + F.tid]; tt += c; bb += (g < F.wg) ? c : 0; } tot[F.tid] = tt; before[F.tid] = bb; lcnt[F.tid] = 0; }
    __syncthreads();
    if (F.tid == 0) { int ts = 0; int* gts = (int*)(F.ws + CTL_TILES) + layer * 32;
        for (int e = 0; e < 16; ++e) { base[e] = ts * 256 + before[e]; if (F.wg == 0) gts[e] = ts; ts += (tot[e] + 255) >> 8; }
        if (F.wg == 0) gts[16] = ts; }
    __syncthreads();
    const int* tok_e = (const int*)(F.ws + SM_TOKE); int* tok_p = (int*)(F.ws + SM_TOKP); int* rowtok = (int*)(F.ws + SM_ROWTOK);
    const int t0 = F.wg * 256;
    { const int i = F.tid; const int e = tok_e[2 * t0 + i]; const int pos = base[e] + lds_add(&lcnt[e], 1); tok_p[2 * t0 + i] = pos; rowtok[pos] = t0 + (i >> 1); }
    if (F.wg == 0) {
        for (int e = 0; e < 16; ++e) { const int rs = base[e] - before[e], lo = rs + tot[e], hi = rs + (((tot[e] + 255) >> 8) << 8);
            for (int i = lo + F.tid; i < hi; i += NTH) rowtok[i] = 0; }
    }
    __syncthreads();
}

DI void ln2_phase(const Frame& F0, float* xout  , const float* lng, const float* lnb, bf16_t* xb, bool use_ffn, unsigned char* xb8 = nullptr  ) {
    Frame F = F0; F.tid = F.wave * 64 + lane_id(); asm volatile("" : "+v"(F.tid)); F.lane = F.tid & 63;
    const int lane = F.lane; const bf16_t* Y = (const bf16_t*)(F.ws + OFF_XS);
    const int* tok_p = (const int*)(F.ws + SM_TOKP); const float* tok_w = (const float*)(F.ws + SM_TOKW);
    f32x4 gv[4], bv[4];
#pragma unroll
    for (int j = 0; j < 4; ++j) { gv[j] = *(const f32x4*)(lng + j * 256 + lane * 4); bv[j] = *(const f32x4*)(lnb + j * 256 + lane * 4); }
    for (int r = F.wave; r < 256; r += 16) {
        size_t t[2]; int p0[2], p1[2]; float w0[2], w1[2]; f32x4 xv[2][4]; u32x2 ya[2][4], yb[2][4];
#pragma unroll
        for (int k = 0; k < 2; ++k) { t[k] = (size_t)F.wg * 256 + r + 8 * k; p0[k] = tok_p[2 * t[k]]; p1[k] = tok_p[2 * t[k] + 1]; w0[k] = tok_w[2 * t[k]]; w1[k] = tok_w[2 * t[k] + 1]; }
#pragma unroll
        for (int k = 0; k < 2; ++k)
#pragma unroll
            for (int j = 0; j < 4; ++j) { const u32x2 xr = *(const u32x2*)(xb + t[k] * D + j * 256 + lane * 4); xv[k][j] = (f32x4){__uint_as_float(xr[0] << 16), __uint_as_float(xr[0] & 0xffff0000u), __uint_as_float(xr[1] << 16), __uint_as_float(xr[1] & 0xffff0000u)}; }
        if (use_ffn) {
#pragma unroll
            for (int k = 0; k < 2; ++k)
#pragma unroll
                for (int j = 0; j < 4; ++j) { ya[k][j] = *(const u32x2*)(Y + (size_t)p0[k] * D + j * 256 + lane * 4); yb[k][j] = *(const u32x2*)(Y + (size_t)p1[k] * D + j * 256 + lane * 4); }
        }
#pragma unroll
        for (int k = 0; k < 2; ++k) {
            f32x4 y[4]; float s = 0.f;
#pragma unroll
            for (int j = 0; j < 4; ++j) { y[j] = xv[k][j] * ALPHA;
                if (use_ffn) { const u32x2 a = ya[k][j], b = yb[k][j];
                    y[j][0] += w0[k] * __uint_as_float(a[0] << 16) + w1[k] * __uint_as_float(b[0] << 16);
                    y[j][1] += w0[k] * __uint_as_float(a[0] & 0xffff0000u) + w1[k] * __uint_as_float(b[0] & 0xffff0000u);
                    y[j][2] += w0[k] * __uint_as_float(a[1] << 16) + w1[k] * __uint_as_float(b[1] << 16);
                    y[j][3] += w0[k] * __uint_as_float(a[1] & 0xffff0000u) + w1[k] * __uint_as_float(b[1] & 0xffff0000u); }
                s += y[j][0] + y[j][1] + y[j][2] + y[j][3]; }
            const float mean = wave_sum(s) * (1.0f / D); float q = 0.f;
#pragma unroll
            for (int j = 0; j < 4; ++j) { y[j] -= mean; q += y[j][0] * y[j][0] + y[j][1] * y[j][1] + y[j][2] * y[j][2] + y[j][3] * y[j][3]; }
            const float rstd = rsqrtf(wave_sum(q) * (1.0f / D) + LN_EPS);
#pragma unroll
            for (int j = 0; j < 4; ++j) { f32x4 o = y[j] * rstd * gv[j] + bv[j];
                if (xout) *(f32x4*)(xout + t[k] * D + j * 256 + lane * 4) = o;
                else { u32x2 ob; ob[0] = pack2(o[0], o[1]); ob[1] = pack2(o[2], o[3]); *(u32x2*)(xb + t[k] * D + j * 256 + lane * 4) = ob;
                    if (xb8) *(unsigned*)(xb8 + t[k] * D + j * 256 + lane * 4) = pk_fp8x4(o[0] * F8_SX, o[1] * F8_SX, o[2] * F8_SX, o[3] * F8_SX); } }
        }
    }
}

typedef short s16x4 __attribute__((ext_vector_type(4)));
#define MFMA16(a, b, c) __builtin_amdgcn_mfma_f32_16x16x32_bf16((a), (b), (c), 0, 0, 0)
DI bf16x8 ld_row(const LAS bf16_t* p) { return *(const LAS bf16x8*)p; }
DI bf16x8 ld_tr2(const LAS bf16_t* pa, const LAS bf16_t* pb) {
    const s16x4 lo = __builtin_amdgcn_ds_read_tr16_b64_v4i16((LAS s16x4*)pa), hi = __builtin_amdgcn_ds_read_tr16_b64_v4i16((LAS s16x4*)pb);
    return __builtin_shufflevector(lo, hi, 0, 1, 2, 3, 4, 5, 6, 7);
}

constexpr int R_LDK = 136, R_LDV = 264;
template <int NCOLS> DI void ret_copy(const Frame& F, const bf16_t* src, size_t gld, LAS bf16_t* dst, int lld) {
    constexpr int cpr = NCOLS >> 3, n = 128 * cpr;
    u32x4 v[n / NTH];
#pragma unroll
    for (int i = 0; i < n / NTH; ++i) { const int id = F.tid + i * NTH, r = id / cpr, ch = id % cpr; v[i] = *(const u32x4*)(src + (size_t)r * gld + ch * 8); }
#pragma unroll
    for (int i = 0; i < n / NTH; ++i) { const int id = F.tid + i * NTH, r = id / cpr, ch = id % cpr; *(LAS u32x4*)(dst + r * lld + ch * 8) = v[i]; }
}
template <int NCOLS> DI void blk_fetch(const Frame& F, const bf16_t* src, int gld, u32x4 (&v)[128 * (NCOLS >> 3) / NTH]) {
    constexpr int cpr = NCOLS >> 3;
    int t_ = F.tid; asm volatile("" : "+v"(t_));
#pragma unroll
    for (int i = 0; i < 128 * cpr / NTH; ++i) { const int id = t_ + i * NTH, r = id / cpr, ch = id % cpr; v[i] = *(const u32x4*)((const char*)src + (unsigned)(r * gld + ch * 8) * 2u); }
}
template <int NCOLS> DI void blk_put(const Frame& F, const u32x4 (&v)[128 * (NCOLS >> 3) / NTH], LAS bf16_t* dst, int lld) {
    constexpr int cpr = NCOLS >> 3;
    int t_ = F.tid; asm volatile("" : "+v"(t_));
#pragma unroll
    for (int i = 0; i < 128 * cpr / NTH; ++i) { const int id = t_ + i * NTH, r = id / cpr, ch = id % cpr; *(LAS u32x4*)(dst + r * lld + ch * 8) = v[i]; }
}
template <int NCOLS> DI void blk_fetch8(const Frame& F, const unsigned char* src, int gld, u32x4 (&v)[128 * (NCOLS >> 4) / NTH]) {
    constexpr int cpr = NCOLS >> 4;
    int t_ = F.tid; asm volatile("" : "+v"(t_));
#pragma unroll
    for (int i = 0; i < 128 * cpr / NTH; ++i) { const int id = t_ + i * NTH, r = id / cpr, ch = id % cpr; v[i] = *(const u32x4*)(src + (unsigned)(r * gld + ch * 16)); }
}
DI u32x2 fp8x4_bf16(unsigned d) { const auto a = __builtin_amdgcn_cvt_pk_f32_fp8((int)d, false), b = __builtin_amdgcn_cvt_pk_f32_fp8((int)d, true); u32x2 o; o[0] = pack2(a[0], a[1]); o[1] = pack2(b[0], b[1]); return o; }
template <int NCOLS> DI void blk_put8(const Frame& F, const u32x4 (&v)[128 * (NCOLS >> 4) / NTH], LAS bf16_t* dst, int lld) {
    constexpr int cpr = NCOLS >> 4;
    int t_ = F.tid; asm volatile("" : "+v"(t_));
#pragma unroll
    for (int i = 0; i < 128 * cpr / NTH; ++i) { const int id = t_ + i * NTH, r = id / cpr, ch = id % cpr; u32x4 lo, hi;
        const u32x2 c0 = fp8x4_bf16(v[i][0]), c1 = fp8x4_bf16(v[i][1]), c2 = fp8x4_bf16(v[i][2]), c3 = fp8x4_bf16(v[i][3]);
        lo = (u32x4){c0[0], c0[1], c1[0], c1[1]}; hi = (u32x4){c2[0], c2[1], c3[0], c3[1]};
        *(LAS u32x4*)(dst + r * lld + ch * 16) = lo; *(LAS u32x4*)(dst + r * lld + ch * 16 + 8) = hi; }
}
DI void ret_r1_unit(const Frame& F0, const bf16_t* Pg, bf16_t* KV, int unit) {
    Frame F = F0; F.tid = F.wave * 64 + lane_id(); asm volatile("" : "+v"(F.tid)); F.lane = F.tid & 63;
    const int c = unit & 63, h = (unit >> 6) & 7, bl = unit >> 9;
    LAS bf16_t* Kd = (LAS bf16_t*)F.lds; LAS bf16_t* Vs = Kd + 128 * R_LDK;
    const size_t row0 = (size_t)bl * 8192 + c * 128;
    const float l2g = log2f(1.0f - exp2f(-5.0f - (float)h));
    __syncthreads();
    { u32x4 kv_[4]; blk_fetch<128>(F, Pg + row0 * PGLD + 1024 + h * 128, PGLD, kv_);
#pragma unroll
      for (int i = 0; i < 4; ++i) { const int r_ = (F.tid + i * NTH) >> 4; const float sc = 0.08838834764831845f * __builtin_amdgcn_exp2f((float)(127 - r_) * l2g); float t8[8]; unpack8(kv_[i], t8);
#pragma unroll
          for (int e = 0; e < 8; ++e) t8[e] *= sc;
          kv_[i] = pack8(t8); }
      blk_put<128>(F, kv_, Kd, R_LDK); }
    if (PGV8) { u32x4 vv_[4]; blk_fetch8<256>(F, (const unsigned char*)Pg + row0 * 8192 + 4096 + h * 256, 8192, vv_); blk_put8<256>(F, vv_, Vs, R_LDV); }
    else ret_copy<256>(F, Pg + row0 * 6144 + 2048 + h * 256, 6144, Vs, R_LDV);
    __syncthreads();
    int w = F.wave; asm volatile("" : "+s"(w));
    const int lane = F.lane, fq = lane >> 4, q = (lane & 15) >> 2, pp = lane & 3;
    f32x4 acc[16];
#pragma unroll
    for (int i = 0; i < 16; ++i) acc[i] = (f32x4){0.f, 0.f, 0.f, 0.f};
#pragma unroll
    for (int ks = 0; ks < 4; ++ks) {
        const int ra = 32 * ks + 8 * fq + q, rb = ra + 4;
        const bf16x8 X = ld_tr2(Kd + ra * R_LDK + 16 * w + 4 * pp, Kd + rb * R_LDK + 16 * w + 4 * pp);
#pragma unroll
        for (int vt = 0; vt < 16; ++vt) { const bf16x8 Y = ld_tr2(Vs + ra * R_LDV + 16 * vt + 4 * pp, Vs + rb * R_LDV + 16 * vt + 4 * pp); acc[vt] = MFMA16(Y, X, acc[vt]); }
    }
    bf16_t* o = KV + (size_t)unit * 32768 + (16 * w + (lane & 15)) * 256 + 4 * fq;
#pragma unroll
    for (int vt = 0; vt < 16; ++vt) { u32x2 ov; ov[0] = pack2(acc[vt][0], acc[vt][1]); ov[1] = pack2(acc[vt][2], acc[vt][3]); *(u32x2*)(o + 16 * vt) = ov; }
}
DI void ret_r2_phase(const Frame& F0, bf16_t* KV) {
    Frame F = F0; F.tid = F.wave * 64 + lane_id(); asm volatile("" : "+v"(F.tid)); F.lane = F.tid & 63;
    const int gt = F.wg * NTH + F.tid;
    if (gt >= 65536) return;
    const int pair = gt >> 12, e8 = gt & 4095, h = pair & 7;
    const float cd = exp2f(128.0f * log2f(1.0f - exp2f(-5.0f - (float)h)));
    float st[8];
#pragma unroll
    for (int i = 0; i < 8; ++i) st[i] = 0.f;
#pragma unroll 8
    for (int c = 0; c < 64; ++c) {
        bf16_t* p = KV + ((size_t)(pair * 64 + c)) * 32768 + (size_t)e8 * 8;
        float kv[8]; unpack8(*(const u32x4*)p, kv);
        *(u32x4*)p = pack8(st);
#pragma unroll
        for (int i = 0; i < 8; ++i) st[i] = st[i] * cd + kv[i];
    }
}
DI void ret_r3_phase(const Frame& F0, const bf16_t* Pg, const bf16_t* RS, bf16_t* O1, int gq, const float* gn) {
    Frame F = F0; F.tid = F.wave * 64 + lane_id(); asm volatile("" : "+v"(F.tid)); F.lane = F.tid & 63;
    LAS bf16_t* Qs = (LAS bf16_t*)F.lds; LAS bf16_t* Ks = Qs + 128 * R_LDK; LAS bf16_t* Vh = Ks + 128 * R_LDK; LAS bf16_t* Rh = Vh + 128 * R_LDK;
    int w = F.wave; asm volatile("" : "+s"(w));
    u32x4 RQ[4], RK[4];
    { const int u0 = F.wg; const size_t r0 = (size_t)(u0 >> 9) * 8192 + (u0 & 63) * 128; const int h0 = (u0 >> 6) & 7;
      blk_fetch<128>(F, Pg + r0 * PGLD + h0 * 128, PGLD, RQ); blk_fetch<128>(F, Pg + r0 * PGLD + 1024 + h0 * 128, PGLD, RK); }
#pragma unroll 1
    for (int unit = F.wg; unit < 1024; unit += GRID) {
        const int c = unit & 63, h = (unit >> 6) & 7, bl = unit >> 9;
        const size_t row0 = (size_t)bl * 8192 + c * 128;
        const float l2g = log2f(1.0f - exp2f(-5.0f - (float)h));
        const bf16_t* rsu = RS + (size_t)unit * 32768;
        int lane = F.lane; asm volatile("" : "+v"(lane));
        const int fr = lane & 15, fq = lane >> 4, q = fr >> 2, pp = lane & 3;
        __syncthreads();
        blk_put<128>(F, RQ, Qs, R_LDK); blk_put<128>(F, RK, Ks, R_LDK);
        static_assert(PGV8, "the chunk-output phase reads v and g as e4m3");
        u32x4 RV[2], RR[4];
        const unsigned char* Pg8 = (const unsigned char*)Pg + row0 * 8192 + 4096 + h * 256;
        blk_fetch8<128>(F, Pg8, 8192, RV);
        blk_fetch<128>(F, rsu, 256, RR);
        __syncthreads();
        f32x4 sacc[8];
#pragma unroll
        for (int jt = 0; jt < 8; ++jt) sacc[jt] = (f32x4){0.f, 0.f, 0.f, 0.f};
#pragma unroll
        for (int ks = 0; ks < 4; ++ks) {
            const bf16x8 Yq = ld_row(Qs + (16 * w + fr) * R_LDK + 32 * ks + 8 * fq);
#pragma unroll
            for (int jt = 0; jt < 8; ++jt) { const bf16x8 Xk = ld_row(Ks + (16 * jt + fr) * R_LDK + 32 * ks + 8 * fq); sacc[jt] = MFMA16(Xk, Yq, sacc[jt]); }
        }
        __syncthreads();
        { const int i = 16 * w + fr;
#pragma unroll
          for (int jt = 0; jt < 8; ++jt) { float pv[4];
#pragma unroll
              for (int r = 0; r < 4; ++r) { const int j = 16 * jt + 4 * fq + r; pv[r] = (i >= j) ? sacc[jt][r] * (0.08838834764831845f * __builtin_amdgcn_exp2f((float)(i - j) * l2g)) : 0.f; }
              u32x2 o; o[0] = pack2(pv[0], pv[1]); o[1] = pack2(pv[2], pv[3]);
              *(LAS u32x2*)(Ks + i * R_LDK + 16 * jt + 4 * fq) = o; } }
        f32x4 acc[16];
#pragma unroll
        for (int i = 0; i < 16; ++i) acc[i] = (f32x4){0.f, 0.f, 0.f, 0.f};
        const float qdec = exp2f((float)(16 * w + fr + 1) * l2g);
        u32x4 RG[4];
#pragma unroll
        for (int half = 0; half < 2; ++half) {
            if (half) __syncthreads();
            blk_put8<128>(F, RV, Vh, R_LDK);
            blk_put<128>(F, RR, Rh, R_LDK);
            if (half == 0) { blk_fetch8<128>(F, Pg8 + 128, 8192, RV);
                blk_fetch<128>(F, rsu + 128, 256, RR); }
            else blk_fetch8<256>(F, Pg8 + 2048, 8192, RG);
            __syncthreads();
#pragma unroll
            for (int ks = 0; ks < 4; ++ks) {
                const bf16x8 Yq = ld_row(Qs + (16 * w + fr) * R_LDK + 32 * ks + 8 * fq);
                const int ra = 32 * ks + 8 * fq + q, rb = ra + 4;
#pragma unroll
                for (int vt = 0; vt < 8; ++vt) { const bf16x8 Xr = ld_tr2(Rh + ra * R_LDK + 16 * vt + 4 * pp, Rh + rb * R_LDK + 16 * vt + 4 * pp); acc[half * 8 + vt] = MFMA16(Xr, Yq, acc[half * 8 + vt]); }
            }
#pragma unroll
            for (int vt = 0; vt < 8; ++vt) acc[half * 8 + vt] *= qdec;
#pragma unroll
            for (int ks = 0; ks < 4; ++ks) {
                const bf16x8 Yp = ld_row(Ks + (16 * w + fr) * R_LDK + 32 * ks + 8 * fq);
                const int ra = 32 * ks + 8 * fq + q, rb = ra + 4;
#pragma unroll
                for (int vt = 0; vt < 8; ++vt) { const bf16x8 Xv = ld_tr2(Vh + ra * R_LDK + 16 * vt + 4 * pp, Vh + rb * R_LDK + 16 * vt + 4 * pp); acc[half * 8 + vt] = MFMA16(Xv, Yp, acc[half * 8 + vt]); }
            }
        }
        __syncthreads();
        LAS bf16_t* Gs = Vh;
        LAS float* gnl = (LAS float*)(Qs);
        blk_put8<256>(F, RG, Gs, R_LDV);
        if (F.tid < 256) { gnl[F.tid] = gn[h * 256 + F.tid]; gnl[256 + F.tid] = gn[2048 + h * 256 + F.tid]; }
        { const int un = unit + GRID; if (un < 1024) { const size_t rn = (size_t)(un >> 9) * 8192 + (un & 63) * 128; const int hn = (un >> 6) & 7;
            blk_fetch<128>(F, Pg + rn * PGLD + hn * 128, PGLD, RQ); blk_fetch<128>(F, Pg + rn * PGLD + 1024 + hn * 128, PGLD, RK); } }
        float s = 0.f;
#pragma unroll
        for (int vt = 0; vt < 16; ++vt) s += acc[vt][0] + acc[vt][1] + acc[vt][2] + acc[vt][3];
        s += shx(s, 16); s += shx(s, 32);
        const float mean = s * (1.0f / 256.0f); float qq = 0.f;
#pragma unroll
        for (int vt = 0; vt < 16; ++vt)
#pragma unroll
            for (int r = 0; r < 4; ++r) { const float d = acc[vt][r] - mean; qq += d * d; }
        qq += shx(qq, 16); qq += shx(qq, 32);
        const float rstd = rsqrtf(qq * (1.0f / 256.0f) + (PGV8 ? 1e-5f * F8_SX * F8_SX : 1e-5f));
        __syncthreads();
        const size_t trow = row0 + 16 * w + fr;
        bf16_t* op = O1 + ((size_t)gq * 16384 + trow) * 2048 + h * 256;
#pragma unroll
        for (int vt = 0; vt < 16; ++vt) {
            const int v0 = 16 * vt + 4 * fq;
            if ((vt & 3) == 0) asm volatile("" ::: "memory");
            const u32x2 gr = *(const LAS u32x2*)(Gs + (16 * w + fr) * R_LDV + v0);
            const f32x4 gg = *(const LAS f32x4*)(gnl + v0), gb = *(const LAS f32x4*)(gnl + 256 + v0);
            float gv[4] = {__uint_as_float(gr[0] << 16), __uint_as_float(gr[0] & 0xffff0000u), __uint_as_float(gr[1] << 16), __uint_as_float(gr[1] & 0xffff0000u)};
            if (PGV8) {
#pragma unroll
                for (int r = 0; r < 4; ++r) gv[r] *= (1.0f / F8_SX); }
            float o[4];
#pragma unroll
            for (int r = 0; r < 4; ++r) { const float nv = (acc[vt][r] - mean) * rstd * gg[r] + gb[r]; o[r] = siluf_(gv[r]) * nv; }
            if (RTO8) *(unsigned*)((unsigned char*)O1 + ((size_t)gq * 16384 + trow) * 2048 + h * 256 + v0) = pk_fp8x4(o[0] * F8_SO, o[1] * F8_SO, o[2] * F8_SO, o[3] * F8_SO);
            else { u32x2 ov; ov[0] = pack2(o[0], o[1]); ov[1] = pack2(o[2], o[3]);
            *(u32x2*)(op + v0) = ov; }
        }
    }
}

DI bf16_t* st_w(const Frame& F) { return (bf16_t*)(F.ws + OFF_STR); }
DI bf16_t* st_kk(const Frame& F) { return (bf16_t*)(F.ws + OFF_STR) + (size_t)T * 512; }
DI bf16_t* st_b(const Frame& F) { return (bf16_t*)F.out; }
DI bf16_t* st_kp(const Frame& F) { return (bf16_t*)F.out + (size_t)T * 512; }
DI bf16_t* st_r(const Frame& F) { return (bf16_t*)F.out + (size_t)T * 1024; }
DI bf16_t* st_v(const Frame& F) { return (bf16_t*)F.out + (size_t)T * 1536; }

DI void rwkv_e1_phase(const Frame& F0) {
    Frame F = F0; F.tid = F.wave * 64 + lane_id(); asm volatile("" : "+v"(F.tid)); F.lane = F.tid & 63;
    const bf16_t* PR = (const bf16_t*)(F.ws + OFF_PR); const float* mu = F.in[3]; const float* kkw = F.in[12];
    const int c = F.lane * 8;
    float m0[8], m1[8], m2[8], kw[8];
#pragma unroll
    for (int i = 0; i < 8; ++i) { m0[i] = mu[c + i]; m1[i] = mu[512 + c + i]; m2[i] = mu[1024 + c + i]; kw[i] = kkw[c + i]; }
    float* rn = (float*)(F.ws + SM_RNORM);
    for (int r = F.wave; r < 256; r += 16) {
        u32x4 ld[2][6]; size_t t[2];
#pragma unroll
        for (int k = 0; k < 2; ++k) { t[k] = (size_t)F.wg * 256 + r + 8 * k; const size_t row = t[k] + (t[k] >> 13) + 1;
            const bf16_t* cur = PR + row * 2048 + c; const bf16_t* prv = cur - 2048;
            ld[k][0] = *(const u32x4*)cur; ld[k][1] = *(const u32x4*)prv; ld[k][2] = *(const u32x4*)(cur + 512); ld[k][3] = *(const u32x4*)(prv + 512); ld[k][4] = *(const u32x4*)(cur + 1024); ld[k][5] = *(const u32x4*)(prv + 1024); }
#pragma unroll
        for (int k = 0; k < 2; ++k) {
            float a[8], p[8], o[8];
            unpack8(ld[k][0], a); unpack8(ld[k][1], p);
#pragma unroll
            for (int i = 0; i < 8; ++i) o[i] = a[i] + (p[i] - a[i]) * m0[i];
            *(u32x4*)(st_r(F) + t[k] * 512 + c) = pack8(o);
            unpack8(ld[k][2], a); unpack8(ld[k][3], p);
            float ss = 0.f;
#pragma unroll
            for (int i = 0; i < 8; ++i) { o[i] = a[i] + (p[i] - a[i]) * m1[i]; const float q = o[i] * kw[i]; ss += q * q; }
            *(u32x4*)(st_kp(F) + t[k] * 512 + c) = pack8(o);
            ss += shx(ss, 1); ss += shx(ss, 2); ss += shx(ss, 4);
            if ((F.lane & 7) == 0) rn[t[k] * 8 + (F.lane >> 3)] = rcpf_(fmaxf(__builtin_amdgcn_sqrtf(ss), 1e-12f));
            unpack8(ld[k][4], a); unpack8(ld[k][5], p);
#pragma unroll
            for (int i = 0; i < 8; ++i) o[i] = a[i] + (p[i] - a[i]) * m2[i];
            *(u32x4*)(st_v(F) + t[k] * 512 + c) = pack8(o);
        }
    }
}

DI float dpp_f(float v, int ctrl_qp1, int) { return v; }
template <int CTRL> DI float dpp_mov(float v) { return __int_as_float(__builtin_amdgcn_update_dpp(0, __float_as_int(v), CTRL, 0xf, 0xf, true)); }
DI float row_sum16(float v) {
    v += dpp_mov<0xB1>(v);
    v += dpp_mov<0x4E>(v);
    v += dpp_mov<0x141>(v);
    v += dpp_mov<0x140>(v);
    return v;
}

DI float row_sum8(float v) {
    v += dpp_mov<0xB1>(v);
    v += dpp_mov<0x4E>(v);
    v += dpp_mov<0x141>(v);
    return v;
}
typedef _Float16 h2_t __attribute__((ext_vector_type(2)));
typedef _Float16 h8_t __attribute__((ext_vector_type(8)));
constexpr int SC_STEPS = 32;
constexpr int SC_BUF = SC_STEPS * (5 * 64 + 64) * 2;
constexpr int SC_WGS = 64;
constexpr int SC_OBS = 260;
struct ScOp { u32x4 a0, a1, a2, a3, a4; unsigned v0, v1; };
template <int U> DI void sc_ld(ScOp& o, unsigned pb, unsigned pv) {
    asm volatile("ds_read_b128 %0, %1 offset:%c2" : "=v"(o.a0) : "v"(pb), "i"(U * 640) : "memory");
    asm volatile("ds_read_b128 %0, %1 offset:%c2" : "=v"(o.a1) : "v"(pb), "i"(U * 640 + 128) : "memory");
    asm volatile("ds_read_b128 %0, %1 offset:%c2" : "=v"(o.a2) : "v"(pb), "i"(U * 640 + 256) : "memory");
    asm volatile("ds_read_b128 %0, %1 offset:%c2" : "=v"(o.a3) : "v"(pb), "i"(U * 640 + 384) : "memory");
    asm volatile("ds_read_b128 %0, %1 offset:%c2" : "=v"(o.a4) : "v"(pb), "i"(U * 640 + 512) : "memory");
    asm volatile("ds_read_u16 %0, %1 offset:%c2" : "=v"(o.v0) : "v"(pv), "i"(U * 128) : "memory");
    asm volatile("ds_read_u16 %0, %1 offset:%c2" : "=v"(o.v1) : "v"(pv), "i"(U * 128 + 2) : "memory");
}
DI void sc_wait(ScOp& o) { asm volatile("s_waitcnt lgkmcnt(0)" : "+v"(o.a0), "+v"(o.a1), "+v"(o.a2), "+v"(o.a3), "+v"(o.a4), "+v"(o.v0), "+v"(o.v1) :: "memory"); }
DI h2_t h2of(unsigned x) { return __builtin_bit_cast(h2_t, x); }
DI float dot2z(h2_t a, h2_t b) { float r; asm("v_dot2_f32_f16 %0, %1, %2, 0" : "=v"(r) : "v"(a), "v"(b)); return r; }
DI float sc_dot(const h2_t (&S)[4], const u32x4& x) {
    float o = dot2z(S[0], h2of(x[0])); o = __builtin_amdgcn_fdot2(S[1], h2of(x[1]), o, false); o = __builtin_amdgcn_fdot2(S[2], h2of(x[2]), o, false); return __builtin_amdgcn_fdot2(S[3], h2of(x[3]), o, false); }
DI unsigned sc_readout(const h2_t (&S)[2][4], const u32x4& rp) {
    const float o0 = sc_dot(S[0], rp), o1 = sc_dot(S[1], rp);
    return __builtin_bit_cast(unsigned, __builtin_amdgcn_cvt_pkrtz(o0, o1));
}
template <int U> DI void sc_step(h2_t (&S)[2][4], ScOp& cur, u32x4& rp, LAS unsigned* obw, unsigned pb, unsigned pv) {
    ScOp nxt; sc_ld<U + 1>(nxt, pb, pv);
    __builtin_amdgcn_sched_barrier(0);
    const float sa0 = sc_dot(S[0], cur.a1), sa1 = sc_dot(S[1], cur.a1);
    obw[U * SC_OBS] = sc_readout(S, rp);
    const _Float16 sh0 = (_Float16)(-row_sum8(sa0)), sh1 = (_Float16)(-row_sum8(sa1));
    const h2_t sav[2] = {(h2_t){sh0, sh0}, (h2_t){sh1, sh1}};
    const _Float16 vh0 = h2of(cur.v0)[0], vh1 = h2of(cur.v1)[0];
    const h2_t vv2[2] = {(h2_t){vh0, vh0}, (h2_t){vh1, vh1}};
#pragma unroll
    for (int rw = 0; rw < 2; ++rw)
#pragma unroll
        for (int i = 0; i < 4; ++i) S[rw][i] = S[rw][i] * h2of(cur.a0[i]) + (sav[rw] * h2of(cur.a2[i]) + vv2[rw] * h2of(cur.a3[i]));
    rp = cur.a4;
    __builtin_amdgcn_sched_barrier(0);
    sc_wait(nxt); cur = nxt;
}
DI void rwkv_scan(const Frame& F0, const bool do_post = true) {
    Frame F = F0; F.tid = F.wave * 64 + lane_id(); asm volatile("" : "+v"(F.tid)); F.lane = F.tid & 63;
    const int stream = F.wg, b = stream >> 3, h = stream & 7;
    const int rloc = 16 * F.wave + 2 * (F.lane >> 3), cg = F.lane & 7;
    const size_t tb = (size_t)b * SEQ;
    LAS unsigned* OBP = (LAS unsigned*)(F.lds + 2 * SC_BUF);
    const bf16_t* arrs[6] = {st_w(F), st_kk(F), st_b(F), st_kp(F), st_r(F), st_v(F)};
    u32x4 stage[3];
    const bool hiw = F.wave >= 4;
    const bf16_t* ab0 = hiw ? arrs[1] : arrs[0]; const bf16_t* ab1 = hiw ? arrs[3] : arrs[2]; const bf16_t* ab2 = hiw ? arrs[5] : arrs[4];
    const int lstep = (F.tid & 255) >> 3, lch = F.tid & 7;
    const size_t loff = (tb + (size_t)lstep) * 512 + h * 64 + lch * 8;
    auto issue = [&](int chunk) { const size_t o = loff + (size_t)chunk * SC_STEPS * 512;
        stage[0] = *(const u32x4*)(ab0 + o); stage[1] = *(const u32x4*)(ab1 + o); stage[2] = *(const u32x4*)(ab2 + o);
    };
    auto commit = [&](int buf) {
        LAS _Float16* L = (LAS _Float16*)(F.lds + buf * SC_BUF);
#pragma unroll
        for (int i = 0; i < 3; ++i) {
            float v[8]; unpack8(stage[i], v);
            h8_t hv;
#pragma unroll
            for (int e = 0; e < 8; ++e) hv[e] = (_Float16)v[e];
            LAS _Float16* d = (i == 2 && hiw) ? (L + SC_STEPS * 320 + lstep * 64 + lch * 8) : (L + lstep * 320 + (2 * i + (hiw ? 1 : 0)) * 64 + lch * 8);
            *(LAS h8_t*)d = hv; }
    };
    const int pstep = (F.tid - 256) >> 3, pc = h * 64 + 8 * (F.tid & 7);
    float lg[8], lb[8], rk[8];
    if (F.wave >= 4) {
#pragma unroll
        for (int i = 0; i < 8; ++i) { lg[i] = F.in[15][pc + i]; lb[i] = F.in[15][512 + pc + i]; rk[i] = F.in[14][pc + i]; } }
    bf16_t* O0 = (bf16_t*)(F.ws + OFF_O0);
    auto post = [&](int chunk) {
        const size_t t = tb + (size_t)chunk * SC_STEPS + pstep;
        const LAS unsigned* ob = OBP + ((chunk & 1) * (SC_STEPS + 1) + pstep + 1) * SC_OBS + 32 * (F.tid & 7);
        float o[8];
#pragma unroll
        for (int p = 0; p < 4; ++p) { float s0 = 0.f, s1 = 0.f;
#pragma unroll
            for (int hf = 0; hf < 2; ++hf) { const u32x4 q = *(const LAS u32x4*)(ob + p * 8 + hf * 4);
#pragma unroll
                for (int e = 0; e < 4; ++e) { const h2_t hv = h2of(q[e]); s0 += (float)hv[0]; s1 += (float)hv[1]; } }
            o[2 * p] = s0; o[2 * p + 1] = s1; }
        float rr[8], kp[8], vv[8], gg[8];
        unpack8(*(const u32x4*)(st_r(F) + t * 512 + pc), rr); unpack8(*(const u32x4*)(st_kp(F) + t * 512 + pc), kp); unpack8(*(const u32x4*)(st_v(F) + t * 512 + pc), vv);
        unpack8(*(const u32x4*)(O0 + t * 1024 + pc), gg);
        float s = 0.f, bs = 0.f;
#pragma unroll
        for (int i = 0; i < 8; ++i) { s += o[i]; bs += rr[i] * kp[i] * rk[i]; }
        s += shx(s, 1); s += shx(s, 2); s += shx(s, 4);
        bs += shx(bs, 1); bs += shx(bs, 2); bs += shx(bs, 4);
        const float mean = s * (1.0f / 64.0f); float q = 0.f;
#pragma unroll
        for (int i = 0; i < 8; ++i) { const float d = o[i] - mean; q += d * d; }
        q += shx(q, 1); q += shx(q, 2); q += shx(q, 4);
        const float rstd = rsqrtf(q * (1.0f / 64.0f) + 64e-5f);
        float res[8];
#pragma unroll
        for (int i = 0; i < 8; ++i) res[i] = ((o[i] - mean) * rstd * lg[i] + lb[i] + bs * vv[i]) * gg[i];
        *(u32x4*)(O0 + t * 1024 + pc) = pack8(res);
    };
    h2_t S[2][4];
#pragma unroll
    for (int i = 0; i < 4; ++i) { S[0][i] = (h2_t){(_Float16)0.f, (_Float16)0.f}; S[1][i] = S[0][i]; }
    __syncthreads();
    issue(0); commit(0);
    __syncthreads();
    constexpr int NCH = SEQ / SC_STEPS;
    for (int chunk = 0; chunk < NCH; ++chunk) {
        if (chunk + 1 < NCH) issue(chunk + 1);
        const LAS _Float16* L = (const LAS _Float16*)(F.lds + (chunk & 1) * SC_BUF);
        if (F.wave < 4) {
            LAS unsigned* obw = OBP + (chunk & 1) * (SC_STEPS + 1) * SC_OBS + F.tid;
            unsigned pb = (unsigned)(size_t)(F.lds + (chunk & 1) * SC_BUF) + 16 * cg, pv = (unsigned)(size_t)(F.lds + (chunk & 1) * SC_BUF) + SC_STEPS * 640 + 2 * rloc;
            ScOp cur; sc_ld<0>(cur, pb, pv); sc_wait(cur);
            u32x4 rp = cur.a4;
#pragma unroll 1
            for (int g8 = 0; g8 < SC_STEPS / 8; ++g8) {
                sc_step<0>(S, cur, rp, obw, pb, pv); sc_step<1>(S, cur, rp, obw, pb, pv); sc_step<2>(S, cur, rp, obw, pb, pv); sc_step<3>(S, cur, rp, obw, pb, pv);
                sc_step<4>(S, cur, rp, obw, pb, pv); sc_step<5>(S, cur, rp, obw, pb, pv); sc_step<6>(S, cur, rp, obw, pb, pv); sc_step<7>(S, cur, rp, obw, pb, pv);
                pb += 8 * 640; pv += 8 * 128; obw += 8 * SC_OBS;
            }
            obw[0] = sc_readout(S, rp);
        } else if (chunk > 0 && do_post) post(chunk - 1);
        if (chunk + 1 < NCH) commit((chunk + 1) & 1);
        __syncthreads();
    }
    if (F.wave >= 4 && do_post) post(NCH - 1);
}

DI void nsa_rope_phase(const Frame& F0) {
    Frame F = F0; F.tid = F.wave * 64 + lane_id(); asm volatile("" : "+v"(F.tid)); F.lane = F.tid & 63;
    bf16_t* PN = (bf16_t*)(F.ws + OFF_PN); const float* tab = (const float*)(F.ws + SM_ROPEN);
    const int hh = F.lane >> 2, j0 = (F.lane & 3) * 2;
    const int col = hh < 8 ? hh * 64 : 512 + ((hh - 8) >> 1) * 256 + ((hh - 8) & 1) * 64;
    if (hh >= 14) return;
    for (int r = F.wave; r < 256; r += 8) {
        const size_t t = (size_t)F.wg * 256 + r; const int pos = (int)(t & 8191);
        bf16_t* p = PN + t * 1536 + col + j0;
        const unsigned a = *(const unsigned*)p, bq = *(const unsigned*)(p + 8);
        const f32x4 cs = *(const f32x4*)(tab + ((size_t)pos * 8 + j0) * 2);
        const float x10 = __uint_as_float(a << 16), x11 = __uint_as_float(a & 0xffff0000u), x20 = __uint_as_float(bq << 16), x21 = __uint_as_float(bq & 0xffff0000u);
        *(unsigned*)p = pack2(x10 * cs[0] - x20 * cs[1], x11 * cs[2] - x21 * cs[3]);
        *(unsigned*)(p + 8) = pack2(x20 * cs[0] + x10 * cs[1], x21 * cs[2] + x11 * cs[3]);
    }
}
namespace pg8 {
struct CmpSched {
    const char* A; const char* B; size_t slotstepA, tstepA, bstride; int G, c;
    DI bool next(int i, Unit& u) const {
        const int L = i * G + c; if (L >= 64) return false;
        const int slot = L >> 4, pm = L & 15; u.pm = pm; u.pn = 0; u.aux = slot;
        u.a = A + (size_t)slot * slotstepA + (size_t)pm * tstepA; u.b = B + (size_t)(slot >> 1) * bstride; u.rows = nullptr; return true;
    }
};
}
constexpr int NS_STG = 16384, NS_NSTG = 4;
constexpr int NS_OFF_IMP = NS_NSTG * NS_STG, NS_OFF_SEL = NS_OFF_IMP + 128 * 128 * 4, NS_OFF_U = NS_OFF_SEL + 2048;
constexpr float NS_C = 0.125f * 1.44269504088896341f;
struct FState { f32x4 o[4][4]; float m[4], l[4]; };
struct TileSrc { const bf16_t* k; const bf16_t* v; size_t rstride; };
DI void ns_dma(const Frame& F, const TileSrc& S, int j, int stage) {
    int l_ = F.lane; asm volatile("" : "+v"(l_));
    const int row = 8 * F.wave + (l_ >> 3), c = (l_ & 7) ^ (l_ >> 3);
    const unsigned off = ((unsigned)(j * 64 + row) * (unsigned)S.rstride + c * 8) * 2u;
    LAS unsigned char* base = F.lds + stage * NS_STG + F.wave * 1024;
    __builtin_amdgcn_global_load_lds((const unsigned*)((const char*)S.k + off), (LAS unsigned*)base, 16, 0, 0);
    __builtin_amdgcn_global_load_lds((const unsigned*)((const char*)S.v + off), (LAS unsigned*)(base + 8192), 16, 0, 0);
}
DI void ns_wait(int after) {
    if (after >= 2) asm volatile("s_waitcnt vmcnt(4)" ::: "memory"); else if (after == 1) asm volatile("s_waitcnt vmcnt(2)" ::: "memory"); else asm volatile("s_waitcnt vmcnt(0)" ::: "memory");
    __builtin_amdgcn_s_barrier(); asm volatile("" ::: "memory");
}
DI float fexp2(float x) { return __builtin_amdgcn_exp2f(x); }
DI unsigned cvtpk(float lo, float hi) { return pack2(lo, hi); }
constexpr float NS_NINF = -__builtin_inff();
DI float vmax(float a, float b) { return __builtin_fmaxf(a, b); }
DI float vmax3(float a, float b, float c) { return __builtin_fmaxf(__builtin_fmaxf(a, b), c); }
DI float xquad_max(float v) {
    u32x2 r = __builtin_amdgcn_permlane16_swap(__float_as_uint(v), __float_as_uint(v), false, false);
    v = vmax(__uint_as_float(r[0]), __uint_as_float(r[1]));
    r = __builtin_amdgcn_permlane32_swap(__float_as_uint(v), __float_as_uint(v), false, false);
    return vmax(__uint_as_float(r[0]), __uint_as_float(r[1]));
}
template <int MM, bool PV, bool CMPHI = false, bool QL = false>
DI void ns_step(const LAS unsigned char* tb  , int kabs, const bf16x8 (&Qf)[4][2], FState& st, unsigned rtm, unsigned sb, int posl, int lod, int fr, int fq, int q, int pp, const LAS bf16_t* qb = nullptr) {
    const int lk = fr * 128 + ((fq ^ (fr & 7)) << 4);
    const int m_ = (4 * fq + q) & 7, vbl = (4 * fq + q) * 128 + ((((pp >> 1) ^ (m_ & 1))) << 4) + (pp & 1) * 8 + ((m_ >> 1) << 5);
    const LAS unsigned char* kp0 = tb + lk; const LAS unsigned char* kp1 = tb + (lk ^ 64); const LAS unsigned char* vp_ = tb + 8192 + vbl;
    asm volatile("" : "+v"(kp0), "+v"(kp1), "+v"(vp_));
    f32x4 s[2][4];
    bf16x8 X[2][2];
#pragma unroll
    for (int kt = 0; kt < 2; ++kt) { X[kt][0] = *(const LAS bf16x8*)(kp0 + kt * 2048); X[kt][1] = *(const LAS bf16x8*)(kp1 + kt * 2048); }
#pragma unroll
    for (int rt = 0; rt < 4; ++rt) if ((rtm >> rt) & 1u) {
        const bf16x8 q0 = QL ? ld_row(qb + (rt * 2 + 0) * 512) : Qf[rt][0], q1 = QL ? ld_row(qb + (rt * 2 + 1) * 512) : Qf[rt][1];
#pragma unroll
        for (int kt = 0; kt < 2; ++kt) { s[kt][rt] = MFMA16(X[kt][0], q0, ((f32x4){0.f, 0.f, 0.f, 0.f})); s[kt][rt] = MFMA16(X[kt][1], q1, s[kt][rt]); }
    }
    bf16x8 Y[4];
#pragma unroll
    for (int rt = 0; rt < 4; ++rt) {
        if ((rtm >> rt) & 1u) {
            if (MM) {
#pragma unroll
                for (int kt = 0; kt < 2; ++kt)
#pragma unroll
                    for (int r = 0; r < 4; ++r) { const int key = kabs + 16 * kt + 4 * fq + r; const int hi_ = CMPHI ? ((posl + 4 * rt - 31) >> 4) : (posl + 4 * rt);
                        const bool ok = MM == 1 ? (key <= hi_) : (key <= hi_ && key > hi_ - lod);
                        s[kt][rt][r] = ok ? s[kt][rt][r] : NS_NINF; }
            }
            const float rowneg = ((sb >> rt) & 1u) ? 0.f : NS_NINF;
            float mx = vmax3(s[0][rt][0], s[0][rt][1], s[0][rt][2]); mx = vmax3(mx, s[0][rt][3], s[1][rt][0]); mx = vmax3(mx, s[1][rt][1], s[1][rt][2]); mx = vmax(mx, s[1][rt][3]);
            mx = vmax(mx + rowneg, st.m[rt]);
            mx = xquad_max(mx);
            const float alpha = fexp2(st.m[rt] - mx); st.m[rt] = mx;
            const float c = rowneg - mx; const f32x2 c2 = (f32x2){c, c};
            f32x2 p[4];
#pragma unroll
            for (int kt = 0; kt < 2; ++kt) { const f32x2 a = (f32x2){s[kt][rt][0], s[kt][rt][1]} + c2, b = (f32x2){s[kt][rt][2], s[kt][rt][3]} + c2;
                p[2 * kt] = (f32x2){fexp2(a[0]), fexp2(a[1])}; p[2 * kt + 1] = (f32x2){fexp2(b[0]), fexp2(b[1])}; }
            const f32x2 ps2 = (p[0] + p[1]) + (p[2] + p[3]);
            st.l[rt] = st.l[rt] * alpha + (ps2[0] + ps2[1]);
            if (PV) {
                if (__ballot(alpha != 1.0f) != 0ull) {
#pragma unroll
                    for (int dt = 0; dt < 4; ++dt) st.o[dt][rt] *= alpha; }
                u32x4 w; w[0] = cvtpk(p[0][0], p[0][1]); w[1] = cvtpk(p[1][0], p[1][1]); w[2] = cvtpk(p[2][0], p[2][1]); w[3] = cvtpk(p[3][0], p[3][1]);
                Y[rt] = __builtin_bit_cast(bf16x8, w);
            }
        } else if (PV) {
            Y[rt] = (bf16x8){0, 0, 0, 0, 0, 0, 0, 0};
        }
    }
    if (PV) {
        const unsigned a0 = (unsigned)(size_t)vp_, a1 = a0 ^ 32u, a2 = a0 ^ 64u, a3 = a0 ^ 96u;
        s16x4 t0, t1, t2, t3, t4, t5, t6, t7;
        asm volatile("ds_read_b64_tr_b16 %0, %8\n\tds_read_b64_tr_b16 %1, %8 offset:2048\n\tds_read_b64_tr_b16 %2, %9\n\tds_read_b64_tr_b16 %3, %9 offset:2048\n\t"
                     "ds_read_b64_tr_b16 %4, %10\n\tds_read_b64_tr_b16 %5, %10 offset:2048\n\tds_read_b64_tr_b16 %6, %11\n\tds_read_b64_tr_b16 %7, %11 offset:2048\n\ts_waitcnt lgkmcnt(0)"
                     : "=&v"(t0), "=&v"(t1), "=&v"(t2), "=&v"(t3), "=&v"(t4), "=&v"(t5), "=&v"(t6), "=&v"(t7) : "v"(a0), "v"(a1), "v"(a2), "v"(a3) : "memory");
        const bf16x8 Xv[4] = {__builtin_shufflevector(t0, t1, 0, 1, 2, 3, 4, 5, 6, 7), __builtin_shufflevector(t2, t3, 0, 1, 2, 3, 4, 5, 6, 7), __builtin_shufflevector(t4, t5, 0, 1, 2, 3, 4, 5, 6, 7), __builtin_shufflevector(t6, t7, 0, 1, 2, 3, 4, 5, 6, 7)};
#pragma unroll
        for (int dt = 0; dt < 4; ++dt)
#pragma unroll
            for (int rt = 0; rt < 4; ++rt) st.o[dt][rt] = MFMA16(Xv[dt], Y[rt], st.o[dt][rt]);
    }
}
DI void ns_reset(FState& st) {
#pragma unroll
    for (int rt = 0; rt < 4; ++rt) { st.m[rt] = -1e30f; st.l[rt] = 0.f;
#pragma unroll
        for (int dt = 0; dt < 4; ++dt) st.o[dt][rt] = (f32x4){0.f, 0.f, 0.f, 0.f}; }
}


DI void ns_vtr8(const LAS unsigned char* vp_, bf16x8 (&Xv)[4]) {
    const unsigned a0 = (unsigned)(size_t)vp_, a1 = a0 ^ 32u, a2 = a0 ^ 64u, a3 = a0 ^ 96u;
    s16x4 t0, t1, t2, t3, t4, t5, t6, t7;
    asm volatile("ds_read_b64_tr_b16 %0, %8\n\tds_read_b64_tr_b16 %1, %8 offset:2048\n\tds_read_b64_tr_b16 %2, %9\n\tds_read_b64_tr_b16 %3, %9 offset:2048\n\t"
                 "ds_read_b64_tr_b16 %4, %10\n\tds_read_b64_tr_b16 %5, %10 offset:2048\n\tds_read_b64_tr_b16 %6, %11\n\tds_read_b64_tr_b16 %7, %11 offset:2048\n\ts_waitcnt lgkmcnt(0)"
                 : "=&v"(t0), "=&v"(t1), "=&v"(t2), "=&v"(t3), "=&v"(t4), "=&v"(t5), "=&v"(t6), "=&v"(t7) : "v"(a0), "v"(a1), "v"(a2), "v"(a3) : "memory");
    Xv[0] = __builtin_shufflevector(t0, t1, 0, 1, 2, 3, 4, 5, 6, 7); Xv[1] = __builtin_shufflevector(t2, t3, 0, 1, 2, 3, 4, 5, 6, 7);
    Xv[2] = __builtin_shufflevector(t4, t5, 0, 1, 2, 3, 4, 5, 6, 7); Xv[3] = __builtin_shufflevector(t6, t7, 0, 1, 2, 3, 4, 5, 6, 7);
}

namespace nsb {
typedef float f32x16 __attribute__((ext_vector_type(16)));
constexpr int NSLOT = 3, SLOTB = 8192, LDS_K = 0, LDS_V = NSLOT * SLOTB, LDS_WS = 2 * NSLOT * SLOTB, LDS_OST = LDS_WS + 8 * 64 * 4, LDS_BYTES = LDS_OST + 8 * 4096;
constexpr int PITCH = 1536;
DI int crow(int r, int hi) { return (r & 3) + 8 * (r >> 2) + 4 * hi; }
#define NSB_SBAR() __builtin_amdgcn_sched_barrier(0)
DI void glds16(const void* sbase_, unsigned voff, unsigned lds_dst) { unsigned keep;
    const unsigned long long a_ = (unsigned long long)sbase_;
    const unsigned long long sbase = ((unsigned long long)(unsigned)__builtin_amdgcn_readfirstlane((int)(a_ >> 32)) << 32) | (unsigned)__builtin_amdgcn_readfirstlane((int)a_);
    asm volatile("s_mov_b32 %0, m0\n\ts_mov_b32 m0, %3\n\ts_nop 0\n\tglobal_load_lds_dwordx4 %1, %2\n\ts_mov_b32 m0, %0" : "=&s"(keep) : "v"(voff), "s"(sbase), "s"(lds_dst) : "memory"); }
DI float max3f(float a, float b, float c) { float r; asm("v_max3_f32 %0, %1, %2, %3" : "=v"(r) : "v"(a), "v"(b), "v"(c)); return r; }
DI float max2f(float a, float b) { float r; asm("v_max_f32_e32 %0, %1, %2" : "=v"(r) : "v"(a), "v"(b)); return r; }
DI float fadd_s(float a, float b) { float r; asm("v_add_f32_e32 %0, %1, %2" : "=v"(r) : "v"(a), "v"(b)); return r; }
DI float fsub_s(float a, float b) { float r; asm("v_sub_f32_e32 %0, %1, %2" : "=v"(r) : "v"(a), "v"(b)); return r; }
#define NSB_WAIT_BAR(N) asm volatile("s_waitcnt vmcnt(" #N ") lgkmcnt(0)\n\ts_barrier" ::: "memory")
typedef LAS const char* lds_cptr;
DI void qkt(f32x16& p0, f32x16& p1, lds_cptr Kslot, const bf16x8* qr, const f32x16& negm, int r32, int hi) {
    lds_cptr kb = Kslot + hi * 1024 + r32 * 16;
#pragma unroll
    for (int d0 = 0; d0 < 4; ++d0) {
        const bf16x8 b0 = *(const LAS bf16x8*)(kb + d0 * 2048), b1 = *(const LAS bf16x8*)(kb + d0 * 2048 + 512);
        if (d0 == 0) { p0 = __builtin_amdgcn_mfma_f32_32x32x16_bf16(b0, qr[0], negm, 0, 0, 0); p1 = __builtin_amdgcn_mfma_f32_32x32x16_bf16(b1, qr[0], negm, 0, 0, 0); }
        else { p0 = __builtin_amdgcn_mfma_f32_32x32x16_bf16(b0, qr[d0], p0, 0, 0, 0); p1 = __builtin_amdgcn_mfma_f32_32x32x16_bf16(b1, qr[d0], p1, 0, 0, 0); } }
}
DI void kload8(bf16x8* kf, lds_cptr kp) {
    kf[0] = *(const LAS bf16x8*)(kp);        kf[1] = *(const LAS bf16x8*)(kp + 512);
    kf[2] = *(const LAS bf16x8*)(kp + 2048); kf[3] = *(const LAS bf16x8*)(kp + 2560);
    kf[4] = *(const LAS bf16x8*)(kp + 4096); kf[5] = *(const LAS bf16x8*)(kp + 4608);
    kf[6] = *(const LAS bf16x8*)(kp + 6144); kf[7] = *(const LAS bf16x8*)(kp + 6656);
}
DI void kload2(bf16x8* kf, lds_cptr kp, int j) { kf[2 * j] = *(const LAS bf16x8*)(kp + j * 2048); kf[2 * j + 1] = *(const LAS bf16x8*)(kp + j * 2048 + 512); }
DI s16x4 vtr(lds_cptr p) { return __builtin_amdgcn_ds_read_tr16_b64_v4i16((LAS s16x4*)p); }
DI float rowmax(const f32x16& p0, const f32x16& p1) {
    float a = max3f(p0[0], p0[1], p1[0]), b = max3f(p0[2], p0[3], p1[1]); a = max3f(a, p1[2], p1[3]);
#pragma unroll
    for (int r = 4; r < 16; r += 4) { a = max3f(a, p0[r], p0[r + 1]); b = max3f(b, p0[r + 2], p0[r + 3]); a = max3f(a, p1[r], p1[r + 1]); b = max3f(b, p1[r + 2], p1[r + 3]); }
    const float m = max2f(a, b);
    auto rr = __builtin_amdgcn_permlane32_swap(__float_as_uint(m), __float_as_uint(m), false, false);
    return max2f(__uint_as_float(rr[0]), __uint_as_float(rr[1]));
}
DI void pv(f32x16* o, int vb, bf16x8 pa0, bf16x8 pa1, bf16x8 pa2, bf16x8 pa3) {
#pragma unroll
    for (int d0 = 0; d0 < 2; ++d0) { s16x4 lo[4], hi[4];
#pragma unroll
        for (int ks = 0; ks < 4; ++ks) {
            asm volatile("ds_read_b64_tr_b16 %0,%1 offset:%c2" : "=&v"(lo[ks]) : "v"(vb), "i"(d0 * 4096 + ks * 1024) : "memory");
            asm volatile("ds_read_b64_tr_b16 %0,%1 offset:%c2" : "=&v"(hi[ks]) : "v"(vb), "i"(d0 * 4096 + ks * 1024 + 512) : "memory"); }
        asm volatile("s_waitcnt lgkmcnt(0)" ::: "memory"); NSB_SBAR();
#define NSB_PK(k) (bf16x8){lo[k][0], lo[k][1], lo[k][2], lo[k][3], hi[k][0], hi[k][1], hi[k][2], hi[k][3]}
        o[d0] = __builtin_amdgcn_mfma_f32_32x32x16_bf16(pa0, NSB_PK(0), o[d0], 0, 0, 0);
        o[d0] = __builtin_amdgcn_mfma_f32_32x32x16_bf16(pa1, NSB_PK(1), o[d0], 0, 0, 0);
        o[d0] = __builtin_amdgcn_mfma_f32_32x32x16_bf16(pa2, NSB_PK(2), o[d0], 0, 0, 0);
        o[d0] = __builtin_amdgcn_mfma_f32_32x32x16_bf16(pa3, NSB_PK(3), o[d0], 0, 0, 0);
#undef NSB_PK
    }
}
DI void tmask(f32x16& p0, f32x16& p1, int mode, int tl, int hi) {
    const float NEG = -__builtin_inff();
#pragma unroll
    for (int r = 0; r < 16; ++r) { const int k0 = crow(r, hi), k1 = k0 + 32;
        const bool m0 = mode == 3 || (mode == 1 ? k0 > tl : (mode == 2 && k0 <= tl)), m1 = mode == 3 || (mode == 1 ? k1 > tl : (mode == 2 && k1 <= tl));
        if (m0) p0[r] = NEG; if (m1) p1[r] = NEG; }
}
template <int THRL, int BR>
DI void unit(const Frame& F, int b, int g, int tok0, const bf16_t* PN, bf16_t* O0, LAS char* shm, const LAS unsigned* selm_tok0, const bool do_store = true) {
    const int lane = F.lane, r32 = lane & 31, hi = lane >> 5, wid = F.wave;
    const long rowbase = (long)b * SEQ; const int jq = tok0 >> 6;
    const int tl = 8 * wid + (r32 >> 2);
    const bf16_t* Qw = PN + (rowbase + tok0 + tl) * PITCH + (g * 4 + (r32 & 3)) * 64;
    const bf16_t* Kh = PN + rowbase * PITCH + 512 + (BR == 1 ? 2 : 4) * 128 + g * 64; const bf16_t* Vh = PN + rowbase * PITCH + 512 + (BR == 1 ? 3 : 5) * 128 + g * 64;
    const unsigned lds0 = (unsigned)(size_t)shm;
    LAS float* wsf = (LAS float*)(shm + LDS_WS) + wid * 64;
    const int NTreal = BR == 1 ? jq + 1 : (jq + 1 < 9 ? jq + 1 : 9);
    int NT = (NTreal + 1) & ~1; if (NT < 4) NT = 4;
#define NSB_TILE(t) (((t) < NTreal) ? (jq - (t)) : 0)
    const bf16_t* ksrc = Kh + wid * 8; const unsigned koff = (unsigned)lane * (PITCH * 2);
    const bf16_t* vsrc = Vh + (long)(16 * (wid & 3)) * PITCH + (wid >> 2) * 32; const unsigned voff = (unsigned)(lane >> 2) * (PITCH * 2) + (lane & 3) * 16;
    const unsigned kdst = lds0 + LDS_K + wid * 1024, vdst = lds0 + LDS_V + wid * 1024;
#define NSB_DMA_K(t, slot) glds16(ksrc + (long)NSB_TILE(t) * 64 * PITCH, koff, (unsigned)__builtin_amdgcn_readfirstlane(kdst + (slot)))
#define NSB_DMA_V(t, slot) glds16(vsrc + (long)NSB_TILE(t) * 64 * PITCH, voff, (unsigned)__builtin_amdgcn_readfirstlane(vdst + (slot)))
    const int vb0 = (int)(lds0 + LDS_V) + ((lane >> 4) & 1) * 32 + (lane & 3) * 8 + (4 * hi + ((lane & 15) >> 2)) * 64;
    const lds_cptr shm3 = (lds_cptr)shm; const lds_cptr Kbase = shm3 + LDS_K; bf16x8 kf[8];
    const lds_cptr kp0 = shm3 + LDS_K + hi * 1024 + r32 * 16; const lds_cptr vp0 = shm3 + LDS_V + ((lane >> 4) & 1) * 32 + (lane & 3) * 8 + (4 * hi + ((lane & 15) >> 2)) * 64;
    NSB_DMA_K(0, 0); NSB_DMA_V(0, 0); NSB_DMA_K(1, SLOTB);
    bf16x8 qr[4];
#pragma unroll
    for (int d0 = 0; d0 < 4; ++d0) qr[d0] = *(const bf16x8*)(Qw + d0 * 16 + hi * 8);
    unsigned selw[4] = {0xFFFFFFFFu, 0xFFFFFFFFu, 0xFFFFFFFFu, 0xFFFFFFFFu};
    if (BR == 1) {
#pragma unroll
        for (int i = 0; i < 4; ++i) selw[i] = selm_tok0[tl * 4 + i]; }
    float mhat = 0.f, l_reg = 0.f; f32x16 o[2]; o[0] = f32x16{}; o[1] = f32x16{}; f32x16 negm = f32x16{}; asm volatile("" : "+v"(negm));
#define NSB_CMASK(P0, P1, t) do { const int t_ = (t); if (t_ == 0) tmask(P0, P1, 1, tl, hi); else if (t_ >= NTreal) tmask(P0, P1, 3, tl, hi); else if (BR == 2 && t_ == 8) tmask(P0, P1, 2, tl, hi); } while (0)
#define NSB_NEGM(t) do { if (BR == 1) { const int j_ = NSB_TILE(t); const unsigned wq_ = (j_ >> 5) == 0 ? selw[0] : ((j_ >> 5) == 1 ? selw[1] : ((j_ >> 5) == 2 ? selw[2] : selw[3])); const float nm_ = ((wq_ >> (j_ & 31)) & 1u) ? -mhat : -__builtin_inff(); \
        _Pragma("unroll") for (int r = 0; r < 16; ++r) negm[r] = nm_; asm volatile("" : "+v"(negm)); } } while (0)
    bool resc = false;
#define NSB_START(P0, P1) do { const float rm = rowmax(P0, P1); resc = false; \
    { const float dl = rm; mhat = fadd_s(mhat, dl); \
      _Pragma("unroll") for (int r = 0; r < 16; ++r) { P0[r] = fsub_s(P0[r], dl); P1[r] = fsub_s(P1[r], dl); } \
      if (BR != 1) { _Pragma("unroll") for (int r = 0; r < 16; ++r) negm[r] = -mhat; asm volatile("" : "+v"(negm)); } } \
    _Pragma("unroll") for (int r = 0; r < 16; ++r) P0[r] = __builtin_amdgcn_exp2f(P0[r]); } while (0)
#define NSB_RESC() do { if (resc) { asm volatile("s_waitcnt lgkmcnt(0)" ::: "memory"); \
      _Pragma("unroll") for (int d_ = 0; d_ < 2; ++d_) _Pragma("unroll") for (int r = 0; r < 16; ++r) o[d_][r] *= wsf[crow(r, hi)]; } } while (0)
    f32x16 pA0, pA1, pB0, pB1;
    int sl_prev = 0, sl_cur = 0, sl_next = SLOTB;
#define NSB_ROT() do { sl_prev = sl_cur; sl_cur = sl_next; sl_next = (sl_next == (NSLOT - 1) * SLOTB) ? 0 : sl_next + SLOTB; } while (0)
    NSB_DMA_K(2, 2 * SLOTB);
    NSB_WAIT_BAR(3);
    qkt(pA0, pA1, Kbase, qr, negm, r32, hi); asm volatile("s_nop 15\n\ts_nop 7" : "+v"(pA0), "+v"(pA1)); NSB_CMASK(pA0, pA1, 0);
    NSB_START(pA0, pA1);
#pragma unroll
    for (int r = 0; r < 16; ++r) pA1[r] = __builtin_amdgcn_exp2f(pA1[r]);
    NSB_WAIT_BAR(0);
    NSB_DMA_K(3, 0); NSB_DMA_V(1, SLOTB);
    NSB_ROT();
    kload8(kf, kp0 + sl_cur);
    NSB_WAIT_BAR(2);
    s16x4 vlo[8], vhi[8]; u32x4 pw0, pw1, pw2, pw3;
#define NSB_PKW(P, B) pack2(P[B], P[B + 1])
#define NSB_PAF(k) __builtin_bit_cast(bf16x8, pw##k)
#define NSB_VFR(i) (bf16x8){vlo[i][0], vlo[i][1], vlo[i][2], vlo[i][3], vhi[i][0], vhi[i][1], vhi[i][2], vhi[i][3]}
#define NSB_PIN(x) asm volatile("" : "+v"(x))
#define NSB_MX3(a, b, c) __builtin_fmaxf(__builtin_fmaxf((a), (b)), (c))
#define NSB_GAPA(MF, A0, A1, A2, A3, W0, W1, PW) do { MF; sacc += A0; sacc += A1; sacc += A2; sacc += A3; NSB_PIN(sacc); W0; W1; NSB_PIN(PW); NSB_SBAR(); } while (0)
#define NSB_EX(v) __builtin_amdgcn_exp2f(v)
#define NSB_GAPB(MF, X, B) do { MF; X[B] = NSB_EX(X[B]); X[B + 1] = NSB_EX(X[B + 1]); X[B + 2] = NSB_EX(X[B + 2]); X[B + 3] = NSB_EX(X[B + 3]); NSB_PIN(X); NSB_SBAR(); } while (0)
#define NSB_VRD(i) do { vlo[i] = vtr(vp_ + (((i) >> 2) * 4096 + ((i) & 3) * 1024)); vhi[i] = vtr(vp_ + (((i) >> 2) * 4096 + ((i) & 3) * 1024 + 512)); } while (0)
#define NSB_KRD(G, j) do { if (G) { kload2(kf, kp0 + sl_next, j); NSB_SBAR(); } } while (0)
#define NSB_STEP(C0, C1, P0, P1, t, GK, GV, GL) do { NSB_SBAR(); \
    const lds_cptr vp_ = vp0 + sl_prev; NSB_NEGM(t); \
    NSB_VRD(0); NSB_SBAR(); float sacc = (P0[0] + P0[1]); \
    NSB_GAPA(C0 = __builtin_amdgcn_mfma_f32_32x32x16_bf16(kf[0], qr[0], negm, 0, 0, 0), P0[2], P0[3], P0[4], P0[5],     pw0[0] = NSB_PKW(P0, 0), pw0[1] = NSB_PKW(P0, 2), pw0); \
    NSB_VRD(4); NSB_SBAR(); NSB_GAPA(C1 = __builtin_amdgcn_mfma_f32_32x32x16_bf16(kf[1], qr[0], negm, 0, 0, 0), P0[6], P0[7], P0[8], P0[9],     pw0[2] = NSB_PKW(P0, 4), pw0[3] = NSB_PKW(P0, 6), pw0); \
    NSB_VRD(1); NSB_SBAR(); NSB_GAPA(C0 = __builtin_amdgcn_mfma_f32_32x32x16_bf16(kf[2], qr[1], C0, 0, 0, 0),   P0[10], P0[11], P0[12], P0[13], pw1[0] = NSB_PKW(P0, 8), pw1[1] = NSB_PKW(P0, 10), pw1); \
    NSB_VRD(5); NSB_SBAR(); NSB_GAPA(C1 = __builtin_amdgcn_mfma_f32_32x32x16_bf16(kf[3], qr[1], C1, 0, 0, 0),   P0[14], P0[15], P1[0], P1[1],   pw1[2] = NSB_PKW(P0, 12), pw1[3] = NSB_PKW(P0, 14), pw1); \
    NSB_VRD(2); NSB_SBAR(); NSB_GAPA(C0 = __builtin_amdgcn_mfma_f32_32x32x16_bf16(kf[4], qr[2], C0, 0, 0, 0),   P1[2], P1[3], P1[4], P1[5],     pw2[0] = NSB_PKW(P1, 0), pw2[1] = NSB_PKW(P1, 2), pw2); \
    NSB_VRD(6); NSB_SBAR(); NSB_GAPA(C1 = __builtin_amdgcn_mfma_f32_32x32x16_bf16(kf[5], qr[2], C1, 0, 0, 0),   P1[6], P1[7], P1[8], P1[9],     pw2[2] = NSB_PKW(P1, 4), pw2[3] = NSB_PKW(P1, 6), pw2); \
    NSB_VRD(3); NSB_SBAR(); NSB_GAPA(C0 = __builtin_amdgcn_mfma_f32_32x32x16_bf16(kf[6], qr[3], C0, 0, 0, 0),   P1[10], P1[11], P1[12], P1[13], pw3[0] = NSB_PKW(P1, 8), pw3[1] = NSB_PKW(P1, 10), pw3); \
    NSB_VRD(7); NSB_SBAR(); NSB_GAPA(C1 = __builtin_amdgcn_mfma_f32_32x32x16_bf16(kf[7], qr[3], C1, 0, 0, 0),   P1[14], P1[15], 0.f, 0.f,       pw3[2] = NSB_PKW(P1, 12), pw3[3] = NSB_PKW(P1, 14), pw3); \
    l_reg += sacc; \
    if (GK) { NSB_DMA_K((t) + 3, sl_cur); } if (GV) { NSB_DMA_V((t) + 1, sl_next); } \
    NSB_CMASK2(C0, C1, t); \
    { float a = NSB_MX3(C0[0], C0[1], C1[0]), b_ = NSB_MX3(C0[2], C0[3], C1[1]); a = NSB_MX3(a, C1[2], C1[3]); \
      _Pragma("unroll") for (int r = 4; r < 16; r += 4) { a = NSB_MX3(a, C0[r], C0[r + 1]); b_ = NSB_MX3(b_, C0[r + 2], C0[r + 3]); a = NSB_MX3(a, C1[r], C1[r + 1]); b_ = NSB_MX3(b_, C1[r + 2], C1[r + 3]); } \
      float rm = __builtin_fmaxf(a, b_); { auto rr = __builtin_amdgcn_permlane32_swap(__float_as_uint(rm), __float_as_uint(rm), false, false); rm = __builtin_fmaxf(__uint_as_float(rr[0]), __uint_as_float(rr[1])); } \
      resc = false; \
      if (__builtin_expect(__any(rm > (float)THRL), 0)) { const float dl = __builtin_fmaxf(rm, 0.f); mhat += dl; \
        _Pragma("unroll") for (int r = 0; r < 16; ++r) { C0[r] -= dl; C1[r] -= dl; } \
        if (BR != 1) { _Pragma("unroll") for (int r = 0; r < 16; ++r) negm[r] = -mhat; asm volatile("" : "+v"(negm)); } \
        const float f = __builtin_amdgcn_exp2f(-dl); l_reg *= f; if (hi == 0) wsf[r32] = f; resc = true; } } \
    NSB_SBAR(); \
    NSB_GAPB(o[0] = __builtin_amdgcn_mfma_f32_32x32x16_bf16(NSB_PAF(0), NSB_VFR(0), o[0], 0, 0, 0), C0, 0); \
    NSB_GAPB(o[1] = __builtin_amdgcn_mfma_f32_32x32x16_bf16(NSB_PAF(0), NSB_VFR(4), o[1], 0, 0, 0), C0, 4); \
    NSB_KRD(GL, 0); NSB_GAPB(o[0] = __builtin_amdgcn_mfma_f32_32x32x16_bf16(NSB_PAF(1), NSB_VFR(1), o[0], 0, 0, 0), C0, 8); \
    NSB_KRD(GL, 1); NSB_GAPB(o[1] = __builtin_amdgcn_mfma_f32_32x32x16_bf16(NSB_PAF(1), NSB_VFR(5), o[1], 0, 0, 0), C0, 12); \
    NSB_KRD(GL, 2); NSB_GAPB(o[0] = __builtin_amdgcn_mfma_f32_32x32x16_bf16(NSB_PAF(2), NSB_VFR(2), o[0], 0, 0, 0), C1, 0); \
    NSB_KRD(GL, 3); NSB_GAPB(o[1] = __builtin_amdgcn_mfma_f32_32x32x16_bf16(NSB_PAF(2), NSB_VFR(6), o[1], 0, 0, 0), C1, 4); \
    NSB_GAPB(o[0] = __builtin_amdgcn_mfma_f32_32x32x16_bf16(NSB_PAF(3), NSB_VFR(3), o[0], 0, 0, 0), C1, 8); \
    NSB_GAPB(o[1] = __builtin_amdgcn_mfma_f32_32x32x16_bf16(NSB_PAF(3), NSB_VFR(7), o[1], 0, 0, 0), C1, 12); \
    } while (0)
    int t = 1;
#define NSB_CMASK2(P0, P1, t) do {} while (0)
    for (; t + 5 < NT; t += 2) {
        NSB_STEP(pB0, pB1, pA0, pA1, t, true, true, true);     NSB_WAIT_BAR(2); NSB_RESC(); NSB_ROT();
        NSB_STEP(pA0, pA1, pB0, pB1, t + 1, true, true, true); NSB_WAIT_BAR(2); NSB_RESC(); NSB_ROT();
    }
#undef NSB_CMASK2
#define NSB_CMASK2(P0, P1, t) NSB_CMASK(P0, P1, t)
#define NSB_ENDW(tt) do { if ((tt) + 3 < NT) { NSB_WAIT_BAR(2); } else if ((tt) + 2 < NT) { NSB_WAIT_BAR(1); } else { NSB_WAIT_BAR(0); } } while (0)
    for (; t + 1 < NT; t += 2) {
        NSB_STEP(pB0, pB1, pA0, pA1, t, (t + 3 < NT), (t + 1 < NT), (t + 1 < NT));         NSB_ENDW(t);     NSB_RESC(); NSB_ROT();
        NSB_STEP(pA0, pA1, pB0, pB1, t + 1, (t + 4 < NT), (t + 2 < NT), (t + 2 < NT));     NSB_ENDW(t + 1); NSB_RESC(); NSB_ROT();
    }
    NSB_STEP(pB0, pB1, pA0, pA1, NT - 1, false, false, false); NSB_RESC();
    { float sacc = pB0[0] + pB0[1];
#pragma unroll
      for (int r = 2; r < 16; ++r) sacc += pB0[r];
#pragma unroll
      for (int r = 0; r < 16; ++r) sacc += pB1[r];
      l_reg += sacc;
      pw0 = (u32x4){NSB_PKW(pB0, 0), NSB_PKW(pB0, 2), NSB_PKW(pB0, 4), NSB_PKW(pB0, 6)}; pw1 = (u32x4){NSB_PKW(pB0, 8), NSB_PKW(pB0, 10), NSB_PKW(pB0, 12), NSB_PKW(pB0, 14)};
      pw2 = (u32x4){NSB_PKW(pB1, 0), NSB_PKW(pB1, 2), NSB_PKW(pB1, 4), NSB_PKW(pB1, 6)}; pw3 = (u32x4){NSB_PKW(pB1, 8), NSB_PKW(pB1, 10), NSB_PKW(pB1, 12), NSB_PKW(pB1, 14)};
      NSB_SBAR(); pv(o, vb0 + sl_cur, NSB_PAF(0), NSB_PAF(1), NSB_PAF(2), NSB_PAF(3)); }
    { auto rr = __builtin_amdgcn_permlane32_swap(__float_as_uint(l_reg), __float_as_uint(l_reg), false, false); l_reg = __uint_as_float(rr[0]) + __uint_as_float(rr[1]); }
    const int lane2 = lane_id(), r32b = lane2 & 31, hib = lane2 >> 5;
    if (hib == 0) { const float gt = sigmoidf_(bf2f(PN[(rowbase + tok0 + 8 * wid + (r32b >> 2)) * PITCH + 1280 + BR * 8 + g * 4 + (r32b & 3)])); wsf[32 + r32b] = l_reg > 0.f ? gt * rcpf_(l_reg) : 0.f; }
    asm volatile("s_waitcnt lgkmcnt(0)" ::: "memory");
    float rli[16];
#pragma unroll
    for (int r = 0; r < 16; ++r) rli[r] = wsf[32 + crow(r, hib)];
    { LAS bf16_t* stg = (LAS bf16_t*)(shm + LDS_OST) + wid * 2048;
#pragma unroll
      for (int r = 0; r < 16; ++r) { const int orow = crow(r, hib);
#pragma unroll
          for (int d0 = 0; d0 < 2; ++d0) stg[orow * 64 + d0 * 32 + r32b] = f2bf(o[d0][r] * rli[r]); }
      asm volatile("s_waitcnt lgkmcnt(0)" ::: "memory");
#pragma unroll
      for (int i = 0; i < 4; ++i) { const int row = i * 8 + (lane2 >> 3), ch = lane2 & 7; const u32x4 v = *(const LAS u32x4*)(stg + row * 64 + ch * 8);
          bf16_t* op = O0 + (rowbase + tok0 + 8 * wid + (row >> 2)) * 1024 + 512 + (g * 4 + (row & 3)) * 64 + ch * 8;
          if (do_store) { float a8[8], b8[8]; unpack8(*(const u32x4*)op, a8); unpack8(v, b8);
#pragma unroll
              for (int e = 0; e < 8; ++e) a8[e] += b8[e];
              *(u32x4*)op = pack8(a8); }
          else asm volatile("" :: "v"(v)); } }
    asm volatile("s_waitcnt vmcnt(0) lgkmcnt(0)\n\ts_barrier" ::: "memory");
#undef NSB_TILE
#undef NSB_DMA_K
#undef NSB_DMA_V
#undef NSB_CMASK
#undef NSB_CMASK2
#undef NSB_NEGM
#undef NSB_START
#undef NSB_RESC
#undef NSB_ROT
#undef NSB_PKW
#undef NSB_PAF
#undef NSB_VFR
#undef NSB_PIN
#undef NSB_MX3
#undef NSB_GAPA
#undef NSB_GAPB
#undef NSB_EX
#undef NSB_VRD
#undef NSB_KRD
#undef NSB_STEP
#undef NSB_ENDW
}
#undef NSB_SBAR
#undef NSB_WAIT_BAR
}

DI void nsa_unit(const Frame& F0, int unit, const int mode = 0x3F) {
    Frame F = F0; F.tid = F.wave * 64 + lane_id(); asm volatile("" : "+v"(F.tid)); F.lane = F.tid & 63;
    const int qt = 63 - (unit >> 4), b = (unit >> 1) & 7, g = unit & 1;
    const int t0 = qt * 128, tw = t0 + 16 * F.wave;
    const size_t tokb = (size_t)b * SEQ;
    const int lane = F.lane, fr = lane & 15, fq = lane >> 4, q = fr >> 2, pp = lane & 3;
    const bf16_t* PN = (const bf16_t*)(F.ws + OFF_PN);
    LAS float* imp = (LAS float*)(F.lds + NS_OFF_IMP); LAS unsigned* selm = (LAS unsigned*)(F.lds + NS_OFF_SEL);
    const int hd = fr & 3, posl = tw + (fr >> 2);
    bf16x8 Qf[4][2];
#pragma unroll
    for (int rt = 0; rt < 4; ++rt)
#pragma unroll
        for (int ks = 0; ks < 2; ++ks) { float v[8]; unpack8(*(const u32x4*)(PN + (tokb + posl + 4 * rt) * 1536 + (g * 4 + hd) * 64 + 32 * ks + 8 * fq), v);
            u32x4 w; w[0] = cvtpk(v[0], v[1]); w[1] = cvtpk(v[2], v[3]); w[2] = cvtpk(v[4], v[5]); w[3] = cvtpk(v[6], v[7]);
            Qf[rt][ks] = __builtin_bit_cast(bf16x8, w); }
    __syncthreads();
    for (int i = F.tid; i < 128 * 128; i += NTH) imp[i] = 0.f;
    FState st;
    bf16_t* O0 = (bf16_t*)(F.ws + OFF_O0);
    if (mode & 1) {
        TileSrc S{(const bf16_t*)(F.ws + SM_KCMP) + ((size_t)b * 512 * 2 + g) * 64, (const bf16_t*)(F.ws + SM_VCMPT) + ((size_t)b * 512 * 2 + g) * 64, 128};
        int nmax = (t0 + 96) >> 4; if (nmax > 510) nmax = 510;
        const int ntl = (nmax >> 6) + 1;
        const int nfull = (tw - 31) >> 4;
        ns_reset(st);
        asm volatile("s_waitcnt vmcnt(0)" ::: "memory"); __syncthreads();
        for (int p_ = 0; p_ < 3 && p_ < ntl; ++p_) ns_dma(F, S, p_, p_);
#pragma unroll 1
        for (int j = 0; j < ntl; ++j) {
            ns_wait(ntl - 1 - j);
            if (j + 3 < ntl) ns_dma(F, S, j + 3, (j + 3) & 3);
            const LAS unsigned char* tb0 = F.lds + (j & 3) * NS_STG;
#pragma unroll 1
            for (int koff = 0; koff < 64; koff += 32) {
                const int nb = j * 64 + koff;
                if (16 * nb + 31 > tw + 15) continue;
                if (nb + 31 <= nfull) ns_step<0, false, true>(tb0 + koff * 128, nb, Qf, st, 0xFu, 0xFu, posl, 0, fr, fq, q, pp);
                else ns_step<1, false, true>(tb0 + koff * 128, nb, Qf, st, 0xFu, 0xFu, posl, 0, fr, fq, q, pp);
            }
        }
        float il[4];
#pragma unroll
        for (int rt = 0; rt < 4; ++rt) { float l = st.l[rt]; l += shx(l, 16); l += shx(l, 32); il[rt] = l > 0.f ? rcpf_(l) : 0.f; }
        __syncthreads();
        float carry[4] = {0.f, 0.f, 0.f, 0.f}; const int bpa = ((lane + 48) & 63) << 2;
        for (int p_ = 0; p_ < 3 && p_ < ntl; ++p_) ns_dma(F, S, p_, p_);
#pragma unroll 1
        for (int j = 0; j < ntl; ++j) {
            ns_wait(ntl - 1 - j);
            if (j + 3 < ntl) ns_dma(F, S, j + 3, (j + 3) & 3);
            const LAS unsigned char* tb0 = F.lds + (j & 3) * NS_STG;
#pragma unroll 1
            for (int koff = 0; koff < 64; koff += 32) {
                const int nb = j * 64 + koff;
                if (16 * nb + 31 > tw + 15) continue;
                const LAS unsigned char* tb = tb0 + koff * 128;
                const int lk = fr * 128 + ((fq ^ (fr & 7)) << 4);
                const int m_ = (4 * fq + q) & 7, vbl = (4 * fq + q) * 128 + ((((pp >> 1) ^ (m_ & 1))) << 4) + (pp & 1) * 8 + ((m_ >> 1) << 5);
                const LAS unsigned char* kp0 = tb + lk; const LAS unsigned char* kp1 = tb + (lk ^ 64); const LAS unsigned char* vp_ = tb + 8192 + vbl;
                asm volatile("" : "+v"(kp0), "+v"(kp1), "+v"(vp_));
                f32x4 s[2][4];
#pragma unroll
                for (int rt = 0; rt < 4; ++rt) { s[0][rt] = (f32x4){0.f, 0.f, 0.f, 0.f}; s[1][rt] = s[0][rt]; }
#pragma unroll
                for (int ks = 0; ks < 2; ++ks)
#pragma unroll
                    for (int kt = 0; kt < 2; ++kt) { const bf16x8 X = *(const LAS bf16x8*)((ks ? kp1 : kp0) + kt * 2048);
#pragma unroll
                        for (int rt = 0; rt < 4; ++rt) s[kt][rt] = MFMA16(X, Qf[rt][ks], s[kt][rt]); }
                bf16x8 Y[4];
#pragma unroll
                for (int rt = 0; rt < 4; ++rt) {
#pragma unroll
                    for (int kt = 0; kt < 2; ++kt) {
#pragma unroll
                        for (int r = 0; r < 4; ++r) { const int n = nb + 16 * kt + 4 * fq + r; s[kt][rt][r] = (n <= ((posl + 4 * rt - 31) >> 4)) ? fexp2(s[kt][rt][r] - st.m[rt]) * il[rt] : 0.f; }
                        float a = s[kt][rt][0] + s[kt][rt][1] + s[kt][rt][2] + 0.5f * s[kt][rt][3], bb = 0.5f * s[kt][rt][3];
                        a += dpp_mov<0xB1>(a); a += dpp_mov<0x4E>(a); bb += dpp_mov<0xB1>(bb); bb += dpp_mov<0x4E>(bb);
                        const float pull = __int_as_float(__builtin_amdgcn_ds_bpermute(bpa, __float_as_int(bb)));
                        const float val = a + (fq > 0 ? pull : carry[rt]); carry[rt] = pull;
                        if (hd == 0) { const int jj = (nb >> 2) + 4 * kt + fq; const int tl = 16 * F.wave + 4 * rt + (fr >> 2);
                            asm volatile("ds_write_b32 %0, %1" :: "v"((unsigned)(size_t)imp + (unsigned)(tl * 128 + jj) * 4u), "v"(val) : "memory"); }
                    }
                    u32x4 w; w[0] = cvtpk(s[0][rt][0], s[0][rt][1]); w[1] = cvtpk(s[0][rt][2], s[0][rt][3]); w[2] = cvtpk(s[1][rt][0], s[1][rt][1]); w[3] = cvtpk(s[1][rt][2], s[1][rt][3]);
                    Y[rt] = __builtin_bit_cast(bf16x8, w);
                }
                bf16x8 Xv[4]; ns_vtr8(vp_, Xv);
#pragma unroll
                for (int dt = 0; dt < 4; ++dt)
#pragma unroll
                    for (int rt = 0; rt < 4; ++rt) st.o[dt][rt] = MFMA16(Xv[dt], Y[rt], st.o[dt][rt]);
            }
        }
        int pl_ = posl; asm volatile("" : "+v"(pl_));
#pragma unroll
        for (int rt = 0; rt < 4; ++rt) { const float gt = sigmoidf_(bf2f(PN[(tokb + pl_ + 4 * rt) * 1536 + 1280 + 0 * 8 + g * 4 + hd]));
#pragma unroll
            for (int dt = 0; dt < 4; ++dt) { const f32x4 v = st.o[dt][rt] * gt; u32x2 o; o[0] = cvtpk(v[0], v[1]); o[1] = cvtpk(v[2], v[3]);
                if (mode & 16) *(u32x2*)(O0 + (tokb + pl_ + 4 * rt) * 1024 + 512 + (g * 4 + hd) * 64 + 16 * dt + 4 * fq) = o; } }
    }
    __syncthreads();
    {
        const int cur = tw >> 6; const int j0 = lane, j1 = lane + 64;
        const bool c0 = j0 >= 1 && j0 <= cur - 2, c1 = j1 <= cur - 2;
#pragma unroll 1
        for (int tl0 = 0; tl0 < ((mode & 2) ? 16 : 0); tl0 += 4) {
            bool s0[4], s1[4];
            if (cur < 16) {
#pragma unroll
                for (int i = 0; i < 4; ++i) { s0[i] = j0 <= cur; s1[i] = false; }
            } else {
                unsigned v0[4], v1[4], thr[4]; bool ex[4];
#pragma unroll
                for (int i = 0; i < 4; ++i) { const int tg = 16 * F.wave + tl0 + i;
                    v0[i] = c0 ? __float_as_uint(imp[tg * 128 + j0]) : 0u; v1[i] = c1 ? __float_as_uint(imp[tg * 128 + j1]) : 0u;
                    thr[i] = 0u; ex[i] = false; }
#pragma unroll 1
                for (int bit = 30; bit >= 0; --bit) {
#pragma unroll
                    for (int i = 0; i < 4; ++i) {
                        const unsigned cand = thr[i] | (1u << bit);
                        const int cnt = __popcll(__ballot(v0[i] >= cand)) + __popcll(__ballot(v1[i] >= cand));
                        thr[i] = (!ex[i] && cnt >= 13) ? cand : thr[i]; ex[i] = ex[i] || cnt == 13;
                    }
                    if (ex[0] && ex[1] && ex[2] && ex[3]) break;
                }
#pragma unroll
                for (int i = 0; i < 4; ++i) {
                    if (ex[i]) { s0[i] = c0 && v0[i] >= thr[i]; s1[i] = c1 && v1[i] >= thr[i]; }
                    else {
                        const unsigned long long g0 = __ballot(c0 && v0[i] > thr[i]), g1 = __ballot(c1 && v1[i] > thr[i]), e0 = __ballot(c0 && v0[i] == thr[i]), e1 = __ballot(c1 && v1[i] == thr[i]);
                        const int need = 13 - __popcll(g0) - __popcll(g1);
                        const unsigned long long lt = (1ull << lane) - 1ull;
                        s0[i] = c0 && (v0[i] > thr[i] || (v0[i] == thr[i] && __popcll(e0 & lt) < need));
                        s1[i] = c1 && (v1[i] > thr[i] || (v1[i] == thr[i] && __popcll(e0) + __popcll(e1 & lt) < need));
                    }
                    s0[i] = s0[i] || j0 == 0 || j0 == cur - 1 || j0 == cur; s1[i] = s1[i] || j1 == cur - 1 || j1 == cur;
                }
            }
#pragma unroll
            for (int i = 0; i < 4; ++i) { const int tg = 16 * F.wave + tl0 + i;
                const unsigned long long m0 = __ballot(s0[i]), m1 = __ballot(s1[i]);
                if (lane == 0) { selm[tg * 4 + 0] = (unsigned)m0; selm[tg * 4 + 1] = (unsigned)(m0 >> 32); selm[tg * 4 + 2] = (unsigned)m1; selm[tg * 4 + 3] = (unsigned)(m1 >> 32); } }
        }
    }
    __syncthreads();
    if (mode & 4) {
#pragma unroll 1
        for (int half = 0; half < 2; ++half) {
            nsb::unit<8, 1>(F, b, g, t0 + 64 * half, PN, O0, (LAS char*)F.lds, selm + 64 * half * 4, (mode & 16) != 0);
            if (mode & 8) nsb::unit<8, 2>(F, b, g, t0 + 64 * half, PN, O0, (LAS char*)F.lds, selm, (mode & 16) != 0);
        }
    }
}
DI void nsa_phase(const Frame& F0, int qi = 0, const int mode = 0x3F) {
    Frame F = F0; F.tid = F.wave * 64 + lane_id(); F.lane = F.tid & 63;
    LAS int* uw = (LAS int*)(F.lds + NS_OFF_U);
    unsigned* qh = (unsigned*)(F.ws + CTL_Q) + 64 * qi;
    for (;;) {
        __syncthreads();
        if (F.tid == 0) *uw = (int)__hip_atomic_fetch_add(qh, 1u, __ATOMIC_RELAXED, __HIP_MEMORY_SCOPE_AGENT);
        __syncthreads();
        const int u = *uw;
        if (u >= 1024) break;
        nsa_unit(F, u, mode);
    }
}

__global__ void __launch_bounds__(NTH, 2) fwd_kernel(Args args) {
    extern __shared__ __attribute__((aligned(16))) unsigned char lds_raw[];
    Frame F;
    F.lds = (LAS unsigned char*)lds_raw + LDS_SCR; F.tid = threadIdx.x; F.lane = F.tid & 63; F.wave = __builtin_amdgcn_readfirstlane(F.tid >> 6); F.wg = blockIdx.x;
    F.ws = args.ws; F.out = args.out; F.in = args.in;
    volatile LAS unsigned* misc = (volatile LAS unsigned*)((LAS unsigned char*)lds_raw);
    if (F.tid < 64) misc[F.tid] = 0u;
    __syncthreads();
    XcdBarrier bar = xcd_barrier_post((unsigned*)(F.ws + CTL_BAR), misc);
    LAS int* tile_start = (LAS int*)((LAS unsigned char*)lds_raw + 256);
    const int lo = args.ph_lo, hi = args.ph_hi;
#define IN(k) (lo <= (k) && (k) < hi)
#define SEAM(k) do { if (IN(k) && IN((k) + 1)) xcd_barrier(bar); } while (0)
    const float* ln = F.in[27];

    if (IN(0)) {
        tr_job(F, F.in[1], 3352, 1024, 3352, 3584, (bf16_t*)(F.ws + W_IN0), 1024, 0);
        tr_job(F, F.in[2], 1024, 1024, 1024, 1024, (bf16_t*)(F.ws + W_OUT0), 1024, 0);
        {
          const float* x = F.in[0]; bf16_t* xb = (bf16_t*)(F.ws + OFF_XB);
          for (size_t i0 = (size_t)F.wg * NTH + F.tid; i0 < (size_t)T * D / 8; i0 += (size_t)GRID * NTH * 4) {
              f32x4 a[4], b[4];
#pragma unroll
              for (int k = 0; k < 4; ++k) { const size_t i = i0 + (size_t)k * GRID * NTH; a[k] = *(const f32x4*)(x + i * 8); b[k] = *(const f32x4*)(x + i * 8 + 4); }
#pragma unroll
              for (int k = 0; k < 4; ++k) { const size_t i = i0 + (size_t)k * GRID * NTH; u32x4 o; o[0] = pack2(a[k][0], a[k][1]); o[1] = pack2(a[k][2], a[k][3]); o[2] = pack2(b[k][0], b[k][1]); o[3] = pack2(b[k][2], b[k][3]);
                  *(u32x4*)(xb + i * 8) = o; } } }
        {
          bf16_t* wl1 = (bf16_t*)(F.ws + W_L1); const float* mu = F.in[3];
          for (int i = F.wg * NTH + F.tid; i < 256 * 1024; i += GRID * NTH) { const int n = i >> 10, k = i & 1023, kk = k & 511;
              const int which = n < 64 ? 0 : (n < 128 ? 1 : 2); const int j = n - (which == 0 ? 0 : (which == 1 ? 64 : 128));
              const float* X1 = which == 0 ? F.in[5] : (which == 1 ? F.in[8] : F.in[10]); const int ldx = which == 2 ? 128 : 64;
              const float m = mu[(3 + which) * 512 + kk]; wl1[i] = f2bf((k < 512 ? (1.0f - m) : m) * X1[kk * ldx + j]); }
          bf16_t* wl2 = (bf16_t*)(F.ws + W_L2);
          for (int i = F.wg * NTH + F.tid; i < 1536 * 256; i += GRID * NTH) { const int n = i >> 8, k = i & 255; float v = 0.f;
              if (n < 512) { if (k < 64) v = F.in[6][k * 512 + n]; } else if (n < 1024) { if (k >= 64 && k < 128) v = F.in[9][(k - 64) * 512 + n - 512]; } else { if (k >= 128) v = F.in[11][(k - 128) * 512 + n - 1024]; }
              wl2[i] = f2bf(v); }
          bf16_t* pr = (bf16_t*)(F.ws + OFF_PR);
          for (int i = F.wg * NTH + F.tid; i < 8 * 2048; i += GRID * NTH) pr[(size_t)(i >> 11) * 8193 * 2048 + (i & 2047)] = 0; }
        tr_job(F, F.in[17], 128, 2048, 128, 256, (bf16_t*)(F.ws + W_C1), 2048, 0);
        tr_job(F, F.in[17] + 2048 * 128, 128, 2048, 128, 256, (bf16_t*)(F.ws + W_C1) + 256 * 2048, 2048, 0);
        {
          bf16_t* wc2 = (bf16_t*)(F.ws + W_C2);
          for (int i = F.wg * NTH + F.tid; i < 2 * 256 * 256; i += GRID * NTH) { const int kv = i >> 16, n = (i >> 8) & 255, k = i & 255;
              wc2[i] = f2bf((n < 64 && k < 128) ? F.in[18][(size_t)kv * 128 * 64 + k * 64 + n] : 0.f); }
          float* cb = (float*)(F.ws + SM_CBIAS);
          { const int i = F.wg * 8 + F.wave; if (i < 512) { const int kv = i >> 8, n = i & 255; float acc = 0.f;
              if (n < 128) { for (int k = F.tid & 63; k < 2048; k += 64) acc += F.in[16][kv * 2048 + k] * F.in[17][((size_t)kv * 2048 + k) * 128 + n]; acc = wave_sum(acc); }
              if ((F.tid & 63) == 0) cb[i] = acc; } }
          float* rn = (float*)(F.ws + SM_ROPEN);
          for (int i = F.wg * NTH + F.tid; i < 8192 * 8; i += GRID * NTH) { const int p = i >> 3, k = i & 7;
              const double ang = (double)p * exp(-13.122363377404328 * (double)k / 8.0); rn[2 * i] = (float)cos(ang); rn[2 * i + 1] = (float)sin(ang); } }
        tr_job(F, F.in[19], 6144, 1024, 6144, 6144, (bf16_t*)(F.ws + W_RTIN), 1024, 3, RTI8 ? F8_SW : 0.f);
        tr_job(F, F.in[20], 1024, 2048, 1024, 1024, (bf16_t*)(F.ws + W_RTOUT), 2048, 0, RTO8 ? F8_SWO : 0.f);
        __syncthreads();
    }
    SEAM(0);
#if PROBE == 11
    {
        tr_job(F, F.in[1], 3352, 1024, 3352, 3584, (bf16_t*)(F.ws + W_IN0), 1024, 0);
        tr_job(F, F.in[2], 1024, 1024, 1024, 1024, (bf16_t*)(F.ws + W_OUT0), 1024, 0);
        {
          const float* x = F.in[0]; bf16_t* xb = (bf16_t*)(F.ws + OFF_XB);
          for (size_t i0 = (size_t)F.wg * NTH + F.tid; i0 < (size_t)T * D / 8; i0 += (size_t)GRID * NTH * 4) {
              f32x4 a[4], b[4];
#pragma unroll
              for (int k = 0; k < 4; ++k) { const size_t i = i0 + (size_t)k * GRID * NTH; a[k] = *(const f32x4*)(x + i * 8); b[k] = *(const f32x4*)(x + i * 8 + 4); }
#pragma unroll
              for (int k = 0; k < 4; ++k) { const size_t i = i0 + (size_t)k * GRID * NTH; u32x4 o; o[0] = pack2(a[k][0], a[k][1]); o[1] = pack2(a[k][2], a[k][3]); o[2] = pack2(b[k][0], b[k][1]); o[3] = pack2(b[k][2], b[k][3]);
                  *(u32x4*)(xb + i * 8) = o; } } }
        {
          bf16_t* wl1 = (bf16_t*)(F.ws + W_L1); const float* mu = F.in[3];
          for (int i = F.wg * NTH + F.tid; i < 256 * 1024; i += GRID * NTH) { const int n = i >> 10, k = i & 1023, kk = k & 511;
              const int which = n < 64 ? 0 : (n < 128 ? 1 : 2); const int j = n - (which == 0 ? 0 : (which == 1 ? 64 : 128));
              const float* X1 = which == 0 ? F.in[5] : (which == 1 ? F.in[8] : F.in[10]); const int ldx = which == 2 ? 128 : 64;
              const float m = mu[(3 + which) * 512 + kk]; wl1[i] = f2bf((k < 512 ? (1.0f - m) : m) * X1[kk * ldx + j]); }
          bf16_t* wl2 = (bf16_t*)(F.ws + W_L2);
          for (int i = F.wg * NTH + F.tid; i < 1536 * 256; i += GRID * NTH) { const int n = i >> 8, k = i & 255; float v = 0.f;
              if (n < 512) { if (k < 64) v = F.in[6][k * 512 + n]; } else if (n < 1024) { if (k >= 64 && k < 128) v = F.in[9][(k - 64) * 512 + n - 512]; } else { if (k >= 128) v = F.in[11][(k - 128) * 512 + n - 1024]; }
              wl2[i] = f2bf(v); }
          bf16_t* pr = (bf16_t*)(F.ws + OFF_PR);
          for (int i = F.wg * NTH + F.tid; i < 8 * 2048; i += GRID * NTH) pr[(size_t)(i >> 11) * 8193 * 2048 + (i & 2047)] = 0; }
        tr_job(F, F.in[17], 128, 2048, 128, 256, (bf16_t*)(F.ws + W_C1), 2048, 0);
        tr_job(F, F.in[17] + 2048 * 128, 128, 2048, 128, 256, (bf16_t*)(F.ws + W_C1) + 256 * 2048, 2048, 0);
        {
          bf16_t* wc2 = (bf16_t*)(F.ws + W_C2);
          for (int i = F.wg * NTH + F.tid; i < 2 * 256 * 256; i += GRID * NTH) { const int kv = i >> 16, n = (i >> 8) & 255, k = i & 255;
              wc2[i] = f2bf((n < 64 && k < 128) ? F.in[18][(size_t)kv * 128 * 64 + k * 64 + n] : 0.f); }
          float* cb = (float*)(F.ws + SM_CBIAS);
          { const int i = F.wg * 8 + F.wave; if (i < 512) { const int kv = i >> 8, n = i & 255; float acc = 0.f;
              if (n < 128) { for (int k = F.tid & 63; k < 2048; k += 64) acc += F.in[16][kv * 2048 + k] * F.in[17][((size_t)kv * 2048 + k) * 128 + n]; acc = wave_sum(acc); }
              if ((F.tid & 63) == 0) cb[i] = acc; } }
          float* rn = (float*)(F.ws + SM_ROPEN);
          for (int i = F.wg * NTH + F.tid; i < 8192 * 8; i += GRID * NTH) { const int p = i >> 3, k = i & 7;
              const double ang = (double)p * exp(-13.122363377404328 * (double)k / 8.0); rn[2 * i] = (float)cos(ang); rn[2 * i + 1] = (float)sin(ang); } }
        tr_job(F, F.in[19], 6144, 1024, 6144, 6144, (bf16_t*)(F.ws + W_RTIN), 1024, 3, RTI8 ? F8_SW : 0.f);
        tr_job(F, F.in[20], 1024, 2048, 1024, 1024, (bf16_t*)(F.ws + W_RTOUT), 2048, 0, RTO8 ? F8_SWO : 0.f);
        __syncthreads();
        { float* rr = (float*)(F.ws + SM_ROPER);
          for (int i = F.wg * NTH + F.tid; i < 8192 * 64; i += GRID * NTH) { const int p = i >> 6, k = i & 63;
              const double ang = (double)p * exp(-9.210340371976184 * (double)k / 63.0); rr[2 * i] = (float)cos(ang); rr[2 * i + 1] = (float)sin(ang); } }
    }
    xcd_barrier(bar);
#endif
    if (IN(1)) {
        pg8::GemmK g{1024, 1024, 1024, 128, 1 << 30, 0};
        pg8::DenseSched S; S.init(F.ws + OFF_XB, 1024, F.ws + W_IN0, 1024, T, 3584, GRID, F.wg);
        bf16_t* PR = (bf16_t*)(F.ws + OFF_PR); bf16_t* PN = (bf16_t*)(F.ws + OFF_PN);
        auto f = [PR, PN](const pg8::Unit&, int row, int col, const float (&v)[8]) {
            if (col < 2048) store8(PR + ((size_t)row + (row >> 13) + 1) * 2048 + col, v);
            else if (col < 2560) { float o[8];
#pragma unroll
                for (int i = 0; i < 8; ++i) o[i] = v[i] * NS_C;
                store8(PN + (size_t)row * 1536 + (col - 2048), o); }
            else store8(PN + (size_t)row * 1536 + (col - 2048), v); };
        pg8::EpiRow8<decltype(f)> E{f};
        pg8::gemm_phase(F.lds, F.wave, g, S, E);
    }
    SEAM(1);
#if PROBE == 6
    {
        pg8::GemmK g{1024, 1024, 1024, 128, 1 << 30, 0};
        pg8::DenseSched S; S.init(F.ws + OFF_XB, 1024, F.ws + W_IN0, 1024, T, 3584, GRID, F.wg);
        bf16_t* PR = (bf16_t*)(F.ws + OFF_PR); bf16_t* PN = (bf16_t*)(F.ws + OFF_PN);
        auto f = [PR, PN](const pg8::Unit&, int row, int col, const float (&v)[8]) {
            if (col < 2048) store8(PR + ((size_t)row + (row >> 13) + 1) * 2048 + col, v);
            else if (col < 2560) { float o[8];
#pragma unroll
                for (int i = 0; i < 8; ++i) o[i] = v[i] * NS_C;
                store8(PN + (size_t)row * 1536 + (col - 2048), o); }
            else store8(PN + (size_t)row * 1536 + (col - 2048), v); };
        pg8::EpiRow8<decltype(f)> E{f};
        pg8::gemm_phase(F.lds, F.wave, g, S, E);
        xcd_barrier(bar);
    }
#endif
    if (IN(2)) {
        rwkv_e1_phase(F);
        nsa_rope_phase(F);
        pg8::GemmK g{2048, 1024, 1024, 128, 8, -5120};
        pg8::DenseSched S; S.init(F.ws + OFF_PR + 1536 * 2, 2048, F.ws + W_L1, 1024, T, 256, GRID, F.wg, 1);
        bf16_t* HID = (bf16_t*)(F.ws + OFF_O0) + 512;
        auto f = [HID](const pg8::Unit&, int row, int col, const float (&v)[8]) {
            float o[8];
#pragma unroll
            for (int i = 0; i < 8; ++i) o[i] = col < 64 ? tanhf_(v[i]) : (col < 128 ? v[i] : sigmoidf_(v[i]));
            store8(HID + (size_t)row * 1024 + col, o); };
        pg8::EpiRow8<decltype(f)> E{f};
        pg8::gemm_phase(F.lds, F.wave, g, S, E);
    }
    SEAM(2);
    if (IN(3) && F.wg >= 64) {
        pg8::GemmK g{1024, 256, 256, 128, 1 << 30, 0};
        pg8::DenseSched S; S.init(F.ws + OFF_O0 + 512 * 2, 1024, F.ws + W_L2, 256, T, 1536, GRID - 64, F.wg - 64);
        bf16_t* SW = st_w(F); bf16_t* SKK = st_kk(F); bf16_t* SB = st_b(F); bf16_t* SKP = st_kp(F); bf16_t* O0 = (bf16_t*)(F.ws + OFF_O0);
        const float* w0 = F.in[4]; const float* a0 = F.in[7]; const float* kkw = F.in[12]; const float* kaw = F.in[13]; const float* rn = (const float*)(F.ws + SM_RNORM);
        auto f = [=](const pg8::Unit&, int row, int col, const float (&v)[8]) {
            float o[8];
            if (col < 512) {
#pragma unroll
                for (int i = 0; i < 8; ++i) o[i] = __builtin_amdgcn_exp2f(-0.606531f * 1.44269504088896341f * sigmoidf_(w0[col + i] + v[i]));
                store8(SW + (size_t)row * 512 + col, o);
            } else if (col < 1024) {
                const int c = col - 512; float k[8], kk[8], bb[8];
                unpack8(*(const u32x4*)(SKP + (size_t)row * 512 + c), k);
                const float r = rn[(size_t)row * 8 + (c >> 6)];
#pragma unroll
                for (int i = 0; i < 8; ++i) { const float a = sigmoidf_(a0[c + i] + v[i]); kk[i] = k[i] * kkw[c + i] * r; bb[i] = kk[i] * a; o[i] = k[i] * (1.0f + (a - 1.0f) * kaw[c + i]); }
                store8(SKK + (size_t)row * 512 + c, kk); store8(SB + (size_t)row * 512 + c, bb); store8(SKP + (size_t)row * 512 + c, o);
            } else {
                store8(O0 + (size_t)row * 1024 + (col - 1024), v);
            } };
        pg8::EpiRow8<decltype(f)> E{f};
        pg8::gemm_phase(F.lds, F.wave, g, S, E);
    }
    if (IN(3)) {
        pg8::GemmK g{16 * 1536, 2048, 2048, 1536 * 2, 1 << 30, 0};
        pg8::CmpSched S{(const char*)(F.ws + OFF_PN + 512 * 2), (const char*)(F.ws + W_C1), (size_t)128, (size_t)256 * 16 * 1536 * 2, (size_t)256 * 2048 * 2, GRID, F.wg};
        bf16_t* HC = (bf16_t*)(F.ws + OFF_HC); const float* cb = (const float*)(F.ws + SM_CBIAS);
        auto f = [HC, cb](const pg8::Unit& u, int row, int col, const float (&v)[8]) {
            float o[8];
#pragma unroll
            for (int i = 0; i < 8; ++i) { const float x = v[i] + cb[(u.aux >> 1) * 256 + col + i]; o[i] = 0.5f * x * (1.0f + tanhf(0.7978845608028654f * (x + 0.044715f * x * x * x))); }
            store8(HC + ((size_t)u.aux * 4096 + row) * 256 + col, o); };
        pg8::EpiRow8<decltype(f)> E{f};
        pg8::gemm_phase(F.lds, F.wave, g, S, E);
        __threadfence(); __syncthreads();
    }
    if (IN(3)) {
        pg8::GemmK g{256, 256, 256, 128, 1 << 30, 0};
        pg8::CmpSched S{(const char*)(F.ws + OFF_HC), (const char*)(F.ws + W_C2), (size_t)4096 * 256 * 2, (size_t)256 * 256 * 2, (size_t)256 * 256 * 2, GRID, F.wg};
        bf16_t* KC = (bf16_t*)(F.ws + SM_KCMP); bf16_t* VC = (bf16_t*)(F.ws + SM_VCMPT);
        auto f = [KC, VC](const pg8::Unit& u, int row, int col, const float (&v)[8]) {
            if (col < 64) store8((u.aux < 2 ? KC : VC) + ((size_t)row * 2 + (u.aux & 1)) * 64 + col, v); };
        pg8::EpiRow8<decltype(f)> E{f};
        pg8::gemm_phase(F.lds, F.wave, g, S, E);
    }
    SEAM(3);
    if (IN(5)) { if (F.wg < SC_WGS) rwkv_scan(F); nsa_phase(F); }
    SEAM(5);
#if PROBE == 1
    if (F.wg < SC_WGS) rwkv_scan(F, false);
    xcd_barrier(bar);
#elif PROBE == 2
    nsa_phase(F, 1);
    xcd_barrier(bar);
#elif PROBE >= 20 && PROBE < 30
    nsa_phase(F, 1, PROBE == 20 ? 0x01 : PROBE == 21 ? 0x03 : PROBE == 22 ? 0x07 : PROBE == 23 ? 0x27 : PROBE == 24 ? 0x2B : PROBE == 25 ? 0x0B : 0x2F);
    xcd_barrier(bar);
#endif
    if (IN(7)) {
        pg8::GemmK g{1024, 1024, 1024, 128, 1 << 30, 0};
        pg8::DenseSched S; S.init(F.ws + OFF_O0, 1024, F.ws + W_OUT0, 1024, T, 1024, GRID, F.wg);
        bf16_t* MX = (bf16_t*)(F.ws + OFF_MIX);
        auto f = [MX](const pg8::Unit&, int row, int col, const float (&v)[8]) { store8(MX + (size_t)row * 1024 + col, v); };
        pg8::EpiRow8<decltype(f)> E{f};
        pg8::gemm_phase(F.lds, F.wave, g, S, E);
    }
    SEAM(7);
    if (IN(10)) { ln1_router_phase(F, nullptr  , (const bf16_t*)(F.ws + OFF_MIX), (bf16_t*)(F.ws + OFF_XB), ln + 0 * 1024, ln + 1 * 1024, 0, MOE8_L0 ? F.ws + OFF_XB8 : nullptr); moe_weights(F, 0, MOE8_L0); }
    SEAM(10);
#if PROBE == 5
    ln1_router_phase(F, F.in[0], (const bf16_t*)(F.ws + OFF_MIX), (bf16_t*)(F.ws + OFF_XB), ln + 0 * 1024, ln + 1 * 1024, 0); moe_weights(F, 0);
    xcd_barrier(bar);
#endif
    if (IN(11)) moe_scatter_phase(F, nullptr, 0);
    SEAM(11);
#if PROBE == 7
    moe_scatter_phase(F, nullptr, 0);
    xcd_barrier(bar);
#endif
    if (IN(12)) {
        { const int kt_ = F.wave * 64 + lane_id(); if (kt_ < 17) tile_start[kt_] = ((const int*)(F.ws + CTL_TILES))[kt_]; }
        __syncthreads();
        if (MOE8_L0) {
            pg8::GemmK g{512, 512, 512, 128, 1 << 30, 0};
            pg8::MoeSched S{(const char*)(F.ws + OFF_XB8), (const char*)(F.ws + OFF_WMOE), (size_t)0, (size_t)256 * 1024, tile_start, 8, GRID, F.wg, (const int*)(F.ws + SM_ROWTOK)};
            pg8::EpiGU8 E{F.ws + OFF_H};
            pg8::gemm_phase<pg8::EpiGU8, pg8::MoeSched, true, true>(F.lds, F.wave, g, S, E);
        } else {
        pg8::GemmK g{1024, 1024, 1024, 128, 1 << 30, 0};
        pg8::MoeSched S{(const char*)(F.ws + OFF_XB), (const char*)(F.ws + OFF_WMOE), (size_t)0, (size_t)256 * 1024 * 2, tile_start, 8, GRID, F.wg, (const int*)(F.ws + SM_ROWTOK)};
        pg8::EpiGU E{(bf16_t*)(F.ws + OFF_H)};
        pg8::gemm_phase<pg8::EpiGU, pg8::MoeSched, true>(F.lds, F.wave, g, S, E);
        }
    }
    SEAM(12);
    if (IN(13)) {
        { const int kt_ = F.wave * 64 + lane_id(); if (kt_ < 17) tile_start[kt_] = ((const int*)(F.ws + CTL_TILES))[kt_]; }
        __syncthreads();
        bf16_t* Y = (bf16_t*)(F.ws + OFF_XS);
        if (MOE8_L0) {
            pg8::GemmK g{512, 512, 512, 128, 1 << 30, 0};
            pg8::MoeSched S{(const char*)(F.ws + OFF_H), (const char*)(F.ws + OFF_WMOE + (size_t)16 * 2048 * 1024), (size_t)256 * 1024, (size_t)256 * 1024, tile_start, 4, GRID, F.wg};
            auto f = [Y](const pg8::Unit&, int row, int col, const float (&v)[8]) { float o[8];
#pragma unroll
                for (int i = 0; i < 8; ++i) o[i] = v[i] * (1.0f / (F8_SH * F8_SD));
                store8(Y + (size_t)row * 1024 + col, o); };
            pg8::EpiRow8<decltype(f)> E{f};
            pg8::gemm_phase<decltype(E), pg8::MoeSched, false, true>(F.lds, F.wave, g, S, E);
        } else {
        pg8::GemmK g{1024, 1024, 1024, 128, 1 << 30, 0};
        pg8::MoeSched S{(const char*)(F.ws + OFF_H), (const char*)(F.ws + OFF_WMOE + (size_t)16 * 2048 * 1024 * 2), (size_t)256 * 1024 * 2, (size_t)256 * 1024 * 2, tile_start, 4, GRID, F.wg};
        auto f = [Y](const pg8::Unit&, int row, int col, const float (&v)[8]) { store8(Y + (size_t)row * 1024 + col, v); };
        pg8::EpiRow8<decltype(f)> E{f};
        pg8::gemm_phase(F.lds, F.wave, g, S, E);
        }
    }
    SEAM(13);
#if PROBE == 4
    {
        { const int kt_ = F.wave * 64 + lane_id(); if (kt_ < 17) tile_start[kt_] = ((const int*)(F.ws + CTL_TILES))[kt_]; }
        __syncthreads();
        pg8::GemmK g{1024, 1024, 1024, 128, 1 << 30, 0};
        pg8::MoeSched S{(const char*)(F.ws + OFF_XB), (const char*)(F.ws + OFF_WMOE), (size_t)0, (size_t)256 * 1024 * 2, tile_start, 8, GRID, F.wg, (const int*)(F.ws + SM_ROWTOK)};
        pg8::EpiGU E{(bf16_t*)(F.ws + OFF_H)};
        pg8::gemm_phase<pg8::EpiGU, pg8::MoeSched, true>(F.lds, F.wave, g, S, E);
        xcd_barrier(bar);
    }
#endif
    if (IN(14)) { ln2_phase(F, nullptr, ln + 2 * 1024, ln + 3 * 1024, (bf16_t*)(F.ws + OFF_XB), true, RTI8 ? F.ws + OFF_XB8B : nullptr); }
    SEAM(14);
#pragma unroll 1
    for (int k_ = 0; k_ < (PROBE == 12 ? 10 : 5); ++k_) { const int k = k_ % 5;
        if (IN(20)) {
#define PGB(j) ((bf16_t*)(F.ws + OFF_PG + (size_t)((j) & 1) * PG_BYTES))
#define KVB(j) ((bf16_t*)(F.ws + OFF_KV + (size_t)((j) & 1) * KV_BYTES))
            if (k >= 1) ret_r2_phase(F, KVB(k - 1));
            if (k <= 3) {
                pg8::GemmK g{RTI8 ? 512 : 1024, RTI8 ? 512 : 1024, RTI8 ? 512 : 1024, 128, 1 << 30, 0};
                pg8::DenseSched S; if (RTI8) S.init(F.ws + OFF_XB8B + (size_t)k * 16384 * 1024, 512, F.ws + W_RTIN, 512, 16384, 6144, GRID, F.wg); else S.init(F.ws + OFF_XB + (size_t)k * 16384 * 1024 * 2, 1024, F.ws + W_RTIN, 1024, 16384, 6144, GRID, F.wg);
                bf16_t* P = PGB(k);
                auto f = [P](const pg8::Unit&, int row, int col, const float (&v_)[8]) {
                    float v[8];
#pragma unroll
                    for (int i = 0; i < 8; ++i) v[i] = RTI8 ? v_[i] * (1.0f / (F8_SX * F8_SW)) : v_[i];
                    if (col < 2048) {
                        float o[8]; const float posf = (float)(row & 8191); const int m0 = (col & 127) >> 1;
#pragma unroll
                        for (int i = 0; i < 4; ++i) { const float rev = __builtin_amdgcn_fractf(posf * (__builtin_amdgcn_exp2f((float)(m0 + i) * (-13.287712379549449f / 63.0f)) * 0.15915494309189535f));
                            const float co = __builtin_amdgcn_cosf(rev), si = __builtin_amdgcn_sinf(rev); o[2 * i] = v[2 * i] * co - v[2 * i + 1] * si; o[2 * i + 1] = v[2 * i + 1] * co + v[2 * i] * si; }
                        store8(P + (size_t)row * PGLD + col, o);
                    } else if (PGV8) { u32x2 w8; w8[0] = pk_fp8x4(v[0] * F8_SX, v[1] * F8_SX, v[2] * F8_SX, v[3] * F8_SX); w8[1] = pk_fp8x4(v[4] * F8_SX, v[5] * F8_SX, v[6] * F8_SX, v[7] * F8_SX);
                        *(u32x2*)((unsigned char*)P + (size_t)row * 8192 + 4096 + (col - 2048)) = w8; }
                    else store8(P + (size_t)row * 6144 + col, v); };
                pg8::EpiRow8<decltype(f)> E{f};
                pg8::gemm_phase<decltype(E), pg8::DenseSched, false, RTI8>(F.lds, F.wave, g, S, E);
            }
            xcd_barrier(bar);
            if (k >= 1) ret_r3_phase(F, PGB(k - 1), KVB(k - 1), (bf16_t*)(F.ws + OFF_O1), k - 1, F.in[21]);
            if (k <= 3) { for (int u = F.wg; u < 1024; u += GRID) ret_r1_unit(F, PGB(k), KVB(k), u); }
            xcd_barrier(bar);
#undef PGB
#undef KVB
        }
    }
    if (IN(20)) {
        bf16_t* MX = (bf16_t*)(F.ws + OFF_MIX1);
        if (RTO8) {
            pg8::GemmK g{1024, 1024, 1024, 128, 1 << 30, 0};
            pg8::DenseSched S; S.init(F.ws + OFF_O1, 1024, F.ws + W_RTOUT, 1024, T, 1024, GRID, F.wg);
            auto f = [MX](const pg8::Unit&, int row, int col, const float (&v)[8]) { float o[8];
#pragma unroll
                for (int i = 0; i < 8; ++i) o[i] = v[i] * (1.0f / (F8_SO * F8_SWO));
                store8(MX + (size_t)row * 1024 + col, o); };
            pg8::EpiRow8<decltype(f)> E{f};
            pg8::gemm_phase<decltype(E), pg8::DenseSched, false, true>(F.lds, F.wave, g, S, E);
        } else {
        pg8::GemmK g{2048, 2048, 2048, 128, 1 << 30, 0};
        pg8::DenseSched S; S.init(F.ws + OFF_O1, 2048, F.ws + W_RTOUT, 2048, T, 1024, GRID, F.wg);
        auto f = [MX](const pg8::Unit&, int row, int col, const float (&v)[8]) { store8(MX + (size_t)row * 1024 + col, v); };
        pg8::EpiRow8<decltype(f)> E{f};
        pg8::gemm_phase(F.lds, F.wave, g, S, E);
        }
        xcd_barrier(bar);
    }
    if (IN(30)) { ln1_router_phase(F, nullptr, (const bf16_t*)(F.ws + OFF_MIX1), (bf16_t*)(F.ws + OFF_XB), ln + 4 * 1024, ln + 5 * 1024, 1, MOE8_L1 ? F.ws + OFF_XB8 : nullptr); moe_weights(F, 1, MOE8_L1); }
    SEAM(30);
    if (IN(31)) moe_scatter_phase(F, nullptr, 1);
    SEAM(31);
    if (IN(32)) {
        { const int kt_ = F.wave * 64 + lane_id(); if (kt_ < 17) tile_start[kt_] = ((const int*)(F.ws + CTL_TILES))[32 + kt_]; }
        __syncthreads();
        if (MOE8_L1) {
            pg8::GemmK g{512, 512, 512, 128, 1 << 30, 0};
            pg8::MoeSched S{(const char*)(F.ws + OFF_XB8), (const char*)(F.ws + OFF_WMOE), (size_t)0, (size_t)256 * 1024, tile_start, 8, GRID, F.wg, (const int*)(F.ws + SM_ROWTOK)};
            pg8::EpiGU8 E{F.ws + OFF_H};
            pg8::gemm_phase<pg8::EpiGU8, pg8::MoeSched, true, true>(F.lds, F.wave, g, S, E);
        } else {
        pg8::GemmK g{1024, 1024, 1024, 128, 1 << 30, 0};
        pg8::MoeSched S{(const char*)(F.ws + OFF_XB), (const char*)(F.ws + OFF_WMOE), (size_t)0, (size_t)256 * 1024 * 2, tile_start, 8, GRID, F.wg, (const int*)(F.ws + SM_ROWTOK)};
        pg8::EpiGU E{(bf16_t*)(F.ws + OFF_H)};
        pg8::gemm_phase<pg8::EpiGU, pg8::MoeSched, true>(F.lds, F.wave, g, S, E);
        }
    }
    SEAM(32);
    if (IN(33)) {
        { const int kt_ = F.wave * 64 + lane_id(); if (kt_ < 17) tile_start[kt_] = ((const int*)(F.ws + CTL_TILES))[32 + kt_]; }
        __syncthreads();
        bf16_t* Y = (bf16_t*)(F.ws + OFF_XS);
        if (MOE8_L1) {
            pg8::GemmK g{512, 512, 512, 128, 1 << 30, 0};
            pg8::MoeSched S{(const char*)(F.ws + OFF_H), (const char*)(F.ws + OFF_WMOE + (size_t)16 * 2048 * 1024), (size_t)256 * 1024, (size_t)256 * 1024, tile_start, 4, GRID, F.wg};
            auto f = [Y](const pg8::Unit&, int row, int col, const float (&v)[8]) { float o[8];
#pragma unroll
                for (int i = 0; i < 8; ++i) o[i] = v[i] * (1.0f / (F8_SH * F8_SD));
                store8(Y + (size_t)row * 1024 + col, o); };
            pg8::EpiRow8<decltype(f)> E{f};
            pg8::gemm_phase<decltype(E), pg8::MoeSched, false, true>(F.lds, F.wave, g, S, E);
        } else {
        pg8::GemmK g{1024, 1024, 1024, 128, 1 << 30, 0};
        pg8::MoeSched S{(const char*)(F.ws + OFF_H), (const char*)(F.ws + OFF_WMOE + (size_t)16 * 2048 * 1024 * 2), (size_t)256 * 1024 * 2, (size_t)256 * 1024 * 2, tile_start, 4, GRID, F.wg};
        auto f = [Y](const pg8::Unit&, int row, int col, const float (&v)[8]) { store8(Y + (size_t)row * 1024 + col, v); };
        pg8::EpiRow8<decltype(f)> E{f};
        pg8::gemm_phase(F.lds, F.wave, g, S, E);
        }
    }
    SEAM(33);
    if (IN(34)) ln2_phase(F, F.out, ln + 6 * 1024, ln + 7 * 1024, (bf16_t*)(F.ws + OFF_XB), true);
#undef IN
#undef SEAM
}

extern "C" void kernel_launch(void* const* d_in, const int* in_sizes, int n_in, void* d_out, int out_size, void* d_ws, size_t ws_size, hipStream_t stream) {
    static int ready = 0;
    if (ready == 0) {
        if (n_in != 28 || out_size != T * D || ws_size < WS_END) { fprintf(stderr, "kernel_launch: unexpected shapes / workspace (%d inputs, out %d, ws %zu)\n", n_in, out_size, ws_size); ready = -1; return; }
        if (hipFuncSetAttribute((const void*)fwd_kernel, hipFuncAttributeMaxDynamicSharedMemorySize, LDS_BYTES) != hipSuccess) { fprintf(stderr, "kernel_launch: hipFuncSetAttribute failed\n"); ready = -1; return; }
        int per_cu = 0;
        if (hipOccupancyMaxActiveBlocksPerMultiprocessor(&per_cu, (const void*)fwd_kernel, NTH, LDS_BYTES) != hipSuccess || per_cu < 1) { fprintf(stderr, "kernel_launch: occupancy query says %d\n", per_cu); }
        (void)hipGetLastError();
        ready = 1;
    }
    if (ready < 0) return;
    (void)hipMemsetAsync((char*)d_ws + OFF_CTL, 0, CTL_BYTES, stream);
    Args a{};
    for (int i = 0; i < 28; ++i) a.in[i] = (const float*)d_in[i];
    a.out = (float*)d_out; a.ws = (unsigned char*)d_ws; a.ph_lo = 0; a.ph_hi = 1000;
    hipLaunchKernelGGL(fwd_kernel, dim3(GRID), dim3(NTH), LDS_BYTES, stream, a);
}
```
